# Optimizing an MI355X kernel written in HIP

```python
import math
import jax, jax.numpy as jnp
from jax import lax
import numpy as np

D_MODEL = 1024
BATCH = 32
SEQ = 2048
DEPTH = 4

N_MIXERS = 2
N_MLA_LAYERS = (DEPTH + 1) // 2
N_SWA_LAYERS = DEPTH // 2
N_DENSE_LAYERS = (DEPTH + 1) // 2
N_MOE_LAYERS = DEPTH // 2

MLA_HEADS = 8
MLA_Q_RANK = 256
MLA_KV_RANK = 256
MLA_NOPE_DIM = 128
MLA_ROPE_DIM = 64
MLA_V_DIM = 128
MLA_QK_DIM = MLA_NOPE_DIM + MLA_ROPE_DIM
MLA_DOWN_DIM = MLA_Q_RANK + MLA_KV_RANK + MLA_ROPE_DIM
ROPE_THETA = 10000.0

SWA_Q_HEADS = 16
SWA_KV_HEADS = 4
SWA_GROUP = SWA_Q_HEADS // SWA_KV_HEADS
SWA_HEAD_DIM = 64
SWA_WINDOW = 128
SWA_Q_DIM = SWA_Q_HEADS * SWA_HEAD_DIM
SWA_KV_DIM = SWA_KV_HEADS * SWA_HEAD_DIM
SWA_QKV_DIM = SWA_Q_DIM + 2 * SWA_KV_DIM

BLOCK = 128

FFN_DIM = 2816
N_EXPERTS = 8
TOP_K = 2
EXPERT_DIM = 2048

EPS = 1e-6
NEG_INF = -1e30

kernel_name = "hybrid_mla_swa_moe_encoder"


def rmsnorm(x, g):
    xf = x.astype(jnp.float32)
    y = xf * lax.rsqrt(jnp.mean(xf * xf, axis=-1, keepdims=True) + EPS)
    return (y * g.astype(jnp.float32)).astype(x.dtype)


def rope_tables(seq, dim):
    inv = 1.0 / (ROPE_THETA ** (jnp.arange(0, dim, 2, dtype=jnp.float32) / dim))
    ang = jnp.arange(seq, dtype=jnp.float32)[:, None] * inv[None, :]
    return jnp.cos(ang), jnp.sin(ang)


def apply_rope(x, cos, sin):
    xf = x.astype(jnp.float32)
    x1, x2 = jnp.split(xf, 2, axis=-1)
    return jnp.concatenate([x1 * cos - x2 * sin, x2 * cos + x1 * sin], axis=-1).astype(x.dtype)


def alibi_slopes(n):
    return 2.0 ** (-8.0 * jnp.arange(1, n + 1, dtype=jnp.float32) / n)


def mla(h, w_dqkv, q_norm, w_uq, kv_norm, w_uk, w_uv, w_o):
    B, S, _ = h.shape
    nb = S // BLOCK
    cos, sin = rope_tables(S, MLA_ROPE_DIM)
    down = h @ w_dqkv
    c_q = rmsnorm(down[..., :MLA_Q_RANK], q_norm)
    c_kv = rmsnorm(down[..., MLA_Q_RANK:MLA_Q_RANK + MLA_KV_RANK], kv_norm)
    k_rope = apply_rope(down[..., MLA_Q_RANK + MLA_KV_RANK:], cos, sin)
    q = jnp.einsum('bsr,rhd->bshd', c_q, w_uq)
    q_nope = q[..., :MLA_NOPE_DIM]
    q_rope = apply_rope(q[..., MLA_NOPE_DIM:], cos[:, None, :], sin[:, None, :])
    k_nope = jnp.einsum('bsr,rhd->bshd', c_kv, w_uk)
    v = jnp.einsum('bsr,rhd->bshd', c_kv, w_uv)
    scale = MLA_QK_DIM ** -0.5
    qn_b = jnp.moveaxis(q_nope.reshape(B, nb, BLOCK, MLA_HEADS, MLA_NOPE_DIM), 1, 0)
    qr_b = jnp.moveaxis(q_rope.reshape(B, nb, BLOCK, MLA_HEADS, MLA_ROPE_DIM), 1, 0)

    def attend(blk):
        qn, qr = blk
        s = (jnp.einsum('bqhd,bkhd->bhqk', qn, k_nope)
             + jnp.einsum('bqhd,bkd->bhqk', qr, k_rope))
        p = jax.nn.softmax(s.astype(jnp.float32) * scale, axis=-1).astype(v.dtype)
        return jnp.einsum('bhqk,bkhd->bqhd', p, v)

    o = lax.map(attend, (qn_b, qr_b))
    o = jnp.moveaxis(o, 0, 1).reshape(B, S, MLA_HEADS * MLA_V_DIM)
    return o @ w_o


def swa(h, w_qkv, sink, w_o):
    B, S, _ = h.shape
    nb = S // BLOCK
    span = BLOCK + 2 * SWA_WINDOW
    qkv = h @ w_qkv
    q = qkv[..., :SWA_Q_DIM].reshape(B, S, SWA_KV_HEADS, SWA_GROUP, SWA_HEAD_DIM)
    k = qkv[..., SWA_Q_DIM:SWA_Q_DIM + SWA_KV_DIM].reshape(B, S, SWA_KV_HEADS, SWA_HEAD_DIM)
    v = qkv[..., SWA_Q_DIM + SWA_KV_DIM:].reshape(B, S, SWA_KV_HEADS, SWA_HEAD_DIM)
    padw = ((0, 0), (SWA_WINDOW, SWA_WINDOW), (0, 0), (0, 0))
    kp = jnp.pad(k, padw)
    vp = jnp.pad(v, padw)
    slopes = alibi_slopes(SWA_Q_HEADS).reshape(SWA_KV_HEADS, SWA_GROUP)
    sink_l = sink.astype(jnp.float32).reshape(SWA_KV_HEADS, SWA_GROUP)
    scale = SWA_HEAD_DIM ** -0.5

    def block(i):
        start = i * BLOCK
        qb = lax.dynamic_slice_in_dim(q, start, BLOCK, axis=1)
        kb = lax.dynamic_slice_in_dim(kp, start, span, axis=1)
        vb = lax.dynamic_slice_in_dim(vp, start, span, axis=1)
        qpos = start + jnp.arange(BLOCK)
        kpos = start - SWA_WINDOW + jnp.arange(span)
        dist = jnp.abs(qpos[:, None] - kpos[None, :])
        valid = (dist <= SWA_WINDOW) & (kpos >= 0)[None, :] & (kpos < S)[None, :]
        s = jnp.einsum('bqgrd,bkgd->bgrqk', qb, kb).astype(jnp.float32) * scale
        s = s - slopes[:, :, None, None] * dist.astype(jnp.float32)
        s = jnp.where(valid, s, NEG_INF)
        snk = jnp.broadcast_to(sink_l[None, :, :, None, None], s.shape[:-1] + (1,))
        p = jax.nn.softmax(jnp.concatenate([s, snk], axis=-1), axis=-1)[..., :span]
        return jnp.einsum('bgrqk,bkgd->bqgrd', p.astype(vb.dtype), vb)

    o = lax.map(block, jnp.arange(nb))
    o = jnp.moveaxis(o, 0, 1).reshape(B, S, SWA_Q_DIM)
    return o @ w_o


def swiglu(h, w_gate, w_up, w_down):
    return (jax.nn.silu(h @ w_gate) * (h @ w_up)) @ w_down


def moe(h, router, w_gate, w_up, w_down):
    B, S, D = h.shape
    t = h.reshape(-1, D)
    logits = (t @ router).astype(jnp.float32)
    top_val, top_idx = lax.top_k(logits, TOP_K)
    gates = jax.nn.softmax(top_val, axis=-1)
    combine = jnp.sum(jax.nn.one_hot(top_idx, N_EXPERTS, dtype=jnp.float32) * gates[..., None], axis=1)
    combine = combine.astype(t.dtype)
    y = jnp.zeros_like(t)
    for e in range(N_EXPERTS):
        y = y + combine[:, e:e + 1] * swiglu(t, w_gate[e], w_up[e], w_down[e])
    return y.reshape(B, S, D)


def setup_inputs(seed: int = 0) -> dict:
    key = jax.random.key(seed)
    ks = iter(jax.random.split(key, 32))

    def nrm(shape, fan_in):
        return jax.random.normal(next(ks), shape, jnp.float32) * (fan_in ** -0.5)

    def gain(shape):
        return 1.0 + 0.02 * jax.random.normal(next(ks), shape, jnp.float32)

    NA, NS, ND, NM = N_MLA_LAYERS, N_SWA_LAYERS, N_DENSE_LAYERS, N_MOE_LAYERS
    D = D_MODEL
    return {
        "x": jax.random.normal(next(ks), (BATCH, SEQ, D), jnp.float32),
        "mla_norm": gain((NA, D)),
        "mla_w_dqkv": nrm((NA, D, MLA_DOWN_DIM), D),
        "mla_q_norm": gain((NA, MLA_Q_RANK)),
        "mla_w_uq": nrm((NA, MLA_Q_RANK, MLA_HEADS, MLA_QK_DIM), MLA_Q_RANK),
        "mla_kv_norm": gain((NA, MLA_KV_RANK)),
        "mla_w_uk": nrm((NA, MLA_KV_RANK, MLA_HEADS, MLA_NOPE_DIM), MLA_KV_RANK),
        "mla_w_uv": nrm((NA, MLA_KV_RANK, MLA_HEADS, MLA_V_DIM), MLA_KV_RANK),
        "mla_w_o": nrm((NA, MLA_HEADS * MLA_V_DIM, D), MLA_HEADS * MLA_V_DIM),
        "swa_norm": gain((NS, D)),
        "swa_w_qkv": nrm((NS, D, SWA_QKV_DIM), D),
        "swa_sink": 0.5 * jax.random.normal(next(ks), (NS, SWA_Q_HEADS), jnp.float32),
        "swa_w_o": nrm((NS, SWA_Q_DIM, D), SWA_Q_DIM),
        "ffn_norm": gain((ND, D)),
        "ffn_w_gate": nrm((ND, D, FFN_DIM), D),
        "ffn_w_up": nrm((ND, D, FFN_DIM), D),
        "ffn_w_down": nrm((ND, FFN_DIM, D), FFN_DIM),
        "moe_norm": gain((NM, D)),
        "moe_router": nrm((NM, D, N_EXPERTS), D),
        "moe_w_gate": nrm((NM, N_EXPERTS, D, EXPERT_DIM), D),
        "moe_w_up": nrm((NM, N_EXPERTS, D, EXPERT_DIM), D),
        "moe_w_down": nrm((NM, N_EXPERTS, EXPERT_DIM, D), EXPERT_DIM),
        "final_norm": gain((D,)),
    }


def reference(x, mla_norm, mla_w_dqkv, mla_q_norm, mla_w_uq, mla_kv_norm, mla_w_uk, mla_w_uv, mla_w_o,
              swa_norm, swa_w_qkv, swa_sink, swa_w_o,
              ffn_norm, ffn_w_gate, ffn_w_up, ffn_w_down,
              moe_norm, moe_router, moe_w_gate, moe_w_up, moe_w_down,
              final_norm):
    h = x
    for i in range(DEPTH):
        j = i // N_MIXERS
        if i % N_MIXERS == 0:
            h = h + mla(rmsnorm(h, mla_norm[j]), mla_w_dqkv[j], mla_q_norm[j], mla_w_uq[j],
                        mla_kv_norm[j], mla_w_uk[j], mla_w_uv[j], mla_w_o[j])
        else:
            h = h + swa(rmsnorm(h, swa_norm[j]), swa_w_qkv[j], swa_sink[j], swa_w_o[j])
        c = i // 2
        if i % 2 == 0:
            h = h + swiglu(rmsnorm(h, ffn_norm[c]), ffn_w_gate[c], ffn_w_up[c], ffn_w_down[c])
        else:
            h = h + moe(rmsnorm(h, moe_norm[c]), moe_router[c], moe_w_gate[c], moe_w_up[c], moe_w_down[c])
    return rmsnorm(h, final_norm)
```

```cpp
#include <hip/hip_runtime.h>
#include <hip/hip_bf16.h>
#include <cstdio>
#include <cstdint>

#define LAS __attribute__((address_space(3)))
#define GAS __attribute__((address_space(1)))
typedef unsigned short bf16_t;
typedef short bf16x8 __attribute__((ext_vector_type(8)));
typedef short s16x4 __attribute__((ext_vector_type(4)));
typedef float f32x4 __attribute__((ext_vector_type(4)));
typedef float f32x2 __attribute__((ext_vector_type(2)));
typedef float f32x16 __attribute__((ext_vector_type(16)));
typedef unsigned u32x4 __attribute__((ext_vector_type(4)));
typedef unsigned u32x2 __attribute__((ext_vector_type(2)));
typedef int i32x4 __attribute__((ext_vector_type(4)));

constexpr int DM = 1024, BATCH = 32, SEQ = 2048, NTOK = BATCH * SEQ;
constexpr int MLA_H = 8, QKD = 192, DOWNP = 768;
constexpr int NQ = MLA_H * QKD  , NKV = 2048;
constexpr int SWA_NQKV = 1536;
constexpr int FFN = 2816, NE = 8, ED = 2048;
constexpr int NPAIR = NTOK * 2;
constexpr float EPS = 1e-6f;
constexpr float LOG2E = 1.4426950408889634f;
#ifndef PHMASK
#define PHMASK 0xFFFFFFFFu
#endif
#define PH(k) (((PHMASK) >> (k)) & 1u)

constexpr size_t MiB = 1u << 20;
constexpr size_t WS_CTL = 0, CTL_ZERO_BYTES = 1 * MiB;
constexpr size_t WS_ROPE = 1 * MiB;
constexpr size_t WS_ROUTE = 2 * MiB;
constexpr size_t WS_GATE = 3 * MiB;
constexpr size_t WS_POS = 4 * MiB;
constexpr size_t WS_CNT = 5 * MiB;
constexpr size_t WS_W = 6 * MiB;
constexpr size_t W_DQKV = 0;
constexpr size_t W_UQ = W_DQKV + (size_t)DOWNP * DM * 2;
constexpr size_t W_UKV = W_UQ + (size_t)NQ * 256 * 2;
constexpr size_t W_MO = W_UKV + (size_t)NKV * 256 * 2;
constexpr size_t W_SQKV = W_MO + (size_t)DM * DM * 2;
constexpr size_t W_SO = W_SQKV + (size_t)SWA_NQKV * DM * 2;
constexpr size_t W_FGU = W_SO + (size_t)DM * DM * 2;
constexpr size_t W_FD = W_FGU + (size_t)2 * FFN * DM * 2;
constexpr size_t W_MGU = W_FD + (size_t)DM * FFN * 2;
constexpr size_t W_MD = W_MGU + (size_t)NE * 2 * ED * DM * 2;
constexpr size_t W_PAIR = W_MD + (size_t)NE * DM * ED * 2;
constexpr size_t WS_ACT = 254 * MiB;
static_assert(WS_W + 2 * W_PAIR <= WS_ACT, "weights fit");
constexpr size_t A_XN = 0;
constexpr size_t A_DOWN = 128 * MiB;
constexpr size_t A_Q = 224 * MiB;
constexpr size_t A_KV = 416 * MiB;
constexpr size_t A_FACT = 128 * MiB;
constexpr size_t A_SQKV = 128 * MiB;
constexpr size_t A_XS = 0;
constexpr size_t A_MACT = 256 * MiB;
constexpr size_t A_XN2 = 256 * MiB;
constexpr size_t WS_NEED = WS_ACT + 770 * MiB;
static_assert(WS_NEED <= 1024 * MiB, "ws");

constexpr int RING_BYTES = 131072;
constexpr int LDSCTL_OFF = RING_BYTES;
constexpr int MISC_OFF = LDSCTL_OFF + 320;
constexpr int MOETAB_OFF = LDSCTL_OFF + 1024;
constexpr int LDS_BYTES = 147456;

#define RLX_AGENT __ATOMIC_RELAXED, __HIP_MEMORY_SCOPE_AGENT
#define LDS_WAIT() asm volatile("s_waitcnt lgkmcnt(0)" ::: "memory")
#define VM_WAIT() asm volatile("s_waitcnt vmcnt(0)" ::: "memory")
#define SBAR() __builtin_amdgcn_sched_barrier(0)
__device__ __forceinline__ unsigned f2bf(float f) { unsigned u = __builtin_bit_cast(unsigned, f); return (u + 0x7fffu + ((u >> 16) & 1u)) >> 16; }
__device__ __forceinline__ unsigned pk2(float lo, float hi) { return f2bf(lo) | (f2bf(hi) << 16); }
__device__ __forceinline__ unsigned cvt_pk_bf16(float lo, float hi) { unsigned r; asm volatile("v_cvt_pk_bf16_f32 %0, %1, %2" : "=v"(r) : "v"(lo), "v"(hi)); return r; }
__device__ __forceinline__ float bf_lo(unsigned w) { return __builtin_bit_cast(float, w << 16); }
__device__ __forceinline__ float bf_hi(unsigned w) { return __builtin_bit_cast(float, w & 0xffff0000u); }
__device__ __forceinline__ int opaque_tid(int wv) { int l; asm volatile("v_mbcnt_lo_u32_b32 %0, -1, 0\n\tv_mbcnt_hi_u32_b32 %0, -1, %0" : "=v"(l)); return wv * 64 + l; }
__device__ __forceinline__ int opaque_lane() { int l; asm volatile("v_mbcnt_lo_u32_b32 %0, -1, 0\n\tv_mbcnt_hi_u32_b32 %0, -1, %0" : "=v"(l)); return l; }
__device__ __forceinline__ float shx(float v, int o, int lane) { return __builtin_bit_cast(float, __builtin_amdgcn_ds_bpermute((lane ^ o) << 2, __builtin_bit_cast(int, v))); }
__device__ __forceinline__ int shxi(int v, int o, int lane) { return __builtin_amdgcn_ds_bpermute((lane ^ o) << 2, v); }
__device__ __forceinline__ float wave_sum(float v, int lane) {
#pragma unroll
    for (int o = 1; o < 64; o <<= 1) v += shx(v, o, lane);
    return v;
}

#define XB_TMO      128
#define XB_XCNT(j)  (256  + 64 * (j))
#define XB_XSUB(j)  (1280 + 64 * (j))
#define XB_XGEN(j)  (2304 + 64 * (j))
#define XB_TOP      3328
#define XB_TOPGEN   3392
#define XCD_BAR_WORDS 3456
#define XB_SPIN_CAP (1u << 18)
__device__ __forceinline__ unsigned xb_ld(unsigned* p)              { return __hip_atomic_load(p, __ATOMIC_RELAXED, __HIP_MEMORY_SCOPE_AGENT); }
__device__ __forceinline__ unsigned xb_add(unsigned* p, unsigned v) { return __hip_atomic_fetch_add(p, v, __ATOMIC_RELAXED, __HIP_MEMORY_SCOPE_AGENT); }
__device__ __forceinline__ unsigned xb_xcc_id() { return (unsigned)__builtin_amdgcn_s_getreg((3 << 11) | 20) & 0xFu; }
#define XB_SPIN(cond, bar) do { unsigned _sp = 0; while (cond) { __builtin_amdgcn_s_sleep(1); \
    if ((++_sp & 255u) == 0u) { if (xb_ld(&(bar)[XB_TMO])) break; if (_sp > XB_SPIN_CAP) { atomicAdd(&(bar)[XB_TMO], 1u); break; } } } } while (0)
struct XcdBarrier { unsigned* bar; unsigned x; volatile LAS unsigned* st; int wv; };
__device__ __forceinline__ XcdBarrier xcd_barrier_post(unsigned* bar, volatile LAS unsigned* st, int wv) {
    XcdBarrier b; b.bar = bar; b.x = xb_xcc_id(); b.st = st; b.wv = wv;
    if (opaque_tid(wv) == 0) (void)xb_add(&bar[XB_XCNT(b.x)], 1u);
    return b;
}
__device__ __forceinline__ void xcd_barrier_complete(unsigned* bar, unsigned x, unsigned& nloc, unsigned& nx) {
    const unsigned G = gridDim.x * gridDim.y * gridDim.z;
    unsigned sum, cnt, mine, sp = 0u;
    for (;;) {
        sum = 0u; cnt = 0u; mine = 0u;
#pragma unroll
        for (unsigned j = 0; j < 16; ++j) { const unsigned c = xb_ld(&bar[XB_XCNT(j)]); sum += c; cnt += (c > 0u) ? 1u : 0u; mine = (j == x) ? c : mine; }
        if (sum == G) break;
        __builtin_amdgcn_s_sleep(1);
        if ((++sp & 255u) == 0u) { if (xb_ld(&bar[XB_TMO])) break; if (sp > XB_SPIN_CAP) { atomicAdd(&bar[XB_TMO], 1u); break; } }
    }
    nloc = mine > 0u ? mine : 1u; nx = cnt > 0u ? cnt : 1u;
}
__device__ __forceinline__ void xcd_barrier(const XcdBarrier& b) {
    asm volatile("s_waitcnt vmcnt(0)" ::: "memory");
    __syncthreads();
    if (opaque_tid(b.wv) == 0) {
        unsigned* bar = b.bar;
        __builtin_amdgcn_s_waitcnt(0);
        unsigned nloc = b.st[0], nx = b.st[1];
        if (nloc == 0u) { xcd_barrier_complete(bar, b.x, nloc, nx); b.st[0] = nloc; b.st[1] = nx; }
        const unsigned old = xb_add(&bar[XB_XSUB(b.x)], 1u);
        const unsigned gen = old / nloc;
        if (old + 1u == (gen + 1u) * nloc) {
            __builtin_amdgcn_fence(__ATOMIC_RELEASE, "agent");
            asm volatile("s_waitcnt vmcnt(0)" ::: "memory");
            const unsigned og = xb_add(&bar[XB_TOP], 1u);
            const unsigned tg = og / nx;
            if (og + 1u == (tg + 1u) * nx) xb_add(&bar[XB_TOPGEN], 1u);
            else XB_SPIN(xb_ld(&bar[XB_TOPGEN]) == tg, bar);
            __builtin_amdgcn_fence(__ATOMIC_ACQUIRE, "agent");
            xb_add(&bar[XB_XGEN(b.x)], 1u);
            asm volatile("s_waitcnt vmcnt(0)" ::: "memory");
        } else {
            XB_SPIN(xb_ld(&bar[XB_XGEN(b.x)]) == gen, bar);
            __builtin_amdgcn_fence(__ATOMIC_ACQUIRE, "agent");
            asm volatile("s_waitcnt vmcnt(0)" ::: "memory");
        }
    }
    __syncthreads();
}

namespace pg8 {
constexpr int BM = 256, BK = 64, HALF = 128, HTB = HALF * BK * 2, STAGE_BYTES = 8 * HTB, NXCD = 8, WGM = 8;
__host__ __device__ __forceinline__ int lds_byte(int r, int c) { const int st = (r >> 4) * 2 + (c >> 5), rr = r & 15, cc = c & 31, ob = rr * 64 + cc * 2; return st * 1024 + (ob ^ (((ob >> 9) & 1) << 5)); }
__host__ __device__ __forceinline__ void stage_rc(int b, int& R, int& C) { const int st = b / 1024, sb = b % 1024, swz = sb ^ (((sb >> 9) & 1) << 5); R = (st >> 1) * 16 + swz / 64; C = (st & 1) * 32 + (swz % 64) / 2; }
__host__ __device__ __forceinline__ int perm32(int rho) { const int n = rho >> 4, i = rho & 15; return 8 * (i >> 2) + 4 * n + (i & 3); }

struct Unit { int arow, brow, col, nvalid; };
struct Gemm { const bf16_t* A; const bf16_t* Bt; int lda, ldb, K; };

struct DenseOrder {
    int nM, nN, nwg, G, c, colw;
    __device__ void init(int M, int N, int G_, int c_, int colw_) { nM = M / BM; nN = N / BM; nwg = nM * nN; G = G_; c = c_; colw = colw_; }
    __device__ __forceinline__ bool next(int i, Unit& u) const {
        const long L = (long)i * G + c; if (L >= nwg) return false;
        int wgid = (int)L; { const int q = nwg / NXCD, r = nwg % NXCD, xcd = wgid % NXCD, off = wgid / NXCD; wgid = (xcd < r ? xcd * (q + 1) : r * (q + 1) + (xcd - r) * q) + off; }
        const int nig = WGM * nN, gid = wgid / nig, fm = gid * WGM, gsz = (nM - fm) < WGM ? (nM - fm) : WGM;
        const int pm = fm + ((wgid % nig) % gsz), pn = (wgid % nig) / gsz;
        u.arow = pm * BM; u.brow = pn * BM; u.col = pn * colw; u.nvalid = BM; return true;
    }
};
struct GroupedOrder {
    int nM, nN, nwg, G, c, colw, erows; const LAS int* tab;
    __device__ void init(const LAS int* tab_, int N, int G_, int c_, int colw_) { tab = tab_; nM = tab_[8]; nN = N / BM; nwg = nM * nN; G = G_; c = c_; colw = colw_; erows = N; }
    __device__ __forceinline__ bool next(int i, Unit& u) const {
        const long L = (long)i * G + c; if (L >= nwg) return false;
        int wgid = (int)L; { const int q = nwg / NXCD, r = nwg % NXCD, xcd = wgid % NXCD, off = wgid / NXCD; wgid = (xcd < r ? xcd * (q + 1) : r * (q + 1) + (xcd - r) * q) + off; }
        const int nig = WGM * nN, gid = wgid / nig, fm = gid * WGM, gsz = (nM - fm) < WGM ? (nM - fm) : WGM;
        const int T = fm + ((wgid % nig) % gsz), pn = (wgid % nig) / gsz;
        int e = 0;
#pragma unroll
        for (int k = 1; k < 8; ++k) e += (T >= tab[k]) ? 1 : 0;
        const int lt = T - tab[e], arow = tab[16 + e] + lt * BM; int nv = tab[16 + e + 1] - arow; nv = nv > BM ? BM : nv;
        u.arow = __builtin_amdgcn_readfirstlane(arow); u.nvalid = __builtin_amdgcn_readfirstlane(nv);
        u.brow = __builtin_amdgcn_readfirstlane(e * erows + pn * BM); u.col = __builtin_amdgcn_readfirstlane(pn * colw); return true;
    }
};

template <bool MASK> struct EpiBf16 {
    static constexpr bool PERM = true;
    bf16_t* O; int ldc;
    __device__ __forceinline__ void operator()(const f32x4 (&acc)[2][2][4][2], const Unit& u, int wr, int wc, int fr, int fq) const {
        const int col0 = u.col + wc * 32 + 8 * fq;
#pragma unroll
        for (int ai = 0; ai < 2; ++ai)
#pragma unroll
            for (int m = 0; m < 4; ++m) { const int rl = ai * HALF + wr * 64 + m * 16 + fr; if (MASK && rl >= u.nvalid) continue;
                bf16_t* rowp = O + (size_t)(u.arow + rl) * ldc + col0;
#pragma unroll
                for (int bj = 0; bj < 2; ++bj) { const f32x4 v0 = acc[ai][bj][m][0], v1 = acc[ai][bj][m][1];
                    u32x4 w; w.x = cvt_pk_bf16(v0[0], v0[1]); w.y = cvt_pk_bf16(v0[2], v0[3]); w.z = cvt_pk_bf16(v1[0], v1[1]); w.w = cvt_pk_bf16(v1[2], v1[3]);
                    *(u32x4*)(rowp + bj * HALF) = w; } }
    }
};
template <bool MASK> struct EpiSwiGLU {
    static constexpr bool PERM = true;
    bf16_t* O; int ldc;
    __device__ __forceinline__ void operator()(const f32x4 (&acc)[2][2][4][2], const Unit& u, int wr, int wc, int fr, int fq) const {
        const int col0 = u.col + wc * 32 + 8 * fq;
#pragma unroll
        for (int ai = 0; ai < 2; ++ai)
#pragma unroll
            for (int m = 0; m < 4; ++m) { const int rl = ai * HALF + wr * 64 + m * 16 + fr; if (MASK && rl >= u.nvalid) continue;
                float o[8];
#pragma unroll
                for (int n = 0; n < 2; ++n)
#pragma unroll
                    for (int k = 0; k < 4; ++k) { const float g = acc[ai][0][m][n][k], up = acc[ai][1][m][n][k];
                        const float s = __builtin_amdgcn_rcpf(1.0f + __builtin_amdgcn_exp2f(-g * LOG2E)); o[n * 4 + k] = g * s * up; }
                u32x4 w; w.x = cvt_pk_bf16(o[0], o[1]); w.y = cvt_pk_bf16(o[2], o[3]); w.z = cvt_pk_bf16(o[4], o[5]); w.w = cvt_pk_bf16(o[6], o[7]);
                *(u32x4*)(O + (size_t)(u.arow + rl) * ldc + col0) = w; }
    }
};
struct EpiResid {
    static constexpr bool PERM = true;
    const float* base; float* out;
    __device__ __forceinline__ void operator()(const f32x4 (&acc)[2][2][4][2], const Unit& u, int wr, int wc, int fr, int fq) const {
        const int col0 = u.col + wc * 32 + 8 * fq;
#pragma unroll
        for (int ai = 0; ai < 2; ++ai)
#pragma unroll
            for (int m = 0; m < 4; ++m) { const size_t off = (size_t)(u.arow + ai * HALF + wr * 64 + m * 16 + fr) * DM + col0;
#pragma unroll
                for (int bj = 0; bj < 2; ++bj)
#pragma unroll
                    for (int n = 0; n < 2; ++n) { const f32x4 b = *(const f32x4*)(base + off + bj * HALF + n * 4); *(f32x4*)(out + off + bj * HALF + n * 4) = b + acc[ai][bj][m][n]; }
                if (m & 1) asm volatile("" ::: "memory"); }
    }
};
struct EpiQRope {
    static constexpr bool PERM = true;
    bf16_t* O; const f32x2* rope;
    __device__ __forceinline__ void operator()(const f32x4 (&acc)[2][2][4][2], const Unit& u, int wr, int wc, int fr, int fq) const {
        const int col0 = u.col + wc * 32 + 8 * fq;
#pragma unroll
        for (int bj = 0; bj < 2; ++bj) { const int c = col0 + bj * HALF, d = c % QKD; const bool isr = d >= 128; const int i0 = (d - 128) >> 1;
#pragma unroll
            for (int ai = 0; ai < 2; ++ai)
#pragma unroll
                for (int m = 0; m < 4; ++m) { const int row = u.arow + ai * HALF + wr * 64 + m * 16 + fr;
                    f32x4 v0 = acc[ai][bj][m][0], v1 = acc[ai][bj][m][1];
                    if (isr) { const f32x4* rp = (const f32x4*)(rope + (size_t)(row & (SEQ - 1)) * 32 + i0); const f32x4 cs0 = rp[0], cs1 = rp[1];
                        const float a0 = v0[0] * cs0[0] - v0[1] * cs0[1], b0 = v0[1] * cs0[0] + v0[0] * cs0[1];
                        const float a1 = v0[2] * cs0[2] - v0[3] * cs0[3], b1 = v0[3] * cs0[2] + v0[2] * cs0[3];
                        const float a2 = v1[0] * cs1[0] - v1[1] * cs1[1], b2 = v1[1] * cs1[0] + v1[0] * cs1[1];
                        const float a3 = v1[2] * cs1[2] - v1[3] * cs1[3], b3 = v1[3] * cs1[2] + v1[2] * cs1[3];
                        v0 = (f32x4){a0, b0, a1, b1}; v1 = (f32x4){a2, b2, a3, b3}; }
                    u32x4 w; w.x = cvt_pk_bf16(v0[0], v0[1]); w.y = cvt_pk_bf16(v0[2], v0[3]); w.z = cvt_pk_bf16(v1[0], v1[1]); w.w = cvt_pk_bf16(v1[2], v1[3]);
                    *(u32x4*)(O + (size_t)row * NQ + c) = w; } }
    }
};

template <class Epi, class Sched, bool ALIGN_EPI>
__device__ __forceinline__ void gemm_phase(LAS unsigned char* lds, const Gemm g, const Sched& S, const Epi& E, const int wv) {
    const int tid = opaque_tid(wv), wid = __builtin_amdgcn_readfirstlane(tid >> 6), lane = tid & 63, wr = wid >> 2, wc = wid & 3, fr = lane & 15, fq = lane >> 4;
    const int K = g.K, nt = K / BK;
    unsigned voffA[2], voffB[2];
#pragma unroll
    for (int i = 0; i < 2; ++i) { int R, C; stage_rc(tid * 16 + i * 8192, R, C); const int Rb = Epi::PERM ? ((R & ~31) + perm32(R & 31)) : R;
        voffA[i] = (unsigned)(R * g.lda + C) * 2u; voffB[i] = (unsigned)(Rb * g.ldb + C) * 2u; }
    const size_t kstep = (size_t)(BK * 2);
    const size_t hsA = (size_t)HALF * g.lda * 2, hsB = (size_t)HALF * g.ldb * 2;
    const unsigned ldsw = (unsigned)wid * 1024u;
    const int aoff = lds_byte(wr * 64 + fr, fq * 8), boff = lds_byte(wc * 32 + fr, fq * 8);
#define PG8_SA(b, h) (((b) * 2 + (h)) * HTB)
#define PG8_SB(b, h) ((4 + (b) * 2 + (h)) * HTB)
#define PG8_STAGE(bufoff, gbase, voff) do { _Pragma("unroll") for (int _i = 0; _i < 2; ++_i) \
        __builtin_amdgcn_global_load_lds((const unsigned*)((const char*)(gbase) + (voff)[_i]), (LAS unsigned*)(lds + (bufoff) + ldsw + _i * 8192), 16, 0, 0); } while (0)
#define PG8_LDA(dst, b, h) do { _Pragma("unroll") for (int m = 0; m < 4; ++m) _Pragma("unroll") for (int k = 0; k < 2; ++k) dst[m][k] = *(const LAS bf16x8*)(lds + PG8_SA(b, h) + aoff + m * 2048 + k * 1024); } while (0)
#define PG8_LDB(dst, b, h) do { _Pragma("unroll") for (int n = 0; n < 2; ++n) _Pragma("unroll") for (int k = 0; k < 2; ++k) dst[n][k] = *(const LAS bf16x8*)(lds + PG8_SB(b, h) + boff + n * 2048 + k * 1024); } while (0)
#define PG8_MMA(ai, bj, At, Bt) do { __builtin_amdgcn_s_setprio(1); _Pragma("unroll") for (int m = 0; m < 4; ++m) _Pragma("unroll") for (int n = 0; n < 2; ++n) _Pragma("unroll") for (int k = 0; k < 2; ++k) \
        acc[ai][bj][m][n] = __builtin_amdgcn_mfma_f32_16x16x32_bf16(Bt[n][k], At[m][k], acc[ai][bj][m][n], 0, 0, 0); __builtin_amdgcn_s_setprio(0); } while (0)
#define PG8_WAIT_V(n) asm volatile("s_waitcnt vmcnt(" #n ")" ::: "memory")
#define PG8_WAIT_L(n) asm volatile("s_waitcnt lgkmcnt(" #n ")" ::: "memory")
#define PG8_BAR __builtin_amdgcn_s_barrier()
#define PG8_SCHED __builtin_amdgcn_sched_barrier(0)
    Unit cur, nxt; int ui = 0;
    if (!S.next(0, cur)) return;
    f32x4 acc[2][2][4][2];
#pragma unroll
    for (int a = 0; a < 2; ++a)
#pragma unroll
        for (int b = 0; b < 2; ++b)
#pragma unroll
            for (int m = 0; m < 4; ++m)
#pragma unroll
                for (int n = 0; n < 2; ++n) acc[a][b][m][n] = (f32x4){0.f, 0.f, 0.f, 0.f};
    bf16x8 At[4][2], B0[2][2], B1[2][2];
    const char* cA = (const char*)g.A + (size_t)cur.arow * g.lda * 2; const char* cB = (const char*)g.Bt + (size_t)cur.brow * g.ldb * 2;
    PG8_STAGE(PG8_SB(0, 0), cB, voffB); PG8_STAGE(PG8_SB(0, 1), cB + hsB, voffB); PG8_STAGE(PG8_SA(0, 0), cA, voffA); PG8_STAGE(PG8_SA(0, 1), cA + hsA, voffA);
    if (wr == 1) PG8_BAR;
    PG8_WAIT_V(2); PG8_BAR;
    PG8_STAGE(PG8_SB(1, 0), cB + kstep, voffB); PG8_STAGE(PG8_SA(1, 0), cA + kstep, voffA); PG8_STAGE(PG8_SB(1, 1), cB + hsB + kstep, voffB);
    PG8_WAIT_V(6); PG8_BAR;
    for (;;) {
        const bool has_next = S.next(ui + 1, nxt);
        const char* nA = has_next ? (const char*)g.A + (size_t)nxt.arow * g.lda * 2 : cA; const char* nB = has_next ? (const char*)g.Bt + (size_t)nxt.brow * g.ldb * 2 : cB;
        for (int t = 0; t < nt; t += 2) {
            const bool last = (t == nt - 2);
            const char* a1 = cA + (size_t)(t + 1) * kstep;
            const char* a2 = last ? nA : cA + (size_t)(t + 2) * kstep; const char* b2 = last ? nB : cB + (size_t)(t + 2) * kstep;
            const char* a3 = a2 + kstep; const char* b3 = b2 + kstep;
            PG8_LDB(B0, 0, 0); PG8_LDB(B1, 0, 1); PG8_SCHED; PG8_LDA(At, 0, 0); PG8_STAGE(PG8_SA(1, 1), a1 + hsA, voffA);
            PG8_WAIT_V(8); PG8_WAIT_L(0); PG8_BAR; PG8_MMA(0, 0, At, B0); PG8_MMA(0, 1, At, B1); PG8_BAR; PG8_SCHED;
            PG8_LDA(At, 0, 1); PG8_STAGE(PG8_SB(0, 0), b2, voffB); PG8_STAGE(PG8_SB(0, 1), b2 + hsB, voffB); PG8_STAGE(PG8_SA(0, 0), a2, voffA);
            PG8_WAIT_V(8); PG8_WAIT_L(0); PG8_BAR; PG8_MMA(1, 0, At, B0); PG8_MMA(1, 1, At, B1); PG8_BAR; PG8_SCHED;
            PG8_LDB(B0, 1, 0); PG8_LDB(B1, 1, 1); PG8_SCHED; PG8_LDA(At, 1, 0); PG8_STAGE(PG8_SA(0, 1), a2 + hsA, voffA);
            PG8_WAIT_V(8); PG8_WAIT_L(0); PG8_BAR; PG8_MMA(0, 0, At, B0); PG8_MMA(0, 1, At, B1); PG8_BAR; PG8_SCHED;
            PG8_LDA(At, 1, 1); PG8_STAGE(PG8_SB(1, 0), b3, voffB); PG8_STAGE(PG8_SB(1, 1), b3 + hsB, voffB); PG8_STAGE(PG8_SA(1, 0), a3, voffA);
            PG8_WAIT_V(8); PG8_WAIT_L(0); PG8_BAR; PG8_MMA(1, 0, At, B0); PG8_MMA(1, 1, At, B1); PG8_BAR; PG8_SCHED;
        }
        if constexpr (ALIGN_EPI) { if (wr == 0) PG8_BAR; }
        { const int l2 = opaque_lane(); E(acc, cur, wr, wc, l2 & 15, l2 >> 4); }
        if (!has_next) break;
#pragma unroll
        for (int a = 0; a < 2; ++a)
#pragma unroll
            for (int b = 0; b < 2; ++b)
#pragma unroll
                for (int m = 0; m < 4; ++m)
#pragma unroll
                    for (int n = 0; n < 2; ++n) acc[a][b][m][n] = (f32x4){0.f, 0.f, 0.f, 0.f};
        cur = nxt; cA = nA; cB = nB; ++ui;
        if constexpr (ALIGN_EPI) { if (wr == 1) PG8_BAR; }
    }
    PG8_WAIT_V(0);
    if constexpr (!ALIGN_EPI) { if (wr == 0) PG8_BAR; }
    PG8_BAR;
#undef PG8_SA
#undef PG8_SB
#undef PG8_STAGE
#undef PG8_LDA
#undef PG8_LDB
#undef PG8_MMA
#undef PG8_WAIT_V
#undef PG8_WAIT_L
#undef PG8_BAR
#undef PG8_SCHED
}
}

__device__ __forceinline__ int crow(int r, int hi) { return (r & 3) + 8 * (r >> 2) + 4 * hi; }
__device__ __forceinline__ int v_rd_base(int lane) { return ((lane & 3) << 3) | (((lane >> 2) & 3) << 6) | (((lane >> 4) & 1) << 5) | (((lane >> 5) & 1) << 8); }
template <int NCB> __device__ __forceinline__ int v_st(int k, int c) { const int kk = (k & ~0xC) | ((k & 4) << 1) | ((k & 8) >> 1); return ((kk >> 3) * NCB + (c >> 5)) * 512 + ((kk & 7) * 32 + (c & 31)) * 2; }
template <int OFF> __device__ __forceinline__ s16x4 tr_read(int vb) {
    s16x4 r; asm volatile("ds_read_b64_tr_b16 %0, %1 offset:%2" : "=&v"(r) : "v"(vb), "i"(OFF) : "memory"); return r;
}
template <int D0, int NCB> __device__ __forceinline__ void pv_one(f32x16& od, int vb, bf16x8 pa0, bf16x8 pa1, bf16x8 pa2, bf16x8 pa3) {
    constexpr int KS = NCB * 1024, HF = NCB * 512;
    const s16x4 l0 = tr_read<D0 * 512 + 0 * KS>(vb), h0 = tr_read<D0 * 512 + 0 * KS + HF>(vb), l1 = tr_read<D0 * 512 + 1 * KS>(vb), h1 = tr_read<D0 * 512 + 1 * KS + HF>(vb);
    const s16x4 l2 = tr_read<D0 * 512 + 2 * KS>(vb), h2 = tr_read<D0 * 512 + 2 * KS + HF>(vb), l3 = tr_read<D0 * 512 + 3 * KS>(vb), h3 = tr_read<D0 * 512 + 3 * KS + HF>(vb);
    asm volatile("s_waitcnt lgkmcnt(0)" ::: "memory"); SBAR();
#define PK(L, H) (bf16x8){L[0], L[1], L[2], L[3], H[0], H[1], H[2], H[3]}
    od = __builtin_amdgcn_mfma_f32_32x32x16_bf16(pa0, PK(l0, h0), od, 0, 0, 0);
    od = __builtin_amdgcn_mfma_f32_32x32x16_bf16(pa1, PK(l1, h1), od, 0, 0, 0);
    od = __builtin_amdgcn_mfma_f32_32x32x16_bf16(pa2, PK(l2, h2), od, 0, 0, 0);
    od = __builtin_amdgcn_mfma_f32_32x32x16_bf16(pa3, PK(l3, h3), od, 0, 0, 0);
#undef PK
}
#define PK4(P, BASE, OUT) do { unsigned a0 = cvt_pk_bf16(P[BASE + 0], P[BASE + 1]), a1 = cvt_pk_bf16(P[BASE + 2], P[BASE + 3]);   \
    unsigned b0 = cvt_pk_bf16(P[BASE + 4], P[BASE + 5]), b1 = cvt_pk_bf16(P[BASE + 6], P[BASE + 7]);                              \
    auto r0 = __builtin_amdgcn_permlane32_swap(a0, b0, false, false); auto r1 = __builtin_amdgcn_permlane32_swap(a1, b1, false, false); \
    u32x4 w = {r0[0], r1[0], r0[1], r1[1]}; OUT = __builtin_bit_cast(bf16x8, w); } while (0)

namespace mla {
constexpr int NW = 8, QBLK = 32, KVBLK = 64, KSTR = 400;
constexpr int SHM_K = KVBLK * KSTR  , SHM_V = KVBLK * 128 * 2  ;
constexpr int OFF_V = 0, OFF_K = 2 * SHM_V, OFF_WS = OFF_K + 2 * SHM_K  , OFF_QR = OFF_WS + NW * 64 * 4  , OFF_END = OFF_QR + NW * 4096;
static_assert(OFF_END <= RING_BYTES, "mla lds");
constexpr int OSTR = 272;
static_assert(NW * 32 * OSTR <= OFF_WS, "O staging aliases K/V buffers");
constexpr float SCALE = 0.07216878364870323f;
constexpr float THR = 8.f;
constexpr int LDQ = NQ, LDKV = NKV, LDR = DOWNP, LDO = DM;

__device__ __forceinline__ void partialSM(f32x16& p0, f32x16& p1, float& m_reg, float& mn, float& alpha) {
    constexpr float C = SCALE * LOG2E;
    float pmax = p0[0];
#pragma unroll
    for (int r = 1; r < 16; ++r) pmax = fmaxf(pmax, p0[r]);
#pragma unroll
    for (int r = 0; r < 16; ++r) pmax = fmaxf(pmax, p1[r]);
    { auto rr = __builtin_amdgcn_permlane32_swap(__float_as_uint(pmax), __float_as_uint(pmax), false, false);
      pmax = fmaxf(__uint_as_float(rr[0]), __uint_as_float(rr[1])); }
    if (__builtin_expect(__all(pmax - m_reg <= THR / SCALE), 1)) { mn = m_reg; alpha = 1.f; }
    else { mn = fmaxf(m_reg, pmax); alpha = __builtin_amdgcn_exp2f((m_reg - mn) * C); m_reg = mn; }
    const float mnC = -mn * C;
#pragma unroll
    for (int r = 0; r < 16; ++r) p0[r] = fmaf(p0[r], C, mnC);
#pragma unroll
    for (int r = 0; r < 16; ++r) p1[r] = fmaf(p1[r], C, mnC);
#pragma unroll
    for (int r = 0; r < 16; ++r) p0[r] = __builtin_amdgcn_exp2f(p0[r]);
}
__device__ __forceinline__ void finishSM(f32x16& p0, f32x16& p1, float alpha, float& l_reg, bf16x8& pa0, bf16x8& pa1, bf16x8& pa2, bf16x8& pa3) {
#pragma unroll
    for (int r = 0; r < 16; ++r) p1[r] = __builtin_amdgcn_exp2f(p1[r]);
    float ps = 0;
#pragma unroll
    for (int r = 0; r < 16; ++r) ps += p0[r];
#pragma unroll
    for (int r = 0; r < 16; ++r) ps += p1[r];
    { auto rr = __builtin_amdgcn_permlane32_swap(__float_as_uint(ps), __float_as_uint(ps), false, false);
      ps = __uint_as_float(rr[0]) + __uint_as_float(rr[1]); }
    l_reg = l_reg * alpha + ps;
    PK4(p0, 0, pa0); PK4(p0, 8, pa1); PK4(p1, 0, pa2); PK4(p1, 8, pa3);
}
__device__ __forceinline__ void qkt(f32x16& p0, f32x16& p1, const LAS unsigned char* Ks, const bf16x8* qr, const LAS unsigned char* qrl, int r32, int hi) {
    p0 = f32x16{}; p1 = f32x16{};
#pragma unroll
    for (int d0 = 0; d0 < 12; ++d0) { const int cb = (d0 * 16 + hi * 8) * 2;
        const bf16x8 b0 = *(const LAS bf16x8*)(Ks + r32 * KSTR + cb);
        const bf16x8 b1 = *(const LAS bf16x8*)(Ks + (32 + r32) * KSTR + cb);
        const bf16x8 q = d0 < 8 ? qr[d0 < 8 ? d0 : 0] : *(const volatile LAS bf16x8*)(qrl + (d0 - 8) * 1024);
        p0 = __builtin_amdgcn_mfma_f32_32x32x16_bf16(b0, q, p0, 0, 0, 0);
        p1 = __builtin_amdgcn_mfma_f32_32x32x16_bf16(b1, q, p1, 0, 0, 0); }
}
__device__ __forceinline__ void pv_all(f32x16* o, int vb, bf16x8 pa0, bf16x8 pa1, bf16x8 pa2, bf16x8 pa3) {
    pv_one<0, 4>(o[0], vb, pa0, pa1, pa2, pa3); pv_one<1, 4>(o[1], vb, pa0, pa1, pa2, pa3); pv_one<2, 4>(o[2], vb, pa0, pa1, pa2, pa3); pv_one<3, 4>(o[3], vb, pa0, pa1, pa2, pa3);
}
__device__ __forceinline__ void unit(int b, int h, int qb, const bf16_t* __restrict__ Q, const bf16_t* __restrict__ KV, const bf16_t* __restrict__ DN, bf16_t* __restrict__ O, LAS unsigned char* lds, const int wv) {
    const int tid = opaque_tid(wv), wid = __builtin_amdgcn_readfirstlane(tid >> 6), lane = tid & 63, r32 = lane & 31, hi = lane >> 5;
    const size_t tok0 = (size_t)b * SEQ;
    const bf16_t* Qb = Q + (tok0 + (size_t)qb * 256) * LDQ + h * QKD;
    const bf16_t* Kn = KV + tok0 * LDKV + h * 128;
    const bf16_t* Vh = KV + tok0 * LDKV + 1024 + h * 128;
    const bf16_t* Kr = DN + tok0 * LDR + 512;
    LAS unsigned char* V_lds = lds + OFF_V; LAS unsigned char* K_lds = lds + OFF_K;
    LAS float* ws = (LAS float*)(lds + OFF_WS) + wid * 64; LAS float* li_l = ws; LAS float* al_l = ws + 32;
    float m_reg = -1e30f, l_reg = 0; f32x16 o[4] = {}; bf16x8 qr[8];
    const bf16_t* Qw = Qb + (size_t)(wid * QBLK + r32) * LDQ + hi * 8;
    LAS unsigned char* qrl = lds + OFF_QR + wid * 4096 + (hi * 32 + r32) * 16;
#pragma unroll
    for (int d0 = 0; d0 < 8; ++d0) qr[d0] = *(const bf16x8*)(Qw + d0 * 16);
#pragma unroll
    for (int d0 = 0; d0 < 4; ++d0) *(LAS bf16x8*)(qrl + d0 * 1024) = *(const bf16x8*)(Qw + 128 + d0 * 16);
    const int sr = tid >> 4, sc = (tid & 15) * 8, vst0 = v_st<4>(sr, sc), vst1 = v_st<4>(32 + sr, sc);
    const int rr = tid >> 3, rc = (tid & 7) * 8;
    const int vb0 = (int)(uintptr_t)V_lds + v_rd_base(lane);
    bf16x8 vs0, vs1, ks0, ks1, kr0;
#define SLOAD(k0) do { vs0 = *(const bf16x8*)(Vh + (size_t)((k0) + sr) * LDKV + sc); vs1 = *(const bf16x8*)(Vh + (size_t)((k0) + 32 + sr) * LDKV + sc); \
    ks0 = *(const bf16x8*)(Kn + (size_t)((k0) + sr) * LDKV + sc); ks1 = *(const bf16x8*)(Kn + (size_t)((k0) + 32 + sr) * LDKV + sc); \
    kr0 = *(const bf16x8*)(Kr + (size_t)((k0) + rr) * LDR + rc); } while (0)
#define SWRITE(bf) do { *(LAS bf16x8*)(V_lds + (bf) * SHM_V + vst0) = vs0; *(LAS bf16x8*)(V_lds + (bf) * SHM_V + vst1) = vs1; \
    *(LAS bf16x8*)(K_lds + (bf) * SHM_K + sr * KSTR + sc * 2) = ks0; *(LAS bf16x8*)(K_lds + (bf) * SHM_K + (32 + sr) * KSTR + sc * 2) = ks1; \
    *(LAS bf16x8*)(K_lds + (bf) * SHM_K + rr * KSTR + 256 + rc * 2) = kr0; } while (0)
#define RESC(a) do { if (__any((a) < 1.f)) { if (hi == 0) al_l[r32] = (a); asm volatile("s_waitcnt lgkmcnt(0)" ::: "memory"); \
    _Pragma("unroll") for (int d = 0; d < 4; ++d) _Pragma("unroll") for (int r = 0; r < 16; ++r) o[d][r] *= al_l[crow(r, hi)]; } } while (0)
    f32x16 pA0, pA1, pB0, pB1; float mnA, mnB, alA, alB; bf16x8 pa0, pa1, pa2, pa3; constexpr int NT = SEQ / KVBLK;
    SLOAD(0); asm volatile("s_waitcnt vmcnt(0)" ::: "memory"); SWRITE(0); __syncthreads();
    qkt(pA0, pA1, K_lds, qr, qrl, r32, hi); partialSM(pA0, pA1, m_reg, mnA, alA);
    SLOAD(KVBLK);
    asm volatile("s_waitcnt vmcnt(0)" ::: "memory"); SWRITE(1); __syncthreads();
    for (int j = 1; j + 1 < NT; j += 2) {
        SBAR(); qkt(pB0, pB1, K_lds + SHM_K, qr, qrl, r32, hi);
        finishSM(pA0, pA1, alA, l_reg, pa0, pa1, pa2, pa3); SBAR();
        SLOAD((j + 1) * KVBLK); SBAR();
        pv_all(o, vb0, pa0, pa1, pa2, pa3); partialSM(pB0, pB1, m_reg, mnB, alB);
        __syncthreads(); asm volatile("s_waitcnt vmcnt(0)" ::: "memory"); SWRITE(0);
        RESC(alB); __syncthreads();
        SBAR(); qkt(pA0, pA1, K_lds, qr, qrl, r32, hi);
        finishSM(pB0, pB1, alB, l_reg, pa0, pa1, pa2, pa3); SBAR();
        SLOAD((j + 2) * KVBLK); SBAR();
        pv_all(o, vb0 + SHM_V, pa0, pa1, pa2, pa3); partialSM(pA0, pA1, m_reg, mnA, alA);
        __syncthreads(); asm volatile("s_waitcnt vmcnt(0)" ::: "memory"); SWRITE(1);
        RESC(alA); __syncthreads();
    }
    SBAR(); qkt(pB0, pB1, K_lds + SHM_K, qr, qrl, r32, hi);
    finishSM(pA0, pA1, alA, l_reg, pa0, pa1, pa2, pa3); SBAR();
    pv_all(o, vb0, pa0, pa1, pa2, pa3); partialSM(pB0, pB1, m_reg, mnB, alB);
    __syncthreads(); RESC(alB);
    finishSM(pB0, pB1, alB, l_reg, pa0, pa1, pa2, pa3); SBAR();
    pv_all(o, vb0 + SHM_V, pa0, pa1, pa2, pa3);
    if (hi == 0) li_l[r32] = l_reg; asm volatile("s_waitcnt lgkmcnt(0)" ::: "memory");
    float rli[16];
#pragma unroll
    for (int r = 0; r < 16; ++r) rli[r] = __builtin_amdgcn_rcpf(li_l[crow(r, hi)]);
    __syncthreads();
    LAS unsigned char* ost = lds + wid * (32 * OSTR);
#pragma unroll
    for (int r = 0; r < 16; ++r) { const int orow = crow(r, hi);
#pragma unroll
        for (int d0 = 0; d0 < 4; ++d0) *(LAS unsigned short*)(ost + orow * OSTR + (d0 * 32 + r32) * 2) = (unsigned short)f2bf(o[d0][r] * rli[r]); }
    asm volatile("s_waitcnt lgkmcnt(0)" ::: "memory");
    bf16_t* Ow = O + (tok0 + (size_t)qb * 256 + wid * QBLK) * LDO + h * 128;
#pragma unroll
    for (int it = 0; it < 8; ++it) { const int ch = it * 64 + lane, row = ch >> 4, c16 = ch & 15;
        const u32x4 v = *(const LAS u32x4*)(ost + row * OSTR + c16 * 16); *(u32x4*)(Ow + (size_t)row * LDO + c16 * 8) = v; }
    __syncthreads();
#undef SLOAD
#undef SWRITE
#undef RESC
}
}

namespace swa {
constexpr int KSTR = 144, KT = 64 * KSTR  , VT = 8192, NTILE = 5;
constexpr int OFF_K = 0, OFF_V = NTILE * KT  , OFF_O = OFF_V + NTILE * VT  , OSTR = 144, OFF_WS = OFF_O + 8 * 32 * OSTR  , OFF_END = OFF_WS + 8 * 64 * 4;
static_assert(OFF_END <= RING_BYTES, "swa lds");
constexpr int LD = SWA_NQKV;
constexpr float C = 0.125f * LOG2E;
__device__ __forceinline__ void unit(int b, int g, int qb, const bf16_t* __restrict__ QKV, const float* __restrict__ sink, bf16_t* __restrict__ O, LAS unsigned char* lds, const int wv) {
    const int tid = opaque_tid(wv), wid = __builtin_amdgcn_readfirstlane(tid >> 6), lane = tid & 63, r32 = lane & 31, hi = lane >> 5;
    const int q0 = qb * 64; const size_t tok0 = (size_t)b * SEQ;
    int t_lo = 0, t_hi = NTILE;
    if (q0 < 128) t_lo = (128 - q0) / 64;
    if (q0 + 64 + 128 > SEQ) t_hi = (SEQ + 128 - q0) / 64;
    { const int row = tid >> 3, c8 = (tid & 7) * 8; bf16x8 kreg[NTILE], vreg[NTILE];
#pragma unroll
      for (int t = 0; t < NTILE; ++t) if (t >= t_lo && t < t_hi) { const bf16_t* p = QKV + (tok0 + (size_t)(q0 - 128 + 64 * t + row)) * LD + g * 64 + c8;
          kreg[t] = *(const bf16x8*)(p + 1024); vreg[t] = *(const bf16x8*)(p + 1280); }
#pragma unroll
      for (int t = 0; t < NTILE; ++t) if (t >= t_lo && t < t_hi) { *(LAS bf16x8*)(lds + OFF_K + t * KT + row * KSTR + c8 * 2) = kreg[t];
          *(LAS bf16x8*)(lds + OFF_V + t * VT + v_st<2>(row, c8)) = vreg[t]; } }
    const int qh = g * 4 + (wid >> 1), rowb = q0 + (wid & 1) * 32;
    bf16x8 qr[4];
    { const bf16_t* Qw = QKV + (tok0 + (size_t)(rowb + r32)) * LD + qh * 64 + hi * 8;
#pragma unroll
      for (int d0 = 0; d0 < 4; ++d0) qr[d0] = *(const bf16x8*)(Qw + d0 * 16); }
    const float slope2 = __builtin_amdgcn_exp2f(-0.5f * (float)(qh + 1)) * LOG2E;
    const float sink2 = sink[qh] * LOG2E;
    __syncthreads();
    LAS float* al_l = (LAS float*)(lds + OFF_WS) + wid * 64; LAS float* li_l = al_l + 32;
    const int vb0 = (int)(uintptr_t)(lds + OFF_V) + v_rd_base(lane);
    float m_reg = -1e30f, l_reg = 0.f; f32x16 o[2] = {};
    for (int t = t_lo; t < t_hi; ++t) {
        const LAS unsigned char* Ks = lds + OFF_K + t * KT;
        f32x16 p0 = {}, p1 = {};
#pragma unroll
        for (int d0 = 0; d0 < 4; ++d0) { const int cb = (d0 * 16 + hi * 8) * 2;
            const bf16x8 b0 = *(const LAS bf16x8*)(Ks + r32 * KSTR + cb), b1 = *(const LAS bf16x8*)(Ks + (32 + r32) * KSTR + cb);
            p0 = __builtin_amdgcn_mfma_f32_32x32x16_bf16(b0, qr[d0], p0, 0, 0, 0);
            p1 = __builtin_amdgcn_mfma_f32_32x32x16_bf16(b1, qr[d0], p1, 0, 0, 0); }
        const int kb = (q0 - 128 + 64 * t) - (rowb + r32);
        float pmax = -INFINITY;
#pragma unroll
        for (int r = 0; r < 16; ++r) { const int rel0 = kb + crow(r, hi), rel1 = rel0 + 32; const int d0 = rel0 < 0 ? -rel0 : rel0, d1 = rel1 < 0 ? -rel1 : rel1;
            float x0 = fmaf(p0[r], C, -slope2 * (float)d0), x1 = fmaf(p1[r], C, -slope2 * (float)d1);
            x0 = d0 > 128 ? -INFINITY : x0; x1 = d1 > 128 ? -INFINITY : x1; p0[r] = x0; p1[r] = x1; pmax = fmaxf(pmax, fmaxf(x0, x1)); }
        { auto rr = __builtin_amdgcn_permlane32_swap(__float_as_uint(pmax), __float_as_uint(pmax), false, false);
          pmax = fmaxf(__uint_as_float(rr[0]), __uint_as_float(rr[1])); }
        const float mn = fmaxf(m_reg, pmax), alpha = __builtin_amdgcn_exp2f(m_reg - mn); m_reg = mn;
        float ps = 0.f;
#pragma unroll
        for (int r = 0; r < 16; ++r) { p0[r] = __builtin_amdgcn_exp2f(p0[r] - mn); p1[r] = __builtin_amdgcn_exp2f(p1[r] - mn); ps += p0[r] + p1[r]; }
        { auto rr = __builtin_amdgcn_permlane32_swap(__float_as_uint(ps), __float_as_uint(ps), false, false);
          ps = __uint_as_float(rr[0]) + __uint_as_float(rr[1]); }
        l_reg = l_reg * alpha + ps;
        if (hi == 0) al_l[r32] = alpha; asm volatile("s_waitcnt lgkmcnt(0)" ::: "memory");
#pragma unroll
        for (int d = 0; d < 2; ++d)
#pragma unroll
            for (int r = 0; r < 16; ++r) o[d][r] *= al_l[crow(r, hi)];
        bf16x8 pa0, pa1, pa2, pa3;
        PK4(p0, 0, pa0); PK4(p0, 8, pa1); PK4(p1, 0, pa2); PK4(p1, 8, pa3);
        const int vb = vb0 + t * VT;
        pv_one<0, 2>(o[0], vb, pa0, pa1, pa2, pa3); pv_one<1, 2>(o[1], vb, pa0, pa1, pa2, pa3);
    }
    l_reg += __builtin_amdgcn_exp2f(sink2 - m_reg);
    if (hi == 0) li_l[r32] = l_reg; asm volatile("s_waitcnt lgkmcnt(0)" ::: "memory");
    LAS unsigned char* ost = lds + OFF_O + wid * (32 * OSTR);
#pragma unroll
    for (int r = 0; r < 16; ++r) { const int orow = crow(r, hi); const float rl = __builtin_amdgcn_rcpf(li_l[orow]);
#pragma unroll
        for (int d0 = 0; d0 < 2; ++d0) *(LAS unsigned short*)(ost + orow * OSTR + (d0 * 32 + r32) * 2) = (unsigned short)f2bf(o[d0][r] * rl); }
    asm volatile("s_waitcnt lgkmcnt(0)" ::: "memory");
    bf16_t* Ow = O + (tok0 + (size_t)rowb) * DM + qh * 64;
#pragma unroll
    for (int it = 0; it < 4; ++it) { const int ch = it * 64 + lane, row = ch >> 3, c16 = ch & 7;
        const u32x4 v = *(const LAS u32x4*)(ost + row * OSTR + c16 * 16); *(u32x4*)(Ow + (size_t)row * DM + c16 * 8) = v; }
    __syncthreads();
}
}

constexpr int NWAVES = 8;
struct Args { const float* in[23]; float* out; unsigned char* ws; };
static_assert(sizeof(Args) == 25 * 8, "no padding");

template <int KIND> __device__ __forceinline__ int map_row(int n) {
    if (KIND == 0) return n;
    if (KIND == 1) return ((n >> 7) << 8) + (n & 127);
    if (KIND == 2) return ((n >> 7) << 8) + 128 + (n & 127);
    if (KIND == 3) { const int h = n / QKD; int d = n - h * QKD; if (d >= 128) { const int i = d - 128; d = 128 + (i < 32 ? 2 * i : 2 * (i - 32) + 1); } return h * QKD + d; }
    if (KIND == 4) { if (n >= 512) { const int i = n - 512; n = 512 + (i < 32 ? 2 * i : 2 * (i - 32) + 1); } return n; }
    return n;
}
template <int KIND> __device__ __forceinline__ void transpose_matrix(const float* W, int K, int N, bf16_t* WT, int row_off, LAS float* scr, int gw, int NGW, int lane) {
    const int nblk = N / 32, nitems = (K / 64) * nblk;
    for (int item = gw; item < nitems; item += NGW) {
        const int kb = item / nblk, nb = item % nblk, k0 = 64 * kb, n0 = 32 * nb;
#pragma unroll 8
        for (int i = 0; i < 32; ++i) { const int kk = 2 * i + (lane >> 5); scr[kk * 33 + (lane & 31)] = W[(size_t)(k0 + kk) * N + n0 + (lane & 31)]; }
        LDS_WAIT(); asm volatile("" ::: "memory");
        const int c = lane & 7;
#pragma unroll
        for (int j = 0; j < 4; ++j) { const int n = (lane >> 3) + 8 * j; const LAS float* s = scr + (8 * c) * 33 + n;
            u32x4 o; o.x = pk2(s[0 * 33], s[1 * 33]); o.y = pk2(s[2 * 33], s[3 * 33]); o.z = pk2(s[4 * 33], s[5 * 33]); o.w = pk2(s[6 * 33], s[7 * 33]);
            *(u32x4*)(WT + (size_t)(row_off + map_row<KIND>(n0 + n)) * K + k0 + 8 * c) = o; }
        LDS_WAIT(); asm volatile("" ::: "memory");
    }
}
__device__ __forceinline__ void rms_row_to_bf16(const float* xrow, const f32x4 (&gv)[4], bf16_t* orow, int lane) {
    const f32x4* xr = (const f32x4*)xrow + lane; f32x4 v[4]; float s = 0.f;
#pragma unroll
    for (int j = 0; j < 4; ++j) { v[j] = xr[64 * j]; s += (v[j].x * v[j].x + v[j].y * v[j].y) + (v[j].z * v[j].z + v[j].w * v[j].w); }
    const float rstd = 1.0f / sqrtf(wave_sum(s, lane) * (1.f / DM) + EPS);
    unsigned long long* o8 = (unsigned long long*)orow + lane;
#pragma unroll
    for (int j = 0; j < 4; ++j) { const f32x4 y = v[j] * rstd * gv[j]; o8[64 * j] = (unsigned long long)pk2(y.x, y.y) | ((unsigned long long)pk2(y.z, y.w) << 32); }
}

#define PHASE_IDS const int tid = opaque_tid(bar.wv), lane = tid & 63, wave = __builtin_amdgcn_readfirstlane(tid >> 6), gw = vcu * NWAVES + wave; (void)gw; (void)lane
template <int j> __device__ __forceinline__ void pair_body(const Args& args, LAS unsigned char* lds, const XcdBarrier& bar, const int G, const int bx, const int vcu) {
    const int NGW = G * NWAVES;
    unsigned char* ws = args.ws;
    LAS int* moetab = (LAS int*)(lds + MOETAB_OFF);
    const float* x = args.in[0]; float* hbuf = args.out;
    f32x2* rope = (f32x2*)(ws + WS_ROPE);
    int* route = (int*)(ws + WS_ROUTE); f32x2* gate = (f32x2*)(ws + WS_GATE); int* posb = (int*)(ws + WS_POS); int* cnt = (int*)(ws + WS_CNT);
    unsigned char* act = ws + WS_ACT;
    bf16_t* XN = (bf16_t*)(act + A_XN); bf16_t* DOWN = (bf16_t*)(act + A_DOWN); bf16_t* QB = (bf16_t*)(act + A_Q); bf16_t* KVB = (bf16_t*)(act + A_KV);
    bf16_t* FACT = (bf16_t*)(act + A_FACT); bf16_t* SQKV = (bf16_t*)(act + A_SQKV); bf16_t* XS = (bf16_t*)(act + A_XS); bf16_t* MACT = (bf16_t*)(act + A_MACT);
    {
        unsigned char* wb = ws + WS_W + (size_t)j * W_PAIR;
        if (PH(1)) { pg8::Gemm g{j == 0 ? XN : (const bf16_t*)(act + A_XN2), (const bf16_t*)(wb + W_DQKV), DM, DM, DM}; pg8::DenseOrder S; S.init(NTOK, DOWNP, G, bx, 256);
          pg8::EpiBf16<false> E{DOWN, DOWNP}; pg8::gemm_phase<pg8::EpiBf16<false>, pg8::DenseOrder, true>(lds, g, S, E, bar.wv); }
        xcd_barrier(bar);
        if (PH(2)) { PHASE_IDS; const f32x4 gq = ((const f32x4*)(args.in[3] + j * 256))[lane], gk = ((const f32x4*)(args.in[5] + j * 256))[lane];
          for (int m = gw; m < NTOK; m += NGW) { bf16_t* row = DOWN + (size_t)m * DOWNP;
              const u32x2 a = ((const u32x2*)row)[lane], b = ((const u32x2*)(row + 256))[lane];
              unsigned kr = 0; if (lane < 32) kr = ((const unsigned*)(row + 512))[lane];
              const float a0 = bf_lo(a.x), a1 = bf_hi(a.x), a2 = bf_lo(a.y), a3 = bf_hi(a.y);
              const float b0 = bf_lo(b.x), b1 = bf_hi(b.x), b2 = bf_lo(b.y), b3 = bf_hi(b.y);
              const float ra = 1.0f / sqrtf(wave_sum((a0 * a0 + a1 * a1) + (a2 * a2 + a3 * a3), lane) * (1.f / 256.f) + EPS);
              const float rb = 1.0f / sqrtf(wave_sum((b0 * b0 + b1 * b1) + (b2 * b2 + b3 * b3), lane) * (1.f / 256.f) + EPS);
              u32x2 oa, ob; oa.x = pk2(a0 * ra * gq.x, a1 * ra * gq.y); oa.y = pk2(a2 * ra * gq.z, a3 * ra * gq.w);
              ob.x = pk2(b0 * rb * gk.x, b1 * rb * gk.y); ob.y = pk2(b2 * rb * gk.z, b3 * rb * gk.w);
              ((u32x2*)row)[lane] = oa; ((u32x2*)(row + 256))[lane] = ob;
              if (lane < 32) { const f32x2 cs = rope[(size_t)(m & (SEQ - 1)) * 32 + lane]; const float x1 = bf_lo(kr), x2 = bf_hi(kr);
                  ((unsigned*)(row + 512))[lane] = pk2(x1 * cs.x - x2 * cs.y, x2 * cs.x + x1 * cs.y); } } }
        xcd_barrier(bar);
        if (PH(3)) { pg8::Gemm g{DOWN, (const bf16_t*)(wb + W_UQ), DOWNP, 256, 256}; pg8::DenseOrder S; S.init(NTOK, NQ, G, bx, 256);
          pg8::EpiQRope E{QB, rope}; pg8::gemm_phase<pg8::EpiQRope, pg8::DenseOrder, true>(lds, g, S, E, bar.wv); }
        { pg8::Gemm g{DOWN + 256, (const bf16_t*)(wb + W_UKV), DOWNP, 256, 256}; pg8::DenseOrder S; S.init(NTOK, NKV, G, bx, 256);
          pg8::EpiBf16<false> E{KVB, NKV}; pg8::gemm_phase<pg8::EpiBf16<false>, pg8::DenseOrder, true>(lds, g, S, E, bar.wv); }
        xcd_barrier(bar);
        if (PH(4)) { const int NU = BATCH * MLA_H * (SEQ / 256);
          for (int u = vcu; u < NU; u += G) { const int bh = u >> 3, qb = u & 7; mla::unit(bh >> 3, bh & 7, qb, QB, KVB, DOWN, XN, lds, bar.wv); } }
        xcd_barrier(bar);
        if (PH(5)) { pg8::Gemm g{XN, (const bf16_t*)(wb + W_MO), DM, DM, DM}; pg8::DenseOrder S; S.init(NTOK, DM, G, bx, 256);
          pg8::EpiResid E{j == 0 ? x : hbuf, hbuf}; pg8::gemm_phase<pg8::EpiResid, pg8::DenseOrder, true>(lds, g, S, E, bar.wv); }
        xcd_barrier(bar);
        if (PH(6)) { PHASE_IDS; f32x4 gv[4];
#pragma unroll
          for (int k = 0; k < 4; ++k) gv[k] = ((const f32x4*)(args.in[13] + j * DM))[lane + 64 * k];
          for (int m = gw; m < NTOK; m += NGW) rms_row_to_bf16(hbuf + (size_t)m * DM, gv, XN + (size_t)m * DM, lane); }
        xcd_barrier(bar);
        if (PH(7)) { pg8::Gemm g{XN, (const bf16_t*)(wb + W_FGU), DM, DM, DM}; pg8::DenseOrder S; S.init(NTOK, 2 * FFN, G, bx, 128);
          pg8::EpiSwiGLU<false> E{FACT, FFN}; pg8::gemm_phase<pg8::EpiSwiGLU<false>, pg8::DenseOrder, true>(lds, g, S, E, bar.wv); }
        xcd_barrier(bar);
        if (PH(8)) { pg8::Gemm g{FACT, (const bf16_t*)(wb + W_FD), FFN, FFN, FFN}; pg8::DenseOrder S; S.init(NTOK, DM, G, bx, 256);
          pg8::EpiResid E{hbuf, hbuf}; pg8::gemm_phase<pg8::EpiResid, pg8::DenseOrder, true>(lds, g, S, E, bar.wv); }
        xcd_barrier(bar);
        if (PH(9)) { PHASE_IDS; f32x4 gv[4];
#pragma unroll
          for (int k = 0; k < 4; ++k) gv[k] = ((const f32x4*)(args.in[9] + j * DM))[lane + 64 * k];
          for (int m = gw; m < NTOK; m += NGW) rms_row_to_bf16(hbuf + (size_t)m * DM, gv, XN + (size_t)m * DM, lane); }
        xcd_barrier(bar);
        if (PH(10)) { pg8::Gemm g{XN, (const bf16_t*)(wb + W_SQKV), DM, DM, DM}; pg8::DenseOrder S; S.init(NTOK, SWA_NQKV, G, bx, 256);
          pg8::EpiBf16<false> E{SQKV, SWA_NQKV}; pg8::gemm_phase<pg8::EpiBf16<false>, pg8::DenseOrder, true>(lds, g, S, E, bar.wv); }
        xcd_barrier(bar);
        if (PH(11)) { const int NU = BATCH * 4 * (SEQ / 64);
          for (int u = vcu; u < NU; u += G) { const int bg = u >> 5, qb = u & 31; swa::unit(bg >> 2, bg & 3, qb, SQKV, args.in[11] + j * 16, XN, lds, bar.wv); } }
        xcd_barrier(bar);
        if (PH(12)) { pg8::Gemm g{XN, (const bf16_t*)(wb + W_SO), DM, DM, DM}; pg8::DenseOrder S; S.init(NTOK, DM, G, bx, 256);
          pg8::EpiResid E{hbuf, hbuf}; pg8::gemm_phase<pg8::EpiResid, pg8::DenseOrder, true>(lds, g, S, E, bar.wv); }
        xcd_barrier(bar);
        if (PH(13)) { PHASE_IDS; LAS float* rt = (LAS float*)lds;
          LAS int* lcnt = (LAS int*)(lds + 32768);
          const float* router = args.in[18] + (size_t)j * DM * NE;
          for (int i = tid; i < DM * NE; i += NWAVES * 64) rt[(i & 7) * DM + (i >> 3)] = router[i];
          f32x4 gv[4];
#pragma unroll
          for (int k = 0; k < 4; ++k) gv[k] = ((const f32x4*)(args.in[17] + j * DM))[lane + 64 * k];
          for (int ck = vcu; ck < NTOK / 256; ck += G) {
              if (tid < 8) lcnt[tid] = 0;
              __syncthreads();
              for (int r = 0; r < 32; ++r) { const int tok = ck * 256 + wave * 32 + r;
                  const f32x4* xr = (const f32x4*)(hbuf + (size_t)tok * DM) + lane; f32x4 v[4]; float s = 0.f;
#pragma unroll
                  for (int k = 0; k < 4; ++k) { v[k] = xr[64 * k]; s += (v[k].x * v[k].x + v[k].y * v[k].y) + (v[k].z * v[k].z + v[k].w * v[k].w); }
                  const float rstd = 1.0f / sqrtf(wave_sum(s, lane) * (1.f / DM) + EPS);
#pragma unroll
                  for (int k = 0; k < 4; ++k) v[k] = v[k] * rstd * gv[k];
                  float lg[8];
#pragma unroll
                  for (int e = 0; e < 8; ++e) { float a = 0.f;
#pragma unroll
                      for (int k = 0; k < 4; ++k) { const f32x4 w = *(const LAS f32x4*)(rt + e * DM + 4 * lane + 256 * k); a += (v[k].x * w.x + v[k].y * w.y) + (v[k].z * w.z + v[k].w * w.w); }
                      lg[e] = wave_sum(a, lane); }
                  int i0 = 0; float v0 = lg[0];
#pragma unroll
                  for (int e = 1; e < 8; ++e) if (lg[e] > v0) { v0 = lg[e]; i0 = e; }
                  int i1 = -1; float v1 = -INFINITY;
#pragma unroll
                  for (int e = 0; e < 8; ++e) if (e != i0 && lg[e] > v1) { v1 = lg[e]; i1 = e; }
                  const float g0 = 1.0f / (1.0f + __expf(v1 - v0));
                  if (lane == 0) { route[tok] = i0 | (i1 << 8); gate[tok] = (f32x2){g0, 1.0f - g0}; __hip_atomic_fetch_add(lcnt + i0, 1, __ATOMIC_RELAXED, __HIP_MEMORY_SCOPE_WORKGROUP); __hip_atomic_fetch_add(lcnt + i1, 1, __ATOMIC_RELAXED, __HIP_MEMORY_SCOPE_WORKGROUP); } }
              __syncthreads();
              if (tid < 8) cnt[ck * 8 + tid] = lcnt[tid];
              __syncthreads();
          } }
        xcd_barrier(bar);
        if (PH(14)) { PHASE_IDS; LAS int* red = (LAS int*)lds;
          LAS int* tp = (LAS int*)(lds + 1024);
          LAS int* wcn = (LAS int*)(lds + 2048);
          LAS int* lpos = (LAS int*)(lds + 4096);
          f32x4 gv[4];
#pragma unroll
          for (int k = 0; k < 4; ++k) gv[k] = ((const f32x4*)(args.in[17] + j * DM))[lane + 64 * k];
          int v[8];
          if (tid < 256) { const i32x4 c0 = ((const i32x4*)cnt)[tid * 2], c1 = ((const i32x4*)cnt)[tid * 2 + 1]; v[0] = c0.x; v[1] = c0.y; v[2] = c0.z; v[3] = c0.w; v[4] = c1.x; v[5] = c1.y; v[6] = c1.z; v[7] = c1.w; }
          else {
#pragma unroll
              for (int e = 0; e < 8; ++e) v[e] = 0; }
#pragma unroll
          for (int e = 0; e < 8; ++e) { int tot = v[e];
#pragma unroll
              for (int o = 1; o < 64; o <<= 1) tot += shxi(tot, o, lane);
              if (lane == 0) red[wave * 16 + e] = tot; }
          __syncthreads();
          if (tid < 8) { int s = 0;
#pragma unroll
              for (int w = 0; w < 8; ++w) s += red[w * 16 + tid];
              tp[tid] = s; }
          __syncthreads();
          if (tid == 0) { int rs = 0, ts = 0;
              for (int e = 0; e < 8; ++e) { moetab[e] = ts; moetab[16 + e] = rs; rs += tp[e]; ts += (tp[e] + 255) >> 8; }
              moetab[8] = ts; moetab[24] = rs; }
          __syncthreads();
          for (int ck = vcu; ck < NTOK / 256; ck += G) {
#pragma unroll
              for (int e = 0; e < 8; ++e) { int pre = (tid < ck) ? v[e] : 0;
#pragma unroll
                  for (int o = 1; o < 64; o <<= 1) pre += shxi(pre, o, lane);
                  if (lane == 0) red[wave * 16 + 8 + e] = pre; }
              __syncthreads();
              if (tid < 8) { int s = 0;
#pragma unroll
                  for (int w = 0; w < 8; ++w) s += red[w * 16 + 8 + tid];
                  tp[8 + tid] = s; }
              int e0 = 0, e1 = 0, r0 = 0, r1 = 0;
              if (tid < 256) { const int re = route[ck * 256 + tid]; e0 = re & 255; e1 = re >> 8; }
#pragma unroll
              for (int e = 0; e < 8; ++e) { const bool f = (tid < 256) && (e0 == e || e1 == e); const unsigned long long mk = __ballot(f);
                  const int rk = __popcll(mk & ((1ull << lane) - 1ull));
                  if (e0 == e) r0 = rk; if (e1 == e) r1 = rk;
                  if (lane == 0 && wave < 4) wcn[wave * 8 + e] = __popcll(mk); }
              __syncthreads();
              if (tid < 256) { int p0 = moetab[16 + e0] + tp[8 + e0] + r0, p1 = moetab[16 + e1] + tp[8 + e1] + r1;
                  for (int w = 0; w < wave; ++w) { p0 += wcn[w * 8 + e0]; p1 += wcn[w * 8 + e1]; }
                  lpos[tid * 2] = p0; lpos[tid * 2 + 1] = p1; posb[(size_t)(ck * 256 + tid) * 2] = p0; posb[(size_t)(ck * 256 + tid) * 2 + 1] = p1; }
              __syncthreads();
              for (int r = 0; r < 32; ++r) { const int t = wave * 32 + r, tok = ck * 256 + t; const int p0 = lpos[t * 2], p1 = lpos[t * 2 + 1];
                  const f32x4* xr = (const f32x4*)(hbuf + (size_t)tok * DM) + lane; f32x4 xv[4]; float s = 0.f;
#pragma unroll
                  for (int k = 0; k < 4; ++k) { xv[k] = xr[64 * k]; s += (xv[k].x * xv[k].x + xv[k].y * xv[k].y) + (xv[k].z * xv[k].z + xv[k].w * xv[k].w); }
                  const float rstd = 1.0f / sqrtf(wave_sum(s, lane) * (1.f / DM) + EPS);
                  unsigned long long* o0 = (unsigned long long*)(XS + (size_t)p0 * DM) + lane; unsigned long long* o1 = (unsigned long long*)(XS + (size_t)p1 * DM) + lane;
#pragma unroll
                  for (int k = 0; k < 4; ++k) { const f32x4 y = xv[k] * rstd * gv[k]; const unsigned long long w = (unsigned long long)pk2(y.x, y.y) | ((unsigned long long)pk2(y.z, y.w) << 32); o0[64 * k] = w; o1[64 * k] = w; } }
              __syncthreads();
          } }
        xcd_barrier(bar);
        if (PH(15)) { pg8::Gemm g{XS, (const bf16_t*)(wb + W_MGU), DM, DM, DM}; pg8::GroupedOrder S; S.init(moetab, 2 * ED, G, bx, 128);
          pg8::EpiSwiGLU<true> E{MACT, ED}; pg8::gemm_phase<pg8::EpiSwiGLU<true>, pg8::GroupedOrder, true>(lds, g, S, E, bar.wv); }
        xcd_barrier(bar);
        if (PH(16)) { pg8::Gemm g{MACT, (const bf16_t*)(wb + W_MD), ED, ED, ED}; pg8::GroupedOrder S; S.init(moetab, DM, G, bx, 256);
          pg8::EpiBf16<true> E{XS, DM}; pg8::gemm_phase<pg8::EpiBf16<true>, pg8::GroupedOrder, true>(lds, g, S, E, bar.wv); }
        xcd_barrier(bar);
        if (PH(17)) { PHASE_IDS; const float* gsrc = (j == 0) ? args.in[1] + DM : args.in[22];
          f32x4 gv[4];
#pragma unroll
          for (int k = 0; k < 4; ++k) gv[k] = ((const f32x4*)gsrc)[lane + 64 * k];
          for (int m = gw; m < NTOK; m += NGW) {
              const int p0 = posb[(size_t)m * 2], p1 = posb[(size_t)m * 2 + 1]; const f32x2 gg = gate[m];
              f32x4* hr = (f32x4*)(hbuf + (size_t)m * DM) + lane;
              const u32x2* y0 = (const u32x2*)(XS + (size_t)p0 * DM) + lane; const u32x2* y1 = (const u32x2*)(XS + (size_t)p1 * DM) + lane;
              f32x4 v[4]; float s = 0.f;
#pragma unroll
              for (int k = 0; k < 4; ++k) { const u32x2 a = y0[64 * k], b = y1[64 * k]; f32x4 hv = hr[64 * k];
                  hv.x += gg.x * bf_lo(a.x) + gg.y * bf_lo(b.x); hv.y += gg.x * bf_hi(a.x) + gg.y * bf_hi(b.x);
                  hv.z += gg.x * bf_lo(a.y) + gg.y * bf_lo(b.y); hv.w += gg.x * bf_hi(a.y) + gg.y * bf_hi(b.y);
                  v[k] = hv; s += (hv.x * hv.x + hv.y * hv.y) + (hv.z * hv.z + hv.w * hv.w); }
              const float rstd = 1.0f / sqrtf(wave_sum(s, lane) * (1.f / DM) + EPS);
              if (j == 0) { unsigned long long* o8 = (unsigned long long*)((bf16_t*)(act + A_XN2) + (size_t)m * DM) + lane;
#pragma unroll
                  for (int k = 0; k < 4; ++k) { hr[64 * k] = v[k]; const f32x4 y = v[k] * rstd * gv[k]; o8[64 * k] = (unsigned long long)pk2(y.x, y.y) | ((unsigned long long)pk2(y.z, y.w) << 32); } }
              else {
#pragma unroll
                  for (int k = 0; k < 4; ++k) hr[64 * k] = v[k] * rstd * gv[k]; }
          } }
        if (j == 0) xcd_barrier(bar);
    }
}

__global__ void __launch_bounds__(NWAVES * 64, 2) fwd(Args args) {
    extern __shared__ __attribute__((aligned(16))) unsigned char lds_raw[];
    LAS unsigned char* lds = (LAS unsigned char*)lds_raw;
    const int G = gridDim.x, bx = blockIdx.x, vcu = (G % 8 == 0) ? (bx % 8) * (G / 8) + bx / 8 : bx;
    const int NGW = G * NWAVES;
    unsigned char* ws = args.ws;
    unsigned* ctl = (unsigned*)(ws + WS_CTL);
    const int wv0 = __builtin_amdgcn_readfirstlane((int)threadIdx.x >> 6);
    for (int u = opaque_tid(wv0); u < (LDS_BYTES - LDSCTL_OFF) / 4; u += NWAVES * 64) ((LAS unsigned*)(lds + LDSCTL_OFF))[u] = 0u;
    __syncthreads();
    volatile LAS unsigned* MISC = (volatile LAS unsigned*)(lds + MISC_OFF);
    XcdBarrier bar = xcd_barrier_post(ctl + 4096, MISC + 8, wv0);
    LAS int* moetab = (LAS int*)(lds + MOETAB_OFF);

    const float* x = args.in[0]; float* hbuf = args.out;
    f32x2* rope = (f32x2*)(ws + WS_ROPE);
    int* route = (int*)(ws + WS_ROUTE); f32x2* gate = (f32x2*)(ws + WS_GATE); int* posb = (int*)(ws + WS_POS); int* cnt = (int*)(ws + WS_CNT);
    unsigned char* act = ws + WS_ACT;
    bf16_t* XN = (bf16_t*)(act + A_XN); bf16_t* DOWN = (bf16_t*)(act + A_DOWN); bf16_t* QB = (bf16_t*)(act + A_Q); bf16_t* KVB = (bf16_t*)(act + A_KV);
    bf16_t* FACT = (bf16_t*)(act + A_FACT); bf16_t* SQKV = (bf16_t*)(act + A_SQKV); bf16_t* XS = (bf16_t*)(act + A_XS); bf16_t* MACT = (bf16_t*)(act + A_MACT);

    if (PH(0)) { PHASE_IDS;
        LAS float* scr = (LAS float*)(lds + wave * 16384);
        for (int j = 0; j < 2; ++j) {
            unsigned char* wb = ws + WS_W + (size_t)j * W_PAIR;
            transpose_matrix<4>(args.in[2] + (size_t)j * DM * 576, DM, 576, (bf16_t*)(wb + W_DQKV), 0, scr, gw, NGW, lane);
            for (int i = gw * 64 + lane; i < (DOWNP - 576) * DM / 8; i += NGW * 64) ((u32x4*)(wb + W_DQKV + (size_t)576 * DM * 2))[i] = (u32x4){0u, 0u, 0u, 0u};
            transpose_matrix<3>(args.in[4] + (size_t)j * 256 * NQ, 256, NQ, (bf16_t*)(wb + W_UQ), 0, scr, gw, NGW, lane);
            transpose_matrix<0>(args.in[6] + (size_t)j * 256 * 1024, 256, 1024, (bf16_t*)(wb + W_UKV), 0, scr, gw, NGW, lane);
            transpose_matrix<0>(args.in[7] + (size_t)j * 256 * 1024, 256, 1024, (bf16_t*)(wb + W_UKV), 1024, scr, gw, NGW, lane);
            transpose_matrix<0>(args.in[8] + (size_t)j * DM * DM, DM, DM, (bf16_t*)(wb + W_MO), 0, scr, gw, NGW, lane);
            transpose_matrix<0>(args.in[10] + (size_t)j * DM * SWA_NQKV, DM, SWA_NQKV, (bf16_t*)(wb + W_SQKV), 0, scr, gw, NGW, lane);
            transpose_matrix<0>(args.in[12] + (size_t)j * DM * DM, DM, DM, (bf16_t*)(wb + W_SO), 0, scr, gw, NGW, lane);
            transpose_matrix<1>(args.in[14] + (size_t)j * DM * FFN, DM, FFN, (bf16_t*)(wb + W_FGU), 0, scr, gw, NGW, lane);
            transpose_matrix<2>(args.in[15] + (size_t)j * DM * FFN, DM, FFN, (bf16_t*)(wb + W_FGU), 0, scr, gw, NGW, lane);
            transpose_matrix<0>(args.in[16] + (size_t)j * FFN * DM, FFN, DM, (bf16_t*)(wb + W_FD), 0, scr, gw, NGW, lane);
            for (int e = 0; e < NE; ++e) {
                transpose_matrix<1>(args.in[19] + ((size_t)j * NE + e) * DM * ED, DM, ED, (bf16_t*)(wb + W_MGU), e * 2 * ED, scr, gw, NGW, lane);
                transpose_matrix<2>(args.in[20] + ((size_t)j * NE + e) * DM * ED, DM, ED, (bf16_t*)(wb + W_MGU), e * 2 * ED, scr, gw, NGW, lane);
                transpose_matrix<0>(args.in[21] + ((size_t)j * NE + e) * ED * DM, ED, DM, (bf16_t*)(wb + W_MD), e * DM, scr, gw, NGW, lane);
            }
        }
        for (int i = gw * 64 + lane; i < SEQ * 32; i += NGW * 64) { const int pos = i >> 5, k = i & 31;
            const float inv = __builtin_amdgcn_exp2f(-(float)k * (13.287712379549449f / 32.0f));
            const float ang = (float)pos * inv; float tt = ang * 0.15915494309189535f; tt -= rintf(tt);
            rope[i] = (f32x2){__builtin_amdgcn_cosf(tt), __builtin_amdgcn_sinf(tt)}; }
        f32x4 gv[4];
#pragma unroll
        for (int j = 0; j < 4; ++j) gv[j] = ((const f32x4*)args.in[1])[lane + 64 * j];
        for (int m = gw; m < NTOK; m += NGW) rms_row_to_bf16(x + (size_t)m * DM, gv, XN + (size_t)m * DM, lane);
    }
    xcd_barrier(bar);

    pair_body<0>(args, lds, bar, G, bx, vcu);
    pair_body<1>(args, lds, bar, G, bx, vcu);
}

extern "C" void kernel_launch(void* const* d_in, const int* in_sizes, int n_in, void* d_out, int out_size, void* d_ws, size_t ws_size, hipStream_t stream) {
    static int grid = 0;
    if (grid == 0) {
        if (n_in != 23 || out_size != NTOK * DM || ws_size < WS_NEED) { fprintf(stderr, "kernel_launch: shape/workspace mismatch (n_in %d out %d ws %zu need %zu)\n", n_in, out_size, ws_size, (size_t)WS_NEED); grid = -1; return; }
        int dev = 0, cus = 0;
        if (hipGetDevice(&dev) != hipSuccess || hipDeviceGetAttribute(&cus, hipDeviceAttributeMultiprocessorCount, dev) != hipSuccess) { grid = -1; return; }
        if (hipFuncSetAttribute((const void*)fwd, hipFuncAttributeMaxDynamicSharedMemorySize, LDS_BYTES) != hipSuccess) { fprintf(stderr, "kernel_launch: hipFuncSetAttribute failed\n"); grid = -1; return; }
        int per_cu = 0;
        if (hipOccupancyMaxActiveBlocksPerMultiprocessor(&per_cu, (const void*)fwd, NWAVES * 64, LDS_BYTES) != hipSuccess || per_cu < 1) fprintf(stderr, "kernel_launch: occupancy query reports %d\n", per_cu);
        (void)hipGetLastError();
        grid = cus;
    }
    if (grid < 0) return;
    if (hipMemsetAsync((char*)d_ws + WS_CTL, 0, CTL_ZERO_BYTES, stream) != hipSuccess) return;
    Args a{};
    for (int i = 0; i < 23; ++i) a.in[i] = (const float*)d_in[i];
    a.out = (float*)d_out; a.ws = (unsigned char*)d_ws;
    hipLaunchKernelGGL(fwd, dim3(grid), dim3(NWAVES * 64), LDS_BYTES, stream, a);
    const hipError_t le = hipPeekAtLastError();
    if (le != hipSuccess) fprintf(stderr, "kernel_launch: launch failed: %s\n", hipGetErrorName(le));
}
```

```cpp
#include <hip/hip_runtime.h>
#include <hip/hip_bf16.h>
#include <cstdio>
#include <cstdint>

#define LAS __attribute__((address_space(3)))
#define GAS __attribute__((address_space(1)))
typedef unsigned short bf16_t;
typedef short bf16x8 __attribute__((ext_vector_type(8)));
typedef short s16x4 __attribute__((ext_vector_type(4)));
typedef float f32x4 __attribute__((ext_vector_type(4)));
typedef float f32x2 __attribute__((ext_vector_type(2)));
typedef float f32x16 __attribute__((ext_vector_type(16)));
typedef unsigned u32x4 __attribute__((ext_vector_type(4)));
typedef unsigned u32x2 __attribute__((ext_vector_type(2)));
typedef int i32x4 __attribute__((ext_vector_type(4)));

constexpr int DM = 1024, BATCH = 32, SEQ = 2048, NTOK = BATCH * SEQ;
constexpr int MLA_H = 8, QKD = 192, DOWNP = 768;
constexpr int NQ = MLA_H * QKD  , NKV = 2048;
constexpr int SWA_NQKV = 1536;
constexpr int FFN = 2816, NE = 8, ED = 2048;
constexpr int NPAIR = NTOK * 2;
constexpr float EPS = 1e-6f;
constexpr float LOG2E = 1.4426950408889634f;
#ifndef PHMASK
#define PHMASK 0xFFFFFFFFu
#endif
#define PH(k) (((PHMASK) >> (k)) & 1u)
#define RESID_SCALE 1.0f

constexpr size_t MiB = 1u << 20;
constexpr size_t WS_CTL = 0, CTL_ZERO_BYTES = 1 * MiB;
constexpr size_t WS_ROPE = 1 * MiB;
constexpr size_t WS_ROUTE = 2 * MiB;
constexpr size_t WS_GATE = 3 * MiB;
constexpr size_t WS_POS = 4 * MiB;
constexpr size_t WS_CNT = 5 * MiB;
constexpr size_t WS_W = 6 * MiB;
constexpr size_t W_DQKV = 0;
constexpr size_t W_UQ = W_DQKV + (size_t)DOWNP * DM * 2;
constexpr size_t W_UKV = W_UQ + (size_t)NQ * 256 * 2;
constexpr size_t W_MO = W_UKV + (size_t)NKV * 256 * 2;
constexpr size_t W_SQKV = W_MO + (size_t)DM * DM * 2;
constexpr size_t W_SO = W_SQKV + (size_t)SWA_NQKV * DM * 2;
constexpr size_t W_FGU = W_SO + (size_t)DM * DM * 2;
constexpr size_t W_FD = W_FGU + (size_t)2 * FFN * DM * 2;
constexpr size_t W_MGU = W_FD + (size_t)DM * FFN * 2;
constexpr size_t W_MD = W_MGU + (size_t)NE * 2 * ED * DM * 2;
constexpr size_t W_PAIR = W_MD + (size_t)NE * DM * ED * 2;
constexpr size_t WS_ACT = 254 * MiB;
static_assert(WS_W + 2 * W_PAIR <= WS_ACT, "weights fit");
constexpr size_t A_H = 0;
constexpr size_t A_XN = 128 * MiB;
constexpr size_t A_DOWN = 256 * MiB;
constexpr size_t A_Q = 352 * MiB;
constexpr size_t A_FACT = 128 * MiB;
constexpr size_t A_SQKV = 128 * MiB;
constexpr size_t A_SO = 320 * MiB;
constexpr size_t A_MACT = 128 * MiB;
constexpr size_t A_STAT = 768 * MiB;
constexpr size_t WS_NEED = WS_ACT + 770 * MiB;
static_assert(WS_NEED <= 1024 * MiB, "ws");

constexpr int RING_BYTES = 147456;
constexpr int LDSCTL_OFF = RING_BYTES;
constexpr int MISC_OFF = LDSCTL_OFF + 320;
constexpr int PART_OFF = LDSCTL_OFF + 2048;
constexpr int MOETAB_OFF = LDSCTL_OFF + 1024;
constexpr int LDS_BYTES = 163840;

#define RLX_AGENT __ATOMIC_RELAXED, __HIP_MEMORY_SCOPE_AGENT
#define LDS_WAIT() asm volatile("s_waitcnt lgkmcnt(0)" ::: "memory")
#define VM_WAIT() asm volatile("s_waitcnt vmcnt(0)" ::: "memory")
#define SBAR() __builtin_amdgcn_sched_barrier(0)
__device__ __forceinline__ unsigned f2bf(float f) { unsigned u = __builtin_bit_cast(unsigned, f); return (u + 0x7fffu + ((u >> 16) & 1u)) >> 16; }
__device__ __forceinline__ unsigned pk2(float lo, float hi) { return f2bf(lo) | (f2bf(hi) << 16); }
__device__ __forceinline__ unsigned cvt_pk_bf16(float lo, float hi) { unsigned r; asm volatile("v_cvt_pk_bf16_f32 %0, %1, %2" : "=v"(r) : "v"(lo), "v"(hi)); return r; }
__device__ __forceinline__ float bf_lo(unsigned w) { return __builtin_bit_cast(float, w << 16); }
__device__ __forceinline__ float bf_hi(unsigned w) { return __builtin_bit_cast(float, w & 0xffff0000u); }
__device__ __forceinline__ int opaque_tid(int wv) { int l; asm volatile("v_mbcnt_lo_u32_b32 %0, -1, 0\n\tv_mbcnt_hi_u32_b32 %0, -1, %0" : "=v"(l)); return wv * 64 + l; }
__device__ __forceinline__ int opaque_lane() { int l; asm volatile("v_mbcnt_lo_u32_b32 %0, -1, 0\n\tv_mbcnt_hi_u32_b32 %0, -1, %0" : "=v"(l)); return l; }
__device__ __forceinline__ void glds16_s(const void* sbase, unsigned voff, unsigned lds_dst) {
    unsigned keep;
    asm volatile("s_mov_b32 %0, m0\n\ts_mov_b32 m0, %3\n\ts_nop 0\n\tglobal_load_lds_dwordx4 %1, %2\n\ts_mov_b32 m0, %0" : "=&s"(keep) : "v"(voff), "s"(sbase), "s"(lds_dst) : "memory");
}
__device__ __forceinline__ float shx(float v, int o, int lane) { return __builtin_bit_cast(float, __builtin_amdgcn_ds_bpermute((lane ^ o) << 2, __builtin_bit_cast(int, v))); }
__device__ __forceinline__ int shxi(int v, int o, int lane) { return __builtin_amdgcn_ds_bpermute((lane ^ o) << 2, v); }
__device__ __forceinline__ float wave_sum(float v, int lane) {
#pragma unroll
    for (int o = 1; o < 64; o <<= 1) v += shx(v, o, lane);
    return v;
}

#define XB_TMO      128
#define XB_XCNT(j)  (256  + 64 * (j))
#define XB_XSUB(j)  (1280 + 64 * (j))
#define XB_XGEN(j)  (2304 + 64 * (j))
#define XB_TOP      3328
#define XB_TOPGEN   3392
#define XCD_BAR_WORDS 3456
#define XB_SPIN_CAP (1u << 18)
__device__ __forceinline__ unsigned xb_ld(unsigned* p)              { return __hip_atomic_load(p, __ATOMIC_RELAXED, __HIP_MEMORY_SCOPE_AGENT); }
__device__ __forceinline__ unsigned xb_add(unsigned* p, unsigned v) { return __hip_atomic_fetch_add(p, v, __ATOMIC_RELAXED, __HIP_MEMORY_SCOPE_AGENT); }
__device__ __forceinline__ unsigned xb_xcc_id() { return (unsigned)__builtin_amdgcn_s_getreg((3 << 11) | 20) & 0xFu; }
#define XB_SPIN(cond, bar) do { unsigned _sp = 0; while (cond) { __builtin_amdgcn_s_sleep(1); \
    if ((++_sp & 255u) == 0u) { if (xb_ld(&(bar)[XB_TMO])) break; if (_sp > XB_SPIN_CAP) { atomicAdd(&(bar)[XB_TMO], 1u); break; } } } } while (0)
struct XcdBarrier { unsigned* bar; unsigned x; volatile LAS unsigned* st; int wv; };
__device__ __forceinline__ XcdBarrier xcd_barrier_post(unsigned* bar, volatile LAS unsigned* st, int wv) {
    XcdBarrier b; b.bar = bar; b.x = xb_xcc_id(); b.st = st; b.wv = wv;
    if (opaque_tid(wv) == 0) (void)xb_add(&bar[XB_XCNT(b.x)], 1u);
    return b;
}
__device__ __forceinline__ void xcd_barrier_complete(unsigned* bar, unsigned x, unsigned& nloc, unsigned& nx) {
    const unsigned G = gridDim.x * gridDim.y * gridDim.z;
    unsigned sum, cnt, mine, sp = 0u;
    for (;;) {
        sum = 0u; cnt = 0u; mine = 0u;
#pragma unroll
        for (unsigned j = 0; j < 16; ++j) { const unsigned c = xb_ld(&bar[XB_XCNT(j)]); sum += c; cnt += (c > 0u) ? 1u : 0u; mine = (j == x) ? c : mine; }
        if (sum == G) break;
        __builtin_amdgcn_s_sleep(1);
        if ((++sp & 255u) == 0u) { if (xb_ld(&bar[XB_TMO])) break; if (sp > XB_SPIN_CAP) { atomicAdd(&bar[XB_TMO], 1u); break; } }
    }
    nloc = mine > 0u ? mine : 1u; nx = cnt > 0u ? cnt : 1u;
}
__device__ __forceinline__ void xcd_barrier(const XcdBarrier& b) {
    asm volatile("s_waitcnt vmcnt(0)" ::: "memory");
    __syncthreads();
    if (opaque_tid(b.wv) == 0) {
        unsigned* bar = b.bar;
        __builtin_amdgcn_s_waitcnt(0);
        unsigned nloc = b.st[0], nx = b.st[1];
        if (nloc == 0u) { xcd_barrier_complete(bar, b.x, nloc, nx); b.st[0] = nloc; b.st[1] = nx; }
        const unsigned old = xb_add(&bar[XB_XSUB(b.x)], 1u);
        const unsigned gen = old / nloc;
        if (old + 1u == (gen + 1u) * nloc) {
            __builtin_amdgcn_fence(__ATOMIC_RELEASE, "agent");
            asm volatile("s_waitcnt vmcnt(0)" ::: "memory");
            const unsigned og = xb_add(&bar[XB_TOP], 1u);
            const unsigned tg = og / nx;
            if (og + 1u == (tg + 1u) * nx) xb_add(&bar[XB_TOPGEN], 1u);
            else XB_SPIN(xb_ld(&bar[XB_TOPGEN]) == tg, bar);
            __builtin_amdgcn_fence(__ATOMIC_ACQUIRE, "agent");
            xb_add(&bar[XB_XGEN(b.x)], 1u);
            asm volatile("s_waitcnt vmcnt(0)" ::: "memory");
        } else {
            XB_SPIN(xb_ld(&bar[XB_XGEN(b.x)]) == gen, bar);
            __builtin_amdgcn_fence(__ATOMIC_ACQUIRE, "agent");
            asm volatile("s_waitcnt vmcnt(0)" ::: "memory");
        }
    }
    __syncthreads();
}

namespace pg8 {
constexpr int BM = 256, BK = 64, HALF = 128, HTB = HALF * BK * 2, STAGE_BYTES = 8 * HTB, NXCD = 8, WGM = 8;
__host__ __device__ __forceinline__ int lds_byte(int r, int c) { const int st = (r >> 4) * 2 + (c >> 5), rr = r & 15, cc = c & 31, ob = rr * 64 + cc * 2; return st * 1024 + (ob ^ (((ob >> 9) & 1) << 5)); }
__host__ __device__ __forceinline__ void stage_rc(int b, int& R, int& C) { const int st = b / 1024, sb = b % 1024, swz = sb ^ (((sb >> 9) & 1) << 5); R = (st >> 1) * 16 + swz / 64; C = (st & 1) * 32 + (swz % 64) / 2; }
__host__ __device__ __forceinline__ int perm32(int rho) { const int n = rho >> 4, i = rho & 15; return 8 * (i >> 2) + 4 * n + (i & 3); }

struct Unit { int arow, brow, col, nvalid, nlo; };
struct Gemm { const bf16_t* A; const bf16_t* Bt; int lda, ldb, K; };

struct DenseOrder {
    int nM, nN, nwg, G, c, colw;
    __device__ void init(int M, int N, int G_, int c_, int colw_) { nM = M / BM; nN = N / BM; nwg = nM * nN; G = G_; c = c_; colw = colw_; }
    __device__ __forceinline__ bool next(int i, Unit& u) const {
        const long L = (long)i * G + c; if (L >= nwg) return false;
        int wgid = (int)L; { const int q = nwg / NXCD, r = nwg % NXCD, xcd = wgid % NXCD, off = wgid / NXCD; wgid = (xcd < r ? xcd * (q + 1) : r * (q + 1) + (xcd - r) * q) + off; }
        const int nig = WGM * nN, gid = wgid / nig, fm = gid * WGM, gsz = (nM - fm) < WGM ? (nM - fm) : WGM;
        const int pm = fm + ((wgid % nig) % gsz), pn = (wgid % nig) / gsz;
        u.arow = pm * BM; u.brow = pn * BM; u.col = pn * colw; u.nvalid = BM; u.nlo = 0; return true;
    }
};
struct GroupedOrder {
    int nM, nN, nwg, G, c, colw, erows; const LAS int* tab;
    __device__ void init(const LAS int* tab_, int N, int G_, int c_, int colw_) { tab = tab_; nM = tab_[8]; nN = N / BM; nwg = nM * nN; G = G_; c = c_; colw = colw_; erows = N; }
    __device__ __forceinline__ bool next(int i, Unit& u) const {
        const long L = (long)i * G + c; if (L >= nwg) return false;
        int wgid = (int)L; { const int q = nwg / NXCD, r = nwg % NXCD, xcd = wgid % NXCD, off = wgid / NXCD; wgid = (xcd < r ? xcd * (q + 1) : r * (q + 1) + (xcd - r) * q) + off; }
        const int nig = WGM * nN, gid = wgid / nig, fm = gid * WGM, gsz = (nM - fm) < WGM ? (nM - fm) : WGM;
        const int T = fm + ((wgid % nig) % gsz), pn = (wgid % nig) / gsz;
        int e = 0;
#pragma unroll
        for (int k = 1; k < 8; ++k) e += (T >= tab[k]) ? 1 : 0;
        const int lt = T - tab[e]; int arow = tab[16 + e] + lt * BM; int nv = tab[16 + e + 1] - arow; nv = nv > BM ? BM : nv;
        int lo = 0; { const int over = arow + BM - tab[24]; if (over > 0) { arow -= over; lo = over; nv += over; } }
        u.arow = __builtin_amdgcn_readfirstlane(arow); u.nvalid = __builtin_amdgcn_readfirstlane(nv); u.nlo = __builtin_amdgcn_readfirstlane(lo);
        u.brow = __builtin_amdgcn_readfirstlane(e * erows + pn * BM); u.col = __builtin_amdgcn_readfirstlane(pn * colw); return true;
    }
};

template <int NS> __device__ __forceinline__ float row_rstd(const float* stat, int row, int slot0, float inv_n) {
    float s;
    if (NS == 4) { const f32x4 a = *(const f32x4*)(stat + (size_t)row * 4); s = (a.x + a.y) + (a.z + a.w); }
    else s = stat[(size_t)row * 4 + slot0];
    return __builtin_amdgcn_rsqf(s + EPS / inv_n) * __builtin_sqrtf(1.0f / inv_n);
}
template <int NS> __device__ __forceinline__ void row_rstd8(float (&rs)[2][4], const float* stat, int row0, int slot0, float inv_n) {
#pragma unroll
    for (int ai = 0; ai < 2; ++ai)
#pragma unroll
        for (int m = 0; m < 4; ++m) rs[ai][m] = NS ? row_rstd<NS ? NS : 1>(stat, row0 + ai * HALF + m * 16, slot0, inv_n) : 1.f;
}
__device__ __forceinline__ void stat_combine(LAS float* part, float* stat, const Unit& u, int slot, int wr, int wc, int fr, int fq) {
    asm volatile("s_waitcnt lgkmcnt(0)" ::: "memory"); __builtin_amdgcn_s_barrier(); asm volatile("" ::: "memory");
    const int t = (wr * 4 + wc) * 64 + fq * 16 + fr;
    if (t < 256) { const float sum = (part[t] + part[256 + t]) + (part[512 + t] + part[768 + t]); stat[(size_t)(u.arow + t) * 4 + slot] = sum; }
}
template <bool MASK, int NS> struct EpiBf16 {
    static constexpr bool PERM = true;
    bf16_t* O; int ldc; const float* stat; int slot0; float inv_n;
    __device__ __forceinline__ void operator()(const f32x4 (&acc)[2][2][4][2], const Unit& u, int wr, int wc, int fr, int fq) const {
        const int col0 = u.col + wc * 32 + 8 * fq;
        float rs[2][4]; row_rstd8<NS>(rs, stat, u.arow + wr * 64 + fr, slot0, inv_n);
#pragma unroll
        for (int ai = 0; ai < 2; ++ai)
#pragma unroll
            for (int m = 0; m < 4; ++m) { const int rl = ai * HALF + wr * 64 + m * 16 + fr; if (MASK && (rl >= u.nvalid || rl < u.nlo)) continue;
                const float r = rs[ai][m];
                bf16_t* rowp = O + (size_t)(u.arow + rl) * ldc + col0;
#pragma unroll
                for (int bj = 0; bj < 2; ++bj) { const f32x4 v0 = acc[ai][bj][m][0] * r, v1 = acc[ai][bj][m][1] * r;
                    u32x4 w; w.x = cvt_pk_bf16(v0[0], v0[1]); w.y = cvt_pk_bf16(v0[2], v0[3]); w.z = cvt_pk_bf16(v1[0], v1[1]); w.w = cvt_pk_bf16(v1[2], v1[3]);
                    *(u32x4*)(rowp + bj * HALF) = w; } }
    }
};
template <bool MASK, int NS> struct EpiSwiGLU {
    static constexpr bool PERM = true;
    bf16_t* O; int ldc; const float* stat; float inv_n;
    __device__ __forceinline__ void operator()(const f32x4 (&acc)[2][2][4][2], const Unit& u, int wr, int wc, int fr, int fq) const {
        const int col0 = u.col + wc * 32 + 8 * fq;
        float rs[2][4]; row_rstd8<NS>(rs, stat, u.arow + wr * 64 + fr, 0, inv_n);
#pragma unroll
        for (int ai = 0; ai < 2; ++ai)
#pragma unroll
            for (int m = 0; m < 4; ++m) { const int rl = ai * HALF + wr * 64 + m * 16 + fr; if (MASK && (rl >= u.nvalid || rl < u.nlo)) continue;
                const float r = rs[ai][m];
                float o[8];
#pragma unroll
                for (int n = 0; n < 2; ++n)
#pragma unroll
                    for (int k = 0; k < 4; ++k) { const float g = acc[ai][0][m][n][k] * r, up = acc[ai][1][m][n][k] * r;
                        const float sg = __builtin_amdgcn_rcpf(1.0f + __builtin_amdgcn_exp2f(-g * LOG2E)); o[n * 4 + k] = g * sg * up; }
                u32x4 w; w.x = cvt_pk_bf16(o[0], o[1]); w.y = cvt_pk_bf16(o[2], o[3]); w.z = cvt_pk_bf16(o[4], o[5]); w.w = cvt_pk_bf16(o[6], o[7]);
                *(u32x4*)(O + (size_t)(u.arow + rl) * ldc + col0) = w; }
    }
};
template <bool BASE_F32> struct EpiResid {
    static constexpr bool PERM = true;
    const void* base; bf16_t* out; float* stat; LAS float* part; float scale;
    __device__ __forceinline__ void operator()(f32x4 (&acc)[2][2][4][2], const Unit& u, int wr, int wc, int fr, int fq) const {
        const int col0 = u.col + wc * 32 + 8 * fq; const int lane = fq * 16 + fr;
#pragma unroll
        for (int ai = 0; ai < 2; ++ai)
#pragma unroll
          for (int mh = 0; mh < 2; ++mh) {
            if (BASE_F32) { f32x4 t[2][2][2];
#pragma unroll
                for (int m = 0; m < 2; ++m) { const float* bp = (const float*)base + (size_t)(u.arow + ai * HALF + wr * 64 + (mh * 2 + m) * 16 + fr) * DM + col0;
#pragma unroll
                    for (int bj = 0; bj < 2; ++bj)
#pragma unroll
                        for (int n = 0; n < 2; ++n) t[m][bj][n] = *(const f32x4*)(bp + bj * HALF + n * 4); }
#pragma unroll
                for (int m = 0; m < 2; ++m)
#pragma unroll
                    for (int bj = 0; bj < 2; ++bj)
#pragma unroll
                        for (int n = 0; n < 2; ++n) acc[ai][bj][mh * 2 + m][n] = acc[ai][bj][mh * 2 + m][n] * scale + t[m][bj][n];
            } else { u32x4 t[2][2];
#pragma unroll
                for (int m = 0; m < 2; ++m) { const bf16_t* bp = (const bf16_t*)base + (size_t)(u.arow + ai * HALF + wr * 64 + (mh * 2 + m) * 16 + fr) * DM + col0;
#pragma unroll
                    for (int bj = 0; bj < 2; ++bj) t[m][bj] = *(const u32x4*)(bp + bj * HALF); }
#pragma unroll
                for (int m = 0; m < 2; ++m)
#pragma unroll
                    for (int bj = 0; bj < 2; ++bj) { const u32x4 w = t[m][bj];
                        acc[ai][bj][mh * 2 + m][0] = acc[ai][bj][mh * 2 + m][0] * scale + (f32x4){bf_lo(w.x), bf_hi(w.x), bf_lo(w.y), bf_hi(w.y)};
                        acc[ai][bj][mh * 2 + m][1] = acc[ai][bj][mh * 2 + m][1] * scale + (f32x4){bf_lo(w.z), bf_hi(w.z), bf_lo(w.w), bf_hi(w.w)}; }
            }
#pragma unroll
            for (int m = 0; m < 2; ++m)
                asm volatile("" : "+v"(acc[ai][0][mh * 2 + m][0]), "+v"(acc[ai][0][mh * 2 + m][1]), "+v"(acc[ai][1][mh * 2 + m][0]), "+v"(acc[ai][1][mh * 2 + m][1]) :: "memory"); }
#pragma unroll
        for (int ai = 0; ai < 2; ++ai)
#pragma unroll
            for (int m = 0; m < 4; ++m) { const int rl = ai * HALF + wr * 64 + m * 16 + fr; const size_t off = (size_t)(u.arow + rl) * DM + col0; float ss = 0.f;
#pragma unroll
                for (int bj = 0; bj < 2; ++bj) { const f32x4 h0 = acc[ai][bj][m][0], h1 = acc[ai][bj][m][1];
                    ss += ((h0.x * h0.x + h0.y * h0.y) + (h0.z * h0.z + h0.w * h0.w)) + ((h1.x * h1.x + h1.y * h1.y) + (h1.z * h1.z + h1.w * h1.w));
                    u32x4 w; w.x = cvt_pk_bf16(h0.x, h0.y); w.y = cvt_pk_bf16(h0.z, h0.w); w.z = cvt_pk_bf16(h1.x, h1.y); w.w = cvt_pk_bf16(h1.z, h1.w);
                    *(u32x4*)(out + off + bj * HALF) = w; }
                ss += shx(ss, 16, lane); ss += shx(ss, 32, lane); if (fq == 0) part[wc * 256 + rl] = ss; }
        stat_combine(part, stat, u, u.col >> 8, wr, wc, fr, fq);
    }
};
__device__ __forceinline__ void rope_inv4(float (&inv)[4], int i0) {
#pragma unroll
    for (int k = 0; k < 4; ++k) inv[k] = __builtin_amdgcn_exp2f(-(float)(i0 + k) * (13.287712379549449f / 32.0f)) * 0.15915494309189535f;
}
__device__ __forceinline__ void rope8(f32x4& v0, f32x4& v1, float pos, const float (&inv)[4]) {
    float c[4], sn[4];
#pragma unroll
    for (int k = 0; k < 4; ++k) { float t = pos * inv[k]; t -= rintf(t); c[k] = __builtin_amdgcn_cosf(t); sn[k] = __builtin_amdgcn_sinf(t); }
    const float a0 = v0[0] * c[0] - v0[1] * sn[0], b0 = v0[1] * c[0] + v0[0] * sn[0];
    const float a1 = v0[2] * c[1] - v0[3] * sn[1], b1 = v0[3] * c[1] + v0[2] * sn[1];
    const float a2 = v1[0] * c[2] - v1[1] * sn[2], b2 = v1[1] * c[2] + v1[0] * sn[2];
    const float a3 = v1[2] * c[3] - v1[3] * sn[3], b3 = v1[3] * c[3] + v1[2] * sn[3];
    v0 = (f32x4){a0, b0, a1, b1}; v1 = (f32x4){a2, b2, a3, b3};
}
struct EpiQRope {
    static constexpr bool PERM = true;
    bf16_t* O;
    __device__ __forceinline__ void operator()(const f32x4 (&acc)[2][2][4][2], const Unit& u, int wr, int wc, int fr, int fq) const {
        const int col0 = u.col + wc * 32 + 8 * fq;
#pragma unroll
        for (int bj = 0; bj < 2; ++bj) { const int c = col0 + bj * HALF, d = c % QKD; const bool isr = d >= 128; float inv[4]; rope_inv4(inv, isr ? ((d - 128) >> 1) : 0);
#pragma unroll
            for (int ai = 0; ai < 2; ++ai)
#pragma unroll
                for (int m = 0; m < 4; ++m) { const int row = u.arow + ai * HALF + wr * 64 + m * 16 + fr;
                    f32x4 v0 = acc[ai][bj][m][0], v1 = acc[ai][bj][m][1];
                    if (isr) rope8(v0, v1, (float)(row & (SEQ - 1)), inv);
                    u32x4 w; w.x = cvt_pk_bf16(v0[0], v0[1]); w.y = cvt_pk_bf16(v0[2], v0[3]); w.z = cvt_pk_bf16(v1[0], v1[1]); w.w = cvt_pk_bf16(v1[2], v1[3]);
                    *(u32x4*)(O + (size_t)row * NQ + c) = w; } }
    }
};
struct EpiDown {
    static constexpr bool PERM = true;
    bf16_t* O; float* stat; LAS float* part;
    __device__ __forceinline__ void operator()(const f32x4 (&acc)[2][2][4][2], const Unit& u, int wr, int wc, int fr, int fq) const {
        const int col0 = u.col + wc * 32 + 8 * fq, pn = u.col >> 8, lane = fq * 16 + fr;
        if (pn < 2) {
#pragma unroll
            for (int ai = 0; ai < 2; ++ai)
#pragma unroll
                for (int m = 0; m < 4; ++m) { const int rl = ai * HALF + wr * 64 + m * 16 + fr; float ss = 0.f;
#pragma unroll
                    for (int bj = 0; bj < 2; ++bj) { const f32x4 v0 = acc[ai][bj][m][0], v1 = acc[ai][bj][m][1];
                        ss += ((v0.x * v0.x + v0.y * v0.y) + (v0.z * v0.z + v0.w * v0.w)) + ((v1.x * v1.x + v1.y * v1.y) + (v1.z * v1.z + v1.w * v1.w));
                        u32x4 w; w.x = cvt_pk_bf16(v0[0], v0[1]); w.y = cvt_pk_bf16(v0[2], v0[3]); w.z = cvt_pk_bf16(v1[0], v1[1]); w.w = cvt_pk_bf16(v1[2], v1[3]);
                        *(u32x4*)(O + (size_t)(u.arow + rl) * DOWNP + col0 + bj * HALF) = w; }
                    ss += shx(ss, 16, lane); ss += shx(ss, 32, lane); if (fq == 0) part[wc * 256 + rl] = ss; }
        } else if (wc < 2) {
            float inv[4]; rope_inv4(inv, wc * 16 + 4 * fq);
#pragma unroll
            for (int ai = 0; ai < 2; ++ai)
#pragma unroll
                for (int m = 0; m < 4; ++m) { const int row = u.arow + ai * HALF + wr * 64 + m * 16 + fr;
                    f32x4 v0 = acc[ai][0][m][0], v1 = acc[ai][0][m][1];
                    rope8(v0, v1, (float)(row & (SEQ - 1)), inv);
                    u32x4 w; w.x = cvt_pk_bf16(v0[0], v0[1]); w.y = cvt_pk_bf16(v0[2], v0[3]); w.z = cvt_pk_bf16(v1[0], v1[1]); w.w = cvt_pk_bf16(v1[2], v1[3]);
                    *(u32x4*)(O + (size_t)row * DOWNP + col0) = w; }
        }
        if (pn < 2) stat_combine(part, stat, u, pn, wr, wc, fr, fq);
        else { asm volatile("s_waitcnt lgkmcnt(0)" ::: "memory"); __builtin_amdgcn_s_barrier(); }
    }
};

template <class Epi, class Sched, bool ALIGN_EPI>
__device__ __forceinline__ void gemm_phase(LAS unsigned char* lds, const Gemm g, const Sched& S, const Epi& E, const int wv) {
    const int tid = opaque_tid(wv), wid = __builtin_amdgcn_readfirstlane(tid >> 6), lane = tid & 63, wr = wid >> 2, wc = wid & 3, fr = lane & 15, fq = lane >> 4;
    const int K = g.K, nt = K / BK;
    unsigned voffA[2], voffB[2];
#pragma unroll
    for (int i = 0; i < 2; ++i) { int R, C; stage_rc(tid * 16 + i * 8192, R, C); const int Rb = Epi::PERM ? ((R & ~31) + perm32(R & 31)) : R;
        voffA[i] = (unsigned)(R * g.lda + C) * 2u; voffB[i] = (unsigned)(Rb * g.ldb + C) * 2u; }
    const size_t kstep = (size_t)(BK * 2);
    const size_t hsA = (size_t)HALF * g.lda * 2, hsB = (size_t)HALF * g.ldb * 2;
    const unsigned ldsw = (unsigned)wid * 1024u, ldsb = (unsigned)(uintptr_t)lds;
    const int aoff = lds_byte(wr * 64 + fr, fq * 8), boff = lds_byte(wc * 32 + fr, fq * 8);
#define PG8_SA(b, h) (((b) * 2 + (h)) * HTB)
#define PG8_SB(b, h) ((4 + (b) * 2 + (h)) * HTB)
#define PG8_STAGE(bufoff, gbase, voff) do { _Pragma("unroll") for (int _i = 0; _i < 2; ++_i) \
        glds16_s((const char*)(gbase), (voff)[_i], ldsb + (unsigned)(bufoff) + ldsw + (unsigned)(_i * 8192)); } while (0)
#define PG8_LDA(dst, b, h) do { _Pragma("unroll") for (int m = 0; m < 4; ++m) _Pragma("unroll") for (int k = 0; k < 2; ++k) dst[m][k] = *(const LAS bf16x8*)(lds + PG8_SA(b, h) + aoff + m * 2048 + k * 1024); } while (0)
#define PG8_LDB(dst, b, h) do { _Pragma("unroll") for (int n = 0; n < 2; ++n) _Pragma("unroll") for (int k = 0; k < 2; ++k) dst[n][k] = *(const LAS bf16x8*)(lds + PG8_SB(b, h) + boff + n * 2048 + k * 1024); } while (0)
#define PG8_MMA(ai, bj, At, Bt) do { __builtin_amdgcn_s_setprio(1); _Pragma("unroll") for (int m = 0; m < 4; ++m) _Pragma("unroll") for (int n = 0; n < 2; ++n) _Pragma("unroll") for (int k = 0; k < 2; ++k) \
        acc[ai][bj][m][n] = __builtin_amdgcn_mfma_f32_16x16x32_bf16(Bt[n][k], At[m][k], acc[ai][bj][m][n], 0, 0, 0); __builtin_amdgcn_s_setprio(0); } while (0)
#define PG8_WAIT_V(n) asm volatile("s_waitcnt vmcnt(" #n ")" ::: "memory")
#define PG8_WAIT_L(n) asm volatile("s_waitcnt lgkmcnt(" #n ")" ::: "memory")
#define PG8_BAR __builtin_amdgcn_s_barrier()
#define PG8_SCHED __builtin_amdgcn_sched_barrier(0)
    Unit cur, nxt; int ui = 0;
    if (!S.next(0, cur)) return;
    f32x4 acc[2][2][4][2];
#pragma unroll
    for (int a = 0; a < 2; ++a)
#pragma unroll
        for (int b = 0; b < 2; ++b)
#pragma unroll
            for (int m = 0; m < 4; ++m)
#pragma unroll
                for (int n = 0; n < 2; ++n) acc[a][b][m][n] = (f32x4){0.f, 0.f, 0.f, 0.f};
    bf16x8 At[4][2], B0[2][2], B1[2][2];
    const char* cA = (const char*)g.A + (size_t)cur.arow * g.lda * 2; const char* cB = (const char*)g.Bt + (size_t)cur.brow * g.ldb * 2;
    PG8_STAGE(PG8_SB(0, 0), cB, voffB); PG8_STAGE(PG8_SB(0, 1), cB + hsB, voffB); PG8_STAGE(PG8_SA(0, 0), cA, voffA); PG8_STAGE(PG8_SA(0, 1), cA + hsA, voffA);
    if (wr == 1) PG8_BAR;
    PG8_WAIT_V(2); PG8_BAR;
    PG8_STAGE(PG8_SB(1, 0), cB + kstep, voffB); PG8_STAGE(PG8_SA(1, 0), cA + kstep, voffA); PG8_STAGE(PG8_SB(1, 1), cB + hsB + kstep, voffB);
    PG8_WAIT_V(6); PG8_BAR;
    for (;;) {
        const bool has_next = S.next(ui + 1, nxt);
        const char* nA = has_next ? (const char*)g.A + (size_t)nxt.arow * g.lda * 2 : cA; const char* nB = has_next ? (const char*)g.Bt + (size_t)nxt.brow * g.ldb * 2 : cB;
        for (int t = 0; t < nt; t += 2) {
            const bool last = (t == nt - 2);
            const char* a1 = cA + (size_t)(t + 1) * kstep;
            const char* a2 = last ? nA : cA + (size_t)(t + 2) * kstep; const char* b2 = last ? nB : cB + (size_t)(t + 2) * kstep;
            const char* a3 = a2 + kstep; const char* b3 = b2 + kstep;
            PG8_LDB(B0, 0, 0); PG8_LDB(B1, 0, 1); PG8_SCHED; PG8_LDA(At, 0, 0); PG8_STAGE(PG8_SA(1, 1), a1 + hsA, voffA);
            PG8_WAIT_V(8); PG8_WAIT_L(0); PG8_BAR; PG8_MMA(0, 0, At, B0); PG8_MMA(0, 1, At, B1); PG8_BAR; PG8_SCHED;
            PG8_LDA(At, 0, 1); PG8_STAGE(PG8_SB(0, 0), b2, voffB); PG8_STAGE(PG8_SB(0, 1), b2 + hsB, voffB); PG8_STAGE(PG8_SA(0, 0), a2, voffA);
            PG8_WAIT_V(8); PG8_WAIT_L(0); PG8_BAR; PG8_MMA(1, 0, At, B0); PG8_MMA(1, 1, At, B1); PG8_BAR; PG8_SCHED;
            PG8_LDB(B0, 1, 0); PG8_LDB(B1, 1, 1); PG8_SCHED; PG8_LDA(At, 1, 0); PG8_STAGE(PG8_SA(0, 1), a2 + hsA, voffA);
            PG8_WAIT_V(8); PG8_WAIT_L(0); PG8_BAR; PG8_MMA(0, 0, At, B0); PG8_MMA(0, 1, At, B1); PG8_BAR; PG8_SCHED;
            PG8_LDA(At, 1, 1); PG8_STAGE(PG8_SB(1, 0), b3, voffB); PG8_STAGE(PG8_SB(1, 1), b3 + hsB, voffB); PG8_STAGE(PG8_SA(1, 0), a3, voffA);
            PG8_WAIT_V(8); PG8_WAIT_L(0); PG8_BAR; PG8_MMA(1, 0, At, B0); PG8_MMA(1, 1, At, B1); PG8_BAR; PG8_SCHED;
        }
        if constexpr (ALIGN_EPI) { if (wr == 0) PG8_BAR; }
        { const int l2 = opaque_lane(); E(acc, cur, wr, wc, l2 & 15, l2 >> 4); }
        if (!has_next) break;
#pragma unroll
        for (int a = 0; a < 2; ++a)
#pragma unroll
            for (int b = 0; b < 2; ++b)
#pragma unroll
                for (int m = 0; m < 4; ++m)
#pragma unroll
                    for (int n = 0; n < 2; ++n) acc[a][b][m][n] = (f32x4){0.f, 0.f, 0.f, 0.f};
        cur = nxt; cA = nA; cB = nB; ++ui;
        if constexpr (ALIGN_EPI) { if (wr == 1) PG8_BAR; }
    }
    PG8_WAIT_V(0);
    if constexpr (!ALIGN_EPI) { if (wr == 0) PG8_BAR; }
    PG8_BAR;
#undef PG8_SA
#undef PG8_SB
#undef PG8_STAGE
#undef PG8_LDA
#undef PG8_LDB
#undef PG8_MMA
#undef PG8_WAIT_V
#undef PG8_WAIT_L
#undef PG8_BAR
#undef PG8_SCHED
}
}

__device__ __forceinline__ int crow(int r, int hi) { return (r & 3) + 8 * (r >> 2) + 4 * hi; }
__device__ __forceinline__ int v_rd_base(int lane) { return ((lane & 3) << 3) | (((lane >> 2) & 3) << 6) | (((lane >> 4) & 1) << 5) | (((lane >> 5) & 1) << 8); }
template <int NCB> __device__ __forceinline__ int v_st(int k, int c) { const int kk = (k & ~0xC) | ((k & 4) << 1) | ((k & 8) >> 1); return ((kk >> 3) * NCB + (c >> 5)) * 512 + ((kk & 7) * 32 + (c & 31)) * 2; }
template <int OFF> __device__ __forceinline__ s16x4 tr_read(int vb) {
    s16x4 r; asm volatile("ds_read_b64_tr_b16 %0, %1 offset:%2" : "=&v"(r) : "v"(vb), "i"(OFF) : "memory"); return r;
}
template <int D0, int NCB> __device__ __forceinline__ void pv_one(f32x16& od, int vb, bf16x8 pa0, bf16x8 pa1, bf16x8 pa2, bf16x8 pa3) {
    constexpr int KS = NCB * 1024, HF = NCB * 512;
    const s16x4 l0 = tr_read<D0 * 512 + 0 * KS>(vb), h0 = tr_read<D0 * 512 + 0 * KS + HF>(vb), l1 = tr_read<D0 * 512 + 1 * KS>(vb), h1 = tr_read<D0 * 512 + 1 * KS + HF>(vb);
    const s16x4 l2 = tr_read<D0 * 512 + 2 * KS>(vb), h2 = tr_read<D0 * 512 + 2 * KS + HF>(vb), l3 = tr_read<D0 * 512 + 3 * KS>(vb), h3 = tr_read<D0 * 512 + 3 * KS + HF>(vb);
    asm volatile("s_waitcnt lgkmcnt(0)" ::: "memory"); SBAR();
#define PK(L, H) (bf16x8){L[0], L[1], L[2], L[3], H[0], H[1], H[2], H[3]}
    od = __builtin_amdgcn_mfma_f32_32x32x16_bf16(pa0, PK(l0, h0), od, 0, 0, 0);
    od = __builtin_amdgcn_mfma_f32_32x32x16_bf16(pa1, PK(l1, h1), od, 0, 0, 0);
    od = __builtin_amdgcn_mfma_f32_32x32x16_bf16(pa2, PK(l2, h2), od, 0, 0, 0);
    od = __builtin_amdgcn_mfma_f32_32x32x16_bf16(pa3, PK(l3, h3), od, 0, 0, 0);
#undef PK
}
#define PK4(P, BASE, OUT) do { unsigned a0 = cvt_pk_bf16(P[BASE + 0], P[BASE + 1]), a1 = cvt_pk_bf16(P[BASE + 2], P[BASE + 3]);   \
    unsigned b0 = cvt_pk_bf16(P[BASE + 4], P[BASE + 5]), b1 = cvt_pk_bf16(P[BASE + 6], P[BASE + 7]);                              \
    auto r0 = __builtin_amdgcn_permlane32_swap(a0, b0, false, false); auto r1 = __builtin_amdgcn_permlane32_swap(a1, b1, false, false); \
    u32x4 w = {r0[0], r1[0], r0[1], r1[1]}; OUT = __builtin_bit_cast(bf16x8, w); } while (0)

namespace mla {
constexpr int NW = 8, QBLK = 32, KVBLK = 64, KSTR = 400;
constexpr int SHM_K = KVBLK * KSTR  , SHM_V = KVBLK * 128 * 2  ;
constexpr int OFF_V = 0, OFF_K = 2 * SHM_V, OFF_WS = OFF_K + 2 * SHM_K  , OFF_QR = OFF_WS + NW * 64 * 4  , NQREG = 5  , OFF_END = OFF_QR + NW * (12 - NQREG) * 1024;
static_assert(OFF_END <= RING_BYTES, "mla lds");
constexpr int OSTR = 272;
static_assert(NW * 32 * OSTR <= OFF_WS, "O staging aliases K/V buffers");
constexpr float SCALE = 0.07216878364870323f;
constexpr float THR = 8.f;
constexpr int LDQ = NQ, LDKV = NKV, LDR = DOWNP, LDO = DM;

__device__ __forceinline__ void partialSM(f32x16& p0, f32x16& p1, float& m_reg, float& mn, float& alpha, const float C) {
    float pmax = p0[0];
#pragma unroll
    for (int r = 1; r < 16; ++r) pmax = fmaxf(pmax, p0[r]);
#pragma unroll
    for (int r = 0; r < 16; ++r) pmax = fmaxf(pmax, p1[r]);
    { auto rr = __builtin_amdgcn_permlane32_swap(__float_as_uint(pmax), __float_as_uint(pmax), false, false);
      pmax = fmaxf(__uint_as_float(rr[0]), __uint_as_float(rr[1])); }
    if (__builtin_expect(__all((pmax - m_reg) * C <= THR * LOG2E), 1)) { mn = m_reg; alpha = 1.f; }
    else { mn = fmaxf(m_reg, pmax); alpha = __builtin_amdgcn_exp2f((m_reg - mn) * C); m_reg = mn; }
    const float mnC = -mn * C;
#pragma unroll
    for (int r = 0; r < 16; ++r) p0[r] = fmaf(p0[r], C, mnC);
#pragma unroll
    for (int r = 0; r < 16; ++r) p1[r] = fmaf(p1[r], C, mnC);
#pragma unroll
    for (int r = 0; r < 16; ++r) p0[r] = __builtin_amdgcn_exp2f(p0[r]);
}
__device__ __forceinline__ void finishSM(f32x16& p0, f32x16& p1, float alpha, float& l_reg, bf16x8& pa0, bf16x8& pa1, bf16x8& pa2, bf16x8& pa3) {
#pragma unroll
    for (int r = 0; r < 16; ++r) p1[r] = __builtin_amdgcn_exp2f(p1[r]);
    float ps = 0;
#pragma unroll
    for (int r = 0; r < 16; ++r) ps += p0[r];
#pragma unroll
    for (int r = 0; r < 16; ++r) ps += p1[r];
    { auto rr = __builtin_amdgcn_permlane32_swap(__float_as_uint(ps), __float_as_uint(ps), false, false);
      ps = __uint_as_float(rr[0]) + __uint_as_float(rr[1]); }
    l_reg = l_reg * alpha + ps;
    PK4(p0, 0, pa0); PK4(p0, 8, pa1); PK4(p1, 0, pa2); PK4(p1, 8, pa3);
}
__device__ __forceinline__ void qkt(f32x16& p0, f32x16& p1, const LAS unsigned char* Ks, const bf16x8* qr, const LAS unsigned char* qrl, int r32, int hi) {
    p0 = f32x16{}; p1 = f32x16{};
#pragma unroll
    for (int d0 = 0; d0 < 12; ++d0) { const int cb = (d0 * 16 + hi * 8) * 2;
        const bf16x8 b0 = *(const LAS bf16x8*)(Ks + r32 * KSTR + cb);
        const bf16x8 b1 = *(const LAS bf16x8*)(Ks + (32 + r32) * KSTR + cb);
        const bf16x8 q = d0 < NQREG ? qr[d0 < NQREG ? d0 : 0] : *(const volatile LAS bf16x8*)(qrl + (d0 - NQREG) * 1024);
        p0 = __builtin_amdgcn_mfma_f32_32x32x16_bf16(b0, q, p0, 0, 0, 0);
        p1 = __builtin_amdgcn_mfma_f32_32x32x16_bf16(b1, q, p1, 0, 0, 0); }
}
__device__ __forceinline__ void pv_all(f32x16* o, int vb, bf16x8 pa0, bf16x8 pa1, bf16x8 pa2, bf16x8 pa3) {
    pv_one<0, 4>(o[0], vb, pa0, pa1, pa2, pa3); pv_one<1, 4>(o[1], vb, pa0, pa1, pa2, pa3); pv_one<2, 4>(o[2], vb, pa0, pa1, pa2, pa3); pv_one<3, 4>(o[3], vb, pa0, pa1, pa2, pa3);
}
__device__ __forceinline__ void unit(int b, int h, int qb, const bf16_t* __restrict__ Q, const bf16_t* __restrict__ KV, const bf16_t* __restrict__ DN, const float* __restrict__ stat, bf16_t* __restrict__ O, LAS unsigned char* lds, const int wv) {
    const int tid = opaque_tid(wv), wid = __builtin_amdgcn_readfirstlane(tid >> 6), lane = tid & 63, r32 = lane & 31, hi = lane >> 5;
    const size_t tok0 = (size_t)b * SEQ;
    const bf16_t* Qb = Q + (tok0 + (size_t)qb * 256) * LDQ + h * QKD;
    const bf16_t* Kn = KV + tok0 * LDKV + h * 128;
    const bf16_t* Vh = KV + tok0 * LDKV + 1024 + h * 128;
    const bf16_t* Kr = DN + tok0 * LDR + 512;
    LAS unsigned char* V_lds = lds + OFF_V; LAS unsigned char* K_lds = lds + OFF_K;
    LAS float* ws = (LAS float*)(lds + OFF_WS) + wid * 64; LAS float* li_l = ws; LAS float* al_l = ws + 32;
    float m_reg = -1e30f, l_reg = 0; f32x16 o[4] = {}; bf16x8 qr[NQREG];
    const float Cq = SCALE * LOG2E * __builtin_amdgcn_rsqf(stat[(tok0 + (size_t)qb * 256 + wid * QBLK + r32) * 4] * (1.f / 256.f) + EPS);
    const bf16_t* Qw = Qb + (size_t)(wid * QBLK + r32) * LDQ + hi * 8;
    LAS unsigned char* qrl = lds + OFF_QR + wid * ((12 - NQREG) * 1024) + (hi * 32 + r32) * 16;
#pragma unroll
    for (int d0 = 0; d0 < NQREG; ++d0) qr[d0] = *(const bf16x8*)(Qw + d0 * 16);
#pragma unroll
    for (int d0 = NQREG; d0 < 12; ++d0) *(LAS bf16x8*)(qrl + (d0 - NQREG) * 1024) = *(const bf16x8*)(Qw + d0 * 16);
    const int sr = tid >> 4, sc = (tid & 15) * 8, vst0 = v_st<4>(sr, sc), vst1 = v_st<4>(32 + sr, sc);
    const int rr = tid >> 3, rc = (tid & 7) * 8;
    const int vb0 = (int)(uintptr_t)V_lds + v_rd_base(lane);
    bf16x8 vs0, vs1, ks0, ks1, kr0;
#define SLOAD(k0) do { vs0 = *(const bf16x8*)(Vh + (size_t)((k0) + sr) * LDKV + sc); vs1 = *(const bf16x8*)(Vh + (size_t)((k0) + 32 + sr) * LDKV + sc); \
    ks0 = *(const bf16x8*)(Kn + (size_t)((k0) + sr) * LDKV + sc); ks1 = *(const bf16x8*)(Kn + (size_t)((k0) + 32 + sr) * LDKV + sc); \
    kr0 = *(const bf16x8*)(Kr + (size_t)((k0) + rr) * LDR + rc); } while (0)
#define SWRITE(bf) do { *(LAS bf16x8*)(V_lds + (bf) * SHM_V + vst0) = vs0; *(LAS bf16x8*)(V_lds + (bf) * SHM_V + vst1) = vs1; \
    *(LAS bf16x8*)(K_lds + (bf) * SHM_K + sr * KSTR + sc * 2) = ks0; *(LAS bf16x8*)(K_lds + (bf) * SHM_K + (32 + sr) * KSTR + sc * 2) = ks1; \
    *(LAS bf16x8*)(K_lds + (bf) * SHM_K + rr * KSTR + 256 + rc * 2) = kr0; } while (0)
#define RESC(a) do { if (__any((a) < 1.f)) { if (hi == 0) al_l[r32] = (a); asm volatile("s_waitcnt lgkmcnt(0)" ::: "memory"); \
    _Pragma("unroll") for (int d = 0; d < 4; ++d) _Pragma("unroll") for (int r = 0; r < 16; ++r) o[d][r] *= al_l[crow(r, hi)]; } } while (0)
    f32x16 pA0, pA1, pB0, pB1; float mnA, mnB, alA, alB; bf16x8 pa0, pa1, pa2, pa3; constexpr int NT = SEQ / KVBLK;
    SLOAD(0); asm volatile("s_waitcnt vmcnt(0)" ::: "memory"); SWRITE(0); __syncthreads();
    qkt(pA0, pA1, K_lds, qr, qrl, r32, hi); partialSM(pA0, pA1, m_reg, mnA, alA, Cq);
    SLOAD(KVBLK);
    asm volatile("s_waitcnt vmcnt(0)" ::: "memory"); SWRITE(1); __syncthreads();
    for (int j = 1; j + 1 < NT; j += 2) {
        SBAR(); qkt(pB0, pB1, K_lds + SHM_K, qr, qrl, r32, hi);
        finishSM(pA0, pA1, alA, l_reg, pa0, pa1, pa2, pa3); SBAR();
        SLOAD((j + 1) * KVBLK); SBAR();
        pv_all(o, vb0, pa0, pa1, pa2, pa3); partialSM(pB0, pB1, m_reg, mnB, alB, Cq);
        __syncthreads(); asm volatile("s_waitcnt vmcnt(0)" ::: "memory"); SWRITE(0);
        RESC(alB); __syncthreads();
        SBAR(); qkt(pA0, pA1, K_lds, qr, qrl, r32, hi);
        finishSM(pB0, pB1, alB, l_reg, pa0, pa1, pa2, pa3); SBAR();
        SLOAD((j + 2) * KVBLK); SBAR();
        pv_all(o, vb0 + SHM_V, pa0, pa1, pa2, pa3); partialSM(pA0, pA1, m_reg, mnA, alA, Cq);
        __syncthreads(); asm volatile("s_waitcnt vmcnt(0)" ::: "memory"); SWRITE(1);
        RESC(alA); __syncthreads();
    }
    SBAR(); qkt(pB0, pB1, K_lds + SHM_K, qr, qrl, r32, hi);
    finishSM(pA0, pA1, alA, l_reg, pa0, pa1, pa2, pa3); SBAR();
    pv_all(o, vb0, pa0, pa1, pa2, pa3); partialSM(pB0, pB1, m_reg, mnB, alB, Cq);
    __syncthreads(); RESC(alB);
    finishSM(pB0, pB1, alB, l_reg, pa0, pa1, pa2, pa3); SBAR();
    pv_all(o, vb0 + SHM_V, pa0, pa1, pa2, pa3);
    if (hi == 0) li_l[r32] = l_reg; asm volatile("s_waitcnt lgkmcnt(0)" ::: "memory");
    float rli[16];
#pragma unroll
    for (int r = 0; r < 16; ++r) rli[r] = __builtin_amdgcn_rcpf(li_l[crow(r, hi)]);
    __syncthreads();
    LAS unsigned char* ost = lds + wid * (32 * OSTR);
#pragma unroll
    for (int r = 0; r < 16; ++r) { const int orow = crow(r, hi);
#pragma unroll
        for (int d0 = 0; d0 < 4; ++d0) *(LAS unsigned short*)(ost + orow * OSTR + (d0 * 32 + r32) * 2) = (unsigned short)f2bf(o[d0][r] * rli[r]); }
    asm volatile("s_waitcnt lgkmcnt(0)" ::: "memory");
    bf16_t* Ow = O + (tok0 + (size_t)qb * 256 + wid * QBLK) * LDO + h * 128;
#pragma unroll
    for (int it = 0; it < 8; ++it) { const int ch = it * 64 + lane, row = ch >> 4, c16 = ch & 15;
        const u32x4 v = *(const LAS u32x4*)(ost + row * OSTR + c16 * 16); *(u32x4*)(Ow + (size_t)row * LDO + c16 * 8) = v; }
    __syncthreads();
#undef SLOAD
#undef SWRITE
#undef RESC
}
}

namespace swa {
constexpr int KSTR = 144, KT = 64 * KSTR  , VT = 8192, NTILE = 5;
constexpr int OFF_K = 0, OFF_V = NTILE * KT  , OFF_O = OFF_V + NTILE * VT  , OSTR = 144, OFF_WS = OFF_O + 8 * 32 * OSTR  , OFF_END = OFF_WS + 8 * 64 * 4;
static_assert(OFF_END <= RING_BYTES, "swa lds");
constexpr int LD = SWA_NQKV;
constexpr float C = 0.125f * LOG2E;
__device__ __forceinline__ void unit(int b, int g, int qb, const bf16_t* __restrict__ QKV, const float* __restrict__ sink, bf16_t* __restrict__ O, LAS unsigned char* lds, const int wv) {
    const int tid = opaque_tid(wv), wid = __builtin_amdgcn_readfirstlane(tid >> 6), lane = tid & 63, r32 = lane & 31, hi = lane >> 5;
    const int q0 = qb * 64; const size_t tok0 = (size_t)b * SEQ;
    int t_lo = 0, t_hi = NTILE;
    if (q0 < 128) t_lo = (128 - q0) / 64;
    if (q0 + 64 + 128 > SEQ) t_hi = (SEQ + 128 - q0) / 64;
    { const int row = tid >> 3, c8 = (tid & 7) * 8; bf16x8 kreg[NTILE], vreg[NTILE];
#pragma unroll
      for (int t = 0; t < NTILE; ++t) if (t >= t_lo && t < t_hi) { const bf16_t* p = QKV + (tok0 + (size_t)(q0 - 128 + 64 * t + row)) * LD + g * 64 + c8;
          kreg[t] = *(const bf16x8*)(p + 1024); vreg[t] = *(const bf16x8*)(p + 1280); }
#pragma unroll
      for (int t = 0; t < NTILE; ++t) if (t >= t_lo && t < t_hi) { *(LAS bf16x8*)(lds + OFF_K + t * KT + row * KSTR + c8 * 2) = kreg[t];
          *(LAS bf16x8*)(lds + OFF_V + t * VT + v_st<2>(row, c8)) = vreg[t]; } }
    const int qh = g * 4 + (wid >> 1), rowb = q0 + (wid & 1) * 32;
    bf16x8 qr[4];
    { const bf16_t* Qw = QKV + (tok0 + (size_t)(rowb + r32)) * LD + qh * 64 + hi * 8;
#pragma unroll
      for (int d0 = 0; d0 < 4; ++d0) qr[d0] = *(const bf16x8*)(Qw + d0 * 16); }
    const float slope2 = __builtin_amdgcn_exp2f(-0.5f * (float)(qh + 1)) * LOG2E;
    const float sink2 = sink[qh] * LOG2E;
    __syncthreads();
    LAS float* al_l = (LAS float*)(lds + OFF_WS) + wid * 64; LAS float* li_l = al_l + 32;
    const int vb0 = (int)(uintptr_t)(lds + OFF_V) + v_rd_base(lane);
    float m_reg = -1e30f, l_reg = 0.f; f32x16 o[2] = {};
    for (int t = t_lo; t < t_hi; ++t) {
        const LAS unsigned char* Ks = lds + OFF_K + t * KT;
        f32x16 p0 = {}, p1 = {};
#pragma unroll
        for (int d0 = 0; d0 < 4; ++d0) { const int cb = (d0 * 16 + hi * 8) * 2;
            const bf16x8 b0 = *(const LAS bf16x8*)(Ks + r32 * KSTR + cb), b1 = *(const LAS bf16x8*)(Ks + (32 + r32) * KSTR + cb);
            p0 = __builtin_amdgcn_mfma_f32_32x32x16_bf16(b0, qr[d0], p0, 0, 0, 0);
            p1 = __builtin_amdgcn_mfma_f32_32x32x16_bf16(b1, qr[d0], p1, 0, 0, 0); }
        const int kb = (q0 - 128 + 64 * t) - (rowb + r32);
        float pmax = -INFINITY;
#pragma unroll
        for (int r = 0; r < 16; ++r) { const int rel0 = kb + crow(r, hi), rel1 = rel0 + 32; const int d0 = rel0 < 0 ? -rel0 : rel0, d1 = rel1 < 0 ? -rel1 : rel1;
            float x0 = fmaf(p0[r], C, -slope2 * (float)d0), x1 = fmaf(p1[r], C, -slope2 * (float)d1);
            x0 = d0 > 128 ? -INFINITY : x0; x1 = d1 > 128 ? -INFINITY : x1; p0[r] = x0; p1[r] = x1; pmax = fmaxf(pmax, fmaxf(x0, x1)); }
        { auto rr = __builtin_amdgcn_permlane32_swap(__float_as_uint(pmax), __float_as_uint(pmax), false, false);
          pmax = fmaxf(__uint_as_float(rr[0]), __uint_as_float(rr[1])); }
        const float mn = fmaxf(m_reg, pmax), alpha = __builtin_amdgcn_exp2f(m_reg - mn); m_reg = mn;
        float ps = 0.f;
#pragma unroll
        for (int r = 0; r < 16; ++r) { p0[r] = __builtin_amdgcn_exp2f(p0[r] - mn); p1[r] = __builtin_amdgcn_exp2f(p1[r] - mn); ps += p0[r] + p1[r]; }
        { auto rr = __builtin_amdgcn_permlane32_swap(__float_as_uint(ps), __float_as_uint(ps), false, false);
          ps = __uint_as_float(rr[0]) + __uint_as_float(rr[1]); }
        l_reg = l_reg * alpha + ps;
        if (hi == 0) al_l[r32] = alpha; asm volatile("s_waitcnt lgkmcnt(0)" ::: "memory");
#pragma unroll
        for (int d = 0; d < 2; ++d)
#pragma unroll
            for (int r = 0; r < 16; ++r) o[d][r] *= al_l[crow(r, hi)];
        bf16x8 pa0, pa1, pa2, pa3;
        PK4(p0, 0, pa0); PK4(p0, 8, pa1); PK4(p1, 0, pa2); PK4(p1, 8, pa3);
        const int vb = vb0 + t * VT;
        pv_one<0, 2>(o[0], vb, pa0, pa1, pa2, pa3); pv_one<1, 2>(o[1], vb, pa0, pa1, pa2, pa3);
    }
    l_reg += __builtin_amdgcn_exp2f(sink2 - m_reg);
    if (hi == 0) li_l[r32] = l_reg; asm volatile("s_waitcnt lgkmcnt(0)" ::: "memory");
    LAS unsigned char* ost = lds + OFF_O + wid * (32 * OSTR);
#pragma unroll
    for (int r = 0; r < 16; ++r) { const int orow = crow(r, hi); const float rl = __builtin_amdgcn_rcpf(li_l[orow]);
#pragma unroll
        for (int d0 = 0; d0 < 2; ++d0) *(LAS unsigned short*)(ost + orow * OSTR + (d0 * 32 + r32) * 2) = (unsigned short)f2bf(o[d0][r] * rl); }
    asm volatile("s_waitcnt lgkmcnt(0)" ::: "memory");
    bf16_t* Ow = O + (tok0 + (size_t)rowb) * DM + qh * 64;
#pragma unroll
    for (int it = 0; it < 4; ++it) { const int ch = it * 64 + lane, row = ch >> 3, c16 = ch & 7;
        const u32x4 v = *(const LAS u32x4*)(ost + row * OSTR + c16 * 16); *(u32x4*)(Ow + (size_t)row * DM + c16 * 8) = v; }
    __syncthreads();
}
}

constexpr int NWAVES = 8;
struct Args { const float* in[23]; float* out; unsigned char* ws; };
static_assert(sizeof(Args) == 25 * 8, "no padding");

template <int KIND> __device__ __forceinline__ int map_row(int n) {
    if (KIND == 0) return n;
    if (KIND == 1) return ((n >> 7) << 8) + (n & 127);
    if (KIND == 2) return ((n >> 7) << 8) + 128 + (n & 127);
    if (KIND == 3) { const int h = n / QKD; int d = n - h * QKD; if (d >= 128) { const int i = d - 128; d = 128 + (i < 32 ? 2 * i : 2 * (i - 32) + 1); } return h * QKD + d; }
    if (KIND == 4) { if (n >= 512) { const int i = n - 512; n = 512 + (i < 32 ? 2 * i : 2 * (i - 32) + 1); } return n; }
    return n;
}
template <int KIND> __device__ __forceinline__ void transpose_matrix(const float* W, int K, int N, bf16_t* WT, int row_off, LAS float* scr, int gw, int NGW, int lane, const float* gk = nullptr) {
    const int nblk = N / 32, nitems = (K / 64) * nblk;
    for (int item = gw; item < nitems; item += NGW) {
        const int kb = item / nblk, nb = item % nblk, k0 = 64 * kb, n0 = 32 * nb;
#pragma unroll 8
        for (int i = 0; i < 32; ++i) { const int kk = 2 * i + (lane >> 5); float wv_ = W[(size_t)(k0 + kk) * N + n0 + (lane & 31)]; if (gk) wv_ *= gk[k0 + kk]; scr[kk * 33 + (lane & 31)] = wv_; }
        LDS_WAIT(); asm volatile("" ::: "memory");
        const int c = lane & 7;
#pragma unroll
        for (int j = 0; j < 4; ++j) { const int n = (lane >> 3) + 8 * j; const LAS float* s = scr + (8 * c) * 33 + n;
            u32x4 o; o.x = pk2(s[0 * 33], s[1 * 33]); o.y = pk2(s[2 * 33], s[3 * 33]); o.z = pk2(s[4 * 33], s[5 * 33]); o.w = pk2(s[6 * 33], s[7 * 33]);
            *(u32x4*)(WT + (size_t)(row_off + map_row<KIND>(n0 + n)) * K + k0 + 8 * c) = o; }
        LDS_WAIT(); asm volatile("" ::: "memory");
    }
}
__device__ __forceinline__ void rms_row_to_bf16(const float* xrow, const f32x4 (&gv)[4], bf16_t* orow, int lane) {
    const f32x4* xr = (const f32x4*)xrow + lane; f32x4 v[4]; float s = 0.f;
#pragma unroll
    for (int j = 0; j < 4; ++j) { v[j] = xr[64 * j]; s += (v[j].x * v[j].x + v[j].y * v[j].y) + (v[j].z * v[j].z + v[j].w * v[j].w); }
    const float rstd = 1.0f / sqrtf(wave_sum(s, lane) * (1.f / DM) + EPS);
    unsigned long long* o8 = (unsigned long long*)orow + lane;
#pragma unroll
    for (int j = 0; j < 4; ++j) { const f32x4 y = v[j] * rstd * gv[j]; o8[64 * j] = (unsigned long long)pk2(y.x, y.y) | ((unsigned long long)pk2(y.z, y.w) << 32); }
}

#define PHASE_IDS const int tid = opaque_tid(bar.wv), lane = tid & 63, wave = __builtin_amdgcn_readfirstlane(tid >> 6), gw = vcu * NWAVES + wave; (void)gw; (void)lane
template <int j> __device__ __forceinline__ void pair_body(const Args& args, LAS unsigned char* lds, const XcdBarrier& bar, const int G, const int bx, const int vcu) {
    const int NGW = G * NWAVES;
    unsigned char* ws = args.ws;
    LAS int* moetab = (LAS int*)(lds + MOETAB_OFF);
    const float* x = args.in[0];
    int* route = (int*)(ws + WS_ROUTE); f32x2* gate = (f32x2*)(ws + WS_GATE); int* posb = (int*)(ws + WS_POS); int* cnt = (int*)(ws + WS_CNT);
    unsigned char* act = ws + WS_ACT;
    bf16_t* H = (bf16_t*)(act + A_H); bf16_t* XN = (bf16_t*)(act + A_XN); bf16_t* DOWN = (bf16_t*)(act + A_DOWN); bf16_t* QB = (bf16_t*)(act + A_Q);
    bf16_t* KVB = (bf16_t*)args.out;
    bf16_t* FACT = (bf16_t*)(act + A_FACT); bf16_t* SQKV = (bf16_t*)(act + A_SQKV); bf16_t* SO = (bf16_t*)(act + A_SO); bf16_t* XS = (bf16_t*)args.out; bf16_t* MACT = (bf16_t*)(act + A_MACT);
    float* STAT = (float*)(act + A_STAT); LAS float* PART = (LAS float*)(lds + PART_OFF);
    {
        unsigned char* wb = ws + WS_W + (size_t)j * W_PAIR;
        if (PH(1)) { pg8::Gemm g{XN, (const bf16_t*)(wb + W_DQKV), DM, DM, DM}; pg8::DenseOrder S; S.init(NTOK, DOWNP, G, bx, 256);
          pg8::EpiDown E{DOWN, STAT, PART}; pg8::gemm_phase<pg8::EpiDown, pg8::DenseOrder, true>(lds, g, S, E, bar.wv); }
        xcd_barrier(bar);
        if (PH(3)) { pg8::Gemm g{DOWN, (const bf16_t*)(wb + W_UQ), DOWNP, 256, 256}; pg8::DenseOrder S; S.init(NTOK, NQ, G, bx, 256);
          pg8::EpiQRope E{QB}; pg8::gemm_phase<pg8::EpiQRope, pg8::DenseOrder, true>(lds, g, S, E, bar.wv); }
        { pg8::Gemm g{DOWN + 256, (const bf16_t*)(wb + W_UKV), DOWNP, 256, 256}; pg8::DenseOrder S; S.init(NTOK, NKV, G, bx, 256);
          pg8::EpiBf16<false, 1> E{KVB, NKV, STAT, 1, 1.f / 256.f}; pg8::gemm_phase<pg8::EpiBf16<false, 1>, pg8::DenseOrder, true>(lds, g, S, E, bar.wv); }
        xcd_barrier(bar);
        if (PH(4)) { const int NU = BATCH * MLA_H * (SEQ / 256);
          for (int u = vcu; u < NU; u += G) { const int bh = u >> 3, qb = u & 7; mla::unit(bh >> 3, bh & 7, qb, QB, KVB, DOWN, STAT, XN, lds, bar.wv); } }
        xcd_barrier(bar);
        if (PH(5)) { pg8::Gemm g{XN, (const bf16_t*)(wb + W_MO), DM, DM, DM}; pg8::DenseOrder S; S.init(NTOK, DM, G, bx, 256);
          pg8::EpiResid<j == 0> E{j == 0 ? (const void*)x : (const void*)H, H, STAT, PART, RESID_SCALE}; pg8::gemm_phase<pg8::EpiResid<j == 0>, pg8::DenseOrder, true>(lds, g, S, E, bar.wv); }
        xcd_barrier(bar);
        if (PH(7)) { pg8::Gemm g{H, (const bf16_t*)(wb + W_FGU), DM, DM, DM}; pg8::DenseOrder S; S.init(NTOK, 2 * FFN, G, bx, 128);
          pg8::EpiSwiGLU<false, 4> E{FACT, FFN, STAT, 1.f / 1024.f}; pg8::gemm_phase<pg8::EpiSwiGLU<false, 4>, pg8::DenseOrder, true>(lds, g, S, E, bar.wv); }
        xcd_barrier(bar);
        if (PH(8)) { pg8::Gemm g{FACT, (const bf16_t*)(wb + W_FD), FFN, FFN, FFN}; pg8::DenseOrder S; S.init(NTOK, DM, G, bx, 256);
          pg8::EpiResid<false> E{H, H, STAT, PART, RESID_SCALE}; pg8::gemm_phase<pg8::EpiResid<false>, pg8::DenseOrder, true>(lds, g, S, E, bar.wv); }
        xcd_barrier(bar);
        if (PH(10)) { pg8::Gemm g{H, (const bf16_t*)(wb + W_SQKV), DM, DM, DM}; pg8::DenseOrder S; S.init(NTOK, SWA_NQKV, G, bx, 256);
          pg8::EpiBf16<false, 4> E{SQKV, SWA_NQKV, STAT, 0, 1.f / 1024.f}; pg8::gemm_phase<pg8::EpiBf16<false, 4>, pg8::DenseOrder, true>(lds, g, S, E, bar.wv); }
        xcd_barrier(bar);
        if (PH(11)) { const int NU = BATCH * 4 * (SEQ / 64);
          for (int u = vcu; u < NU; u += G) { const int bg = u >> 5, qb = u & 31; swa::unit(bg >> 2, bg & 3, qb, SQKV, args.in[11] + j * 16, SO, lds, bar.wv); } }
        xcd_barrier(bar);
        if (PH(12)) { pg8::Gemm g{SO, (const bf16_t*)(wb + W_SO), DM, DM, DM}; pg8::DenseOrder S; S.init(NTOK, DM, G, bx, 256);
          pg8::EpiResid<false> E{H, H, STAT, PART, RESID_SCALE}; pg8::gemm_phase<pg8::EpiResid<false>, pg8::DenseOrder, true>(lds, g, S, E, bar.wv); }
        xcd_barrier(bar);
        if (PH(13)) { PHASE_IDS; LAS float* rt = (LAS float*)lds;
          LAS int* lcnt = (LAS int*)(lds + 32768);
          const float* router = args.in[18] + (size_t)j * DM * NE; const float* mg = args.in[17] + j * DM;
          for (int i = tid; i < DM * NE; i += NWAVES * 64) rt[(i & 7) * DM + (i >> 3)] = router[i] * mg[i >> 3];
          for (int ck = vcu; ck < NTOK / 256; ck += G) {
              if (tid < 8) lcnt[tid] = 0;
              __syncthreads();
              for (int r = 0; r < 32; ++r) { const int tok = ck * 256 + wave * 32 + r;
                  const u32x2* hr = (const u32x2*)(H + (size_t)tok * DM) + lane; f32x4 v[4];
#pragma unroll
                  for (int k = 0; k < 4; ++k) { const u32x2 w = hr[64 * k]; v[k] = (f32x4){bf_lo(w.x), bf_hi(w.x), bf_lo(w.y), bf_hi(w.y)}; }
                  const f32x4 st4 = *(const f32x4*)(STAT + (size_t)tok * 4);
                  const float rstd = 1.0f / sqrtf(((st4.x + st4.y) + (st4.z + st4.w)) * (1.f / DM) + EPS);
                  float lg[8];
#pragma unroll
                  for (int e = 0; e < 8; ++e) { float a = 0.f;
#pragma unroll
                      for (int k = 0; k < 4; ++k) { const f32x4 w = *(const LAS f32x4*)(rt + e * DM + 4 * lane + 256 * k); a += (v[k].x * w.x + v[k].y * w.y) + (v[k].z * w.z + v[k].w * w.w); }
                      lg[e] = wave_sum(a, lane) * rstd; }
                  int i0 = 0; float v0 = lg[0];
#pragma unroll
                  for (int e = 1; e < 8; ++e) if (lg[e] > v0) { v0 = lg[e]; i0 = e; }
                  int i1 = -1; float v1 = -INFINITY;
#pragma unroll
                  for (int e = 0; e < 8; ++e) if (e != i0 && lg[e] > v1) { v1 = lg[e]; i1 = e; }
                  const float g0 = 1.0f / (1.0f + __expf(v1 - v0));
                  if (lane == 0) { route[tok] = i0 | (i1 << 8); gate[tok] = (f32x2){g0, 1.0f - g0}; __hip_atomic_fetch_add(lcnt + i0, 1, __ATOMIC_RELAXED, __HIP_MEMORY_SCOPE_WORKGROUP); __hip_atomic_fetch_add(lcnt + i1, 1, __ATOMIC_RELAXED, __HIP_MEMORY_SCOPE_WORKGROUP); } }
              __syncthreads();
              if (tid < 8) cnt[ck * 8 + tid] = lcnt[tid];
              __syncthreads();
          } }
        xcd_barrier(bar);
        if (PH(14)) { PHASE_IDS; LAS int* red = (LAS int*)lds;
          LAS int* tp = (LAS int*)(lds + 1024);
          LAS int* wcn = (LAS int*)(lds + 2048);
          LAS int* lpos = (LAS int*)(lds + 4096);
          f32x4 gv[4];
#pragma unroll
          for (int k = 0; k < 4; ++k) gv[k] = ((const f32x4*)(args.in[17] + j * DM))[lane + 64 * k];
          int v[8];
          if (tid < 256) { const i32x4 c0 = ((const i32x4*)cnt)[tid * 2], c1 = ((const i32x4*)cnt)[tid * 2 + 1]; v[0] = c0.x; v[1] = c0.y; v[2] = c0.z; v[3] = c0.w; v[4] = c1.x; v[5] = c1.y; v[6] = c1.z; v[7] = c1.w; }
          else {
#pragma unroll
              for (int e = 0; e < 8; ++e) v[e] = 0; }
#pragma unroll
          for (int e = 0; e < 8; ++e) { int tot = v[e];
#pragma unroll
              for (int o = 1; o < 64; o <<= 1) tot += shxi(tot, o, lane);
              if (lane == 0) red[wave * 16 + e] = tot; }
          __syncthreads();
          if (tid < 8) { int sm = 0;
#pragma unroll
              for (int w = 0; w < 8; ++w) sm += red[w * 16 + tid];
              tp[tid] = sm; }
          __syncthreads();
          if (tid == 0) { int rs = 0, ts = 0;
              for (int e = 0; e < 8; ++e) { moetab[e] = ts; moetab[16 + e] = rs; rs += tp[e]; ts += (tp[e] + 255) >> 8; }
              moetab[8] = ts; moetab[24] = rs; }
          __syncthreads();
          for (int ck = vcu; ck < NTOK / 256; ck += G) {
#pragma unroll
              for (int e = 0; e < 8; ++e) { int pre = (tid < ck) ? v[e] : 0;
#pragma unroll
                  for (int o = 1; o < 64; o <<= 1) pre += shxi(pre, o, lane);
                  if (lane == 0) red[wave * 16 + 8 + e] = pre; }
              __syncthreads();
              if (tid < 8) { int sm = 0;
#pragma unroll
                  for (int w = 0; w < 8; ++w) sm += red[w * 16 + 8 + tid];
                  tp[8 + tid] = sm; }
              int e0 = 0, e1 = 0, r0 = 0, r1 = 0;
              if (tid < 256) { const int re = route[ck * 256 + tid]; e0 = re & 255; e1 = re >> 8; }
#pragma unroll
              for (int e = 0; e < 8; ++e) { const bool f = (tid < 256) && (e0 == e || e1 == e); const unsigned long long mk = __ballot(f);
                  const int rk = __popcll(mk & ((1ull << lane) - 1ull));
                  if (e0 == e) r0 = rk; if (e1 == e) r1 = rk;
                  if (lane == 0 && wave < 4) wcn[wave * 8 + e] = __popcll(mk); }
              __syncthreads();
              if (tid < 256) { int p0 = moetab[16 + e0] + tp[8 + e0] + r0, p1 = moetab[16 + e1] + tp[8 + e1] + r1;
                  for (int w = 0; w < wave; ++w) { p0 += wcn[w * 8 + e0]; p1 += wcn[w * 8 + e1]; }
                  lpos[tid * 2] = p0; lpos[tid * 2 + 1] = p1; posb[(size_t)(ck * 256 + tid) * 2] = p0; posb[(size_t)(ck * 256 + tid) * 2 + 1] = p1; }
              __syncthreads();
              for (int r = 0; r < 32; ++r) { const int t = wave * 32 + r, tok = ck * 256 + t; const int p0 = lpos[t * 2], p1 = lpos[t * 2 + 1];
                  const u32x2* hr = (const u32x2*)(H + (size_t)tok * DM) + lane;
                  const f32x4 st4 = *(const f32x4*)(STAT + (size_t)tok * 4);
                  const float rstd = 1.0f / sqrtf(((st4.x + st4.y) + (st4.z + st4.w)) * (1.f / DM) + EPS);
                  u32x2* o0 = (u32x2*)(XS + (size_t)p0 * DM) + lane; u32x2* o1 = (u32x2*)(XS + (size_t)p1 * DM) + lane;
#pragma unroll
                  for (int k = 0; k < 4; ++k) { const u32x2 w = hr[64 * k]; const f32x4 y = (f32x4){bf_lo(w.x), bf_hi(w.x), bf_lo(w.y), bf_hi(w.y)} * rstd * gv[k];
                      u32x2 ow; ow.x = pk2(y.x, y.y); ow.y = pk2(y.z, y.w); o0[64 * k] = ow; o1[64 * k] = ow; } }
              __syncthreads();
          } }
        xcd_barrier(bar);
        if (PH(15)) { pg8::Gemm g{XS, (const bf16_t*)(wb + W_MGU), DM, DM, DM}; pg8::GroupedOrder S; S.init(moetab, 2 * ED, G, bx, 128);
          pg8::EpiSwiGLU<true, 0> E{MACT, ED, nullptr, 0.f}; pg8::gemm_phase<pg8::EpiSwiGLU<true, 0>, pg8::GroupedOrder, true>(lds, g, S, E, bar.wv); }
        xcd_barrier(bar);
        if (PH(16)) { pg8::Gemm g{MACT, (const bf16_t*)(wb + W_MD), ED, ED, ED}; pg8::GroupedOrder S; S.init(moetab, DM, G, bx, 256);
          pg8::EpiBf16<true, 0> E{XS, DM, nullptr, 0, 0.f}; pg8::gemm_phase<pg8::EpiBf16<true, 0>, pg8::GroupedOrder, true>(lds, g, S, E, bar.wv); }
        xcd_barrier(bar);
        if (PH(17)) { PHASE_IDS;
          f32x4 gv[4];
#pragma unroll
          for (int k = 0; k < 4; ++k) gv[k] = ((const f32x4*)(args.in[1] + DM))[lane + 64 * k];
          for (int m = gw; m < NTOK; m += NGW) {
              const int p0 = posb[(size_t)m * 2], p1 = posb[(size_t)m * 2 + 1]; const f32x2 gg = gate[m] * RESID_SCALE;
              u32x2* hr = (u32x2*)(H + (size_t)m * DM) + lane;
              const u32x2* y0 = (const u32x2*)(XS + (size_t)p0 * DM) + lane; const u32x2* y1 = (const u32x2*)(XS + (size_t)p1 * DM) + lane;
              f32x4 v[4]; float ss = 0.f;
#pragma unroll
              for (int k = 0; k < 4; ++k) { const u32x2 a = y0[64 * k], b = y1[64 * k], hw = hr[64 * k]; f32x4 hv = (f32x4){bf_lo(hw.x), bf_hi(hw.x), bf_lo(hw.y), bf_hi(hw.y)};
                  hv.x += gg.x * bf_lo(a.x) + gg.y * bf_lo(b.x); hv.y += gg.x * bf_hi(a.x) + gg.y * bf_hi(b.x);
                  hv.z += gg.x * bf_lo(a.y) + gg.y * bf_lo(b.y); hv.w += gg.x * bf_hi(a.y) + gg.y * bf_hi(b.y);
                  v[k] = hv; ss += (hv.x * hv.x + hv.y * hv.y) + (hv.z * hv.z + hv.w * hv.w); }
#pragma unroll
              for (int k = 0; k < 4; ++k) { u32x2 ow; ow.x = pk2(v[k].x, v[k].y); ow.y = pk2(v[k].z, v[k].w); hr[64 * k] = ow; }
              if (j == 0) { const float rstd = 1.0f / sqrtf(wave_sum(ss, lane) * (1.f / DM) + EPS);
                  u32x2* o8 = (u32x2*)(XN + (size_t)m * DM) + lane;
#pragma unroll
                  for (int k = 0; k < 4; ++k) { const f32x4 y = v[k] * rstd * gv[k]; u32x2 ow; ow.x = pk2(y.x, y.y); ow.y = pk2(y.z, y.w); o8[64 * k] = ow; } }
          } }
        xcd_barrier(bar);
        if (j == 1 && PH(18)) { PHASE_IDS; float* outp = args.out;
          f32x4 gv[4];
#pragma unroll
          for (int k = 0; k < 4; ++k) gv[k] = ((const f32x4*)args.in[22])[lane + 64 * k];
          for (int m = gw; m < NTOK; m += NGW) {
              const u32x2* hr = (const u32x2*)(H + (size_t)m * DM) + lane; f32x4 v[4]; float ss = 0.f;
#pragma unroll
              for (int k = 0; k < 4; ++k) { const u32x2 hw = hr[64 * k]; v[k] = (f32x4){bf_lo(hw.x), bf_hi(hw.x), bf_lo(hw.y), bf_hi(hw.y)}; ss += (v[k].x * v[k].x + v[k].y * v[k].y) + (v[k].z * v[k].z + v[k].w * v[k].w); }
              const float rstd = 1.0f / sqrtf(wave_sum(ss, lane) * (1.f / DM) + EPS);
              f32x4* o = (f32x4*)(outp + (size_t)m * DM) + lane;
#pragma unroll
              for (int k = 0; k < 4; ++k) o[64 * k] = v[k] * rstd * gv[k];
          } }
    }
}

__global__ void __launch_bounds__(NWAVES * 64, 2) fwd(Args args) {
    extern __shared__ __attribute__((aligned(16))) unsigned char lds_raw[];
    LAS unsigned char* lds = (LAS unsigned char*)lds_raw;
    const int G = gridDim.x, bx = blockIdx.x, vcu = (G % 8 == 0) ? (bx % 8) * (G / 8) + bx / 8 : bx;
    const int NGW = G * NWAVES;
    unsigned char* ws = args.ws;
    unsigned* ctl = (unsigned*)(ws + WS_CTL);
    const int wv0 = __builtin_amdgcn_readfirstlane((int)threadIdx.x >> 6);
    for (int u = opaque_tid(wv0); u < (LDS_BYTES - LDSCTL_OFF) / 4; u += NWAVES * 64) ((LAS unsigned*)(lds + LDSCTL_OFF))[u] = 0u;
    __syncthreads();
    volatile LAS unsigned* MISC = (volatile LAS unsigned*)(lds + MISC_OFF);
    XcdBarrier bar = xcd_barrier_post(ctl + 4096, MISC + 8, wv0);
    const float* x = args.in[0];
    bf16_t* XN = (bf16_t*)(ws + WS_ACT + A_XN);

    if (PH(0)) { PHASE_IDS;
        LAS float* scr = (LAS float*)(lds + wave * 16384);
        for (int j = 0; j < 2; ++j) {
            unsigned char* wb = ws + WS_W + (size_t)j * W_PAIR;
            transpose_matrix<4>(args.in[2] + (size_t)j * DM * 576, DM, 576, (bf16_t*)(wb + W_DQKV), 0, scr, gw, NGW, lane);
            for (int i = gw * 64 + lane; i < (DOWNP - 576) * DM / 8; i += NGW * 64) ((u32x4*)(wb + W_DQKV + (size_t)576 * DM * 2))[i] = (u32x4){0u, 0u, 0u, 0u};
            transpose_matrix<3>(args.in[4] + (size_t)j * 256 * NQ, 256, NQ, (bf16_t*)(wb + W_UQ), 0, scr, gw, NGW, lane, args.in[3] + j * 256);
            transpose_matrix<0>(args.in[6] + (size_t)j * 256 * 1024, 256, 1024, (bf16_t*)(wb + W_UKV), 0, scr, gw, NGW, lane, args.in[5] + j * 256);
            transpose_matrix<0>(args.in[7] + (size_t)j * 256 * 1024, 256, 1024, (bf16_t*)(wb + W_UKV), 1024, scr, gw, NGW, lane, args.in[5] + j * 256);
            transpose_matrix<0>(args.in[8] + (size_t)j * DM * DM, DM, DM, (bf16_t*)(wb + W_MO), 0, scr, gw, NGW, lane);
            transpose_matrix<0>(args.in[10] + (size_t)j * DM * SWA_NQKV, DM, SWA_NQKV, (bf16_t*)(wb + W_SQKV), 0, scr, gw, NGW, lane, args.in[9] + j * DM);
            transpose_matrix<0>(args.in[12] + (size_t)j * DM * DM, DM, DM, (bf16_t*)(wb + W_SO), 0, scr, gw, NGW, lane);
            transpose_matrix<1>(args.in[14] + (size_t)j * DM * FFN, DM, FFN, (bf16_t*)(wb + W_FGU), 0, scr, gw, NGW, lane, args.in[13] + j * DM);
            transpose_matrix<2>(args.in[15] + (size_t)j * DM * FFN, DM, FFN, (bf16_t*)(wb + W_FGU), 0, scr, gw, NGW, lane, args.in[13] + j * DM);
            transpose_matrix<0>(args.in[16] + (size_t)j * FFN * DM, FFN, DM, (bf16_t*)(wb + W_FD), 0, scr, gw, NGW, lane);
            for (int e = 0; e < NE; ++e) {
                transpose_matrix<1>(args.in[19] + ((size_t)j * NE + e) * DM * ED, DM, ED, (bf16_t*)(wb + W_MGU), e * 2 * ED, scr, gw, NGW, lane);
                transpose_matrix<2>(args.in[20] + ((size_t)j * NE + e) * DM * ED, DM, ED, (bf16_t*)(wb + W_MGU), e * 2 * ED, scr, gw, NGW, lane);
                transpose_matrix<0>(args.in[21] + ((size_t)j * NE + e) * ED * DM, ED, DM, (bf16_t*)(wb + W_MD), e * DM, scr, gw, NGW, lane);
            }
        }
        f32x4 gv[4];
#pragma unroll
        for (int j = 0; j < 4; ++j) gv[j] = ((const f32x4*)args.in[1])[lane + 64 * j];
        for (int m = gw; m < NTOK; m += NGW) rms_row_to_bf16(x + (size_t)m * DM, gv, XN + (size_t)m * DM, lane);
    }
    xcd_barrier(bar);

    pair_body<0>(args, lds, bar, G, bx, vcu);
    pair_body<1>(args, lds, bar, G, bx, vcu);
}

extern "C" void kernel_launch(void* const* d_in, const int* in_sizes, int n_in, void* d_out, int out_size, void* d_ws, size_t ws_size, hipStream_t stream) {
    static int grid = 0;
    if (grid == 0) {
        if (n_in != 23 || out_size != NTOK * DM || ws_size < WS_NEED) { fprintf(stderr, "kernel_launch: shape/workspace mismatch (n_in %d out %d ws %zu need %zu)\n", n_in, out_size, ws_size, (size_t)WS_NEED); grid = -1; return; }
        int dev = 0, cus = 0;
        if (hipGetDevice(&dev) != hipSuccess || hipDeviceGetAttribute(&cus, hipDeviceAttributeMultiprocessorCount, dev) != hipSuccess) { grid = -1; return; }
        if (hipFuncSetAttribute((const void*)fwd, hipFuncAttributeMaxDynamicSharedMemorySize, LDS_BYTES) != hipSuccess) { fprintf(stderr, "kernel_launch: hipFuncSetAttribute failed\n"); grid = -1; return; }
        int per_cu = 0;
        if (hipOccupancyMaxActiveBlocksPerMultiprocessor(&per_cu, (const void*)fwd, NWAVES * 64, LDS_BYTES) != hipSuccess || per_cu < 1) fprintf(stderr, "kernel_launch: occupancy query reports %d\n", per_cu);
        (void)hipGetLastError();
        grid = cus;
    }
    if (grid < 0) return;
    if (hipMemsetAsync((char*)d_ws + WS_CTL, 0, CTL_ZERO_BYTES, stream) != hipSuccess) return;
    Args a{};
    for (int i = 0; i < 23; ++i) a.in[i] = (const float*)d_in[i];
    a.out = (float*)d_out; a.ws = (unsigned char*)d_ws;
    hipLaunchKernelGGL(fwd, dim3(grid), dim3(NWAVES * 64), LDS_BYTES, stream, a);
    const hipError_t le = hipPeekAtLastError();
    if (le != hipSuccess) fprintf(stderr, "kernel_launch: launch failed: %s\n", hipGetErrorName(le));
}
```

```cpp
#include <hip/hip_runtime.h>
#include <hip/hip_bf16.h>
#include <cstdio>
#include <cstdint>

#define LAS __attribute__((address_space(3)))
#define GAS __attribute__((address_space(1)))
typedef unsigned short bf16_t;
typedef short bf16x8 __attribute__((ext_vector_type(8)));
typedef short s16x4 __attribute__((ext_vector_type(4)));
typedef float f32x4 __attribute__((ext_vector_type(4)));
typedef float f32x2 __attribute__((ext_vector_type(2)));
typedef float f32x16 __attribute__((ext_vector_type(16)));
typedef unsigned u32x4 __attribute__((ext_vector_type(4)));
typedef unsigned u32x2 __attribute__((ext_vector_type(2)));
typedef int i32x4 __attribute__((ext_vector_type(4)));
typedef int i32x8 __attribute__((ext_vector_type(8)));

constexpr int DM = 1024, BATCH = 32, SEQ = 2048, NTOK = BATCH * SEQ;
constexpr int MLA_H = 8, QKD = 192, DOWNP = 768;
constexpr int NQ = MLA_H * QKD  , NKV = 2048;
constexpr int SWA_NQKV = 1536;
constexpr int FFN = 2816, NE = 8, ED = 2048;
constexpr int NPAIR = NTOK * 2;
constexpr float EPS = 1e-6f;
constexpr float LOG2E = 1.4426950408889634f;
#ifndef PHMASK
#define PHMASK 0xFFFFFFFFu
#endif
#define PH(k) (((PHMASK) >> (k)) & 1u)
#define RESID_SCALE 1.0f
#ifndef FP8_MOE
#define FP8_MOE 3
#endif
constexpr float W8_SCALE = 32.0f;

constexpr size_t MiB = 1u << 20;
constexpr size_t WS_CTL = 0, CTL_ZERO_BYTES = 1 * MiB;
constexpr size_t WS_ROPE = 1 * MiB;
constexpr size_t WS_ROUTE = 2 * MiB;
constexpr size_t WS_GATE = 3 * MiB;
constexpr size_t WS_POS = 4 * MiB;
constexpr size_t WS_CNT = 5 * MiB;
constexpr size_t WS_W = 6 * MiB;
constexpr size_t W_DQKV = 0;
constexpr size_t W_UQ = W_DQKV + (size_t)DOWNP * DM * 2;
constexpr size_t W_UKV = W_UQ + (size_t)NQ * 256 * 2;
constexpr size_t W_MO = W_UKV + (size_t)NKV * 256 * 2;
constexpr size_t W_SQKV = W_MO + (size_t)DM * DM * 2;
constexpr size_t W_SO = W_SQKV + (size_t)SWA_NQKV * DM * 2;
constexpr size_t W_FGU = W_SO + (size_t)DM * DM * 2;
constexpr size_t W_FD = W_FGU + (size_t)2 * FFN * DM * 2;
constexpr size_t W_MGU = W_FD + (size_t)DM * FFN * 2;
constexpr size_t W_MD = W_MGU + (size_t)NE * 2 * ED * DM * 2;
constexpr size_t W_PAIR = W_MD + (size_t)NE * DM * ED * 2;
constexpr size_t WS_ACT = 254 * MiB;
static_assert(WS_W + 2 * W_PAIR <= WS_ACT, "weights fit");
constexpr size_t A_H = 0;
constexpr size_t A_XN = 128 * MiB;
constexpr size_t A_DOWN = 256 * MiB;
constexpr size_t A_Q = 352 * MiB;
constexpr size_t A_FACT = 128 * MiB;
constexpr size_t A_SQKV = 128 * MiB;
constexpr size_t A_SO = 320 * MiB;
constexpr size_t A_MACT = 128 * MiB;
constexpr size_t A_STAT = 768 * MiB;
constexpr size_t WS_NEED = WS_ACT + 770 * MiB;
static_assert(WS_NEED <= 1024 * MiB, "ws");

constexpr int RING_BYTES = 147456;
constexpr int LDSCTL_OFF = RING_BYTES;
constexpr int MISC_OFF = LDSCTL_OFF + 320;
constexpr int PART_OFF = LDSCTL_OFF + 2048;
constexpr int MOETAB_OFF = LDSCTL_OFF + 1024;
constexpr int LDS_BYTES = 163840;

#define RLX_AGENT __ATOMIC_RELAXED, __HIP_MEMORY_SCOPE_AGENT
#define LDS_WAIT() asm volatile("s_waitcnt lgkmcnt(0)" ::: "memory")
#define VM_WAIT() asm volatile("s_waitcnt vmcnt(0)" ::: "memory")
#define SBAR() __builtin_amdgcn_sched_barrier(0)
__device__ __forceinline__ unsigned f2bf(float f) { unsigned u = __builtin_bit_cast(unsigned, f); return (u + 0x7fffu + ((u >> 16) & 1u)) >> 16; }
__device__ __forceinline__ unsigned pk2(float lo, float hi) { return f2bf(lo) | (f2bf(hi) << 16); }
__device__ __forceinline__ unsigned cvt_pk_bf16(float lo, float hi) { unsigned r; asm volatile("v_cvt_pk_bf16_f32 %0, %1, %2" : "=v"(r) : "v"(lo), "v"(hi)); return r; }
__device__ __forceinline__ u32x2 pk8_fp8(const float (&o)[8]) { int w0 = 0, w1 = 0;
    w0 = __builtin_amdgcn_cvt_pk_fp8_f32(o[0], o[1], w0, false); w0 = __builtin_amdgcn_cvt_pk_fp8_f32(o[2], o[3], w0, true);
    w1 = __builtin_amdgcn_cvt_pk_fp8_f32(o[4], o[5], w1, false); w1 = __builtin_amdgcn_cvt_pk_fp8_f32(o[6], o[7], w1, true);
    u32x2 r; r.x = (unsigned)w0; r.y = (unsigned)w1; return r; }
__device__ __forceinline__ float bf_lo(unsigned w) { return __builtin_bit_cast(float, w << 16); }
__device__ __forceinline__ float bf_hi(unsigned w) { return __builtin_bit_cast(float, w & 0xffff0000u); }
__device__ __forceinline__ int opaque_tid(int wv) { int l; asm volatile("v_mbcnt_lo_u32_b32 %0, -1, 0\n\tv_mbcnt_hi_u32_b32 %0, -1, %0" : "=v"(l)); return wv * 64 + l; }
__device__ __forceinline__ int opaque_lane() { int l; asm volatile("v_mbcnt_lo_u32_b32 %0, -1, 0\n\tv_mbcnt_hi_u32_b32 %0, -1, %0" : "=v"(l)); return l; }
__device__ __forceinline__ void glds16_s(const void* sbase, unsigned voff, unsigned lds_dst) {
    unsigned keep;
    asm volatile("s_mov_b32 %0, m0\n\ts_mov_b32 m0, %3\n\ts_nop 0\n\tglobal_load_lds_dwordx4 %1, %2\n\ts_mov_b32 m0, %0" : "=&s"(keep) : "v"(voff), "s"(sbase), "s"(lds_dst) : "memory");
}
__device__ __forceinline__ float shx(float v, int o, int lane) { return __builtin_bit_cast(float, __builtin_amdgcn_ds_bpermute((lane ^ o) << 2, __builtin_bit_cast(int, v))); }
__device__ __forceinline__ int shxi(int v, int o, int lane) { return __builtin_amdgcn_ds_bpermute((lane ^ o) << 2, v); }
__device__ __forceinline__ float wave_sum(float v, int lane) {
#pragma unroll
    for (int o = 1; o < 64; o <<= 1) v += shx(v, o, lane);
    return v;
}

#define XB_TMO      128
#define XB_XCNT(j)  (256  + 64 * (j))
#define XB_XSUB(j)  (1280 + 64 * (j))
#define XB_XGEN(j)  (2304 + 64 * (j))
#define XB_TOP      3328
#define XB_TOPGEN   3392
#define XCD_BAR_WORDS 3456
#define XB_SPIN_CAP (1u << 18)
__device__ __forceinline__ unsigned xb_ld(unsigned* p)              { return __hip_atomic_load(p, __ATOMIC_RELAXED, __HIP_MEMORY_SCOPE_AGENT); }
__device__ __forceinline__ unsigned xb_add(unsigned* p, unsigned v) { return __hip_atomic_fetch_add(p, v, __ATOMIC_RELAXED, __HIP_MEMORY_SCOPE_AGENT); }
__device__ __forceinline__ unsigned xb_xcc_id() { return (unsigned)__builtin_amdgcn_s_getreg((3 << 11) | 20) & 0xFu; }
#define XB_SPIN(cond, bar) do { unsigned _sp = 0; while (cond) { __builtin_amdgcn_s_sleep(1); \
    if ((++_sp & 255u) == 0u) { if (xb_ld(&(bar)[XB_TMO])) break; if (_sp > XB_SPIN_CAP) { atomicAdd(&(bar)[XB_TMO], 1u); break; } } } } while (0)
struct XcdBarrier { unsigned* bar; unsigned x; volatile LAS unsigned* st; int wv; };
__device__ __forceinline__ XcdBarrier xcd_barrier_post(unsigned* bar, volatile LAS unsigned* st, int wv) {
    XcdBarrier b; b.bar = bar; b.x = xb_xcc_id(); b.st = st; b.wv = wv;
    if (opaque_tid(wv) == 0) (void)xb_add(&bar[XB_XCNT(b.x)], 1u);
    return b;
}
__device__ __forceinline__ void xcd_barrier_complete(unsigned* bar, unsigned x, unsigned& nloc, unsigned& nx) {
    const unsigned G = gridDim.x * gridDim.y * gridDim.z;
    unsigned sum, cnt, mine, sp = 0u;
    for (;;) {
        sum = 0u; cnt = 0u; mine = 0u;
#pragma unroll
        for (unsigned j = 0; j < 16; ++j) { const unsigned c = xb_ld(&bar[XB_XCNT(j)]); sum += c; cnt += (c > 0u) ? 1u : 0u; mine = (j == x) ? c : mine; }
        if (sum == G) break;
        __builtin_amdgcn_s_sleep(1);
        if ((++sp & 255u) == 0u) { if (xb_ld(&bar[XB_TMO])) break; if (sp > XB_SPIN_CAP) { atomicAdd(&bar[XB_TMO], 1u); break; } }
    }
    nloc = mine > 0u ? mine : 1u; nx = cnt > 0u ? cnt : 1u;
}
__device__ __forceinline__ void xcd_barrier(const XcdBarrier& b) {
    asm volatile("s_waitcnt vmcnt(0)" ::: "memory");
    __syncthreads();
    if (opaque_tid(b.wv) == 0) {
        unsigned* bar = b.bar;
        __builtin_amdgcn_s_waitcnt(0);
        unsigned nloc = b.st[0], nx = b.st[1];
        if (nloc == 0u) { xcd_barrier_complete(bar, b.x, nloc, nx); b.st[0] = nloc; b.st[1] = nx; }
        const unsigned old = xb_add(&bar[XB_XSUB(b.x)], 1u);
        const unsigned gen = old / nloc;
        if (old + 1u == (gen + 1u) * nloc) {
            __builtin_amdgcn_fence(__ATOMIC_RELEASE, "agent");
            asm volatile("s_waitcnt vmcnt(0)" ::: "memory");
            const unsigned og = xb_add(&bar[XB_TOP], 1u);
            const unsigned tg = og / nx;
            if (og + 1u == (tg + 1u) * nx) xb_add(&bar[XB_TOPGEN], 1u);
            else XB_SPIN(xb_ld(&bar[XB_TOPGEN]) == tg, bar);
            __builtin_amdgcn_fence(__ATOMIC_ACQUIRE, "agent");
            xb_add(&bar[XB_XGEN(b.x)], 1u);
            asm volatile("s_waitcnt vmcnt(0)" ::: "memory");
        } else {
            XB_SPIN(xb_ld(&bar[XB_XGEN(b.x)]) == gen, bar);
            __builtin_amdgcn_fence(__ATOMIC_ACQUIRE, "agent");
            asm volatile("s_waitcnt vmcnt(0)" ::: "memory");
        }
    }
    __syncthreads();
}

namespace pg8 {
constexpr int BM = 256, BK = 64, HALF = 128, HTB = HALF * BK * 2, STAGE_BYTES = 8 * HTB, NXCD = 8, WGM = 8;
__host__ __device__ __forceinline__ int lds_byte(int r, int c) { const int st = (r >> 4) * 2 + (c >> 5), rr = r & 15, cc = c & 31, ob = rr * 64 + cc * 2; return st * 1024 + (ob ^ (((ob >> 9) & 1) << 5)); }
__host__ __device__ __forceinline__ void stage_rc(int b, int& R, int& C) { const int st = b / 1024, sb = b % 1024, swz = sb ^ (((sb >> 9) & 1) << 5); R = (st >> 1) * 16 + swz / 64; C = (st & 1) * 32 + (swz % 64) / 2; }
__host__ __device__ __forceinline__ int perm32(int rho) { const int n = rho >> 4, i = rho & 15; return 8 * (i >> 2) + 4 * n + (i & 3); }

struct Unit { int arow, brow, col, nvalid, nlo; };
struct Gemm { const bf16_t* A; const bf16_t* Bt; int lda, ldb, K; };

struct DenseOrder {
    int nM, nN, nwg, G, c, colw;
    __device__ void init(int M, int N, int G_, int c_, int colw_) { nM = M / BM; nN = N / BM; nwg = nM * nN; G = G_; c = c_; colw = colw_; }
    __device__ __forceinline__ bool next(int i, Unit& u) const {
        const long L = (long)i * G + c; if (L >= nwg) return false;
        int wgid = (int)L; { const int q = nwg / NXCD, r = nwg % NXCD, xcd = wgid % NXCD, off = wgid / NXCD; wgid = (xcd < r ? xcd * (q + 1) : r * (q + 1) + (xcd - r) * q) + off; }
        const int nig = WGM * nN, gid = wgid / nig, fm = gid * WGM, gsz = (nM - fm) < WGM ? (nM - fm) : WGM;
        const int pm = fm + ((wgid % nig) % gsz), pn = (wgid % nig) / gsz;
        u.arow = pm * BM; u.brow = pn * BM; u.col = pn * colw; u.nvalid = BM; u.nlo = 0; return true;
    }
};
struct GroupedOrder {
    int nM, nN, nwg, G, c, colw, erows; const LAS int* tab;
    __device__ void init(const LAS int* tab_, int N, int G_, int c_, int colw_) { tab = tab_; nM = tab_[8]; nN = N / BM; nwg = nM * nN; G = G_; c = c_; colw = colw_; erows = N; }
    __device__ __forceinline__ bool next(int i, Unit& u) const {
        const long L = (long)i * G + c; if (L >= nwg) return false;
        int wgid = (int)L; { const int q = nwg / NXCD, r = nwg % NXCD, xcd = wgid % NXCD, off = wgid / NXCD; wgid = (xcd < r ? xcd * (q + 1) : r * (q + 1) + (xcd - r) * q) + off; }
        const int nig = WGM * nN, gid = wgid / nig, fm = gid * WGM, gsz = (nM - fm) < WGM ? (nM - fm) : WGM;
        const int T = fm + ((wgid % nig) % gsz), pn = (wgid % nig) / gsz;
        int e = 0;
#pragma unroll
        for (int k = 1; k < 8; ++k) e += (T >= tab[k]) ? 1 : 0;
        const int lt = T - tab[e]; int arow = tab[16 + e] + lt * BM; int nv = tab[16 + e + 1] - arow; nv = nv > BM ? BM : nv;
        int lo = 0; { const int over = arow + BM - tab[24]; if (over > 0) { arow -= over; lo = over; nv += over; } }
        u.arow = __builtin_amdgcn_readfirstlane(arow); u.nvalid = __builtin_amdgcn_readfirstlane(nv); u.nlo = __builtin_amdgcn_readfirstlane(lo);
        u.brow = __builtin_amdgcn_readfirstlane(e * erows + pn * BM); u.col = __builtin_amdgcn_readfirstlane(pn * colw); return true;
    }
};

template <int NS> __device__ __forceinline__ float row_rstd(const float* stat, int row, int slot0, float inv_n) {
    float s;
    if (NS == 4) { const f32x4 a = *(const f32x4*)(stat + (size_t)row * 4); s = (a.x + a.y) + (a.z + a.w); }
    else s = stat[(size_t)row * 4 + slot0];
    return __builtin_amdgcn_rsqf(s + EPS / inv_n) * __builtin_sqrtf(1.0f / inv_n);
}
template <int NS> __device__ __forceinline__ void row_rstd8(float (&rs)[2][4], const float* stat, int row0, int slot0, float inv_n) {
#pragma unroll
    for (int ai = 0; ai < 2; ++ai)
#pragma unroll
        for (int m = 0; m < 4; ++m) rs[ai][m] = NS ? row_rstd<NS ? NS : 1>(stat, row0 + ai * HALF + m * 16, slot0, inv_n) : 1.f;
}
__device__ __forceinline__ void stat_combine(LAS float* part, float* stat, const Unit& u, int slot, int wr, int wc, int fr, int fq) {
    asm volatile("s_waitcnt lgkmcnt(0)" ::: "memory"); __builtin_amdgcn_s_barrier(); asm volatile("" ::: "memory");
    const int t = (wr * 4 + wc) * 64 + fq * 16 + fr;
    if (t < 256) { const float sum = (part[t] + part[256 + t]) + (part[512 + t] + part[768 + t]); stat[(size_t)(u.arow + t) * 4 + slot] = sum; }
}
template <bool MASK, int NS> struct EpiBf16 {
    static constexpr bool PERM = true;
    bf16_t* O; int ldc; const float* stat; int slot0; float inv_n; float oscale;
    __device__ __forceinline__ void operator()(const f32x4 (&acc)[2][2][4][2], const Unit& u, int wr, int wc, int fr, int fq) const {
        const int col0 = u.col + wc * 32 + 8 * fq;
        float rs[2][4]; row_rstd8<NS>(rs, stat, u.arow + wr * 64 + fr, slot0, inv_n);
#pragma unroll
        for (int ai = 0; ai < 2; ++ai)
#pragma unroll
            for (int m = 0; m < 4; ++m) { const int rl = ai * HALF + wr * 64 + m * 16 + fr; if (MASK && (rl >= u.nvalid || rl < u.nlo)) continue;
                const float r = rs[ai][m] * oscale;
                bf16_t* rowp = O + (size_t)(u.arow + rl) * ldc + col0;
#pragma unroll
                for (int bj = 0; bj < 2; ++bj) { const f32x4 v0 = acc[ai][bj][m][0] * r, v1 = acc[ai][bj][m][1] * r;
                    u32x4 w; w.x = cvt_pk_bf16(v0[0], v0[1]); w.y = cvt_pk_bf16(v0[2], v0[3]); w.z = cvt_pk_bf16(v1[0], v1[1]); w.w = cvt_pk_bf16(v1[2], v1[3]);
                    *(u32x4*)(rowp + bj * HALF) = w; } }
    }
};
template <bool MASK, int NS, bool F8OUT = false> struct EpiSwiGLU {
    static constexpr bool PERM = true;
    bf16_t* O; int ldc; const float* stat; float inv_n; float oscale;
    __device__ __forceinline__ void operator()(const f32x4 (&acc)[2][2][4][2], const Unit& u, int wr, int wc, int fr, int fq) const {
        const int col0 = u.col + wc * 32 + 8 * fq;
        float rs[2][4]; row_rstd8<NS>(rs, stat, u.arow + wr * 64 + fr, 0, inv_n);
#pragma unroll
        for (int ai = 0; ai < 2; ++ai)
#pragma unroll
            for (int m = 0; m < 4; ++m) { const int rl = ai * HALF + wr * 64 + m * 16 + fr; if (MASK && (rl >= u.nvalid || rl < u.nlo)) continue;
                const float r = rs[ai][m] * oscale;
                float o[8];
#pragma unroll
                for (int n = 0; n < 2; ++n)
#pragma unroll
                    for (int k = 0; k < 4; ++k) { const float g = acc[ai][0][m][n][k] * r, up = acc[ai][1][m][n][k] * r;
                        const float sg = __builtin_amdgcn_rcpf(1.0f + __builtin_amdgcn_exp2f(-g * LOG2E)); o[n * 4 + k] = g * sg * up; }
                if (F8OUT) { *(u32x2*)((unsigned char*)O + (size_t)(u.arow + rl) * ldc + col0) = pk8_fp8(o); }
                else { u32x4 w; w.x = cvt_pk_bf16(o[0], o[1]); w.y = cvt_pk_bf16(o[2], o[3]); w.z = cvt_pk_bf16(o[4], o[5]); w.w = cvt_pk_bf16(o[6], o[7]);
                    *(u32x4*)(O + (size_t)(u.arow + rl) * ldc + col0) = w; } }
    }
};
template <bool BASE_F32> struct EpiResid {
    static constexpr bool PERM = true;
    const void* base; bf16_t* out; float* stat; LAS float* part; float scale;
    __device__ __forceinline__ void operator()(f32x4 (&acc)[2][2][4][2], const Unit& u, int wr, int wc, int fr, int fq) const {
        const int col0 = u.col + wc * 32 + 8 * fq; const int lane = fq * 16 + fr;
#pragma unroll
        for (int ai = 0; ai < 2; ++ai)
#pragma unroll
          for (int mh = 0; mh < 2; ++mh) {
            if (BASE_F32) { f32x4 t[2][2][2];
#pragma unroll
                for (int m = 0; m < 2; ++m) { const float* bp = (const float*)base + (size_t)(u.arow + ai * HALF + wr * 64 + (mh * 2 + m) * 16 + fr) * DM + col0;
#pragma unroll
                    for (int bj = 0; bj < 2; ++bj)
#pragma unroll
                        for (int n = 0; n < 2; ++n) t[m][bj][n] = *(const f32x4*)(bp + bj * HALF + n * 4); }
#pragma unroll
                for (int m = 0; m < 2; ++m)
#pragma unroll
                    for (int bj = 0; bj < 2; ++bj)
#pragma unroll
                        for (int n = 0; n < 2; ++n) acc[ai][bj][mh * 2 + m][n] = acc[ai][bj][mh * 2 + m][n] * scale + t[m][bj][n];
            } else { u32x4 t[2][2];
#pragma unroll
                for (int m = 0; m < 2; ++m) { const bf16_t* bp = (const bf16_t*)base + (size_t)(u.arow + ai * HALF + wr * 64 + (mh * 2 + m) * 16 + fr) * DM + col0;
#pragma unroll
                    for (int bj = 0; bj < 2; ++bj) t[m][bj] = *(const u32x4*)(bp + bj * HALF); }
#pragma unroll
                for (int m = 0; m < 2; ++m)
#pragma unroll
                    for (int bj = 0; bj < 2; ++bj) { const u32x4 w = t[m][bj];
                        acc[ai][bj][mh * 2 + m][0] = acc[ai][bj][mh * 2 + m][0] * scale + (f32x4){bf_lo(w.x), bf_hi(w.x), bf_lo(w.y), bf_hi(w.y)};
                        acc[ai][bj][mh * 2 + m][1] = acc[ai][bj][mh * 2 + m][1] * scale + (f32x4){bf_lo(w.z), bf_hi(w.z), bf_lo(w.w), bf_hi(w.w)}; }
            }
#pragma unroll
            for (int m = 0; m < 2; ++m)
                asm volatile("" : "+v"(acc[ai][0][mh * 2 + m][0]), "+v"(acc[ai][0][mh * 2 + m][1]), "+v"(acc[ai][1][mh * 2 + m][0]), "+v"(acc[ai][1][mh * 2 + m][1]) :: "memory"); }
#pragma unroll
        for (int ai = 0; ai < 2; ++ai)
#pragma unroll
            for (int m = 0; m < 4; ++m) { const int rl = ai * HALF + wr * 64 + m * 16 + fr; const size_t off = (size_t)(u.arow + rl) * DM + col0; float ss = 0.f;
#pragma unroll
                for (int bj = 0; bj < 2; ++bj) { const f32x4 h0 = acc[ai][bj][m][0], h1 = acc[ai][bj][m][1];
                    ss += ((h0.x * h0.x + h0.y * h0.y) + (h0.z * h0.z + h0.w * h0.w)) + ((h1.x * h1.x + h1.y * h1.y) + (h1.z * h1.z + h1.w * h1.w));
                    u32x4 w; w.x = cvt_pk_bf16(h0.x, h0.y); w.y = cvt_pk_bf16(h0.z, h0.w); w.z = cvt_pk_bf16(h1.x, h1.y); w.w = cvt_pk_bf16(h1.z, h1.w);
                    *(u32x4*)(out + off + bj * HALF) = w; }
                ss += shx(ss, 16, lane); ss += shx(ss, 32, lane); if (fq == 0) part[wc * 256 + rl] = ss; }
        stat_combine(part, stat, u, u.col >> 8, wr, wc, fr, fq);
    }
};
__device__ __forceinline__ void rope_inv4(float (&inv)[4], int i0) {
#pragma unroll
    for (int k = 0; k < 4; ++k) inv[k] = __builtin_amdgcn_exp2f(-(float)(i0 + k) * (13.287712379549449f / 32.0f)) * 0.15915494309189535f;
}
__device__ __forceinline__ void rope8(f32x4& v0, f32x4& v1, float pos, const float (&inv)[4]) {
    float c[4], sn[4];
#pragma unroll
    for (int k = 0; k < 4; ++k) { float t = pos * inv[k]; t -= rintf(t); c[k] = __builtin_amdgcn_cosf(t); sn[k] = __builtin_amdgcn_sinf(t); }
    const float a0 = v0[0] * c[0] - v0[1] * sn[0], b0 = v0[1] * c[0] + v0[0] * sn[0];
    const float a1 = v0[2] * c[1] - v0[3] * sn[1], b1 = v0[3] * c[1] + v0[2] * sn[1];
    const float a2 = v1[0] * c[2] - v1[1] * sn[2], b2 = v1[1] * c[2] + v1[0] * sn[2];
    const float a3 = v1[2] * c[3] - v1[3] * sn[3], b3 = v1[3] * c[3] + v1[2] * sn[3];
    v0 = (f32x4){a0, b0, a1, b1}; v1 = (f32x4){a2, b2, a3, b3};
}
struct EpiQRope {
    static constexpr bool PERM = true;
    bf16_t* O;
    __device__ __forceinline__ void operator()(const f32x4 (&acc)[2][2][4][2], const Unit& u, int wr, int wc, int fr, int fq) const {
        const int col0 = u.col + wc * 32 + 8 * fq;
#pragma unroll
        for (int bj = 0; bj < 2; ++bj) { const int c = col0 + bj * HALF, d = c % QKD; const bool isr = d >= 128; float inv[4]; rope_inv4(inv, isr ? ((d - 128) >> 1) : 0);
#pragma unroll
            for (int ai = 0; ai < 2; ++ai)
#pragma unroll
                for (int m = 0; m < 4; ++m) { const int row = u.arow + ai * HALF + wr * 64 + m * 16 + fr;
                    f32x4 v0 = acc[ai][bj][m][0], v1 = acc[ai][bj][m][1];
                    if (isr) rope8(v0, v1, (float)(row & (SEQ - 1)), inv);
                    u32x4 w; w.x = cvt_pk_bf16(v0[0], v0[1]); w.y = cvt_pk_bf16(v0[2], v0[3]); w.z = cvt_pk_bf16(v1[0], v1[1]); w.w = cvt_pk_bf16(v1[2], v1[3]);
                    *(u32x4*)(O + (size_t)row * NQ + c) = w; } }
    }
};
struct EpiDown {
    static constexpr bool PERM = true;
    bf16_t* O; float* stat; LAS float* part;
    __device__ __forceinline__ void operator()(const f32x4 (&acc)[2][2][4][2], const Unit& u, int wr, int wc, int fr, int fq) const {
        const int col0 = u.col + wc * 32 + 8 * fq, pn = u.col >> 8, lane = fq * 16 + fr;
        if (pn < 2) {
#pragma unroll
            for (int ai = 0; ai < 2; ++ai)
#pragma unroll
                for (int m = 0; m < 4; ++m) { const int rl = ai * HALF + wr * 64 + m * 16 + fr; float ss = 0.f;
#pragma unroll
                    for (int bj = 0; bj < 2; ++bj) { const f32x4 v0 = acc[ai][bj][m][0], v1 = acc[ai][bj][m][1];
                        ss += ((v0.x * v0.x + v0.y * v0.y) + (v0.z * v0.z + v0.w * v0.w)) + ((v1.x * v1.x + v1.y * v1.y) + (v1.z * v1.z + v1.w * v1.w));
                        u32x4 w; w.x = cvt_pk_bf16(v0[0], v0[1]); w.y = cvt_pk_bf16(v0[2], v0[3]); w.z = cvt_pk_bf16(v1[0], v1[1]); w.w = cvt_pk_bf16(v1[2], v1[3]);
                        *(u32x4*)(O + (size_t)(u.arow + rl) * DOWNP + col0 + bj * HALF) = w; }
                    ss += shx(ss, 16, lane); ss += shx(ss, 32, lane); if (fq == 0) part[wc * 256 + rl] = ss; }
        } else if (wc < 2) {
            float inv[4]; rope_inv4(inv, wc * 16 + 4 * fq);
#pragma unroll
            for (int ai = 0; ai < 2; ++ai)
#pragma unroll
                for (int m = 0; m < 4; ++m) { const int row = u.arow + ai * HALF + wr * 64 + m * 16 + fr;
                    f32x4 v0 = acc[ai][0][m][0], v1 = acc[ai][0][m][1];
                    rope8(v0, v1, (float)(row & (SEQ - 1)), inv);
                    u32x4 w; w.x = cvt_pk_bf16(v0[0], v0[1]); w.y = cvt_pk_bf16(v0[2], v0[3]); w.z = cvt_pk_bf16(v1[0], v1[1]); w.w = cvt_pk_bf16(v1[2], v1[3]);
                    *(u32x4*)(O + (size_t)row * DOWNP + col0) = w; }
        }
        if (pn < 2) stat_combine(part, stat, u, pn, wr, wc, fr, fq);
        else { asm volatile("s_waitcnt lgkmcnt(0)" ::: "memory"); __builtin_amdgcn_s_barrier(); }
    }
};

template <class Epi, class Sched, bool ALIGN_EPI, bool FP8 = false>
__device__ __forceinline__ void gemm_phase(LAS unsigned char* lds, const Gemm g, const Sched& S, const Epi& E, const int wv) {
    const int tid = opaque_tid(wv), wid = __builtin_amdgcn_readfirstlane(tid >> 6), lane = tid & 63, wr = wid >> 2, wc = wid & 3, fr = lane & 15, fq = lane >> 4;
    const int K = g.K, nt = K / BK;
    unsigned voffA[2], voffB[2];
#pragma unroll
    for (int i = 0; i < 2; ++i) { int R, C; stage_rc(tid * 16 + i * 8192, R, C); const int Rb = Epi::PERM ? ((R & ~31) + perm32(R & 31)) : R;
        voffA[i] = (unsigned)(R * g.lda + C) * 2u; voffB[i] = (unsigned)(Rb * g.ldb + C) * 2u; }
    const size_t kstep = (size_t)(BK * 2);
    const size_t hsA = (size_t)HALF * g.lda * 2, hsB = (size_t)HALF * g.ldb * 2;
    const unsigned ldsw = (unsigned)wid * 1024u, ldsb = (unsigned)(uintptr_t)lds;
    const int aoff = lds_byte(wr * 64 + fr, fq * 8), boff = lds_byte(wc * 32 + fr, fq * 8);
#define PG8_SA(b, h) (((b) * 2 + (h)) * HTB)
#define PG8_SB(b, h) ((4 + (b) * 2 + (h)) * HTB)
#define PG8_STAGE(bufoff, gbase, voff) do { _Pragma("unroll") for (int _i = 0; _i < 2; ++_i) \
        glds16_s((const char*)(gbase), (voff)[_i], ldsb + (unsigned)(bufoff) + ldsw + (unsigned)(_i * 8192)); } while (0)
#define PG8_LDA(dst, b, h) do { _Pragma("unroll") for (int m = 0; m < 4; ++m) _Pragma("unroll") for (int k = 0; k < 2; ++k) dst[m][k] = *(const LAS bf16x8*)(lds + PG8_SA(b, h) + aoff + m * 2048 + k * 1024); } while (0)
#define PG8_LDB(dst, b, h) do { _Pragma("unroll") for (int n = 0; n < 2; ++n) _Pragma("unroll") for (int k = 0; k < 2; ++k) dst[n][k] = *(const LAS bf16x8*)(lds + PG8_SB(b, h) + boff + n * 2048 + k * 1024); } while (0)
#define PG8_MMA(ai, bj, At, Bt) do { __builtin_amdgcn_s_setprio(1); _Pragma("unroll") for (int m = 0; m < 4; ++m) _Pragma("unroll") for (int n = 0; n < 2; ++n) { \
        if constexpr (FP8) { const i32x4 b0_ = __builtin_bit_cast(i32x4, Bt[n][0]), b1_ = __builtin_bit_cast(i32x4, Bt[n][1]), a0_ = __builtin_bit_cast(i32x4, At[m][0]), a1_ = __builtin_bit_cast(i32x4, At[m][1]); \
            acc[ai][bj][m][n] = __builtin_amdgcn_mfma_scale_f32_16x16x128_f8f6f4(__builtin_shufflevector(b0_, b1_, 0, 1, 2, 3, 4, 5, 6, 7), __builtin_shufflevector(a0_, a1_, 0, 1, 2, 3, 4, 5, 6, 7), acc[ai][bj][m][n], 0, 0, 0, 0x7F7F7F7F, 0, 0x7F7F7F7F); } \
        else { _Pragma("unroll") for (int k = 0; k < 2; ++k) acc[ai][bj][m][n] = __builtin_amdgcn_mfma_f32_16x16x32_bf16(Bt[n][k], At[m][k], acc[ai][bj][m][n], 0, 0, 0); } } \
        __builtin_amdgcn_s_setprio(0); } while (0)
#define PG8_WAIT_V(n) asm volatile("s_waitcnt vmcnt(" #n ")" ::: "memory")
#define PG8_WAIT_L(n) asm volatile("s_waitcnt lgkmcnt(" #n ")" ::: "memory")
#define PG8_BAR __builtin_amdgcn_s_barrier()
#define PG8_SCHED __builtin_amdgcn_sched_barrier(0)
    Unit cur, nxt; int ui = 0;
    if (!S.next(0, cur)) return;
    f32x4 acc[2][2][4][2];
#pragma unroll
    for (int a = 0; a < 2; ++a)
#pragma unroll
        for (int b = 0; b < 2; ++b)
#pragma unroll
            for (int m = 0; m < 4; ++m)
#pragma unroll
                for (int n = 0; n < 2; ++n) acc[a][b][m][n] = (f32x4){0.f, 0.f, 0.f, 0.f};
    bf16x8 At[4][2], B0[2][2], B1[2][2];
    const char* cA = (const char*)g.A + (size_t)cur.arow * g.lda * 2; const char* cB = (const char*)g.Bt + (size_t)cur.brow * g.ldb * 2;
    PG8_STAGE(PG8_SB(0, 0), cB, voffB); PG8_STAGE(PG8_SB(0, 1), cB + hsB, voffB); PG8_STAGE(PG8_SA(0, 0), cA, voffA); PG8_STAGE(PG8_SA(0, 1), cA + hsA, voffA);
    if (wr == 1) PG8_BAR;
    PG8_WAIT_V(2); PG8_BAR;
    PG8_STAGE(PG8_SB(1, 0), cB + kstep, voffB); PG8_STAGE(PG8_SA(1, 0), cA + kstep, voffA); PG8_STAGE(PG8_SB(1, 1), cB + hsB + kstep, voffB);
    PG8_WAIT_V(6); PG8_BAR;
    for (;;) {
        const bool has_next = S.next(ui + 1, nxt);
        const char* nA = has_next ? (const char*)g.A + (size_t)nxt.arow * g.lda * 2 : cA; const char* nB = has_next ? (const char*)g.Bt + (size_t)nxt.brow * g.ldb * 2 : cB;
        for (int t = 0; t < nt; t += 2) {
            const bool last = (t == nt - 2);
            const char* a1 = cA + (size_t)(t + 1) * kstep;
            const char* a2 = last ? nA : cA + (size_t)(t + 2) * kstep; const char* b2 = last ? nB : cB + (size_t)(t + 2) * kstep;
            const char* a3 = a2 + kstep; const char* b3 = b2 + kstep;
            PG8_LDB(B0, 0, 0); PG8_LDB(B1, 0, 1); PG8_SCHED; PG8_LDA(At, 0, 0); PG8_STAGE(PG8_SA(1, 1), a1 + hsA, voffA);
            PG8_WAIT_V(8); PG8_WAIT_L(0); PG8_BAR; PG8_MMA(0, 0, At, B0); PG8_MMA(0, 1, At, B1); PG8_BAR; PG8_SCHED;
            PG8_LDA(At, 0, 1); PG8_STAGE(PG8_SB(0, 0), b2, voffB); PG8_STAGE(PG8_SB(0, 1), b2 + hsB, voffB); PG8_STAGE(PG8_SA(0, 0), a2, voffA);
            PG8_WAIT_V(8); PG8_WAIT_L(0); PG8_BAR; PG8_MMA(1, 0, At, B0); PG8_MMA(1, 1, At, B1); PG8_BAR; PG8_SCHED;
            PG8_LDB(B0, 1, 0); PG8_LDB(B1, 1, 1); PG8_SCHED; PG8_LDA(At, 1, 0); PG8_STAGE(PG8_SA(0, 1), a2 + hsA, voffA);
            PG8_WAIT_V(8); PG8_WAIT_L(0); PG8_BAR; PG8_MMA(0, 0, At, B0); PG8_MMA(0, 1, At, B1); PG8_BAR; PG8_SCHED;
            PG8_LDA(At, 1, 1); PG8_STAGE(PG8_SB(1, 0), b3, voffB); PG8_STAGE(PG8_SB(1, 1), b3 + hsB, voffB); PG8_STAGE(PG8_SA(1, 0), a3, voffA);
            PG8_WAIT_V(8); PG8_WAIT_L(0); PG8_BAR; PG8_MMA(1, 0, At, B0); PG8_MMA(1, 1, At, B1); PG8_BAR; PG8_SCHED;
        }
        if constexpr (ALIGN_EPI) { if (wr == 0) PG8_BAR; }
        { const int l2 = opaque_lane(); E(acc, cur, wr, wc, l2 & 15, l2 >> 4); }
        if (!has_next) break;
#pragma unroll
        for (int a = 0; a < 2; ++a)
#pragma unroll
            for (int b = 0; b < 2; ++b)
#pragma unroll
                for (int m = 0; m < 4; ++m)
#pragma unroll
                    for (int n = 0; n < 2; ++n) acc[a][b][m][n] = (f32x4){0.f, 0.f, 0.f, 0.f};
        cur = nxt; cA = nA; cB = nB; ++ui;
        if constexpr (ALIGN_EPI) { if (wr == 1) PG8_BAR; }
    }
    PG8_WAIT_V(0);
    if constexpr (!ALIGN_EPI) { if (wr == 0) PG8_BAR; }
    PG8_BAR;
#undef PG8_SA
#undef PG8_SB
#undef PG8_STAGE
#undef PG8_LDA
#undef PG8_LDB
#undef PG8_MMA
#undef PG8_WAIT_V
#undef PG8_WAIT_L
#undef PG8_BAR
#undef PG8_SCHED
}
}

__device__ __forceinline__ int crow(int r, int hi) { return (r & 3) + 8 * (r >> 2) + 4 * hi; }
__device__ __forceinline__ int v_rd_base(int lane) { return ((lane & 3) << 3) | (((lane >> 2) & 3) << 6) | (((lane >> 4) & 1) << 5) | (((lane >> 5) & 1) << 8); }
template <int NCB> __device__ __forceinline__ int v_st(int k, int c) { const int kk = (k & ~0xC) | ((k & 4) << 1) | ((k & 8) >> 1); return ((kk >> 3) * NCB + (c >> 5)) * 512 + ((kk & 7) * 32 + (c & 31)) * 2; }
template <int OFF> __device__ __forceinline__ s16x4 tr_read(int vb) {
    s16x4 r; asm volatile("ds_read_b64_tr_b16 %0, %1 offset:%2" : "=&v"(r) : "v"(vb), "i"(OFF) : "memory"); return r;
}
template <int D0, int NCB> __device__ __forceinline__ void pv_one(f32x16& od, int vb, bf16x8 pa0, bf16x8 pa1, bf16x8 pa2, bf16x8 pa3) {
    constexpr int KS = NCB * 1024, HF = NCB * 512;
    const s16x4 l0 = tr_read<D0 * 512 + 0 * KS>(vb), h0 = tr_read<D0 * 512 + 0 * KS + HF>(vb), l1 = tr_read<D0 * 512 + 1 * KS>(vb), h1 = tr_read<D0 * 512 + 1 * KS + HF>(vb);
    const s16x4 l2 = tr_read<D0 * 512 + 2 * KS>(vb), h2 = tr_read<D0 * 512 + 2 * KS + HF>(vb), l3 = tr_read<D0 * 512 + 3 * KS>(vb), h3 = tr_read<D0 * 512 + 3 * KS + HF>(vb);
    asm volatile("s_waitcnt lgkmcnt(0)" ::: "memory"); SBAR();
#define PK(L, H) (bf16x8){L[0], L[1], L[2], L[3], H[0], H[1], H[2], H[3]}
    od = __builtin_amdgcn_mfma_f32_32x32x16_bf16(pa0, PK(l0, h0), od, 0, 0, 0);
    od = __builtin_amdgcn_mfma_f32_32x32x16_bf16(pa1, PK(l1, h1), od, 0, 0, 0);
    od = __builtin_amdgcn_mfma_f32_32x32x16_bf16(pa2, PK(l2, h2), od, 0, 0, 0);
    od = __builtin_amdgcn_mfma_f32_32x32x16_bf16(pa3, PK(l3, h3), od, 0, 0, 0);
#undef PK
}
#define PK4(P, BASE, OUT) do { unsigned a0 = cvt_pk_bf16(P[BASE + 0], P[BASE + 1]), a1 = cvt_pk_bf16(P[BASE + 2], P[BASE + 3]);   \
    unsigned b0 = cvt_pk_bf16(P[BASE + 4], P[BASE + 5]), b1 = cvt_pk_bf16(P[BASE + 6], P[BASE + 7]);                              \
    auto r0 = __builtin_amdgcn_permlane32_swap(a0, b0, false, false); auto r1 = __builtin_amdgcn_permlane32_swap(a1, b1, false, false); \
    u32x4 w = {r0[0], r1[0], r0[1], r1[1]}; OUT = __builtin_bit_cast(bf16x8, w); } while (0)

namespace mla {
constexpr int NW = 8, QBLK = 32, KVBLK = 64;
constexpr int KN_B = KVBLK * 256, KR_B = KVBLK * 128, V_B = KVBLK * 256, SLOT = KN_B + KR_B + V_B  , NSLOT = 3;
constexpr int OFF_WS = NSLOT * SLOT  , OFF_END = OFF_WS + NW * 64 * 4;
static_assert(OFF_END <= RING_BYTES, "mla lds");
constexpr int OSTR = 272;
static_assert(NW * 32 * OSTR <= OFF_WS, "O staging aliases the ring");
constexpr float SCALE = 0.07216878364870323f;
constexpr float THR = 8.f;
constexpr int LDQ = NQ, LDKV = NKV, LDR = DOWNP, LDO = DM;

__device__ __forceinline__ void partialSM(f32x16& p0, f32x16& p1, float& m_reg, float& mn, float& alpha, const float C) {
    float pmax = p0[0];
#pragma unroll
    for (int r = 1; r < 16; ++r) pmax = fmaxf(pmax, p0[r]);
#pragma unroll
    for (int r = 0; r < 16; ++r) pmax = fmaxf(pmax, p1[r]);
    { auto rr = __builtin_amdgcn_permlane32_swap(__float_as_uint(pmax), __float_as_uint(pmax), false, false);
      pmax = fmaxf(__uint_as_float(rr[0]), __uint_as_float(rr[1])); }
    if (__builtin_expect(__all((pmax - m_reg) * C <= THR * LOG2E), 1)) { mn = m_reg; alpha = 1.f; }
    else { mn = fmaxf(m_reg, pmax); alpha = __builtin_amdgcn_exp2f((m_reg - mn) * C); m_reg = mn; }
    const float mnC = -mn * C;
#pragma unroll
    for (int r = 0; r < 16; ++r) p0[r] = fmaf(p0[r], C, mnC);
#pragma unroll
    for (int r = 0; r < 16; ++r) p1[r] = fmaf(p1[r], C, mnC);
#pragma unroll
    for (int r = 0; r < 16; ++r) p0[r] = __builtin_amdgcn_exp2f(p0[r]);
}
__device__ __forceinline__ void finishSM(f32x16& p0, f32x16& p1, float alpha, float& l_reg, bf16x8& pa0, bf16x8& pa1, bf16x8& pa2, bf16x8& pa3) {
#pragma unroll
    for (int r = 0; r < 16; ++r) p1[r] = __builtin_amdgcn_exp2f(p1[r]);
    float ps = 0;
#pragma unroll
    for (int r = 0; r < 16; ++r) ps += p0[r];
#pragma unroll
    for (int r = 0; r < 16; ++r) ps += p1[r];
    { auto rr = __builtin_amdgcn_permlane32_swap(__float_as_uint(ps), __float_as_uint(ps), false, false);
      ps = __uint_as_float(rr[0]) + __uint_as_float(rr[1]); }
    l_reg = l_reg * alpha + ps;
    PK4(p0, 0, pa0); PK4(p0, 8, pa1); PK4(p1, 0, pa2); PK4(p1, 8, pa3);
}
__device__ __forceinline__ void qkt(f32x16& p0, f32x16& p1, const LAS unsigned char* slot, const bf16x8* qr, int r32, int hi) {
    p0 = f32x16{}; p1 = f32x16{};
    const LAS unsigned char* kn = slot + r32 * 256; const int xn = (r32 & 7) << 4;
#pragma unroll
    for (int d0 = 0; d0 < 8; ++d0) { const int cb = ((d0 * 16 + hi * 8) * 2) ^ xn;
        const bf16x8 b0 = *(const LAS bf16x8*)(kn + cb), b1 = *(const LAS bf16x8*)(kn + 32 * 256 + cb);
        p0 = __builtin_amdgcn_mfma_f32_32x32x16_bf16(b0, qr[d0], p0, 0, 0, 0);
        p1 = __builtin_amdgcn_mfma_f32_32x32x16_bf16(b1, qr[d0], p1, 0, 0, 0); }
    const LAS unsigned char* kr = slot + KN_B + r32 * 128; const int xr = ((r32 >> 1) & 7) << 4;
#pragma unroll
    for (int d0 = 0; d0 < 4; ++d0) { const int cb = ((d0 * 2 + hi) * 16) ^ xr;
        const bf16x8 b0 = *(const LAS bf16x8*)(kr + cb), b1 = *(const LAS bf16x8*)(kr + 32 * 128 + cb);
        p0 = __builtin_amdgcn_mfma_f32_32x32x16_bf16(b0, qr[8 + d0], p0, 0, 0, 0);
        p1 = __builtin_amdgcn_mfma_f32_32x32x16_bf16(b1, qr[8 + d0], p1, 0, 0, 0); }
}
__device__ __forceinline__ void pv_all(f32x16* o, int vb, bf16x8 pa0, bf16x8 pa1, bf16x8 pa2, bf16x8 pa3) {
    pv_one<0, 4>(o[0], vb, pa0, pa1, pa2, pa3); pv_one<1, 4>(o[1], vb, pa0, pa1, pa2, pa3); pv_one<2, 4>(o[2], vb, pa0, pa1, pa2, pa3); pv_one<3, 4>(o[3], vb, pa0, pa1, pa2, pa3);
}
#define MLA_BAR() asm volatile("s_waitcnt vmcnt(0) lgkmcnt(0)\n\ts_barrier" ::: "memory")
__device__ __forceinline__ void unit(int b, int h, int qb, const bf16_t* __restrict__ Q, const bf16_t* __restrict__ KV, const bf16_t* __restrict__ DN, const float* __restrict__ stat, bf16_t* __restrict__ O, LAS unsigned char* lds, const int wv) {
    const int tid = opaque_tid(wv), wid = __builtin_amdgcn_readfirstlane(tid >> 6), lane = tid & 63, r32 = lane & 31, hi = lane >> 5;
    const size_t tok0 = (size_t)b * SEQ;
    const bf16_t* Qb = Q + (tok0 + (size_t)qb * 256) * LDQ + h * QKD;
    const char* Kn = (const char*)(KV + tok0 * LDKV + h * 128);
    const char* Vh = (const char*)(KV + tok0 * LDKV + 1024 + h * 128);
    const char* Kr = (const char*)(DN + tok0 * LDR + 512);
    LAS float* ws = (LAS float*)(lds + OFF_WS) + wid * 64; LAS float* li_l = ws; LAS float* al_l = ws + 32;
    const unsigned ldsb = (unsigned)(uintptr_t)lds;
    unsigned vkn[2], vv[2], vkr;
#pragma unroll
    for (int i = 0; i < 2; ++i) { const int L = (wid * 2 + i) * 64 + lane; { const int row = L >> 4, c16 = (L & 15) ^ (row & 7); vkn[i] = (unsigned)(row * (LDKV * 2) + c16 * 16); }
        { const int st = L >> 5, w = L & 31, kk = (st >> 2) * 8 + (w >> 2), k = (kk & ~0xC) | ((kk & 4) << 1) | ((kk & 8) >> 1), c = (st & 3) * 32 + (w & 3) * 8; vv[i] = (unsigned)(k * (LDKV * 2) + c * 2); } }
    { const int L = wid * 64 + lane, row = L >> 3, c16 = (L & 7) ^ ((row >> 1) & 7); vkr = (unsigned)(row * (LDR * 2) + c16 * 16); }
#define MLA_ISSUE(t, sl) do { const size_t ko_ = (size_t)(t) * KVBLK; const unsigned sb_ = ldsb + (unsigned)(sl) * SLOT + (unsigned)wid * 2048u; \
        glds16_s(Kn + ko_ * (LDKV * 2), vkn[0], sb_); glds16_s(Kn + ko_ * (LDKV * 2), vkn[1], sb_ + 1024u); \
        glds16_s(Kr + ko_ * (LDR * 2), vkr, ldsb + (unsigned)(sl) * SLOT + KN_B + (unsigned)wid * 1024u); \
        glds16_s(Vh + ko_ * (LDKV * 2), vv[0], sb_ + KN_B + KR_B); glds16_s(Vh + ko_ * (LDKV * 2), vv[1], sb_ + KN_B + KR_B + 1024u); } while (0)
    MLA_ISSUE(0, 0); MLA_ISSUE(1, 1);
    float m_reg = -1e30f, l_reg = 0; f32x16 o[4] = {}; bf16x8 qr[12];
    const float Cq = SCALE * LOG2E * __builtin_amdgcn_rsqf(stat[(tok0 + (size_t)qb * 256 + wid * QBLK + r32) * 4] * (1.f / 256.f) + EPS);
    const bf16_t* Qw = Qb + (size_t)(wid * QBLK + r32) * LDQ + hi * 8;
#pragma unroll
    for (int d0 = 0; d0 < 12; ++d0) qr[d0] = *(const bf16x8*)(Qw + d0 * 16);
    const int vb0 = (int)ldsb + KN_B + KR_B + v_rd_base(lane);
#define RESC(a) do { if (__any((a) < 1.f)) { if (hi == 0) al_l[r32] = (a); asm volatile("s_waitcnt lgkmcnt(0)" ::: "memory"); \
    _Pragma("unroll") for (int d = 0; d < 4; ++d) _Pragma("unroll") for (int r = 0; r < 16; ++r) o[d][r] *= al_l[crow(r, hi)]; } } while (0)
    f32x16 pA0, pA1, pB0, pB1; float mnA, mnB, alA, alB; bf16x8 pa0, pa1, pa2, pa3; constexpr int NT = SEQ / KVBLK;
    MLA_BAR();
    qkt(pA0, pA1, lds, qr, r32, hi); partialSM(pA0, pA1, m_reg, mnA, alA, Cq);
    int sj = 1, sp = 0;
    for (int j = 1; j + 1 < NT; j += 2) {
        { const int sn = sj == 2 ? 0 : sj + 1; MLA_ISSUE(j + 1, sn);
          SBAR(); qkt(pB0, pB1, lds + sj * SLOT, qr, r32, hi);
          finishSM(pA0, pA1, alA, l_reg, pa0, pa1, pa2, pa3); SBAR();
          pv_all(o, vb0 + sp * SLOT, pa0, pa1, pa2, pa3); partialSM(pB0, pB1, m_reg, mnB, alB, Cq);
          RESC(alB); MLA_BAR(); sp = sj; sj = sn; }
        { const int sn = sj == 2 ? 0 : sj + 1; MLA_ISSUE(j + 2, sn);
          SBAR(); qkt(pA0, pA1, lds + sj * SLOT, qr, r32, hi);
          finishSM(pB0, pB1, alB, l_reg, pa0, pa1, pa2, pa3); SBAR();
          pv_all(o, vb0 + sp * SLOT, pa0, pa1, pa2, pa3); partialSM(pA0, pA1, m_reg, mnA, alA, Cq);
          RESC(alA); MLA_BAR(); sp = sj; sj = sn; }
    }
    SBAR(); qkt(pB0, pB1, lds + sj * SLOT, qr, r32, hi);
    finishSM(pA0, pA1, alA, l_reg, pa0, pa1, pa2, pa3); SBAR();
    pv_all(o, vb0 + sp * SLOT, pa0, pa1, pa2, pa3); partialSM(pB0, pB1, m_reg, mnB, alB, Cq);
    RESC(alB);
    finishSM(pB0, pB1, alB, l_reg, pa0, pa1, pa2, pa3); SBAR();
    pv_all(o, vb0 + sj * SLOT, pa0, pa1, pa2, pa3);
    if (hi == 0) li_l[r32] = l_reg; asm volatile("s_waitcnt lgkmcnt(0)" ::: "memory");
    float rli[16];
#pragma unroll
    for (int r = 0; r < 16; ++r) rli[r] = __builtin_amdgcn_rcpf(li_l[crow(r, hi)]);
    MLA_BAR();
    LAS unsigned char* ost = lds + wid * (32 * OSTR);
#pragma unroll
    for (int r = 0; r < 16; ++r) { const int orow = crow(r, hi);
#pragma unroll
        for (int d0 = 0; d0 < 4; ++d0) *(LAS unsigned short*)(ost + orow * OSTR + (d0 * 32 + r32) * 2) = (unsigned short)f2bf(o[d0][r] * rli[r]); }
    asm volatile("s_waitcnt lgkmcnt(0)" ::: "memory");
    bf16_t* Ow = O + (tok0 + (size_t)qb * 256 + wid * QBLK) * LDO + h * 128;
#pragma unroll
    for (int it = 0; it < 8; ++it) { const int ch = it * 64 + lane, row = ch >> 4, c16 = ch & 15;
        const u32x4 v = *(const LAS u32x4*)(ost + row * OSTR + c16 * 16); *(u32x4*)(Ow + (size_t)row * LDO + c16 * 8) = v; }
    MLA_BAR();
#undef MLA_ISSUE
#undef RESC
}
#undef MLA_BAR
}

namespace swa {
constexpr int KSTR = 144, KT = 64 * KSTR  , VT = 8192, NTILE = 5;
constexpr int OFF_K = 0, OFF_V = NTILE * KT  , OFF_O = OFF_V + NTILE * VT  , OSTR = 144, OFF_WS = OFF_O + 8 * 32 * OSTR  , OFF_END = OFF_WS + 8 * 64 * 4;
static_assert(OFF_END <= RING_BYTES, "swa lds");
constexpr int LD = SWA_NQKV;
constexpr float C = 0.125f * LOG2E;
__device__ __forceinline__ void unit(int b, int g, int qb, const bf16_t* __restrict__ QKV, const float* __restrict__ sink, bf16_t* __restrict__ O, LAS unsigned char* lds, const int wv) {
    const int tid = opaque_tid(wv), wid = __builtin_amdgcn_readfirstlane(tid >> 6), lane = tid & 63, r32 = lane & 31, hi = lane >> 5;
    const int q0 = qb * 64; const size_t tok0 = (size_t)b * SEQ;
    int t_lo = 0, t_hi = NTILE;
    if (q0 < 128) t_lo = (128 - q0) / 64;
    if (q0 + 64 + 128 > SEQ) t_hi = (SEQ + 128 - q0) / 64;
    { const int row = tid >> 3, c8 = (tid & 7) * 8; bf16x8 kreg[NTILE], vreg[NTILE];
#pragma unroll
      for (int t = 0; t < NTILE; ++t) if (t >= t_lo && t < t_hi) { const bf16_t* p = QKV + (tok0 + (size_t)(q0 - 128 + 64 * t + row)) * LD + g * 64 + c8;
          kreg[t] = *(const bf16x8*)(p + 1024); vreg[t] = *(const bf16x8*)(p + 1280); }
#pragma unroll
      for (int t = 0; t < NTILE; ++t) if (t >= t_lo && t < t_hi) { *(LAS bf16x8*)(lds + OFF_K + t * KT + row * KSTR + c8 * 2) = kreg[t];
          *(LAS bf16x8*)(lds + OFF_V + t * VT + v_st<2>(row, c8)) = vreg[t]; } }
    const int qh = g * 4 + (wid >> 1), rowb = q0 + (wid & 1) * 32;
    bf16x8 qr[4];
    { const bf16_t* Qw = QKV + (tok0 + (size_t)(rowb + r32)) * LD + qh * 64 + hi * 8;
#pragma unroll
      for (int d0 = 0; d0 < 4; ++d0) qr[d0] = *(const bf16x8*)(Qw + d0 * 16); }
    const float slope2 = __builtin_amdgcn_exp2f(-0.5f * (float)(qh + 1)) * LOG2E;
    const float sink2 = sink[qh] * LOG2E;
    __syncthreads();
    LAS float* al_l = (LAS float*)(lds + OFF_WS) + wid * 64; LAS float* li_l = al_l + 32;
    const int vb0 = (int)(uintptr_t)(lds + OFF_V) + v_rd_base(lane);
    float m_reg = -1e30f, l_reg = 0.f; f32x16 o[2] = {};
    for (int t = t_lo; t < t_hi; ++t) {
        const LAS unsigned char* Ks = lds + OFF_K + t * KT;
        f32x16 p0 = {}, p1 = {};
#pragma unroll
        for (int d0 = 0; d0 < 4; ++d0) { const int cb = (d0 * 16 + hi * 8) * 2;
            const bf16x8 b0 = *(const LAS bf16x8*)(Ks + r32 * KSTR + cb), b1 = *(const LAS bf16x8*)(Ks + (32 + r32) * KSTR + cb);
            p0 = __builtin_amdgcn_mfma_f32_32x32x16_bf16(b0, qr[d0], p0, 0, 0, 0);
            p1 = __builtin_amdgcn_mfma_f32_32x32x16_bf16(b1, qr[d0], p1, 0, 0, 0); }
        const int kb = (q0 - 128 + 64 * t) - (rowb + r32);
        float pmax = -INFINITY;
#pragma unroll
        for (int r = 0; r < 16; ++r) { const int rel0 = kb + crow(r, hi), rel1 = rel0 + 32; const int d0 = rel0 < 0 ? -rel0 : rel0, d1 = rel1 < 0 ? -rel1 : rel1;
            float x0 = fmaf(p0[r], C, -slope2 * (float)d0), x1 = fmaf(p1[r], C, -slope2 * (float)d1);
            x0 = d0 > 128 ? -INFINITY : x0; x1 = d1 > 128 ? -INFINITY : x1; p0[r] = x0; p1[r] = x1; pmax = fmaxf(pmax, fmaxf(x0, x1)); }
        { auto rr = __builtin_amdgcn_permlane32_swap(__float_as_uint(pmax), __float_as_uint(pmax), false, false);
          pmax = fmaxf(__uint_as_float(rr[0]), __uint_as_float(rr[1])); }
        const float mn = fmaxf(m_reg, pmax), alpha = __builtin_amdgcn_exp2f(m_reg - mn); m_reg = mn;
        float ps = 0.f;
#pragma unroll
        for (int r = 0; r < 16; ++r) { p0[r] = __builtin_amdgcn_exp2f(p0[r] - mn); p1[r] = __builtin_amdgcn_exp2f(p1[r] - mn); ps += p0[r] + p1[r]; }
        { auto rr = __builtin_amdgcn_permlane32_swap(__float_as_uint(ps), __float_as_uint(ps), false, false);
          ps = __uint_as_float(rr[0]) + __uint_as_float(rr[1]); }
        l_reg = l_reg * alpha + ps;
        if (hi == 0) al_l[r32] = alpha; asm volatile("s_waitcnt lgkmcnt(0)" ::: "memory");
#pragma unroll
        for (int d = 0; d < 2; ++d)
#pragma unroll
            for (int r = 0; r < 16; ++r) o[d][r] *= al_l[crow(r, hi)];
        bf16x8 pa0, pa1, pa2, pa3;
        PK4(p0, 0, pa0); PK4(p0, 8, pa1); PK4(p1, 0, pa2); PK4(p1, 8, pa3);
        const int vb = vb0 + t * VT;
        pv_one<0, 2>(o[0], vb, pa0, pa1, pa2, pa3); pv_one<1, 2>(o[1], vb, pa0, pa1, pa2, pa3);
    }
    l_reg += __builtin_amdgcn_exp2f(sink2 - m_reg);
    if (hi == 0) li_l[r32] = l_reg; asm volatile("s_waitcnt lgkmcnt(0)" ::: "memory");
    LAS unsigned char* ost = lds + OFF_O + wid * (32 * OSTR);
#pragma unroll
    for (int r = 0; r < 16; ++r) { const int orow = crow(r, hi); const float rl = __builtin_amdgcn_rcpf(li_l[orow]);
#pragma unroll
        for (int d0 = 0; d0 < 2; ++d0) *(LAS unsigned short*)(ost + orow * OSTR + (d0 * 32 + r32) * 2) = (unsigned short)f2bf(o[d0][r] * rl); }
    asm volatile("s_waitcnt lgkmcnt(0)" ::: "memory");
    bf16_t* Ow = O + (tok0 + (size_t)rowb) * DM + qh * 64;
#pragma unroll
    for (int it = 0; it < 4; ++it) { const int ch = it * 64 + lane, row = ch >> 3, c16 = ch & 7;
        const u32x4 v = *(const LAS u32x4*)(ost + row * OSTR + c16 * 16); *(u32x4*)(Ow + (size_t)row * DM + c16 * 8) = v; }
    __syncthreads();
}
}

constexpr int NWAVES = 8;
struct Args { const float* in[23]; float* out; unsigned char* ws; };
static_assert(sizeof(Args) == 25 * 8, "no padding");

template <int KIND> __device__ __forceinline__ int map_row(int n) {
    if (KIND == 0) return n;
    if (KIND == 1) return ((n >> 7) << 8) + (n & 127);
    if (KIND == 2) return ((n >> 7) << 8) + 128 + (n & 127);
    if (KIND == 3) { const int h = n / QKD; int d = n - h * QKD; if (d >= 128) { const int i = d - 128; d = 128 + (i < 32 ? 2 * i : 2 * (i - 32) + 1); } return h * QKD + d; }
    if (KIND == 4) { if (n >= 512) { const int i = n - 512; n = 512 + (i < 32 ? 2 * i : 2 * (i - 32) + 1); } return n; }
    return n;
}
template <int KIND> __device__ __forceinline__ void transpose_matrix(const float* W, int K, int N, bf16_t* WT, int row_off, LAS float* scr, int gw, int NGW, int lane, const float* gk = nullptr) {
    const int nblk = N / 32, nitems = (K / 64) * nblk;
    for (int item = gw; item < nitems; item += NGW) {
        const int kb = item / nblk, nb = item % nblk, k0 = 64 * kb, n0 = 32 * nb;
#pragma unroll 8
        for (int i = 0; i < 32; ++i) { const int kk = 2 * i + (lane >> 5); float wv_ = W[(size_t)(k0 + kk) * N + n0 + (lane & 31)]; if (gk) wv_ *= gk[k0 + kk]; scr[kk * 33 + (lane & 31)] = wv_; }
        LDS_WAIT(); asm volatile("" ::: "memory");
        const int c = lane & 7;
#pragma unroll
        for (int j = 0; j < 4; ++j) { const int n = (lane >> 3) + 8 * j; const LAS float* s = scr + (8 * c) * 33 + n;
            u32x4 o; o.x = pk2(s[0 * 33], s[1 * 33]); o.y = pk2(s[2 * 33], s[3 * 33]); o.z = pk2(s[4 * 33], s[5 * 33]); o.w = pk2(s[6 * 33], s[7 * 33]);
            *(u32x4*)(WT + (size_t)(row_off + map_row<KIND>(n0 + n)) * K + k0 + 8 * c) = o; }
        LDS_WAIT(); asm volatile("" ::: "memory");
    }
}
template <int KIND> __device__ __forceinline__ void transpose_matrix_f8(const float* W, int K, int N, unsigned char* WT, int row_off, LAS float* scr, int gw, int NGW, int lane, float scale) {
    const int nblk = N / 32, nitems = (K / 64) * nblk;
    for (int item = gw; item < nitems; item += NGW) {
        const int kb = item / nblk, nb = item % nblk, k0 = 64 * kb, n0 = 32 * nb;
#pragma unroll 8
        for (int i = 0; i < 32; ++i) { const int kk = 2 * i + (lane >> 5); scr[kk * 33 + (lane & 31)] = W[(size_t)(k0 + kk) * N + n0 + (lane & 31)] * scale; }
        LDS_WAIT(); asm volatile("" ::: "memory");
        const int c = lane & 7;
#pragma unroll
        for (int j = 0; j < 4; ++j) { const int n = (lane >> 3) + 8 * j; const LAS float* sp = scr + (8 * c) * 33 + n;
            const float o[8] = {sp[0 * 33], sp[1 * 33], sp[2 * 33], sp[3 * 33], sp[4 * 33], sp[5 * 33], sp[6 * 33], sp[7 * 33]};
            *(u32x2*)(WT + (size_t)(row_off + map_row<KIND>(n0 + n)) * K + k0 + 8 * c) = pk8_fp8(o); }
        LDS_WAIT(); asm volatile("" ::: "memory");
    }
}
__device__ __forceinline__ void rms_row_to_bf16(const float* xrow, const f32x4 (&gv)[4], bf16_t* orow, int lane) {
    const f32x4* xr = (const f32x4*)xrow + lane; f32x4 v[4]; float s = 0.f;
#pragma unroll
    for (int j = 0; j < 4; ++j) { v[j] = xr[64 * j]; s += (v[j].x * v[j].x + v[j].y * v[j].y) + (v[j].z * v[j].z + v[j].w * v[j].w); }
    const float rstd = 1.0f / sqrtf(wave_sum(s, lane) * (1.f / DM) + EPS);
    unsigned long long* o8 = (unsigned long long*)orow + lane;
#pragma unroll
    for (int j = 0; j < 4; ++j) { const f32x4 y = v[j] * rstd * gv[j]; o8[64 * j] = (unsigned long long)pk2(y.x, y.y) | ((unsigned long long)pk2(y.z, y.w) << 32); }
}

#define PHASE_IDS const int tid = opaque_tid(bar.wv), lane = tid & 63, wave = __builtin_amdgcn_readfirstlane(tid >> 6), gw = vcu * NWAVES + wave; (void)gw; (void)lane
template <int j> __device__ __forceinline__ void pair_body(const Args& args, LAS unsigned char* lds, const XcdBarrier& bar, const int G, const int bx, const int vcu) {
    const int NGW = G * NWAVES;
    unsigned char* ws = args.ws;
    LAS int* moetab = (LAS int*)(lds + MOETAB_OFF);
    const float* x = args.in[0];
    int* route = (int*)(ws + WS_ROUTE); f32x2* gate = (f32x2*)(ws + WS_GATE); int* posb = (int*)(ws + WS_POS); int* cnt = (int*)(ws + WS_CNT);
    unsigned char* act = ws + WS_ACT;
    bf16_t* H = (bf16_t*)(act + A_H); bf16_t* XN = (bf16_t*)(act + A_XN); bf16_t* DOWN = (bf16_t*)(act + A_DOWN); bf16_t* QB = (bf16_t*)(act + A_Q);
    bf16_t* KVB = (bf16_t*)args.out;
    bf16_t* FACT = (bf16_t*)(act + A_FACT); bf16_t* SQKV = (bf16_t*)(act + A_SQKV); bf16_t* SO = (bf16_t*)(act + A_SO); bf16_t* XS = (bf16_t*)args.out; bf16_t* MACT = (bf16_t*)(act + A_MACT);
    float* STAT = (float*)(act + A_STAT); LAS float* PART = (LAS float*)(lds + PART_OFF);
    constexpr bool F8M = ((FP8_MOE >> j) & 1) != 0;
    {
        unsigned char* wb = ws + WS_W + (size_t)j * W_PAIR;
        if (PH(1)) { pg8::Gemm g{XN, (const bf16_t*)(wb + W_DQKV), DM, DM, DM}; pg8::DenseOrder S; S.init(NTOK, DOWNP, G, bx, 256);
          pg8::EpiDown E{DOWN, STAT, PART}; pg8::gemm_phase<pg8::EpiDown, pg8::DenseOrder, true>(lds, g, S, E, bar.wv); }
        xcd_barrier(bar);
        if (PH(3)) { pg8::Gemm g{DOWN, (const bf16_t*)(wb + W_UQ), DOWNP, 256, 256}; pg8::DenseOrder S; S.init(NTOK, NQ, G, bx, 256);
          pg8::EpiQRope E{QB}; pg8::gemm_phase<pg8::EpiQRope, pg8::DenseOrder, true>(lds, g, S, E, bar.wv); }
        { pg8::Gemm g{DOWN + 256, (const bf16_t*)(wb + W_UKV), DOWNP, 256, 256}; pg8::DenseOrder S; S.init(NTOK, NKV, G, bx, 256);
          pg8::EpiBf16<false, 1> E{KVB, NKV, STAT, 1, 1.f / 256.f, 1.f}; pg8::gemm_phase<pg8::EpiBf16<false, 1>, pg8::DenseOrder, true>(lds, g, S, E, bar.wv); }
        xcd_barrier(bar);
        if (PH(4)) { const int NU = BATCH * MLA_H * (SEQ / 256);
          for (int u = vcu; u < NU; u += G) { const int bh = u >> 3, qb = u & 7; mla::unit(bh >> 3, bh & 7, qb, QB, KVB, DOWN, STAT, XN, lds, bar.wv); } }
        xcd_barrier(bar);
        if (PH(5)) { pg8::Gemm g{XN, (const bf16_t*)(wb + W_MO), DM, DM, DM}; pg8::DenseOrder S; S.init(NTOK, DM, G, bx, 256);
          pg8::EpiResid<j == 0> E{j == 0 ? (const void*)x : (const void*)H, H, STAT, PART, RESID_SCALE}; pg8::gemm_phase<pg8::EpiResid<j == 0>, pg8::DenseOrder, true>(lds, g, S, E, bar.wv); }
        xcd_barrier(bar);
        if (PH(7)) { pg8::Gemm g{H, (const bf16_t*)(wb + W_FGU), DM, DM, DM}; pg8::DenseOrder S; S.init(NTOK, 2 * FFN, G, bx, 128);
          pg8::EpiSwiGLU<false, 4> E{FACT, FFN, STAT, 1.f / 1024.f, 1.f}; pg8::gemm_phase<pg8::EpiSwiGLU<false, 4>, pg8::DenseOrder, true>(lds, g, S, E, bar.wv); }
        xcd_barrier(bar);
        if (PH(8)) { pg8::Gemm g{FACT, (const bf16_t*)(wb + W_FD), FFN, FFN, FFN}; pg8::DenseOrder S; S.init(NTOK, DM, G, bx, 256);
          pg8::EpiResid<false> E{H, H, STAT, PART, RESID_SCALE}; pg8::gemm_phase<pg8::EpiResid<false>, pg8::DenseOrder, true>(lds, g, S, E, bar.wv); }
        xcd_barrier(bar);
        if (PH(10)) { pg8::Gemm g{H, (const bf16_t*)(wb + W_SQKV), DM, DM, DM}; pg8::DenseOrder S; S.init(NTOK, SWA_NQKV, G, bx, 256);
          pg8::EpiBf16<false, 4> E{SQKV, SWA_NQKV, STAT, 0, 1.f / 1024.f, 1.f}; pg8::gemm_phase<pg8::EpiBf16<false, 4>, pg8::DenseOrder, true>(lds, g, S, E, bar.wv); }
        xcd_barrier(bar);
        if (PH(11)) { const int NU = BATCH * 4 * (SEQ / 64);
          for (int u = vcu; u < NU; u += G) { const int bg = u >> 5, qb = u & 31; swa::unit(bg >> 2, bg & 3, qb, SQKV, args.in[11] + j * 16, SO, lds, bar.wv); } }
        xcd_barrier(bar);
        if (PH(12)) { pg8::Gemm g{SO, (const bf16_t*)(wb + W_SO), DM, DM, DM}; pg8::DenseOrder S; S.init(NTOK, DM, G, bx, 256);
          pg8::EpiResid<false> E{H, H, STAT, PART, RESID_SCALE}; pg8::gemm_phase<pg8::EpiResid<false>, pg8::DenseOrder, true>(lds, g, S, E, bar.wv); }
        xcd_barrier(bar);
        if (PH(13)) { PHASE_IDS; LAS float* rt = (LAS float*)lds;
          LAS int* lcnt = (LAS int*)(lds + 32768);
          const float* router = args.in[18] + (size_t)j * DM * NE; const float* mg = args.in[17] + j * DM;
          for (int i = tid; i < DM * NE; i += NWAVES * 64) rt[(i & 7) * DM + (i >> 3)] = router[i] * mg[i >> 3];
          for (int ck = vcu; ck < NTOK / 256; ck += G) {
              if (tid < 8) lcnt[tid] = 0;
              __syncthreads();
              for (int r = 0; r < 32; ++r) { const int tok = ck * 256 + wave * 32 + r;
                  const u32x2* hr = (const u32x2*)(H + (size_t)tok * DM) + lane; f32x4 v[4];
#pragma unroll
                  for (int k = 0; k < 4; ++k) { const u32x2 w = hr[64 * k]; v[k] = (f32x4){bf_lo(w.x), bf_hi(w.x), bf_lo(w.y), bf_hi(w.y)}; }
                  const f32x4 st4 = *(const f32x4*)(STAT + (size_t)tok * 4);
                  const float rstd = 1.0f / sqrtf(((st4.x + st4.y) + (st4.z + st4.w)) * (1.f / DM) + EPS);
                  float lg[8];
#pragma unroll
                  for (int e = 0; e < 8; ++e) { float a = 0.f;
#pragma unroll
                      for (int k = 0; k < 4; ++k) { const f32x4 w = *(const LAS f32x4*)(rt + e * DM + 4 * lane + 256 * k); a += (v[k].x * w.x + v[k].y * w.y) + (v[k].z * w.z + v[k].w * w.w); }
                      lg[e] = wave_sum(a, lane) * rstd; }
                  int i0 = 0; float v0 = lg[0];
#pragma unroll
                  for (int e = 1; e < 8; ++e) if (lg[e] > v0) { v0 = lg[e]; i0 = e; }
                  int i1 = -1; float v1 = -INFINITY;
#pragma unroll
                  for (int e = 0; e < 8; ++e) if (e != i0 && lg[e] > v1) { v1 = lg[e]; i1 = e; }
                  const float g0 = 1.0f / (1.0f + __expf(v1 - v0));
                  if (lane == 0) { route[tok] = i0 | (i1 << 8); gate[tok] = (f32x2){g0, 1.0f - g0}; __hip_atomic_fetch_add(lcnt + i0, 1, __ATOMIC_RELAXED, __HIP_MEMORY_SCOPE_WORKGROUP); __hip_atomic_fetch_add(lcnt + i1, 1, __ATOMIC_RELAXED, __HIP_MEMORY_SCOPE_WORKGROUP); } }
              __syncthreads();
              if (tid < 8) cnt[ck * 8 + tid] = lcnt[tid];
              __syncthreads();
          } }
        xcd_barrier(bar);
        if (PH(14)) { PHASE_IDS; LAS int* red = (LAS int*)lds;
          LAS int* tp = (LAS int*)(lds + 1024);
          LAS int* wcn = (LAS int*)(lds + 2048);
          LAS int* lpos = (LAS int*)(lds + 4096);
          f32x4 gv[4];
#pragma unroll
          for (int k = 0; k < 4; ++k) gv[k] = ((const f32x4*)(args.in[17] + j * DM))[lane + 64 * k];
          int v[8];
          if (tid < 256) { const i32x4 c0 = ((const i32x4*)cnt)[tid * 2], c1 = ((const i32x4*)cnt)[tid * 2 + 1]; v[0] = c0.x; v[1] = c0.y; v[2] = c0.z; v[3] = c0.w; v[4] = c1.x; v[5] = c1.y; v[6] = c1.z; v[7] = c1.w; }
          else {
#pragma unroll
              for (int e = 0; e < 8; ++e) v[e] = 0; }
#pragma unroll
          for (int e = 0; e < 8; ++e) { int tot = v[e];
#pragma unroll
              for (int o = 1; o < 64; o <<= 1) tot += shxi(tot, o, lane);
              if (lane == 0) red[wave * 16 + e] = tot; }
          __syncthreads();
          if (tid < 8) { int sm = 0;
#pragma unroll
              for (int w = 0; w < 8; ++w) sm += red[w * 16 + tid];
              tp[tid] = sm; }
          __syncthreads();
          if (tid == 0) { int rs = 0, ts = 0;
              for (int e = 0; e < 8; ++e) { moetab[e] = ts; moetab[16 + e] = rs; rs += tp[e]; ts += (tp[e] + 255) >> 8; }
              moetab[8] = ts; moetab[24] = rs; }
          __syncthreads();
          for (int ck = vcu; ck < NTOK / 256; ck += G) {
#pragma unroll
              for (int e = 0; e < 8; ++e) { int pre = (tid < ck) ? v[e] : 0;
#pragma unroll
                  for (int o = 1; o < 64; o <<= 1) pre += shxi(pre, o, lane);
                  if (lane == 0) red[wave * 16 + 8 + e] = pre; }
              __syncthreads();
              if (tid < 8) { int sm = 0;
#pragma unroll
                  for (int w = 0; w < 8; ++w) sm += red[w * 16 + 8 + tid];
                  tp[8 + tid] = sm; }
              int e0 = 0, e1 = 0, r0 = 0, r1 = 0;
              if (tid < 256) { const int re = route[ck * 256 + tid]; e0 = re & 255; e1 = re >> 8; }
#pragma unroll
              for (int e = 0; e < 8; ++e) { const bool f = (tid < 256) && (e0 == e || e1 == e); const unsigned long long mk = __ballot(f);
                  const int rk = __popcll(mk & ((1ull << lane) - 1ull));
                  if (e0 == e) r0 = rk; if (e1 == e) r1 = rk;
                  if (lane == 0 && wave < 4) wcn[wave * 8 + e] = __popcll(mk); }
              __syncthreads();
              if (tid < 256) { int p0 = moetab[16 + e0] + tp[8 + e0] + r0, p1 = moetab[16 + e1] + tp[8 + e1] + r1;
                  for (int w = 0; w < wave; ++w) { p0 += wcn[w * 8 + e0]; p1 += wcn[w * 8 + e1]; }
                  lpos[tid * 2] = p0; lpos[tid * 2 + 1] = p1; posb[(size_t)(ck * 256 + tid) * 2] = p0; posb[(size_t)(ck * 256 + tid) * 2 + 1] = p1; }
              __syncthreads();
              for (int r = 0; r < 32; ++r) { const int t = wave * 32 + r, tok = ck * 256 + t; const int p0 = lpos[t * 2], p1 = lpos[t * 2 + 1];
                  const u32x2* hr = (const u32x2*)(H + (size_t)tok * DM) + lane;
                  const f32x4 st4 = *(const f32x4*)(STAT + (size_t)tok * 4);
                  const float rstd = 1.0f / sqrtf(((st4.x + st4.y) + (st4.z + st4.w)) * (1.f / DM) + EPS);
                  if (F8M) { unsigned* o0 = (unsigned*)((unsigned char*)XS + (size_t)p0 * DM) + lane; unsigned* o1 = (unsigned*)((unsigned char*)XS + (size_t)p1 * DM) + lane;
#pragma unroll
                      for (int k = 0; k < 4; ++k) { const u32x2 w = hr[64 * k]; const f32x4 y = (f32x4){bf_lo(w.x), bf_hi(w.x), bf_lo(w.y), bf_hi(w.y)} * rstd * gv[k];
                          int ow = 0; ow = __builtin_amdgcn_cvt_pk_fp8_f32(y.x, y.y, ow, false); ow = __builtin_amdgcn_cvt_pk_fp8_f32(y.z, y.w, ow, true); o0[64 * k] = (unsigned)ow; o1[64 * k] = (unsigned)ow; } }
                  else { u32x2* o0 = (u32x2*)(XS + (size_t)p0 * DM) + lane; u32x2* o1 = (u32x2*)(XS + (size_t)p1 * DM) + lane;
#pragma unroll
                  for (int k = 0; k < 4; ++k) { const u32x2 w = hr[64 * k]; const f32x4 y = (f32x4){bf_lo(w.x), bf_hi(w.x), bf_lo(w.y), bf_hi(w.y)} * rstd * gv[k];
                      u32x2 ow; ow.x = pk2(y.x, y.y); ow.y = pk2(y.z, y.w); o0[64 * k] = ow; o1[64 * k] = ow; } } }
              __syncthreads();
          } }
        xcd_barrier(bar);
        if (PH(15)) {
          if constexpr (F8M) { pg8::Gemm g{XS, (const bf16_t*)(wb + W_MGU), DM / 2, DM / 2, DM / 2}; pg8::GroupedOrder S; S.init(moetab, 2 * ED, G, bx, 128);
            pg8::EpiSwiGLU<true, 0, true> E{MACT, ED, nullptr, 0.f, 1.0f / W8_SCALE}; pg8::gemm_phase<pg8::EpiSwiGLU<true, 0, true>, pg8::GroupedOrder, true, true>(lds, g, S, E, bar.wv); }
          else { pg8::Gemm g{XS, (const bf16_t*)(wb + W_MGU), DM, DM, DM}; pg8::GroupedOrder S; S.init(moetab, 2 * ED, G, bx, 128);
            pg8::EpiSwiGLU<true, 0> E{MACT, ED, nullptr, 0.f, 1.f}; pg8::gemm_phase<pg8::EpiSwiGLU<true, 0>, pg8::GroupedOrder, true>(lds, g, S, E, bar.wv); } }
        xcd_barrier(bar);
        if (PH(16)) {
          if constexpr (F8M) { pg8::Gemm g{MACT, (const bf16_t*)(wb + W_MD), ED / 2, ED / 2, ED / 2}; pg8::GroupedOrder S; S.init(moetab, DM, G, bx, 256);
            pg8::EpiBf16<true, 0> E{XS, DM, nullptr, 0, 0.f, 1.0f / W8_SCALE}; pg8::gemm_phase<pg8::EpiBf16<true, 0>, pg8::GroupedOrder, true, true>(lds, g, S, E, bar.wv); }
          else { pg8::Gemm g{MACT, (const bf16_t*)(wb + W_MD), ED, ED, ED}; pg8::GroupedOrder S; S.init(moetab, DM, G, bx, 256);
            pg8::EpiBf16<true, 0> E{XS, DM, nullptr, 0, 0.f, 1.f}; pg8::gemm_phase<pg8::EpiBf16<true, 0>, pg8::GroupedOrder, true>(lds, g, S, E, bar.wv); } }
        xcd_barrier(bar);
        if (PH(17)) { PHASE_IDS;
          f32x4 gv[4];
#pragma unroll
          for (int k = 0; k < 4; ++k) gv[k] = ((const f32x4*)(args.in[1] + DM))[lane + 64 * k];
          for (int m = gw; m < NTOK; m += NGW) {
              const int p0 = posb[(size_t)m * 2], p1 = posb[(size_t)m * 2 + 1]; const f32x2 gg = gate[m] * RESID_SCALE;
              u32x2* hr = (u32x2*)(H + (size_t)m * DM) + lane;
              const u32x2* y0 = (const u32x2*)(XS + (size_t)p0 * DM) + lane; const u32x2* y1 = (const u32x2*)(XS + (size_t)p1 * DM) + lane;
              f32x4 v[4]; float ss = 0.f;
#pragma unroll
              for (int k = 0; k < 4; ++k) { const u32x2 a = y0[64 * k], b = y1[64 * k], hw = hr[64 * k]; f32x4 hv = (f32x4){bf_lo(hw.x), bf_hi(hw.x), bf_lo(hw.y), bf_hi(hw.y)};
                  hv.x += gg.x * bf_lo(a.x) + gg.y * bf_lo(b.x); hv.y += gg.x * bf_hi(a.x) + gg.y * bf_hi(b.x);
                  hv.z += gg.x * bf_lo(a.y) + gg.y * bf_lo(b.y); hv.w += gg.x * bf_hi(a.y) + gg.y * bf_hi(b.y);
                  v[k] = hv; ss += (hv.x * hv.x + hv.y * hv.y) + (hv.z * hv.z + hv.w * hv.w); }
#pragma unroll
              for (int k = 0; k < 4; ++k) { u32x2 ow; ow.x = pk2(v[k].x, v[k].y); ow.y = pk2(v[k].z, v[k].w); hr[64 * k] = ow; }
              if (j == 0) { const float rstd = 1.0f / sqrtf(wave_sum(ss, lane) * (1.f / DM) + EPS);
                  u32x2* o8 = (u32x2*)(XN + (size_t)m * DM) + lane;
#pragma unroll
                  for (int k = 0; k < 4; ++k) { const f32x4 y = v[k] * rstd * gv[k]; u32x2 ow; ow.x = pk2(y.x, y.y); ow.y = pk2(y.z, y.w); o8[64 * k] = ow; } }
          } }
        xcd_barrier(bar);
        if (j == 1 && PH(18)) { PHASE_IDS; float* outp = args.out;
          f32x4 gv[4];
#pragma unroll
          for (int k = 0; k < 4; ++k) gv[k] = ((const f32x4*)args.in[22])[lane + 64 * k];
          for (int m = gw; m < NTOK; m += NGW) {
              const u32x2* hr = (const u32x2*)(H + (size_t)m * DM) + lane; f32x4 v[4]; float ss = 0.f;
#pragma unroll
              for (int k = 0; k < 4; ++k) { const u32x2 hw = hr[64 * k]; v[k] = (f32x4){bf_lo(hw.x), bf_hi(hw.x), bf_lo(hw.y), bf_hi(hw.y)}; ss += (v[k].x * v[k].x + v[k].y * v[k].y) + (v[k].z * v[k].z + v[k].w * v[k].w); }
              const float rstd = 1.0f / sqrtf(wave_sum(ss, lane) * (1.f / DM) + EPS);
              f32x4* o = (f32x4*)(outp + (size_t)m * DM) + lane;
#pragma unroll
              for (int k = 0; k < 4; ++k) o[64 * k] = v[k] * rstd * gv[k];
          } }
    }
}

__global__ void __launch_bounds__(NWAVES * 64, 2) fwd(Args args) {
    extern __shared__ __attribute__((aligned(16))) unsigned char lds_raw[];
    LAS unsigned char* lds = (LAS unsigned char*)lds_raw;
    const int G = gridDim.x, bx = blockIdx.x, vcu = (G % 8 == 0) ? (bx % 8) * (G / 8) + bx / 8 : bx;
    const int NGW = G * NWAVES;
    unsigned char* ws = args.ws;
    unsigned* ctl = (unsigned*)(ws + WS_CTL);
    const int wv0 = __builtin_amdgcn_readfirstlane((int)threadIdx.x >> 6);
    for (int u = opaque_tid(wv0); u < (LDS_BYTES - LDSCTL_OFF) / 4; u += NWAVES * 64) ((LAS unsigned*)(lds + LDSCTL_OFF))[u] = 0u;
    __syncthreads();
    volatile LAS unsigned* MISC = (volatile LAS unsigned*)(lds + MISC_OFF);
    XcdBarrier bar = xcd_barrier_post(ctl + 4096, MISC + 8, wv0);
    const float* x = args.in[0];
    bf16_t* XN = (bf16_t*)(ws + WS_ACT + A_XN);

    if (PH(0)) { PHASE_IDS;
        LAS float* scr = (LAS float*)(lds + wave * 16384);
        for (int j = 0; j < 2; ++j) {
            unsigned char* wb = ws + WS_W + (size_t)j * W_PAIR;
            transpose_matrix<4>(args.in[2] + (size_t)j * DM * 576, DM, 576, (bf16_t*)(wb + W_DQKV), 0, scr, gw, NGW, lane);
            for (int i = gw * 64 + lane; i < (DOWNP - 576) * DM / 8; i += NGW * 64) ((u32x4*)(wb + W_DQKV + (size_t)576 * DM * 2))[i] = (u32x4){0u, 0u, 0u, 0u};
            transpose_matrix<3>(args.in[4] + (size_t)j * 256 * NQ, 256, NQ, (bf16_t*)(wb + W_UQ), 0, scr, gw, NGW, lane, args.in[3] + j * 256);
            transpose_matrix<0>(args.in[6] + (size_t)j * 256 * 1024, 256, 1024, (bf16_t*)(wb + W_UKV), 0, scr, gw, NGW, lane, args.in[5] + j * 256);
            transpose_matrix<0>(args.in[7] + (size_t)j * 256 * 1024, 256, 1024, (bf16_t*)(wb + W_UKV), 1024, scr, gw, NGW, lane, args.in[5] + j * 256);
            transpose_matrix<0>(args.in[8] + (size_t)j * DM * DM, DM, DM, (bf16_t*)(wb + W_MO), 0, scr, gw, NGW, lane);
            transpose_matrix<0>(args.in[10] + (size_t)j * DM * SWA_NQKV, DM, SWA_NQKV, (bf16_t*)(wb + W_SQKV), 0, scr, gw, NGW, lane, args.in[9] + j * DM);
            transpose_matrix<0>(args.in[12] + (size_t)j * DM * DM, DM, DM, (bf16_t*)(wb + W_SO), 0, scr, gw, NGW, lane);
            transpose_matrix<1>(args.in[14] + (size_t)j * DM * FFN, DM, FFN, (bf16_t*)(wb + W_FGU), 0, scr, gw, NGW, lane, args.in[13] + j * DM);
            transpose_matrix<2>(args.in[15] + (size_t)j * DM * FFN, DM, FFN, (bf16_t*)(wb + W_FGU), 0, scr, gw, NGW, lane, args.in[13] + j * DM);
            transpose_matrix<0>(args.in[16] + (size_t)j * FFN * DM, FFN, DM, (bf16_t*)(wb + W_FD), 0, scr, gw, NGW, lane);
            for (int e = 0; e < NE; ++e) {
                if ((FP8_MOE >> j) & 1) {
                    transpose_matrix_f8<1>(args.in[19] + ((size_t)j * NE + e) * DM * ED, DM, ED, wb + W_MGU, e * 2 * ED, scr, gw, NGW, lane, W8_SCALE);
                    transpose_matrix_f8<2>(args.in[20] + ((size_t)j * NE + e) * DM * ED, DM, ED, wb + W_MGU, e * 2 * ED, scr, gw, NGW, lane, W8_SCALE);
                    transpose_matrix_f8<0>(args.in[21] + ((size_t)j * NE + e) * ED * DM, ED, DM, wb + W_MD, e * DM, scr, gw, NGW, lane, W8_SCALE);
                } else {
                transpose_matrix<1>(args.in[19] + ((size_t)j * NE + e) * DM * ED, DM, ED, (bf16_t*)(wb + W_MGU), e * 2 * ED, scr, gw, NGW, lane);
                transpose_matrix<2>(args.in[20] + ((size_t)j * NE + e) * DM * ED, DM, ED, (bf16_t*)(wb + W_MGU), e * 2 * ED, scr, gw, NGW, lane);
                transpose_matrix<0>(args.in[21] + ((size_t)j * NE + e) * ED * DM, ED, DM, (bf16_t*)(wb + W_MD), e * DM, scr, gw, NGW, lane);
                }
            }
        }
        f32x4 gv[4];
#pragma unroll
        for (int j = 0; j < 4; ++j) gv[j] = ((const f32x4*)args.in[1])[lane + 64 * j];
        for (int m = gw; m < NTOK; m += NGW) rms_row_to_bf16(x + (size_t)m * DM, gv, XN + (size_t)m * DM, lane);
    }
    xcd_barrier(bar);

    pair_body<0>(args, lds, bar, G, bx, vcu);
    pair_body<1>(args, lds, bar, G, bx, vcu);
}

extern "C" void kernel_launch(void* const* d_in, const int* in_sizes, int n_in, void* d_out, int out_size, void* d_ws, size_t ws_size, hipStream_t stream) {
    static int grid = 0;
    if (grid == 0) {
        if (n_in != 23 || out_size != NTOK * DM || ws_size < WS_NEED) { fprintf(stderr, "kernel_launch: shape/workspace mismatch (n_in %d out %d ws %zu need %zu)\n", n_in, out_size, ws_size, (size_t)WS_NEED); grid = -1; return; }
        int dev = 0, cus = 0;
        if (hipGetDevice(&dev) != hipSuccess || hipDeviceGetAttribute(&cus, hipDeviceAttributeMultiprocessorCount, dev) != hipSuccess) { grid = -1; return; }
        if (hipFuncSetAttribute((const void*)fwd, hipFuncAttributeMaxDynamicSharedMemorySize, LDS_BYTES) != hipSuccess) { fprintf(stderr, "kernel_launch: hipFuncSetAttribute failed\n"); grid = -1; return; }
        int per_cu = 0;
        if (hipOccupancyMaxActiveBlocksPerMultiprocessor(&per_cu, (const void*)fwd, NWAVES * 64, LDS_BYTES) != hipSuccess || per_cu < 1) fprintf(stderr, "kernel_launch: occupancy query reports %d\n", per_cu);
        (void)hipGetLastError();
        grid = cus;
    }
    if (grid < 0) return;
    if (hipMemsetAsync((char*)d_ws + WS_CTL, 0, CTL_ZERO_BYTES, stream) != hipSuccess) return;
    Args a{};
    for (int i = 0; i < 23; ++i) a.in[i] = (const float*)d_in[i];
    a.out = (float*)d_out; a.ws = (unsigned char*)d_ws;
    hipLaunchKernelGGL(fwd, dim3(grid), dim3(NWAVES * 64), LDS_BYTES, stream, a);
    const hipError_t le = hipPeekAtLastError();
    if (le != hipSuccess) fprintf(stderr, "kernel_launch: launch failed: %s\n", hipGetErrorName(le));
}
```

```cpp
#include <hip/hip_runtime.h>
#include <hip/hip_bf16.h>
#include <cstdio>
#include <cstdint>

#define LAS __attribute__((address_space(3)))
#define GAS __attribute__((address_space(1)))
typedef unsigned short bf16_t;
typedef short bf16x8 __attribute__((ext_vector_type(8)));
typedef short s16x4 __attribute__((ext_vector_type(4)));
typedef float f32x4 __attribute__((ext_vector_type(4)));
typedef float f32x2 __attribute__((ext_vector_type(2)));
typedef float f32x16 __attribute__((ext_vector_type(16)));
typedef unsigned u32x4 __attribute__((ext_vector_type(4)));
typedef unsigned u32x2 __attribute__((ext_vector_type(2)));
typedef int i32x4 __attribute__((ext_vector_type(4)));
typedef int i32x8 __attribute__((ext_vector_type(8)));

constexpr int DM = 1024, BATCH = 32, SEQ = 2048, NTOK = BATCH * SEQ;
constexpr int MLA_H = 8, QKD = 192, DOWNP = 768;
constexpr int NQ = MLA_H * QKD  , NKV = 2048;
constexpr int SWA_NQKV = 1536;
constexpr int FFN = 2816, NE = 8, ED = 2048;
constexpr int NPAIR = NTOK * 2;
constexpr float EPS = 1e-6f;
constexpr float LOG2E = 1.4426950408889634f;
#ifndef PHMASK
#define PHMASK 0xFFFFFFFFu
#endif
#define PH(k) (((PHMASK) >> (k)) & 1u)
#define RESID_SCALE 1.0f
#ifndef FP8_MOE
#define FP8_MOE 3
#endif
#ifndef FP8_FFN
#define FP8_FFN 2
#endif
#ifndef FP8_ATTO
#define FP8_ATTO 0
#endif
constexpr float W8_SCALE = 32.0f, O8_SCALE = 16.0f;

constexpr size_t MiB = 1u << 20;
constexpr size_t WS_CTL = 0, CTL_ZERO_BYTES = 1 * MiB;
constexpr size_t WS_ROPE = 1 * MiB;
constexpr size_t WS_ROUTE = 2 * MiB;
constexpr size_t WS_GATE = 3 * MiB;
constexpr size_t WS_POS = 4 * MiB;
constexpr size_t WS_CNT = 5 * MiB;
constexpr size_t WS_W = 6 * MiB;
constexpr size_t W_DQKV = 0;
constexpr size_t W_UQ = W_DQKV + (size_t)DOWNP * DM * 2;
constexpr size_t W_UKV = W_UQ + (size_t)NQ * 256 * 2;
constexpr size_t W_MO = W_UKV + (size_t)NKV * 256 * 2;
constexpr size_t W_SQKV = W_MO + (size_t)DM * DM * 2;
constexpr size_t W_SO = W_SQKV + (size_t)SWA_NQKV * DM * 2;
constexpr size_t W_FGU = W_SO + (size_t)DM * DM * 2;
constexpr size_t W_FD = W_FGU + (size_t)2 * FFN * DM * 2;
constexpr size_t W_MGU = W_FD + (size_t)DM * FFN * 2;
constexpr size_t W_MD = W_MGU + (size_t)NE * 2 * ED * DM * 2;
constexpr size_t W_PAIR = W_MD + (size_t)NE * DM * ED * 2;
constexpr size_t WS_ACT = 254 * MiB;
static_assert(WS_W + 2 * W_PAIR <= WS_ACT, "weights fit");
constexpr size_t A_H = 0;
constexpr size_t A_XN = 128 * MiB;
constexpr size_t A_DOWN = 256 * MiB;
constexpr size_t A_Q = 352 * MiB;
constexpr size_t A_FACT = 128 * MiB;
constexpr size_t A_SQKV = 128 * MiB;
constexpr size_t A_SO = 320 * MiB;
constexpr size_t A_MACT = 128 * MiB;
constexpr size_t A_YS = 384 * MiB;
constexpr size_t A_H8 = 480 * MiB;
constexpr size_t A_STAT = 768 * MiB;
constexpr size_t WS_NEED = WS_ACT + 770 * MiB;
static_assert(WS_NEED <= 1024 * MiB, "ws");

constexpr int RING_BYTES = 147456;
constexpr int LDSCTL_OFF = RING_BYTES;
constexpr int MISC_OFF = LDSCTL_OFF + 320;
constexpr int PART_OFF = LDSCTL_OFF + 2048;
constexpr int MOETAB_OFF = LDSCTL_OFF + 1024;
constexpr int LDS_BYTES = 163840;

#define RLX_AGENT __ATOMIC_RELAXED, __HIP_MEMORY_SCOPE_AGENT
#define LDS_WAIT() asm volatile("s_waitcnt lgkmcnt(0)" ::: "memory")
#define VM_WAIT() asm volatile("s_waitcnt vmcnt(0)" ::: "memory")
#define SBAR() __builtin_amdgcn_sched_barrier(0)
__device__ __forceinline__ unsigned f2bf(float f) { unsigned u = __builtin_bit_cast(unsigned, f); return (u + 0x7fffu + ((u >> 16) & 1u)) >> 16; }
__device__ __forceinline__ unsigned pk2(float lo, float hi) { return f2bf(lo) | (f2bf(hi) << 16); }
__device__ __forceinline__ unsigned cvt_pk_bf16(float lo, float hi) { unsigned r; asm volatile("v_cvt_pk_bf16_f32 %0, %1, %2" : "=v"(r) : "v"(lo), "v"(hi)); return r; }
__device__ __forceinline__ u32x2 pk8_fp8(const float (&o)[8]) { int w0 = 0, w1 = 0;
    w0 = __builtin_amdgcn_cvt_pk_fp8_f32(o[0], o[1], w0, false); w0 = __builtin_amdgcn_cvt_pk_fp8_f32(o[2], o[3], w0, true);
    w1 = __builtin_amdgcn_cvt_pk_fp8_f32(o[4], o[5], w1, false); w1 = __builtin_amdgcn_cvt_pk_fp8_f32(o[6], o[7], w1, true);
    u32x2 r; r.x = (unsigned)w0; r.y = (unsigned)w1; return r; }
__device__ __forceinline__ unsigned fp8_1(float v) { return (unsigned)__builtin_amdgcn_cvt_pk_fp8_f32(v, v, 0, false) & 0xffu; }
__device__ __forceinline__ float bf_lo(unsigned w) { return __builtin_bit_cast(float, w << 16); }
__device__ __forceinline__ float bf_hi(unsigned w) { return __builtin_bit_cast(float, w & 0xffff0000u); }
__device__ __forceinline__ int opaque_tid(int wv) { int l; asm volatile("v_mbcnt_lo_u32_b32 %0, -1, 0\n\tv_mbcnt_hi_u32_b32 %0, -1, %0" : "=v"(l)); return wv * 64 + l; }
__device__ __forceinline__ int opaque_lane() { int l; asm volatile("v_mbcnt_lo_u32_b32 %0, -1, 0\n\tv_mbcnt_hi_u32_b32 %0, -1, %0" : "=v"(l)); return l; }
__device__ __forceinline__ void glds16_s(const void* sbase, unsigned voff, unsigned lds_dst) {
    unsigned keep;
    asm volatile("s_mov_b32 %0, m0\n\ts_mov_b32 m0, %3\n\ts_nop 0\n\tglobal_load_lds_dwordx4 %1, %2\n\ts_mov_b32 m0, %0" : "=&s"(keep) : "v"(voff), "s"(sbase), "s"(lds_dst) : "memory");
}
__device__ __forceinline__ float shx(float v, int o, int lane) { return __builtin_bit_cast(float, __builtin_amdgcn_ds_bpermute((lane ^ o) << 2, __builtin_bit_cast(int, v))); }
__device__ __forceinline__ int shxi(int v, int o, int lane) { return __builtin_amdgcn_ds_bpermute((lane ^ o) << 2, v); }
__device__ __forceinline__ float wave_sum(float v, int lane) {
#pragma unroll
    for (int o = 1; o < 64; o <<= 1) v += shx(v, o, lane);
    return v;
}

#define XB_TMO      128
#define XB_XCNT(j)  (256  + 64 * (j))
#define XB_XSUB(j)  (1280 + 64 * (j))
#define XB_XGEN(j)  (2304 + 64 * (j))
#define XB_TOP      3328
#define XB_TOPGEN   3392
#define XCD_BAR_WORDS 3456
#define XB_SPIN_CAP (1u << 18)
__device__ __forceinline__ unsigned xb_ld(unsigned* p)              { return __hip_atomic_load(p, __ATOMIC_RELAXED, __HIP_MEMORY_SCOPE_AGENT); }
__device__ __forceinline__ unsigned xb_add(unsigned* p, unsigned v) { return __hip_atomic_fetch_add(p, v, __ATOMIC_RELAXED, __HIP_MEMORY_SCOPE_AGENT); }
__device__ __forceinline__ unsigned xb_xcc_id() { return (unsigned)__builtin_amdgcn_s_getreg((3 << 11) | 20) & 0xFu; }
#define XB_SPIN(cond, bar) do { unsigned _sp = 0; while (cond) { __builtin_amdgcn_s_sleep(1); \
    if ((++_sp & 255u) == 0u) { if (xb_ld(&(bar)[XB_TMO])) break; if (_sp > XB_SPIN_CAP) { atomicAdd(&(bar)[XB_TMO], 1u); break; } } } } while (0)
struct XcdBarrier { unsigned* bar; unsigned x; volatile LAS unsigned* st; int wv; };
__device__ __forceinline__ XcdBarrier xcd_barrier_post(unsigned* bar, volatile LAS unsigned* st, int wv) {
    XcdBarrier b; b.bar = bar; b.x = xb_xcc_id(); b.st = st; b.wv = wv;
    if (opaque_tid(wv) == 0) (void)xb_add(&bar[XB_XCNT(b.x)], 1u);
    return b;
}
__device__ __forceinline__ void xcd_barrier_complete(unsigned* bar, unsigned x, unsigned& nloc, unsigned& nx) {
    const unsigned G = gridDim.x * gridDim.y * gridDim.z;
    unsigned sum, cnt, mine, sp = 0u;
    for (;;) {
        sum = 0u; cnt = 0u; mine = 0u;
#pragma unroll
        for (unsigned j = 0; j < 16; ++j) { const unsigned c = xb_ld(&bar[XB_XCNT(j)]); sum += c; cnt += (c > 0u) ? 1u : 0u; mine = (j == x) ? c : mine; }
        if (sum == G) break;
        __builtin_amdgcn_s_sleep(1);
        if ((++sp & 255u) == 0u) { if (xb_ld(&bar[XB_TMO])) break; if (sp > XB_SPIN_CAP) { atomicAdd(&bar[XB_TMO], 1u); break; } }
    }
    nloc = mine > 0u ? mine : 1u; nx = cnt > 0u ? cnt : 1u;
}
__device__ __forceinline__ void xcd_barrier(const XcdBarrier& b) {
    asm volatile("s_waitcnt vmcnt(0)" ::: "memory");
    __syncthreads();
    if (opaque_tid(b.wv) == 0) {
        unsigned* bar = b.bar;
        __builtin_amdgcn_s_waitcnt(0);
        unsigned nloc = b.st[0], nx = b.st[1];
        if (nloc == 0u) { xcd_barrier_complete(bar, b.x, nloc, nx); b.st[0] = nloc; b.st[1] = nx; }
        const unsigned old = xb_add(&bar[XB_XSUB(b.x)], 1u);
        const unsigned gen = old / nloc;
        if (old + 1u == (gen + 1u) * nloc) {
            __builtin_amdgcn_fence(__ATOMIC_RELEASE, "agent");
            asm volatile("s_waitcnt vmcnt(0)" ::: "memory");
            const unsigned og = xb_add(&bar[XB_TOP], 1u);
            const unsigned tg = og / nx;
            if (og + 1u == (tg + 1u) * nx) xb_add(&bar[XB_TOPGEN], 1u);
            else XB_SPIN(xb_ld(&bar[XB_TOPGEN]) == tg, bar);
            __builtin_amdgcn_fence(__ATOMIC_ACQUIRE, "agent");
            xb_add(&bar[XB_XGEN(b.x)], 1u);
            asm volatile("s_waitcnt vmcnt(0)" ::: "memory");
        } else {
            XB_SPIN(xb_ld(&bar[XB_XGEN(b.x)]) == gen, bar);
            __builtin_amdgcn_fence(__ATOMIC_ACQUIRE, "agent");
            asm volatile("s_waitcnt vmcnt(0)" ::: "memory");
        }
    }
    __syncthreads();
}

namespace pg8 {
constexpr int BM = 256, BK = 64, HALF = 128, HTB = HALF * BK * 2, STAGE_BYTES = 8 * HTB, NXCD = 8, WGM = 8;
__host__ __device__ __forceinline__ int lds_byte(int r, int c) { const int st = (r >> 4) * 2 + (c >> 5), rr = r & 15, cc = c & 31, ob = rr * 64 + cc * 2; return st * 1024 + (ob ^ (((ob >> 9) & 1) << 5)); }
__host__ __device__ __forceinline__ void stage_rc(int b, int& R, int& C) { const int st = b / 1024, sb = b % 1024, swz = sb ^ (((sb >> 9) & 1) << 5); R = (st >> 1) * 16 + swz / 64; C = (st & 1) * 32 + (swz % 64) / 2; }
__host__ __device__ __forceinline__ int perm32(int rho) { const int n = rho >> 4, i = rho & 15; return 8 * (i >> 2) + 4 * n + (i & 3); }

struct Unit { int arow, brow, col, nvalid, nlo; };
struct Gemm { const bf16_t* A; const bf16_t* Bt; int lda, ldb, K; };

struct DenseOrder {
    int nM, nN, nwg, G, c, colw;
    __device__ void init(int M, int N, int G_, int c_, int colw_) { nM = M / BM; nN = N / BM; nwg = nM * nN; G = G_; c = c_; colw = colw_; }
    __device__ __forceinline__ bool next(int i, Unit& u) const {
        const long L = (long)i * G + c; if (L >= nwg) return false;
        int wgid = (int)L; { const int q = nwg / NXCD, r = nwg % NXCD, xcd = wgid % NXCD, off = wgid / NXCD; wgid = (xcd < r ? xcd * (q + 1) : r * (q + 1) + (xcd - r) * q) + off; }
        const int nig = WGM * nN, gid = wgid / nig, fm = gid * WGM, gsz = (nM - fm) < WGM ? (nM - fm) : WGM;
        const int pm = fm + ((wgid % nig) % gsz), pn = (wgid % nig) / gsz;
        u.arow = pm * BM; u.brow = pn * BM; u.col = pn * colw; u.nvalid = BM; u.nlo = 0; return true;
    }
};
struct GroupedOrder {
    int nM, nN, nwg, G, c, colw, erows; const LAS int* tab;
    __device__ void init(const LAS int* tab_, int N, int G_, int c_, int colw_) { tab = tab_; nM = tab_[8]; nN = N / BM; nwg = nM * nN; G = G_; c = c_; colw = colw_; erows = N; }
    __device__ __forceinline__ bool next(int i, Unit& u) const {
        const long L = (long)i * G + c; if (L >= nwg) return false;
        int wgid = (int)L; { const int q = nwg / NXCD, r = nwg % NXCD, xcd = wgid % NXCD, off = wgid / NXCD; wgid = (xcd < r ? xcd * (q + 1) : r * (q + 1) + (xcd - r) * q) + off; }
        const int nig = WGM * nN, gid = wgid / nig, fm = gid * WGM, gsz = (nM - fm) < WGM ? (nM - fm) : WGM;
        const int T = fm + ((wgid % nig) % gsz), pn = (wgid % nig) / gsz;
        int e = 0;
#pragma unroll
        for (int k = 1; k < 8; ++k) e += (T >= tab[k]) ? 1 : 0;
        const int lt = T - tab[e]; int arow = tab[16 + e] + lt * BM; int nv = tab[16 + e + 1] - arow; nv = nv > BM ? BM : nv;
        int lo = 0; { const int over = arow + BM - tab[24]; if (over > 0) { arow -= over; lo = over; nv += over; } }
        u.arow = __builtin_amdgcn_readfirstlane(arow); u.nvalid = __builtin_amdgcn_readfirstlane(nv); u.nlo = __builtin_amdgcn_readfirstlane(lo);
        u.brow = __builtin_amdgcn_readfirstlane(e * erows + pn * BM); u.col = __builtin_amdgcn_readfirstlane(pn * colw); return true;
    }
};

template <int NS> __device__ __forceinline__ float row_rstd(const float* stat, int row, int slot0, float inv_n) {
    float s;
    if (NS == 4) { const f32x4 a = *(const f32x4*)(stat + (size_t)row * 4); s = (a.x + a.y) + (a.z + a.w); }
    else s = stat[(size_t)row * 4 + slot0];
    return __builtin_amdgcn_rsqf(s + EPS / inv_n) * __builtin_sqrtf(1.0f / inv_n);
}
template <int NS> __device__ __forceinline__ void row_rstd8(float (&rs)[2][4], const float* stat, int row0, int slot0, float inv_n) {
#pragma unroll
    for (int ai = 0; ai < 2; ++ai)
#pragma unroll
        for (int m = 0; m < 4; ++m) rs[ai][m] = NS ? row_rstd<NS ? NS : 1>(stat, row0 + ai * HALF + m * 16, slot0, inv_n) : 1.f;
}
__device__ __forceinline__ void stat_combine(LAS float* part, float* stat, const Unit& u, int slot, int wr, int wc, int fr, int fq) {
    asm volatile("s_waitcnt lgkmcnt(0)" ::: "memory"); __builtin_amdgcn_s_barrier(); asm volatile("" ::: "memory");
    const int t = (wr * 4 + wc) * 64 + fq * 16 + fr;
    if (t < 256) { const float sum = (part[t] + part[256 + t]) + (part[512 + t] + part[768 + t]); stat[(size_t)(u.arow + t) * 4 + slot] = sum; }
}
template <bool MASK, int NS> struct EpiBf16 {
    static constexpr bool PERM = true;
    bf16_t* O; int ldc; const float* stat; int slot0; float inv_n; float oscale;
    __device__ __forceinline__ void operator()(const f32x4 (&acc)[2][2][4][2], const Unit& u, int wr, int wc, int fr, int fq) const {
        const int col0 = u.col + wc * 32 + 8 * fq;
        float rs[2][4]; row_rstd8<NS>(rs, stat, u.arow + wr * 64 + fr, slot0, inv_n);
#pragma unroll
        for (int ai = 0; ai < 2; ++ai)
#pragma unroll
            for (int m = 0; m < 4; ++m) { const int rl = ai * HALF + wr * 64 + m * 16 + fr; if (MASK && (rl >= u.nvalid || rl < u.nlo)) continue;
                const float r = rs[ai][m] * oscale;
                bf16_t* rowp = O + (size_t)(u.arow + rl) * ldc + col0;
#pragma unroll
                for (int bj = 0; bj < 2; ++bj) { const f32x4 v0 = acc[ai][bj][m][0] * r, v1 = acc[ai][bj][m][1] * r;
                    u32x4 w; w.x = cvt_pk_bf16(v0[0], v0[1]); w.y = cvt_pk_bf16(v0[2], v0[3]); w.z = cvt_pk_bf16(v1[0], v1[1]); w.w = cvt_pk_bf16(v1[2], v1[3]);
                    *(u32x4*)(rowp + bj * HALF) = w; } }
    }
};
template <bool MASK, int NS, bool F8OUT = false> struct EpiSwiGLU {
    static constexpr bool PERM = true;
    bf16_t* O; int ldc; const float* stat; float inv_n; float oscale;
    __device__ __forceinline__ void operator()(const f32x4 (&acc)[2][2][4][2], const Unit& u, int wr, int wc, int fr, int fq) const {
        const int col0 = u.col + wc * 32 + 8 * fq;
        float rs[2][4]; row_rstd8<NS>(rs, stat, u.arow + wr * 64 + fr, 0, inv_n);
#pragma unroll
        for (int ai = 0; ai < 2; ++ai)
#pragma unroll
            for (int m = 0; m < 4; ++m) { const int rl = ai * HALF + wr * 64 + m * 16 + fr; if (MASK && (rl >= u.nvalid || rl < u.nlo)) continue;
                const float r = rs[ai][m] * oscale;
                float o[8];
#pragma unroll
                for (int n = 0; n < 2; ++n)
#pragma unroll
                    for (int k = 0; k < 4; ++k) { const float g = acc[ai][0][m][n][k] * r, up = acc[ai][1][m][n][k] * r;
                        const float sg = __builtin_amdgcn_rcpf(1.0f + __builtin_amdgcn_exp2f(-g * LOG2E)); o[n * 4 + k] = g * sg * up; }
                if (F8OUT) { *(u32x2*)((unsigned char*)O + (size_t)(u.arow + rl) * ldc + col0) = pk8_fp8(o); }
                else { u32x4 w; w.x = cvt_pk_bf16(o[0], o[1]); w.y = cvt_pk_bf16(o[2], o[3]); w.z = cvt_pk_bf16(o[4], o[5]); w.w = cvt_pk_bf16(o[6], o[7]);
                    *(u32x4*)(O + (size_t)(u.arow + rl) * ldc + col0) = w; } }
    }
};
template <bool BASE_F32, bool H8OUT = false> struct EpiResid {
    static constexpr bool PERM = true;
    const void* base; bf16_t* out; float* stat; LAS float* part; float scale; unsigned char* h8;
    __device__ __forceinline__ void operator()(f32x4 (&acc)[2][2][4][2], const Unit& u, int wr, int wc, int fr, int fq) const {
        const int col0 = u.col + wc * 32 + 8 * fq; const int lane = fq * 16 + fr;
#pragma unroll
        for (int ai = 0; ai < 2; ++ai)
#pragma unroll
          for (int mh = 0; mh < 2; ++mh) {
            if (BASE_F32) { f32x4 t[2][2][2];
#pragma unroll
                for (int m = 0; m < 2; ++m) { const float* bp = (const float*)base + (size_t)(u.arow + ai * HALF + wr * 64 + (mh * 2 + m) * 16 + fr) * DM + col0;
#pragma unroll
                    for (int bj = 0; bj < 2; ++bj)
#pragma unroll
                        for (int n = 0; n < 2; ++n) t[m][bj][n] = *(const f32x4*)(bp + bj * HALF + n * 4); }
#pragma unroll
                for (int m = 0; m < 2; ++m)
#pragma unroll
                    for (int bj = 0; bj < 2; ++bj)
#pragma unroll
                        for (int n = 0; n < 2; ++n) acc[ai][bj][mh * 2 + m][n] = acc[ai][bj][mh * 2 + m][n] * scale + t[m][bj][n];
            } else { u32x4 t[2][2];
#pragma unroll
                for (int m = 0; m < 2; ++m) { const bf16_t* bp = (const bf16_t*)base + (size_t)(u.arow + ai * HALF + wr * 64 + (mh * 2 + m) * 16 + fr) * DM + col0;
#pragma unroll
                    for (int bj = 0; bj < 2; ++bj) t[m][bj] = *(const u32x4*)(bp + bj * HALF); }
#pragma unroll
                for (int m = 0; m < 2; ++m)
#pragma unroll
                    for (int bj = 0; bj < 2; ++bj) { const u32x4 w = t[m][bj];
                        acc[ai][bj][mh * 2 + m][0] = acc[ai][bj][mh * 2 + m][0] * scale + (f32x4){bf_lo(w.x), bf_hi(w.x), bf_lo(w.y), bf_hi(w.y)};
                        acc[ai][bj][mh * 2 + m][1] = acc[ai][bj][mh * 2 + m][1] * scale + (f32x4){bf_lo(w.z), bf_hi(w.z), bf_lo(w.w), bf_hi(w.w)}; }
            }
#pragma unroll
            for (int m = 0; m < 2; ++m)
                asm volatile("" : "+v"(acc[ai][0][mh * 2 + m][0]), "+v"(acc[ai][0][mh * 2 + m][1]), "+v"(acc[ai][1][mh * 2 + m][0]), "+v"(acc[ai][1][mh * 2 + m][1]) :: "memory"); }
#pragma unroll
        for (int ai = 0; ai < 2; ++ai)
#pragma unroll
            for (int m = 0; m < 4; ++m) { const int rl = ai * HALF + wr * 64 + m * 16 + fr; const size_t off = (size_t)(u.arow + rl) * DM + col0; float ss = 0.f;
#pragma unroll
                for (int bj = 0; bj < 2; ++bj) { const f32x4 h0 = acc[ai][bj][m][0], h1 = acc[ai][bj][m][1];
                    ss += ((h0.x * h0.x + h0.y * h0.y) + (h0.z * h0.z + h0.w * h0.w)) + ((h1.x * h1.x + h1.y * h1.y) + (h1.z * h1.z + h1.w * h1.w));
                    u32x4 w; w.x = cvt_pk_bf16(h0.x, h0.y); w.y = cvt_pk_bf16(h0.z, h0.w); w.z = cvt_pk_bf16(h1.x, h1.y); w.w = cvt_pk_bf16(h1.z, h1.w);
                    *(u32x4*)(out + off + bj * HALF) = w;
                    if (H8OUT) { const float o8[8] = {h0.x, h0.y, h0.z, h0.w, h1.x, h1.y, h1.z, h1.w}; *(u32x2*)(h8 + off + bj * HALF) = pk8_fp8(o8); } }
                ss += shx(ss, 16, lane); ss += shx(ss, 32, lane); if (fq == 0) part[wc * 256 + rl] = ss; }
        stat_combine(part, stat, u, u.col >> 8, wr, wc, fr, fq);
    }
};
__device__ __forceinline__ void rope_inv4(float (&inv)[4], int i0) {
#pragma unroll
    for (int k = 0; k < 4; ++k) inv[k] = __builtin_amdgcn_exp2f(-(float)(i0 + k) * (13.287712379549449f / 32.0f)) * 0.15915494309189535f;
}
__device__ __forceinline__ void rope8(f32x4& v0, f32x4& v1, float pos, const float (&inv)[4]) {
    float c[4], sn[4];
#pragma unroll
    for (int k = 0; k < 4; ++k) { float t = pos * inv[k]; t -= rintf(t); c[k] = __builtin_amdgcn_cosf(t); sn[k] = __builtin_amdgcn_sinf(t); }
    const float a0 = v0[0] * c[0] - v0[1] * sn[0], b0 = v0[1] * c[0] + v0[0] * sn[0];
    const float a1 = v0[2] * c[1] - v0[3] * sn[1], b1 = v0[3] * c[1] + v0[2] * sn[1];
    const float a2 = v1[0] * c[2] - v1[1] * sn[2], b2 = v1[1] * c[2] + v1[0] * sn[2];
    const float a3 = v1[2] * c[3] - v1[3] * sn[3], b3 = v1[3] * c[3] + v1[2] * sn[3];
    v0 = (f32x4){a0, b0, a1, b1}; v1 = (f32x4){a2, b2, a3, b3};
}
struct EpiQRope {
    static constexpr bool PERM = true;
    bf16_t* O;
    __device__ __forceinline__ void operator()(const f32x4 (&acc)[2][2][4][2], const Unit& u, int wr, int wc, int fr, int fq) const {
        const int col0 = u.col + wc * 32 + 8 * fq;
#pragma unroll
        for (int bj = 0; bj < 2; ++bj) { const int c = col0 + bj * HALF, d = c % QKD; const bool isr = d >= 128; float inv[4]; rope_inv4(inv, isr ? ((d - 128) >> 1) : 0);
#pragma unroll
            for (int ai = 0; ai < 2; ++ai)
#pragma unroll
                for (int m = 0; m < 4; ++m) { const int row = u.arow + ai * HALF + wr * 64 + m * 16 + fr;
                    f32x4 v0 = acc[ai][bj][m][0], v1 = acc[ai][bj][m][1];
                    if (isr) rope8(v0, v1, (float)(row & (SEQ - 1)), inv);
                    u32x4 w; w.x = cvt_pk_bf16(v0[0], v0[1]); w.y = cvt_pk_bf16(v0[2], v0[3]); w.z = cvt_pk_bf16(v1[0], v1[1]); w.w = cvt_pk_bf16(v1[2], v1[3]);
                    *(u32x4*)(O + (size_t)row * NQ + c) = w; } }
    }
};
struct EpiDown {
    static constexpr bool PERM = true;
    bf16_t* O; float* stat; LAS float* part;
    __device__ __forceinline__ void operator()(const f32x4 (&acc)[2][2][4][2], const Unit& u, int wr, int wc, int fr, int fq) const {
        const int col0 = u.col + wc * 32 + 8 * fq, pn = u.col >> 8, lane = fq * 16 + fr;
        if (pn < 2) {
#pragma unroll
            for (int ai = 0; ai < 2; ++ai)
#pragma unroll
                for (int m = 0; m < 4; ++m) { const int rl = ai * HALF + wr * 64 + m * 16 + fr; float ss = 0.f;
#pragma unroll
                    for (int bj = 0; bj < 2; ++bj) { const f32x4 v0 = acc[ai][bj][m][0], v1 = acc[ai][bj][m][1];
                        ss += ((v0.x * v0.x + v0.y * v0.y) + (v0.z * v0.z + v0.w * v0.w)) + ((v1.x * v1.x + v1.y * v1.y) + (v1.z * v1.z + v1.w * v1.w));
                        u32x4 w; w.x = cvt_pk_bf16(v0[0], v0[1]); w.y = cvt_pk_bf16(v0[2], v0[3]); w.z = cvt_pk_bf16(v1[0], v1[1]); w.w = cvt_pk_bf16(v1[2], v1[3]);
                        *(u32x4*)(O + (size_t)(u.arow + rl) * DOWNP + col0 + bj * HALF) = w; }
                    ss += shx(ss, 16, lane); ss += shx(ss, 32, lane); if (fq == 0) part[wc * 256 + rl] = ss; }
        } else if (wc < 2) {
            float inv[4]; rope_inv4(inv, wc * 16 + 4 * fq);
#pragma unroll
            for (int ai = 0; ai < 2; ++ai)
#pragma unroll
                for (int m = 0; m < 4; ++m) { const int row = u.arow + ai * HALF + wr * 64 + m * 16 + fr;
                    f32x4 v0 = acc[ai][0][m][0], v1 = acc[ai][0][m][1];
                    rope8(v0, v1, (float)(row & (SEQ - 1)), inv);
                    u32x4 w; w.x = cvt_pk_bf16(v0[0], v0[1]); w.y = cvt_pk_bf16(v0[2], v0[3]); w.z = cvt_pk_bf16(v1[0], v1[1]); w.w = cvt_pk_bf16(v1[2], v1[3]);
                    *(u32x4*)(O + (size_t)row * DOWNP + col0) = w; }
        }
        if (pn < 2) stat_combine(part, stat, u, pn, wr, wc, fr, fq);
        else { asm volatile("s_waitcnt lgkmcnt(0)" ::: "memory"); __builtin_amdgcn_s_barrier(); }
    }
};

template <class Epi, class Sched, bool ALIGN_EPI, bool FP8 = false>
__device__ __forceinline__ void gemm_phase(LAS unsigned char* lds, const Gemm g, const Sched& S, const Epi& E, const int wv) {
    const int tid = opaque_tid(wv), wid = __builtin_amdgcn_readfirstlane(tid >> 6), lane = tid & 63, wr = wid >> 2, wc = wid & 3, fr = lane & 15, fq = lane >> 4;
    const int K = g.K, nt = K / BK;
    unsigned voffA[2], voffB[2];
#pragma unroll
    for (int i = 0; i < 2; ++i) { int R, C; stage_rc(tid * 16 + i * 8192, R, C); const int Rb = Epi::PERM ? ((R & ~31) + perm32(R & 31)) : R;
        voffA[i] = (unsigned)(R * g.lda + C) * 2u; voffB[i] = (unsigned)(Rb * g.ldb + C) * 2u; }
    const size_t kstep = (size_t)(BK * 2);
    const size_t hsA = (size_t)HALF * g.lda * 2, hsB = (size_t)HALF * g.ldb * 2;
    const unsigned ldsw = (unsigned)wid * 1024u, ldsb = (unsigned)(uintptr_t)lds;
    const int aoff = lds_byte(wr * 64 + fr, fq * 8), boff = lds_byte(wc * 32 + fr, fq * 8);
#define PG8_SA(b, h) (((b) * 2 + (h)) * HTB)
#define PG8_SB(b, h) ((4 + (b) * 2 + (h)) * HTB)
#define PG8_STAGE(bufoff, gbase, voff) do { _Pragma("unroll") for (int _i = 0; _i < 2; ++_i) \
        glds16_s((const char*)(gbase), (voff)[_i], ldsb + (unsigned)(bufoff) + ldsw + (unsigned)(_i * 8192)); } while (0)
#define PG8_LDA(dst, b, h) do { _Pragma("unroll") for (int m = 0; m < 4; ++m) _Pragma("unroll") for (int k = 0; k < 2; ++k) dst[m][k] = *(const LAS bf16x8*)(lds + PG8_SA(b, h) + aoff + m * 2048 + k * 1024); } while (0)
#define PG8_LDB(dst, b, h) do { _Pragma("unroll") for (int n = 0; n < 2; ++n) _Pragma("unroll") for (int k = 0; k < 2; ++k) dst[n][k] = *(const LAS bf16x8*)(lds + PG8_SB(b, h) + boff + n * 2048 + k * 1024); } while (0)
#define PG8_MMA(ai, bj, At, Bt) do { __builtin_amdgcn_s_setprio(1); _Pragma("unroll") for (int m = 0; m < 4; ++m) _Pragma("unroll") for (int n = 0; n < 2; ++n) { \
        if constexpr (FP8) { const i32x4 b0_ = __builtin_bit_cast(i32x4, Bt[n][0]), b1_ = __builtin_bit_cast(i32x4, Bt[n][1]), a0_ = __builtin_bit_cast(i32x4, At[m][0]), a1_ = __builtin_bit_cast(i32x4, At[m][1]); \
            acc[ai][bj][m][n] = __builtin_amdgcn_mfma_scale_f32_16x16x128_f8f6f4(__builtin_shufflevector(b0_, b1_, 0, 1, 2, 3, 4, 5, 6, 7), __builtin_shufflevector(a0_, a1_, 0, 1, 2, 3, 4, 5, 6, 7), acc[ai][bj][m][n], 0, 0, 0, 0x7F7F7F7F, 0, 0x7F7F7F7F); } \
        else { _Pragma("unroll") for (int k = 0; k < 2; ++k) acc[ai][bj][m][n] = __builtin_amdgcn_mfma_f32_16x16x32_bf16(Bt[n][k], At[m][k], acc[ai][bj][m][n], 0, 0, 0); } } \
        __builtin_amdgcn_s_setprio(0); } while (0)
#define PG8_WAIT_V(n) asm volatile("s_waitcnt vmcnt(" #n ")" ::: "memory")
#define PG8_WAIT_L(n) asm volatile("s_waitcnt lgkmcnt(" #n ")" ::: "memory")
#define PG8_BAR __builtin_amdgcn_s_barrier()
#define PG8_SCHED __builtin_amdgcn_sched_barrier(0)
    Unit cur, nxt; int ui = 0;
    if (!S.next(0, cur)) return;
    f32x4 acc[2][2][4][2];
#pragma unroll
    for (int a = 0; a < 2; ++a)
#pragma unroll
        for (int b = 0; b < 2; ++b)
#pragma unroll
            for (int m = 0; m < 4; ++m)
#pragma unroll
                for (int n = 0; n < 2; ++n) acc[a][b][m][n] = (f32x4){0.f, 0.f, 0.f, 0.f};
    bf16x8 At[4][2], B0[2][2], B1[2][2];
    const char* cA = (const char*)g.A + (size_t)cur.arow * g.lda * 2; const char* cB = (const char*)g.Bt + (size_t)cur.brow * g.ldb * 2;
    PG8_STAGE(PG8_SB(0, 0), cB, voffB); PG8_STAGE(PG8_SB(0, 1), cB + hsB, voffB); PG8_STAGE(PG8_SA(0, 0), cA, voffA); PG8_STAGE(PG8_SA(0, 1), cA + hsA, voffA);
    if (wr == 1) PG8_BAR;
    PG8_WAIT_V(2); PG8_BAR;
    PG8_STAGE(PG8_SB(1, 0), cB + kstep, voffB); PG8_STAGE(PG8_SA(1, 0), cA + kstep, voffA); PG8_STAGE(PG8_SB(1, 1), cB + hsB + kstep, voffB);
    PG8_WAIT_V(6); PG8_BAR;
    for (;;) {
        const bool has_next = S.next(ui + 1, nxt);
        const char* nA = has_next ? (const char*)g.A + (size_t)nxt.arow * g.lda * 2 : cA; const char* nB = has_next ? (const char*)g.Bt + (size_t)nxt.brow * g.ldb * 2 : cB;
        for (int t = 0; t < nt; t += 2) {
            const bool last = (t == nt - 2);
            const char* a1 = cA + (size_t)(t + 1) * kstep;
            const char* a2 = last ? nA : cA + (size_t)(t + 2) * kstep; const char* b2 = last ? nB : cB + (size_t)(t + 2) * kstep;
            const char* a3 = a2 + kstep; const char* b3 = b2 + kstep;
            PG8_LDB(B0, 0, 0); PG8_LDB(B1, 0, 1); PG8_SCHED; PG8_LDA(At, 0, 0); PG8_STAGE(PG8_SA(1, 1), a1 + hsA, voffA);
            PG8_WAIT_V(8); PG8_WAIT_L(0); PG8_BAR; PG8_MMA(0, 0, At, B0); PG8_MMA(0, 1, At, B1); PG8_BAR; PG8_SCHED;
            PG8_LDA(At, 0, 1); PG8_STAGE(PG8_SB(0, 0), b2, voffB); PG8_STAGE(PG8_SB(0, 1), b2 + hsB, voffB); PG8_STAGE(PG8_SA(0, 0), a2, voffA);
            PG8_WAIT_V(8); PG8_WAIT_L(0); PG8_BAR; PG8_MMA(1, 0, At, B0); PG8_MMA(1, 1, At, B1); PG8_BAR; PG8_SCHED;
            PG8_LDB(B0, 1, 0); PG8_LDB(B1, 1, 1); PG8_SCHED; PG8_LDA(At, 1, 0); PG8_STAGE(PG8_SA(0, 1), a2 + hsA, voffA);
            PG8_WAIT_V(8); PG8_WAIT_L(0); PG8_BAR; PG8_MMA(0, 0, At, B0); PG8_MMA(0, 1, At, B1); PG8_BAR; PG8_SCHED;
            PG8_LDA(At, 1, 1); PG8_STAGE(PG8_SB(1, 0), b3, voffB); PG8_STAGE(PG8_SB(1, 1), b3 + hsB, voffB); PG8_STAGE(PG8_SA(1, 0), a3, voffA);
            PG8_WAIT_V(8); PG8_WAIT_L(0); PG8_BAR; PG8_MMA(1, 0, At, B0); PG8_MMA(1, 1, At, B1); PG8_BAR; PG8_SCHED;
        }
        if constexpr (ALIGN_EPI) { if (wr == 0) PG8_BAR; }
        { const int l2 = opaque_lane(); E(acc, cur, wr, wc, l2 & 15, l2 >> 4); }
        if (!has_next) break;
#pragma unroll
        for (int a = 0; a < 2; ++a)
#pragma unroll
            for (int b = 0; b < 2; ++b)
#pragma unroll
                for (int m = 0; m < 4; ++m)
#pragma unroll
                    for (int n = 0; n < 2; ++n) acc[a][b][m][n] = (f32x4){0.f, 0.f, 0.f, 0.f};
        cur = nxt; cA = nA; cB = nB; ++ui;
        if constexpr (ALIGN_EPI) { if (wr == 1) PG8_BAR; }
    }
    PG8_WAIT_V(0);
    if constexpr (!ALIGN_EPI) { if (wr == 0) PG8_BAR; }
    PG8_BAR;
#undef PG8_SA
#undef PG8_SB
#undef PG8_STAGE
#undef PG8_LDA
#undef PG8_LDB
#undef PG8_MMA
#undef PG8_WAIT_V
#undef PG8_WAIT_L
#undef PG8_BAR
#undef PG8_SCHED
}
}

__device__ __forceinline__ int crow(int r, int hi) { return (r & 3) + 8 * (r >> 2) + 4 * hi; }
__device__ __forceinline__ int v_rd_base(int lane) { return ((lane & 3) << 3) | (((lane >> 2) & 3) << 6) | (((lane >> 4) & 1) << 5) | (((lane >> 5) & 1) << 8); }
template <int NCB> __device__ __forceinline__ int v_st(int k, int c) { const int kk = (k & ~0xC) | ((k & 4) << 1) | ((k & 8) >> 1); return ((kk >> 3) * NCB + (c >> 5)) * 512 + ((kk & 7) * 32 + (c & 31)) * 2; }
template <int OFF> __device__ __forceinline__ s16x4 tr_read(int vb) {
    s16x4 r; asm volatile("ds_read_b64_tr_b16 %0, %1 offset:%2" : "=&v"(r) : "v"(vb), "i"(OFF) : "memory"); return r;
}
template <int D0, int NCB> __device__ __forceinline__ void pv_one(f32x16& od, int vb, bf16x8 pa0, bf16x8 pa1, bf16x8 pa2, bf16x8 pa3) {
    constexpr int KS = NCB * 1024, HF = NCB * 512;
    const s16x4 l0 = tr_read<D0 * 512 + 0 * KS>(vb), h0 = tr_read<D0 * 512 + 0 * KS + HF>(vb), l1 = tr_read<D0 * 512 + 1 * KS>(vb), h1 = tr_read<D0 * 512 + 1 * KS + HF>(vb);
    const s16x4 l2 = tr_read<D0 * 512 + 2 * KS>(vb), h2 = tr_read<D0 * 512 + 2 * KS + HF>(vb), l3 = tr_read<D0 * 512 + 3 * KS>(vb), h3 = tr_read<D0 * 512 + 3 * KS + HF>(vb);
    asm volatile("s_waitcnt lgkmcnt(0)" ::: "memory"); SBAR();
#define PK(L, H) (bf16x8){L[0], L[1], L[2], L[3], H[0], H[1], H[2], H[3]}
    od = __builtin_amdgcn_mfma_f32_32x32x16_bf16(pa0, PK(l0, h0), od, 0, 0, 0);
    od = __builtin_amdgcn_mfma_f32_32x32x16_bf16(pa1, PK(l1, h1), od, 0, 0, 0);
    od = __builtin_amdgcn_mfma_f32_32x32x16_bf16(pa2, PK(l2, h2), od, 0, 0, 0);
    od = __builtin_amdgcn_mfma_f32_32x32x16_bf16(pa3, PK(l3, h3), od, 0, 0, 0);
#undef PK
}
#define PK4(P, BASE, OUT) do { unsigned a0 = cvt_pk_bf16(P[BASE + 0], P[BASE + 1]), a1 = cvt_pk_bf16(P[BASE + 2], P[BASE + 3]);   \
    unsigned b0 = cvt_pk_bf16(P[BASE + 4], P[BASE + 5]), b1 = cvt_pk_bf16(P[BASE + 6], P[BASE + 7]);                              \
    auto r0 = __builtin_amdgcn_permlane32_swap(a0, b0, false, false); auto r1 = __builtin_amdgcn_permlane32_swap(a1, b1, false, false); \
    u32x4 w = {r0[0], r1[0], r0[1], r1[1]}; OUT = __builtin_bit_cast(bf16x8, w); } while (0)

namespace mla {
constexpr int NW = 8, QBLK = 32, KVBLK = 64;
constexpr int KN_B = KVBLK * 256, KR_B = KVBLK * 128, V_B = KVBLK * 256, SLOT = KN_B + KR_B + V_B  , NSLOT = 3;
constexpr int OFF_WS = NSLOT * SLOT  , OFF_END = OFF_WS + NW * 64 * 4;
static_assert(OFF_END <= RING_BYTES, "mla lds");
constexpr int OSTR = 272;
static_assert(NW * 32 * OSTR <= OFF_WS, "O staging aliases the ring");
constexpr float SCALE = 0.07216878364870323f;
constexpr float THR = 8.f;
constexpr int LDQ = NQ, LDKV = NKV, LDR = DOWNP, LDO = DM;

__device__ __forceinline__ void partialSM(f32x16& p0, f32x16& p1, float& m_reg, float& mn, float& alpha, const float C) {
    float pmax = p0[0];
#pragma unroll
    for (int r = 1; r < 16; ++r) pmax = fmaxf(pmax, p0[r]);
#pragma unroll
    for (int r = 0; r < 16; ++r) pmax = fmaxf(pmax, p1[r]);
    { auto rr = __builtin_amdgcn_permlane32_swap(__float_as_uint(pmax), __float_as_uint(pmax), false, false);
      pmax = fmaxf(__uint_as_float(rr[0]), __uint_as_float(rr[1])); }
    if (__builtin_expect(__all((pmax - m_reg) * C <= THR * LOG2E), 1)) { mn = m_reg; alpha = 1.f; }
    else { mn = fmaxf(m_reg, pmax); alpha = __builtin_amdgcn_exp2f((m_reg - mn) * C); m_reg = mn; }
    const float mnC = -mn * C;
#pragma unroll
    for (int r = 0; r < 16; ++r) p0[r] = fmaf(p0[r], C, mnC);
#pragma unroll
    for (int r = 0; r < 16; ++r) p1[r] = fmaf(p1[r], C, mnC);
#pragma unroll
    for (int r = 0; r < 16; ++r) p0[r] = __builtin_amdgcn_exp2f(p0[r]);
}
__device__ __forceinline__ void finishSM(f32x16& p0, f32x16& p1, float alpha, float& l_reg, bf16x8& pa0, bf16x8& pa1, bf16x8& pa2, bf16x8& pa3) {
#pragma unroll
    for (int r = 0; r < 16; ++r) p1[r] = __builtin_amdgcn_exp2f(p1[r]);
    float ps = 0;
#pragma unroll
    for (int r = 0; r < 16; ++r) ps += p0[r];
#pragma unroll
    for (int r = 0; r < 16; ++r) ps += p1[r];
    { auto rr = __builtin_amdgcn_permlane32_swap(__float_as_uint(ps), __float_as_uint(ps), false, false);
      ps = __uint_as_float(rr[0]) + __uint_as_float(rr[1]); }
    l_reg = l_reg * alpha + ps;
    PK4(p0, 0, pa0); PK4(p0, 8, pa1); PK4(p1, 0, pa2); PK4(p1, 8, pa3);
}
__device__ __forceinline__ void qkt(f32x16& p0, f32x16& p1, const LAS unsigned char* slot, const bf16x8* qr, int r32, int hi) {
    p0 = f32x16{}; p1 = f32x16{};
    const LAS unsigned char* kn = slot + r32 * 256; const int xn = (r32 & 7) << 4;
#pragma unroll
    for (int d0 = 0; d0 < 8; ++d0) { const int cb = ((d0 * 16 + hi * 8) * 2) ^ xn;
        const bf16x8 b0 = *(const LAS bf16x8*)(kn + cb), b1 = *(const LAS bf16x8*)(kn + 32 * 256 + cb);
        p0 = __builtin_amdgcn_mfma_f32_32x32x16_bf16(b0, qr[d0], p0, 0, 0, 0);
        p1 = __builtin_amdgcn_mfma_f32_32x32x16_bf16(b1, qr[d0], p1, 0, 0, 0); }
    const LAS unsigned char* kr = slot + KN_B + r32 * 128; const int xr = ((r32 >> 1) & 7) << 4;
#pragma unroll
    for (int d0 = 0; d0 < 4; ++d0) { const int cb = ((d0 * 2 + hi) * 16) ^ xr;
        const bf16x8 b0 = *(const LAS bf16x8*)(kr + cb), b1 = *(const LAS bf16x8*)(kr + 32 * 128 + cb);
        p0 = __builtin_amdgcn_mfma_f32_32x32x16_bf16(b0, qr[8 + d0], p0, 0, 0, 0);
        p1 = __builtin_amdgcn_mfma_f32_32x32x16_bf16(b1, qr[8 + d0], p1, 0, 0, 0); }
}
__device__ __forceinline__ void pv_all(f32x16* o, int vb, bf16x8 pa0, bf16x8 pa1, bf16x8 pa2, bf16x8 pa3) {
    pv_one<0, 4>(o[0], vb, pa0, pa1, pa2, pa3); pv_one<1, 4>(o[1], vb, pa0, pa1, pa2, pa3); pv_one<2, 4>(o[2], vb, pa0, pa1, pa2, pa3); pv_one<3, 4>(o[3], vb, pa0, pa1, pa2, pa3);
}
#define MLA_BAR() asm volatile("s_waitcnt vmcnt(0) lgkmcnt(0)\n\ts_barrier" ::: "memory")
template <bool O8> __device__ __forceinline__ void unit(int b, int h, int qb, const bf16_t* __restrict__ Q, const bf16_t* __restrict__ KV, const bf16_t* __restrict__ DN, const float* __restrict__ stat, bf16_t* __restrict__ O, LAS unsigned char* lds, const int wv) {
    const int tid = opaque_tid(wv), wid = __builtin_amdgcn_readfirstlane(tid >> 6), lane = tid & 63, r32 = lane & 31, hi = lane >> 5;
    const size_t tok0 = (size_t)b * SEQ;
    const bf16_t* Qb = Q + (tok0 + (size_t)qb * 256) * LDQ + h * QKD;
    const char* Kn = (const char*)(KV + tok0 * LDKV + h * 128);
    const char* Vh = (const char*)(KV + tok0 * LDKV + 1024 + h * 128);
    const char* Kr = (const char*)(DN + tok0 * LDR + 512);
    LAS float* ws = (LAS float*)(lds + OFF_WS) + wid * 64; LAS float* li_l = ws; LAS float* al_l = ws + 32;
    const unsigned ldsb = (unsigned)(uintptr_t)lds;
    unsigned vkn[2], vv[2], vkr;
#pragma unroll
    for (int i = 0; i < 2; ++i) { const int L = (wid * 2 + i) * 64 + lane; { const int row = L >> 4, c16 = (L & 15) ^ (row & 7); vkn[i] = (unsigned)(row * (LDKV * 2) + c16 * 16); }
        { const int st = L >> 5, w = L & 31, kk = (st >> 2) * 8 + (w >> 2), k = (kk & ~0xC) | ((kk & 4) << 1) | ((kk & 8) >> 1), c = (st & 3) * 32 + (w & 3) * 8; vv[i] = (unsigned)(k * (LDKV * 2) + c * 2); } }
    { const int L = wid * 64 + lane, row = L >> 3, c16 = (L & 7) ^ ((row >> 1) & 7); vkr = (unsigned)(row * (LDR * 2) + c16 * 16); }
#define MLA_ISSUE(t, sl) do { const size_t ko_ = (size_t)(t) * KVBLK; const unsigned sb_ = ldsb + (unsigned)(sl) * SLOT + (unsigned)wid * 2048u; \
        glds16_s(Kn + ko_ * (LDKV * 2), vkn[0], sb_); glds16_s(Kn + ko_ * (LDKV * 2), vkn[1], sb_ + 1024u); \
        glds16_s(Kr + ko_ * (LDR * 2), vkr, ldsb + (unsigned)(sl) * SLOT + KN_B + (unsigned)wid * 1024u); \
        glds16_s(Vh + ko_ * (LDKV * 2), vv[0], sb_ + KN_B + KR_B); glds16_s(Vh + ko_ * (LDKV * 2), vv[1], sb_ + KN_B + KR_B + 1024u); } while (0)
    MLA_ISSUE(0, 0); MLA_ISSUE(1, 1);
    float m_reg = -1e30f, l_reg = 0; f32x16 o[4] = {}; bf16x8 qr[12];
    const float Cq = SCALE * LOG2E * __builtin_amdgcn_rsqf(stat[(tok0 + (size_t)qb * 256 + wid * QBLK + r32) * 4] * (1.f / 256.f) + EPS);
    const bf16_t* Qw = Qb + (size_t)(wid * QBLK + r32) * LDQ + hi * 8;
#pragma unroll
    for (int d0 = 0; d0 < 12; ++d0) qr[d0] = *(const bf16x8*)(Qw + d0 * 16);
    const int vb0 = (int)ldsb + KN_B + KR_B + v_rd_base(lane);
#define RESC(a) do { if (__any((a) < 1.f)) { if (hi == 0) al_l[r32] = (a); asm volatile("s_waitcnt lgkmcnt(0)" ::: "memory"); \
    _Pragma("unroll") for (int d = 0; d < 4; ++d) _Pragma("unroll") for (int r = 0; r < 16; ++r) o[d][r] *= al_l[crow(r, hi)]; } } while (0)
    f32x16 pA0, pA1, pB0, pB1; float mnA, mnB, alA, alB; bf16x8 pa0, pa1, pa2, pa3; constexpr int NT = SEQ / KVBLK;
    MLA_BAR();
    qkt(pA0, pA1, lds, qr, r32, hi); partialSM(pA0, pA1, m_reg, mnA, alA, Cq);
    int sj = 1, sp = 0;
    for (int j = 1; j + 1 < NT; j += 2) {
        { const int sn = sj == 2 ? 0 : sj + 1; MLA_ISSUE(j + 1, sn);
          SBAR(); qkt(pB0, pB1, lds + sj * SLOT, qr, r32, hi);
          finishSM(pA0, pA1, alA, l_reg, pa0, pa1, pa2, pa3); SBAR();
          pv_all(o, vb0 + sp * SLOT, pa0, pa1, pa2, pa3); partialSM(pB0, pB1, m_reg, mnB, alB, Cq);
          RESC(alB); MLA_BAR(); sp = sj; sj = sn; }
        { const int sn = sj == 2 ? 0 : sj + 1; MLA_ISSUE(j + 2, sn);
          SBAR(); qkt(pA0, pA1, lds + sj * SLOT, qr, r32, hi);
          finishSM(pB0, pB1, alB, l_reg, pa0, pa1, pa2, pa3); SBAR();
          pv_all(o, vb0 + sp * SLOT, pa0, pa1, pa2, pa3); partialSM(pA0, pA1, m_reg, mnA, alA, Cq);
          RESC(alA); MLA_BAR(); sp = sj; sj = sn; }
    }
    SBAR(); qkt(pB0, pB1, lds + sj * SLOT, qr, r32, hi);
    finishSM(pA0, pA1, alA, l_reg, pa0, pa1, pa2, pa3); SBAR();
    pv_all(o, vb0 + sp * SLOT, pa0, pa1, pa2, pa3); partialSM(pB0, pB1, m_reg, mnB, alB, Cq);
    RESC(alB);
    finishSM(pB0, pB1, alB, l_reg, pa0, pa1, pa2, pa3); SBAR();
    pv_all(o, vb0 + sj * SLOT, pa0, pa1, pa2, pa3);
    if (hi == 0) li_l[r32] = l_reg; asm volatile("s_waitcnt lgkmcnt(0)" ::: "memory");
    float rli[16];
#pragma unroll
    for (int r = 0; r < 16; ++r) rli[r] = __builtin_amdgcn_rcpf(li_l[crow(r, hi)]);
    MLA_BAR();
    LAS unsigned char* ost = lds + wid * (32 * OSTR);
    if constexpr (O8) {
#pragma unroll
        for (int r = 0; r < 16; ++r) { const int orow = crow(r, hi);
#pragma unroll
            for (int d0 = 0; d0 < 4; ++d0) *(LAS unsigned char*)(ost + orow * 144 + d0 * 32 + r32) = (unsigned char)fp8_1(o[d0][r] * rli[r] * O8_SCALE); }
        asm volatile("s_waitcnt lgkmcnt(0)" ::: "memory");
        unsigned char* Ow = (unsigned char*)O + (tok0 + (size_t)qb * 256 + wid * QBLK) * LDO + h * 128;
#pragma unroll
        for (int it = 0; it < 4; ++it) { const int ch = it * 64 + lane, row = ch >> 3, c16 = ch & 7;
            const u32x4 v = *(const LAS u32x4*)(ost + row * 144 + c16 * 16); *(u32x4*)(Ow + (size_t)row * LDO + c16 * 16) = v; }
    } else {
#pragma unroll
    for (int r = 0; r < 16; ++r) { const int orow = crow(r, hi);
#pragma unroll
        for (int d0 = 0; d0 < 4; ++d0) *(LAS unsigned short*)(ost + orow * OSTR + (d0 * 32 + r32) * 2) = (unsigned short)f2bf(o[d0][r] * rli[r]); }
    asm volatile("s_waitcnt lgkmcnt(0)" ::: "memory");
    bf16_t* Ow = O + (tok0 + (size_t)qb * 256 + wid * QBLK) * LDO + h * 128;
#pragma unroll
    for (int it = 0; it < 8; ++it) { const int ch = it * 64 + lane, row = ch >> 4, c16 = ch & 15;
        const u32x4 v = *(const LAS u32x4*)(ost + row * OSTR + c16 * 16); *(u32x4*)(Ow + (size_t)row * LDO + c16 * 8) = v; }
    }
    MLA_BAR();
#undef MLA_ISSUE
#undef RESC
}
#undef MLA_BAR
}

namespace swa {
constexpr int KT = 8192, SLOT = 16384, NSLOT = 6, NTILE_SEQ = SEQ / 64;
constexpr int OFF_O = NSLOT * SLOT  , OSTR = 144, OFF_WS = OFF_O + 8 * 32 * OSTR  , OFF_END = OFF_WS + 8 * 64 * 4;
static_assert(OFF_END <= RING_BYTES, "swa lds");
constexpr int LD = SWA_NQKV;
constexpr float C = 0.125f * LOG2E;
template <bool O8> __device__ __forceinline__ void superunit(int b, int g, int qb0, int nqb, const bf16_t* __restrict__ QKV, const float* __restrict__ sink, bf16_t* __restrict__ O, LAS unsigned char* lds, const int wv) {
    const int tid = opaque_tid(wv), wid = __builtin_amdgcn_readfirstlane(tid >> 6), lane = tid & 63, r32 = lane & 31, hi = lane >> 5;
    const size_t tok0 = (size_t)b * SEQ; const unsigned ldsb = (unsigned)(uintptr_t)lds;
    const char* Kg = (const char*)(QKV + tok0 * LD + 1024 + g * 64); const char* Vg = (const char*)(QKV + tok0 * LD + 1280 + g * 64);
    unsigned vk, vv;
    { const int L = wid * 64 + lane; { const int row = L >> 3, c16 = (L & 7) ^ ((row >> 1) & 7); vk = (unsigned)(row * (LD * 2) + c16 * 16); }
      { const int st = L >> 5, w = L & 31, kk = (st >> 1) * 8 + (w >> 2), k = (kk & ~0xC) | ((kk & 4) << 1) | ((kk & 8) >> 1), c = (st & 1) * 32 + (w & 3) * 8; vv = (unsigned)(k * (LD * 2) + c * 2); } }
#define SWA_ISSUE(T) do { const size_t ko_ = (size_t)(T) * 64 * (LD * 2); const unsigned sb_ = ldsb + (unsigned)((T) % NSLOT) * SLOT + (unsigned)wid * 1024u; \
        glds16_s(Kg + ko_, vk, sb_); glds16_s(Vg + ko_, vv, sb_ + KT); } while (0)
    { const int t0 = qb0 - 2 < 0 ? 0 : qb0 - 2, t1 = qb0 + 2 > NTILE_SEQ - 1 ? NTILE_SEQ - 1 : qb0 + 2;
      for (int T = t0; T <= t1; ++T) SWA_ISSUE(T); }
    const int qh = g * 4 + (wid >> 1);
    const float slope2 = __builtin_amdgcn_exp2f(-0.5f * (float)(qh + 1)) * LOG2E;
    const float sink2 = sink[qh] * LOG2E;
    LAS float* al_l = (LAS float*)(lds + OFF_WS) + wid * 64; LAS float* li_l = al_l + 32;
    const int vrb = (int)ldsb + KT + v_rd_base(lane);
    const int xr = ((r32 >> 1) & 7) << 4;
    bf16x8 qr[4], qn[4];
    { const bf16_t* Qw = QKV + (tok0 + (size_t)(qb0 * 64 + (wid & 1) * 32 + r32)) * LD + qh * 64 + hi * 8;
#pragma unroll
      for (int d0 = 0; d0 < 4; ++d0) qr[d0] = *(const bf16x8*)(Qw + d0 * 16); }
    asm volatile("s_waitcnt vmcnt(0) lgkmcnt(0)\n\ts_barrier" ::: "memory");
    for (int qb = qb0; qb < qb0 + nqb; ++qb) {
        const bool more = qb + 1 < qb0 + nqb;
        if (more && qb + 3 < NTILE_SEQ) SWA_ISSUE(qb + 3);
        const int q0 = qb * 64, rowb = q0 + (wid & 1) * 32;
        if (more) { const bf16_t* Qw = QKV + (tok0 + (size_t)(rowb + 64 + r32)) * LD + qh * 64 + hi * 8;
#pragma unroll
            for (int d0 = 0; d0 < 4; ++d0) qn[d0] = *(const bf16x8*)(Qw + d0 * 16); }
        asm volatile("" ::: "memory");
        const int T0 = qb - 2 < 0 ? 0 : qb - 2, T1 = qb + 2 > NTILE_SEQ - 1 ? NTILE_SEQ - 1 : qb + 2;
        float m_reg = -1e30f, l_reg = 0.f; f32x16 o[2] = {};
        for (int T = T0; T <= T1; ++T) {
            const LAS unsigned char* Ks = lds + (T % NSLOT) * SLOT + r32 * 128;
            f32x16 p0 = {}, p1 = {};
#pragma unroll
            for (int d0 = 0; d0 < 4; ++d0) { const int cb = ((d0 * 2 + hi) * 16) ^ xr;
                const bf16x8 b0 = *(const LAS bf16x8*)(Ks + cb), b1 = *(const LAS bf16x8*)(Ks + 32 * 128 + cb);
                p0 = __builtin_amdgcn_mfma_f32_32x32x16_bf16(b0, qr[d0], p0, 0, 0, 0);
                p1 = __builtin_amdgcn_mfma_f32_32x32x16_bf16(b1, qr[d0], p1, 0, 0, 0); }
            const int kb = T * 64 - (rowb + r32);
            float pmax = -INFINITY;
#pragma unroll
            for (int r = 0; r < 16; ++r) { const int rel0 = kb + crow(r, hi), rel1 = rel0 + 32; const int d0 = rel0 < 0 ? -rel0 : rel0, d1 = rel1 < 0 ? -rel1 : rel1;
                float x0 = fmaf(p0[r], C, -slope2 * (float)d0), x1 = fmaf(p1[r], C, -slope2 * (float)d1);
                x0 = d0 > 128 ? -INFINITY : x0; x1 = d1 > 128 ? -INFINITY : x1; p0[r] = x0; p1[r] = x1; pmax = fmaxf(pmax, fmaxf(x0, x1)); }
            { auto rr = __builtin_amdgcn_permlane32_swap(__float_as_uint(pmax), __float_as_uint(pmax), false, false);
              pmax = fmaxf(__uint_as_float(rr[0]), __uint_as_float(rr[1])); }
            const float mn = fmaxf(m_reg, pmax), alpha = __builtin_amdgcn_exp2f(m_reg - mn); m_reg = mn;
            float ps = 0.f;
#pragma unroll
            for (int r = 0; r < 16; ++r) { p0[r] = __builtin_amdgcn_exp2f(p0[r] - mn); p1[r] = __builtin_amdgcn_exp2f(p1[r] - mn); ps += p0[r] + p1[r]; }
            { auto rr = __builtin_amdgcn_permlane32_swap(__float_as_uint(ps), __float_as_uint(ps), false, false);
              ps = __uint_as_float(rr[0]) + __uint_as_float(rr[1]); }
            l_reg = l_reg * alpha + ps;
            if (hi == 0) al_l[r32] = alpha; asm volatile("s_waitcnt lgkmcnt(0)" ::: "memory");
#pragma unroll
            for (int d = 0; d < 2; ++d)
#pragma unroll
                for (int r = 0; r < 16; ++r) o[d][r] *= al_l[crow(r, hi)];
            bf16x8 pa0, pa1, pa2, pa3;
            PK4(p0, 0, pa0); PK4(p0, 8, pa1); PK4(p1, 0, pa2); PK4(p1, 8, pa3);
            const int vb = vrb + (T % NSLOT) * SLOT;
            pv_one<0, 2>(o[0], vb, pa0, pa1, pa2, pa3); pv_one<1, 2>(o[1], vb, pa0, pa1, pa2, pa3);
        }
        l_reg += __builtin_amdgcn_exp2f(sink2 - m_reg);
        if (hi == 0) li_l[r32] = l_reg; asm volatile("s_waitcnt lgkmcnt(0)" ::: "memory");
        LAS unsigned char* ost = lds + OFF_O + wid * (32 * OSTR);
        if constexpr (O8) {
#pragma unroll
            for (int r = 0; r < 16; ++r) { const int orow = crow(r, hi); const float rl = __builtin_amdgcn_rcpf(li_l[orow]) * O8_SCALE;
#pragma unroll
                for (int d0 = 0; d0 < 2; ++d0) *(LAS unsigned char*)(ost + orow * 80 + d0 * 32 + r32) = (unsigned char)fp8_1(o[d0][r] * rl); }
            asm volatile("s_waitcnt lgkmcnt(0)" ::: "memory");
            unsigned char* Ow = (unsigned char*)O + (tok0 + (size_t)rowb) * DM + qh * 64;
#pragma unroll
            for (int it = 0; it < 2; ++it) { const int ch = it * 64 + lane, row = ch >> 2, c16 = ch & 3;
                const u32x4 v = *(const LAS u32x4*)(ost + row * 80 + c16 * 16); *(u32x4*)(Ow + (size_t)row * DM + c16 * 16) = v; }
            asm volatile("s_waitcnt vmcnt(2) lgkmcnt(0)\n\ts_barrier" ::: "memory");
        } else {
#pragma unroll
            for (int r = 0; r < 16; ++r) { const int orow = crow(r, hi); const float rl = __builtin_amdgcn_rcpf(li_l[orow]);
#pragma unroll
                for (int d0 = 0; d0 < 2; ++d0) *(LAS unsigned short*)(ost + orow * OSTR + (d0 * 32 + r32) * 2) = (unsigned short)f2bf(o[d0][r] * rl); }
            asm volatile("s_waitcnt lgkmcnt(0)" ::: "memory");
            bf16_t* Ow = O + (tok0 + (size_t)rowb) * DM + qh * 64;
#pragma unroll
            for (int it = 0; it < 4; ++it) { const int ch = it * 64 + lane, row = ch >> 3, c16 = ch & 7;
                const u32x4 v = *(const LAS u32x4*)(ost + row * OSTR + c16 * 16); *(u32x4*)(Ow + (size_t)row * DM + c16 * 8) = v; }
            asm volatile("s_waitcnt vmcnt(4) lgkmcnt(0)\n\ts_barrier" ::: "memory");
        }
#pragma unroll
        for (int d0 = 0; d0 < 4; ++d0) qr[d0] = qn[d0];
    }
    asm volatile("s_waitcnt vmcnt(0)" ::: "memory");
#undef SWA_ISSUE
}
}

constexpr int NWAVES = 8;
struct Args { const float* in[23]; float* out; unsigned char* ws; };
static_assert(sizeof(Args) == 25 * 8, "no padding");

template <int KIND> __device__ __forceinline__ int map_row(int n) {
    if (KIND == 0) return n;
    if (KIND == 1) return ((n >> 7) << 8) + (n & 127);
    if (KIND == 2) return ((n >> 7) << 8) + 128 + (n & 127);
    if (KIND == 3) { const int h = n / QKD; int d = n - h * QKD; if (d >= 128) { const int i = d - 128; d = 128 + (i < 32 ? 2 * i : 2 * (i - 32) + 1); } return h * QKD + d; }
    if (KIND == 4) { if (n >= 512) { const int i = n - 512; n = 512 + (i < 32 ? 2 * i : 2 * (i - 32) + 1); } return n; }
    return n;
}
template <int KIND> __device__ __forceinline__ void transpose_matrix(const float* W, int K, int N, bf16_t* WT, int row_off, LAS float* scr, int gw, int NGW, int lane, const float* gk = nullptr) {
    const int nblk = N / 32, nitems = (K / 64) * nblk;
    for (int item = gw; item < nitems; item += NGW) {
        const int kb = item / nblk, nb = item % nblk, k0 = 64 * kb, n0 = 32 * nb;
        { f32x4 t[8];
#pragma unroll
          for (int i = 0; i < 8; ++i) t[i] = *(const f32x4*)(W + (size_t)(k0 + (lane >> 3) + 8 * i) * N + n0 + 4 * (lane & 7));
#pragma unroll
          for (int i = 0; i < 8; ++i) { const int kk = (lane >> 3) + 8 * i; f32x4 v = t[i]; if (gk) v = v * gk[k0 + kk];
              LAS float* d = scr + kk * 33 + 4 * (lane & 7); d[0] = v.x; d[1] = v.y; d[2] = v.z; d[3] = v.w; } }
        LDS_WAIT(); asm volatile("" ::: "memory");
        const int c = lane & 7;
#pragma unroll
        for (int j = 0; j < 4; ++j) { const int n = (lane >> 3) + 8 * j; const LAS float* s = scr + (8 * c) * 33 + n;
            u32x4 o; o.x = pk2(s[0 * 33], s[1 * 33]); o.y = pk2(s[2 * 33], s[3 * 33]); o.z = pk2(s[4 * 33], s[5 * 33]); o.w = pk2(s[6 * 33], s[7 * 33]);
            *(u32x4*)(WT + (size_t)(row_off + map_row<KIND>(n0 + n)) * K + k0 + 8 * c) = o; }
        LDS_WAIT(); asm volatile("" ::: "memory");
    }
}
template <int KIND> __device__ __forceinline__ void transpose_matrix_f8(const float* W, int K, int N, unsigned char* WT, int row_off, LAS float* scr, int gw, int NGW, int lane, float scale, const float* gk = nullptr) {
    const int nblk = N / 32, nitems = (K / 64) * nblk;
    for (int item = gw; item < nitems; item += NGW) {
        const int kb = item / nblk, nb = item % nblk, k0 = 64 * kb, n0 = 32 * nb;
        { f32x4 t[8];
#pragma unroll
          for (int i = 0; i < 8; ++i) t[i] = *(const f32x4*)(W + (size_t)(k0 + (lane >> 3) + 8 * i) * N + n0 + 4 * (lane & 7));
#pragma unroll
          for (int i = 0; i < 8; ++i) { const int kk = (lane >> 3) + 8 * i; f32x4 v = t[i] * scale; if (gk) v = v * gk[k0 + kk];
              LAS float* d = scr + kk * 33 + 4 * (lane & 7); d[0] = v.x; d[1] = v.y; d[2] = v.z; d[3] = v.w; } }
        LDS_WAIT(); asm volatile("" ::: "memory");
        const int c = lane & 7;
#pragma unroll
        for (int j = 0; j < 4; ++j) { const int n = (lane >> 3) + 8 * j; const LAS float* sp = scr + (8 * c) * 33 + n;
            const float o[8] = {sp[0 * 33], sp[1 * 33], sp[2 * 33], sp[3 * 33], sp[4 * 33], sp[5 * 33], sp[6 * 33], sp[7 * 33]};
            *(u32x2*)(WT + (size_t)(row_off + map_row<KIND>(n0 + n)) * K + k0 + 8 * c) = pk8_fp8(o); }
        LDS_WAIT(); asm volatile("" ::: "memory");
    }
}
__device__ __forceinline__ void rms_row_to_bf16(const float* xrow, const f32x4 (&gv)[4], bf16_t* orow, int lane) {
    const f32x4* xr = (const f32x4*)xrow + lane; f32x4 v[4]; float s = 0.f;
#pragma unroll
    for (int j = 0; j < 4; ++j) { v[j] = xr[64 * j]; s += (v[j].x * v[j].x + v[j].y * v[j].y) + (v[j].z * v[j].z + v[j].w * v[j].w); }
    const float rstd = 1.0f / sqrtf(wave_sum(s, lane) * (1.f / DM) + EPS);
    unsigned long long* o8 = (unsigned long long*)orow + lane;
#pragma unroll
    for (int j = 0; j < 4; ++j) { const f32x4 y = v[j] * rstd * gv[j]; o8[64 * j] = (unsigned long long)pk2(y.x, y.y) | ((unsigned long long)pk2(y.z, y.w) << 32); }
}

#define PHASE_IDS const int tid = opaque_tid(bar.wv), lane = tid & 63, wave = __builtin_amdgcn_readfirstlane(tid >> 6), gw = vcu * NWAVES + wave; (void)gw; (void)lane
template <int j> __device__ __forceinline__ void pair_body(const Args& args, LAS unsigned char* lds, const XcdBarrier& bar, const int G, const int bx, const int vcu) {
    const int NGW = G * NWAVES;
    unsigned char* ws = args.ws;
    LAS int* moetab = (LAS int*)(lds + MOETAB_OFF);
    const float* x = args.in[0];
    int* route = (int*)(ws + WS_ROUTE); f32x2* gate = (f32x2*)(ws + WS_GATE); int* posb = (int*)(ws + WS_POS); int* cnt = (int*)(ws + WS_CNT);
    unsigned char* act = ws + WS_ACT;
    bf16_t* H = (bf16_t*)(act + A_H); bf16_t* XN = (bf16_t*)(act + A_XN); bf16_t* DOWN = (bf16_t*)(act + A_DOWN); bf16_t* QB = (bf16_t*)(act + A_Q);
    bf16_t* KVB = (bf16_t*)args.out;
    bf16_t* FACT = (bf16_t*)(act + A_FACT); bf16_t* SQKV = (bf16_t*)(act + A_SQKV); bf16_t* SO = (bf16_t*)(act + A_SO); bf16_t* XS = (bf16_t*)args.out; bf16_t* MACT = (bf16_t*)(act + A_MACT);
    float* STAT = (float*)(act + A_STAT); LAS float* PART = (LAS float*)(lds + PART_OFF);
    constexpr bool F8M = ((FP8_MOE >> j) & 1) != 0, F8F = ((FP8_FFN >> j) & 1) != 0;
    unsigned char* H8 = act + A_H8;
    bf16_t* YS = F8M ? (bf16_t*)(act + A_YS) : XS;
    constexpr bool FINAL_DIRECT = (j == 1) && F8M;
    {
        unsigned char* wb = ws + WS_W + (size_t)j * W_PAIR;
        if (PH(1)) { pg8::Gemm g{XN, (const bf16_t*)(wb + W_DQKV), DM, DM, DM}; pg8::DenseOrder S; S.init(NTOK, DOWNP, G, bx, 256);
          pg8::EpiDown E{DOWN, STAT, PART}; pg8::gemm_phase<pg8::EpiDown, pg8::DenseOrder, true>(lds, g, S, E, bar.wv); }
        xcd_barrier(bar);
        if (PH(3)) { pg8::Gemm g{DOWN, (const bf16_t*)(wb + W_UQ), DOWNP, 256, 256}; pg8::DenseOrder S; S.init(NTOK, NQ, G, bx, 256);
          pg8::EpiQRope E{QB}; pg8::gemm_phase<pg8::EpiQRope, pg8::DenseOrder, true>(lds, g, S, E, bar.wv); }
        { pg8::Gemm g{DOWN + 256, (const bf16_t*)(wb + W_UKV), DOWNP, 256, 256}; pg8::DenseOrder S; S.init(NTOK, NKV, G, bx, 256);
          pg8::EpiBf16<false, 1> E{KVB, NKV, STAT, 1, 1.f / 256.f, 1.f}; pg8::gemm_phase<pg8::EpiBf16<false, 1>, pg8::DenseOrder, true>(lds, g, S, E, bar.wv); }
        xcd_barrier(bar);
        if (PH(4)) { const int NU = BATCH * MLA_H * (SEQ / 256);
          for (int u = vcu; u < NU; u += G) { const int bh = u >> 3, qb = u & 7; mla::unit<FP8_ATTO != 0>(bh >> 3, bh & 7, qb, QB, KVB, DOWN, STAT, XN, lds, bar.wv); } }
        xcd_barrier(bar);
        if (PH(5)) { constexpr bool F8 = FP8_ATTO != 0; pg8::Gemm g{XN, (const bf16_t*)(wb + W_MO), F8 ? DM / 2 : DM, F8 ? DM / 2 : DM, F8 ? DM / 2 : DM}; pg8::DenseOrder S; S.init(NTOK, DM, G, bx, 256);
          pg8::EpiResid<j == 0, F8F> E{j == 0 ? (const void*)x : (const void*)H, H, STAT, PART, F8 ? RESID_SCALE / (W8_SCALE * O8_SCALE) : RESID_SCALE, H8}; pg8::gemm_phase<pg8::EpiResid<j == 0, F8F>, pg8::DenseOrder, true, F8>(lds, g, S, E, bar.wv); }
        xcd_barrier(bar);
        if (PH(7)) {
          if constexpr (F8F) { pg8::Gemm g{(const bf16_t*)H8, (const bf16_t*)(wb + W_FGU), DM / 2, DM / 2, DM / 2}; pg8::DenseOrder S; S.init(NTOK, 2 * FFN, G, bx, 128);
            pg8::EpiSwiGLU<false, 4, true> E{FACT, FFN, STAT, 1.f / 1024.f, 1.0f / W8_SCALE}; pg8::gemm_phase<pg8::EpiSwiGLU<false, 4, true>, pg8::DenseOrder, true, true>(lds, g, S, E, bar.wv); }
          else { pg8::Gemm g{H, (const bf16_t*)(wb + W_FGU), DM, DM, DM}; pg8::DenseOrder S; S.init(NTOK, 2 * FFN, G, bx, 128);
            pg8::EpiSwiGLU<false, 4> E{FACT, FFN, STAT, 1.f / 1024.f, 1.f}; pg8::gemm_phase<pg8::EpiSwiGLU<false, 4>, pg8::DenseOrder, true>(lds, g, S, E, bar.wv); } }
        xcd_barrier(bar);
        if (PH(8)) {
          if constexpr (F8F) { pg8::Gemm g{FACT, (const bf16_t*)(wb + W_FD), FFN / 2, FFN / 2, FFN / 2}; pg8::DenseOrder S; S.init(NTOK, DM, G, bx, 256);
            pg8::EpiResid<false> E{H, H, STAT, PART, RESID_SCALE / W8_SCALE, nullptr}; pg8::gemm_phase<pg8::EpiResid<false>, pg8::DenseOrder, true, true>(lds, g, S, E, bar.wv); }
          else { pg8::Gemm g{FACT, (const bf16_t*)(wb + W_FD), FFN, FFN, FFN}; pg8::DenseOrder S; S.init(NTOK, DM, G, bx, 256);
            pg8::EpiResid<false> E{H, H, STAT, PART, RESID_SCALE, nullptr}; pg8::gemm_phase<pg8::EpiResid<false>, pg8::DenseOrder, true>(lds, g, S, E, bar.wv); } }
        xcd_barrier(bar);
        if (PH(10)) { pg8::Gemm g{H, (const bf16_t*)(wb + W_SQKV), DM, DM, DM}; pg8::DenseOrder S; S.init(NTOK, SWA_NQKV, G, bx, 256);
          pg8::EpiBf16<false, 4> E{SQKV, SWA_NQKV, STAT, 0, 1.f / 1024.f, 1.f}; pg8::gemm_phase<pg8::EpiBf16<false, 4>, pg8::DenseOrder, true>(lds, g, S, E, bar.wv); }
        xcd_barrier(bar);
        if (PH(11)) { constexpr int NQB = 16, NSU = BATCH * 4 * (SEQ / 64 / NQB);
          for (int su = vcu; su < NSU; su += G) { const int bg = su >> 1, qb0 = (su & 1) * NQB; swa::superunit<FP8_ATTO != 0>(bg >> 2, bg & 3, qb0, NQB, SQKV, args.in[11] + j * 16, SO, lds, bar.wv); } }
        xcd_barrier(bar);
        if (PH(12)) { constexpr bool F8 = FP8_ATTO != 0; pg8::Gemm g{SO, (const bf16_t*)(wb + W_SO), F8 ? DM / 2 : DM, F8 ? DM / 2 : DM, F8 ? DM / 2 : DM}; pg8::DenseOrder S; S.init(NTOK, DM, G, bx, 256);
          pg8::EpiResid<false> E{H, H, STAT, PART, F8 ? RESID_SCALE / (W8_SCALE * O8_SCALE) : RESID_SCALE, nullptr}; pg8::gemm_phase<pg8::EpiResid<false>, pg8::DenseOrder, true, F8>(lds, g, S, E, bar.wv); }
        xcd_barrier(bar);
        if (PH(13)) { PHASE_IDS; LAS float* rt = (LAS float*)lds;
          LAS int* lcnt = (LAS int*)(lds + 32768);
          const float* router = args.in[18] + (size_t)j * DM * NE; const float* mg = args.in[17] + j * DM;
          for (int i = tid; i < DM * NE; i += NWAVES * 64) rt[(i & 7) * DM + (i >> 3)] = router[i] * mg[i >> 3];
          for (int ck = vcu; ck < NTOK / 256; ck += G) {
              if (tid < 8) lcnt[tid] = 0;
              __syncthreads();
              for (int r = 0; r < 32; ++r) { const int tok = ck * 256 + wave * 32 + r;
                  const u32x2* hr = (const u32x2*)(H + (size_t)tok * DM) + lane; f32x4 v[4];
#pragma unroll
                  for (int k = 0; k < 4; ++k) { const u32x2 w = hr[64 * k]; v[k] = (f32x4){bf_lo(w.x), bf_hi(w.x), bf_lo(w.y), bf_hi(w.y)}; }
                  const f32x4 st4 = *(const f32x4*)(STAT + (size_t)tok * 4);
                  const float rstd = 1.0f / sqrtf(((st4.x + st4.y) + (st4.z + st4.w)) * (1.f / DM) + EPS);
                  float lg[8];
#pragma unroll
                  for (int e = 0; e < 8; ++e) { float a = 0.f;
#pragma unroll
                      for (int k = 0; k < 4; ++k) { const f32x4 w = *(const LAS f32x4*)(rt + e * DM + 4 * lane + 256 * k); a += (v[k].x * w.x + v[k].y * w.y) + (v[k].z * w.z + v[k].w * w.w); }
                      lg[e] = wave_sum(a, lane) * rstd; }
                  int i0 = 0; float v0 = lg[0];
#pragma unroll
                  for (int e = 1; e < 8; ++e) if (lg[e] > v0) { v0 = lg[e]; i0 = e; }
                  int i1 = -1; float v1 = -INFINITY;
#pragma unroll
                  for (int e = 0; e < 8; ++e) if (e != i0 && lg[e] > v1) { v1 = lg[e]; i1 = e; }
                  const float g0 = 1.0f / (1.0f + __expf(v1 - v0));
                  if (lane == 0) { route[tok] = i0 | (i1 << 8); gate[tok] = (f32x2){g0, 1.0f - g0}; __hip_atomic_fetch_add(lcnt + i0, 1, __ATOMIC_RELAXED, __HIP_MEMORY_SCOPE_WORKGROUP); __hip_atomic_fetch_add(lcnt + i1, 1, __ATOMIC_RELAXED, __HIP_MEMORY_SCOPE_WORKGROUP); } }
              __syncthreads();
              if (tid < 8) cnt[ck * 8 + tid] = lcnt[tid];
              __syncthreads();
          } }
        xcd_barrier(bar);
        if (PH(14)) { PHASE_IDS; LAS int* red = (LAS int*)lds;
          LAS int* tp = (LAS int*)(lds + 1024);
          LAS int* wcn = (LAS int*)(lds + 2048);
          LAS int* lpos = (LAS int*)(lds + 4096);
          f32x4 gv[4];
#pragma unroll
          for (int k = 0; k < 4; ++k) gv[k] = ((const f32x4*)(args.in[17] + j * DM))[lane + 64 * k];
          int v[8];
          if (tid < 256) { const i32x4 c0 = ((const i32x4*)cnt)[tid * 2], c1 = ((const i32x4*)cnt)[tid * 2 + 1]; v[0] = c0.x; v[1] = c0.y; v[2] = c0.z; v[3] = c0.w; v[4] = c1.x; v[5] = c1.y; v[6] = c1.z; v[7] = c1.w; }
          else {
#pragma unroll
              for (int e = 0; e < 8; ++e) v[e] = 0; }
#pragma unroll
          for (int e = 0; e < 8; ++e) { int tot = v[e];
#pragma unroll
              for (int o = 1; o < 64; o <<= 1) tot += shxi(tot, o, lane);
              if (lane == 0) red[wave * 16 + e] = tot; }
          __syncthreads();
          if (tid < 8) { int sm = 0;
#pragma unroll
              for (int w = 0; w < 8; ++w) sm += red[w * 16 + tid];
              tp[tid] = sm; }
          __syncthreads();
          if (tid == 0) { int rs = 0, ts = 0;
              for (int e = 0; e < 8; ++e) { moetab[e] = ts; moetab[16 + e] = rs; rs += tp[e]; ts += (tp[e] + 255) >> 8; }
              moetab[8] = ts; moetab[24] = rs; }
          __syncthreads();
          for (int ck = vcu; ck < NTOK / 256; ck += G) {
#pragma unroll
              for (int e = 0; e < 8; ++e) { int pre = (tid < ck) ? v[e] : 0;
#pragma unroll
                  for (int o = 1; o < 64; o <<= 1) pre += shxi(pre, o, lane);
                  if (lane == 0) red[wave * 16 + 8 + e] = pre; }
              __syncthreads();
              if (tid < 8) { int sm = 0;
#pragma unroll
                  for (int w = 0; w < 8; ++w) sm += red[w * 16 + 8 + tid];
                  tp[8 + tid] = sm; }
              int e0 = 0, e1 = 0, r0 = 0, r1 = 0;
              if (tid < 256) { const int re = route[ck * 256 + tid]; e0 = re & 255; e1 = re >> 8; }
#pragma unroll
              for (int e = 0; e < 8; ++e) { const bool f = (tid < 256) && (e0 == e || e1 == e); const unsigned long long mk = __ballot(f);
                  const int rk = __popcll(mk & ((1ull << lane) - 1ull));
                  if (e0 == e) r0 = rk; if (e1 == e) r1 = rk;
                  if (lane == 0 && wave < 4) wcn[wave * 8 + e] = __popcll(mk); }
              __syncthreads();
              if (tid < 256) { int p0 = moetab[16 + e0] + tp[8 + e0] + r0, p1 = moetab[16 + e1] + tp[8 + e1] + r1;
                  for (int w = 0; w < wave; ++w) { p0 += wcn[w * 8 + e0]; p1 += wcn[w * 8 + e1]; }
                  lpos[tid * 2] = p0; lpos[tid * 2 + 1] = p1; posb[(size_t)(ck * 256 + tid) * 2] = p0; posb[(size_t)(ck * 256 + tid) * 2 + 1] = p1; }
              __syncthreads();
              for (int r = 0; r < 32; ++r) { const int t = wave * 32 + r, tok = ck * 256 + t; const int p0 = lpos[t * 2], p1 = lpos[t * 2 + 1];
                  const u32x2* hr = (const u32x2*)(H + (size_t)tok * DM) + lane;
                  const f32x4 st4 = *(const f32x4*)(STAT + (size_t)tok * 4);
                  const float rstd = 1.0f / sqrtf(((st4.x + st4.y) + (st4.z + st4.w)) * (1.f / DM) + EPS);
                  if (F8M) { unsigned* o0 = (unsigned*)((unsigned char*)XS + (size_t)p0 * DM) + lane; unsigned* o1 = (unsigned*)((unsigned char*)XS + (size_t)p1 * DM) + lane;
#pragma unroll
                      for (int k = 0; k < 4; ++k) { const u32x2 w = hr[64 * k]; const f32x4 y = (f32x4){bf_lo(w.x), bf_hi(w.x), bf_lo(w.y), bf_hi(w.y)} * rstd * gv[k];
                          int ow = 0; ow = __builtin_amdgcn_cvt_pk_fp8_f32(y.x, y.y, ow, false); ow = __builtin_amdgcn_cvt_pk_fp8_f32(y.z, y.w, ow, true); o0[64 * k] = (unsigned)ow; o1[64 * k] = (unsigned)ow; } }
                  else { u32x2* o0 = (u32x2*)(XS + (size_t)p0 * DM) + lane; u32x2* o1 = (u32x2*)(XS + (size_t)p1 * DM) + lane;
#pragma unroll
                  for (int k = 0; k < 4; ++k) { const u32x2 w = hr[64 * k]; const f32x4 y = (f32x4){bf_lo(w.x), bf_hi(w.x), bf_lo(w.y), bf_hi(w.y)} * rstd * gv[k];
                      u32x2 ow; ow.x = pk2(y.x, y.y); ow.y = pk2(y.z, y.w); o0[64 * k] = ow; o1[64 * k] = ow; } } }
              __syncthreads();
          } }
        xcd_barrier(bar);
        if (PH(15)) {
          if constexpr (F8M) { pg8::Gemm g{XS, (const bf16_t*)(wb + W_MGU), DM / 2, DM / 2, DM / 2}; pg8::GroupedOrder S; S.init(moetab, 2 * ED, G, bx, 128);
            pg8::EpiSwiGLU<true, 0, true> E{MACT, ED, nullptr, 0.f, 1.0f / W8_SCALE}; pg8::gemm_phase<pg8::EpiSwiGLU<true, 0, true>, pg8::GroupedOrder, true, true>(lds, g, S, E, bar.wv); }
          else { pg8::Gemm g{XS, (const bf16_t*)(wb + W_MGU), DM, DM, DM}; pg8::GroupedOrder S; S.init(moetab, 2 * ED, G, bx, 128);
            pg8::EpiSwiGLU<true, 0> E{MACT, ED, nullptr, 0.f, 1.f}; pg8::gemm_phase<pg8::EpiSwiGLU<true, 0>, pg8::GroupedOrder, true>(lds, g, S, E, bar.wv); } }
        xcd_barrier(bar);
        if (PH(16)) {
          if constexpr (F8M) { pg8::Gemm g{MACT, (const bf16_t*)(wb + W_MD), ED / 2, ED / 2, ED / 2}; pg8::GroupedOrder S; S.init(moetab, DM, G, bx, 256);
            pg8::EpiBf16<true, 0> E{YS, DM, nullptr, 0, 0.f, 1.0f / W8_SCALE}; pg8::gemm_phase<pg8::EpiBf16<true, 0>, pg8::GroupedOrder, true, true>(lds, g, S, E, bar.wv); }
          else { pg8::Gemm g{MACT, (const bf16_t*)(wb + W_MD), ED, ED, ED}; pg8::GroupedOrder S; S.init(moetab, DM, G, bx, 256);
            pg8::EpiBf16<true, 0> E{XS, DM, nullptr, 0, 0.f, 1.f}; pg8::gemm_phase<pg8::EpiBf16<true, 0>, pg8::GroupedOrder, true>(lds, g, S, E, bar.wv); } }
        xcd_barrier(bar);
        if (PH(17)) { PHASE_IDS;
          f32x4 gv[4];
#pragma unroll
          for (int k = 0; k < 4; ++k) gv[k] = ((const f32x4*)(j == 0 ? args.in[1] + DM : args.in[22]))[lane + 64 * k];
          for (int m = gw; m < NTOK; m += NGW) {
              const int p0 = posb[(size_t)m * 2], p1 = posb[(size_t)m * 2 + 1]; const f32x2 gg = gate[m] * RESID_SCALE;
              u32x2* hr = (u32x2*)(H + (size_t)m * DM) + lane;
              const u32x2* y0 = (const u32x2*)(YS + (size_t)p0 * DM) + lane; const u32x2* y1 = (const u32x2*)(YS + (size_t)p1 * DM) + lane;
              f32x4 v[4]; float ss = 0.f;
#pragma unroll
              for (int k = 0; k < 4; ++k) { const u32x2 a = y0[64 * k], b = y1[64 * k], hw = hr[64 * k]; f32x4 hv = (f32x4){bf_lo(hw.x), bf_hi(hw.x), bf_lo(hw.y), bf_hi(hw.y)};
                  hv.x += gg.x * bf_lo(a.x) + gg.y * bf_lo(b.x); hv.y += gg.x * bf_hi(a.x) + gg.y * bf_hi(b.x);
                  hv.z += gg.x * bf_lo(a.y) + gg.y * bf_lo(b.y); hv.w += gg.x * bf_hi(a.y) + gg.y * bf_hi(b.y);
                  v[k] = hv; ss += (hv.x * hv.x + hv.y * hv.y) + (hv.z * hv.z + hv.w * hv.w); }
              if (!FINAL_DIRECT) {
#pragma unroll
                  for (int k = 0; k < 4; ++k) { u32x2 ow; ow.x = pk2(v[k].x, v[k].y); ow.y = pk2(v[k].z, v[k].w); hr[64 * k] = ow; } }
              if (j == 0 || FINAL_DIRECT) { const float rstd = 1.0f / sqrtf(wave_sum(ss, lane) * (1.f / DM) + EPS);
                  if (j == 0) { u32x2* o8 = (u32x2*)(XN + (size_t)m * DM) + lane;
#pragma unroll
                      for (int k = 0; k < 4; ++k) { const f32x4 y = v[k] * rstd * gv[k]; u32x2 ow; ow.x = pk2(y.x, y.y); ow.y = pk2(y.z, y.w); o8[64 * k] = ow; } }
                  else { f32x4* o = (f32x4*)(args.out + (size_t)m * DM) + lane;
#pragma unroll
                      for (int k = 0; k < 4; ++k) o[64 * k] = v[k] * rstd * gv[k]; } }
          } }
        if (j == 0 || !FINAL_DIRECT) xcd_barrier(bar);
        if (j == 1 && !FINAL_DIRECT && PH(18)) { PHASE_IDS; float* outp = args.out;
          f32x4 gv[4];
#pragma unroll
          for (int k = 0; k < 4; ++k) gv[k] = ((const f32x4*)args.in[22])[lane + 64 * k];
          for (int m = gw; m < NTOK; m += NGW) {
              const u32x2* hr = (const u32x2*)(H + (size_t)m * DM) + lane; f32x4 v[4]; float ss = 0.f;
#pragma unroll
              for (int k = 0; k < 4; ++k) { const u32x2 hw = hr[64 * k]; v[k] = (f32x4){bf_lo(hw.x), bf_hi(hw.x), bf_lo(hw.y), bf_hi(hw.y)}; ss += (v[k].x * v[k].x + v[k].y * v[k].y) + (v[k].z * v[k].z + v[k].w * v[k].w); }
              const float rstd = 1.0f / sqrtf(wave_sum(ss, lane) * (1.f / DM) + EPS);
              f32x4* o = (f32x4*)(outp + (size_t)m * DM) + lane;
#pragma unroll
              for (int k = 0; k < 4; ++k) o[64 * k] = v[k] * rstd * gv[k];
          } }
    }
}

__global__ void __launch_bounds__(NWAVES * 64, 2) fwd(Args args) {
    extern __shared__ __attribute__((aligned(16))) unsigned char lds_raw[];
    LAS unsigned char* lds = (LAS unsigned char*)lds_raw;
    const int G = gridDim.x, bx = blockIdx.x, vcu = (G % 8 == 0) ? (bx % 8) * (G / 8) + bx / 8 : bx;
    const int NGW = G * NWAVES;
    unsigned char* ws = args.ws;
    unsigned* ctl = (unsigned*)(ws + WS_CTL);
    const int wv0 = __builtin_amdgcn_readfirstlane((int)threadIdx.x >> 6);
    for (int u = opaque_tid(wv0); u < (LDS_BYTES - LDSCTL_OFF) / 4; u += NWAVES * 64) ((LAS unsigned*)(lds + LDSCTL_OFF))[u] = 0u;
    __syncthreads();
    volatile LAS unsigned* MISC = (volatile LAS unsigned*)(lds + MISC_OFF);
    XcdBarrier bar = xcd_barrier_post(ctl + 4096, MISC + 8, wv0);
    const float* x = args.in[0];
    bf16_t* XN = (bf16_t*)(ws + WS_ACT + A_XN);

    if (PH(0)) { PHASE_IDS;
        LAS float* scr = (LAS float*)(lds + wave * 16384);
        for (int j = 0; j < 2; ++j) {
            unsigned char* wb = ws + WS_W + (size_t)j * W_PAIR;
            transpose_matrix<4>(args.in[2] + (size_t)j * DM * 576, DM, 576, (bf16_t*)(wb + W_DQKV), 0, scr, gw, NGW, lane);
            for (int i = gw * 64 + lane; i < (DOWNP - 576) * DM / 8; i += NGW * 64) ((u32x4*)(wb + W_DQKV + (size_t)576 * DM * 2))[i] = (u32x4){0u, 0u, 0u, 0u};
            transpose_matrix<3>(args.in[4] + (size_t)j * 256 * NQ, 256, NQ, (bf16_t*)(wb + W_UQ), 0, scr, gw, NGW, lane, args.in[3] + j * 256);
            transpose_matrix<0>(args.in[6] + (size_t)j * 256 * 1024, 256, 1024, (bf16_t*)(wb + W_UKV), 0, scr, gw, NGW, lane, args.in[5] + j * 256);
            transpose_matrix<0>(args.in[7] + (size_t)j * 256 * 1024, 256, 1024, (bf16_t*)(wb + W_UKV), 1024, scr, gw, NGW, lane, args.in[5] + j * 256);
            if (FP8_ATTO) transpose_matrix_f8<0>(args.in[8] + (size_t)j * DM * DM, DM, DM, wb + W_MO, 0, scr, gw, NGW, lane, W8_SCALE);
            else transpose_matrix<0>(args.in[8] + (size_t)j * DM * DM, DM, DM, (bf16_t*)(wb + W_MO), 0, scr, gw, NGW, lane);
            transpose_matrix<0>(args.in[10] + (size_t)j * DM * SWA_NQKV, DM, SWA_NQKV, (bf16_t*)(wb + W_SQKV), 0, scr, gw, NGW, lane, args.in[9] + j * DM);
            if (FP8_ATTO) transpose_matrix_f8<0>(args.in[12] + (size_t)j * DM * DM, DM, DM, wb + W_SO, 0, scr, gw, NGW, lane, W8_SCALE);
            else transpose_matrix<0>(args.in[12] + (size_t)j * DM * DM, DM, DM, (bf16_t*)(wb + W_SO), 0, scr, gw, NGW, lane);
            if ((FP8_FFN >> j) & 1) {
            transpose_matrix_f8<1>(args.in[14] + (size_t)j * DM * FFN, DM, FFN, wb + W_FGU, 0, scr, gw, NGW, lane, W8_SCALE, args.in[13] + j * DM);
            transpose_matrix_f8<2>(args.in[15] + (size_t)j * DM * FFN, DM, FFN, wb + W_FGU, 0, scr, gw, NGW, lane, W8_SCALE, args.in[13] + j * DM);
            transpose_matrix_f8<0>(args.in[16] + (size_t)j * FFN * DM, FFN, DM, wb + W_FD, 0, scr, gw, NGW, lane, W8_SCALE);
            } else {
            transpose_matrix<1>(args.in[14] + (size_t)j * DM * FFN, DM, FFN, (bf16_t*)(wb + W_FGU), 0, scr, gw, NGW, lane, args.in[13] + j * DM);
            transpose_matrix<2>(args.in[15] + (size_t)j * DM * FFN, DM, FFN, (bf16_t*)(wb + W_FGU), 0, scr, gw, NGW, lane, args.in[13] + j * DM);
            transpose_matrix<0>(args.in[16] + (size_t)j * FFN * DM, FFN, DM, (bf16_t*)(wb + W_FD), 0, scr, gw, NGW, lane);
            }
            for (int e = 0; e < NE; ++e) {
                if ((FP8_MOE >> j) & 1) {
                    transpose_matrix_f8<1>(args.in[19] + ((size_t)j * NE + e) * DM * ED, DM, ED, wb + W_MGU, e * 2 * ED, scr, gw, NGW, lane, W8_SCALE);
                    transpose_matrix_f8<2>(args.in[20] + ((size_t)j * NE + e) * DM * ED, DM, ED, wb + W_MGU, e * 2 * ED, scr, gw, NGW, lane, W8_SCALE);
                    transpose_matrix_f8<0>(args.in[21] + ((size_t)j * NE + e) * ED * DM, ED, DM, wb + W_MD, e * DM, scr, gw, NGW, lane, W8_SCALE);
                } else {
                transpose_matrix<1>(args.in[19] + ((size_t)j * NE + e) * DM * ED, DM, ED, (bf16_t*)(wb + W_MGU), e * 2 * ED, scr, gw, NGW, lane);
                transpose_matrix<2>(args.in[20] + ((size_t)j * NE + e) * DM * ED, DM, ED, (bf16_t*)(wb + W_MGU), e * 2 * ED, scr, gw, NGW, lane);
                transpose_matrix<0>(args.in[21] + ((size_t)j * NE + e) * ED * DM, ED, DM, (bf16_t*)(wb + W_MD), e * DM, scr, gw, NGW, lane);
                }
            }
        }
        f32x4 gv[4];
#pragma unroll
        for (int j = 0; j < 4; ++j) gv[j] = ((const f32x4*)args.in[1])[lane + 64 * j];
        for (int m = gw; m < NTOK; m += NGW) rms_row_to_bf16(x + (size_t)m * DM, gv, XN + (size_t)m * DM, lane);
    }
    xcd_barrier(bar);

    pair_body<0>(args, lds, bar, G, bx, vcu);
    pair_body<1>(args, lds, bar, G, bx, vcu);
}

extern "C" void kernel_launch(void* const* d_in, const int* in_sizes, int n_in, void* d_out, int out_size, void* d_ws, size_t ws_size, hipStream_t stream) {
    static int grid = 0;
    if (grid == 0) {
        if (n_in != 23 || out_size != NTOK * DM || ws_size < WS_NEED) { fprintf(stderr, "kernel_launch: shape/workspace mismatch (n_in %d out %d ws %zu need %zu)\n", n_in, out_size, ws_size, (size_t)WS_NEED); grid = -1; return; }
        int dev = 0, cus = 0;
        if (hipGetDevice(&dev) != hipSuccess || hipDeviceGetAttribute(&cus, hipDeviceAttributeMultiprocessorCount, dev) != hipSuccess) { grid = -1; return; }
        if (hipFuncSetAttribute((const void*)fwd, hipFuncAttributeMaxDynamicSharedMemorySize, LDS_BYTES) != hipSuccess) { fprintf(stderr, "kernel_launch: hipFuncSetAttribute failed\n"); grid = -1; return; }
        int per_cu = 0;
        if (hipOccupancyMaxActiveBlocksPerMultiprocessor(&per_cu, (const void*)fwd, NWAVES * 64, LDS_BYTES) != hipSuccess || per_cu < 1) fprintf(stderr, "kernel_launch: occupancy query reports %d\n", per_cu);
        (void)hipGetLastError();
        grid = cus;
    }
    if (grid < 0) return;
    if (hipMemsetAsync((char*)d_ws + WS_CTL, 0, CTL_ZERO_BYTES, stream) != hipSuccess) return;
    Args a{};
    for (int i = 0; i < 23; ++i) a.in[i] = (const float*)d_in[i];
    a.out = (float*)d_out; a.ws = (unsigned char*)d_ws;
    hipLaunchKernelGGL(fwd, dim3(grid), dim3(NWAVES * 64), LDS_BYTES, stream, a);
    const hipError_t le = hipPeekAtLastError();
    if (le != hipSuccess) fprintf(stderr, "kernel_launch: launch failed: %s\n", hipGetErrorName(le));
}
```

```cpp
#include <hip/hip_runtime.h>
#include <hip/hip_bf16.h>
#include <cstdio>
#include <cstdint>

#define LAS __attribute__((address_space(3)))
#define GAS __attribute__((address_space(1)))
typedef unsigned short bf16_t;
typedef short bf16x8 __attribute__((ext_vector_type(8)));
typedef short s16x4 __attribute__((ext_vector_type(4)));
typedef float f32x4 __attribute__((ext_vector_type(4)));
typedef float f32x2 __attribute__((ext_vector_type(2)));
typedef float f32x16 __attribute__((ext_vector_type(16)));
typedef unsigned u32x4 __attribute__((ext_vector_type(4)));
typedef unsigned u32x2 __attribute__((ext_vector_type(2)));
typedef int i32x4 __attribute__((ext_vector_type(4)));
typedef int i32x8 __attribute__((ext_vector_type(8)));

constexpr int DM = 1024, BATCH = 32, SEQ = 2048, NTOK = BATCH * SEQ;
constexpr int MLA_H = 8, QKD = 192, DOWNP = 768;
constexpr int NQ = MLA_H * QKD  , NKV = 2048;
constexpr int SWA_NQKV = 1536;
constexpr int FFN = 2816, NE = 8, ED = 2048;
constexpr int NPAIR = NTOK * 2;
constexpr float EPS = 1e-6f;
constexpr float LOG2E = 1.4426950408889634f;
#ifndef PHMASK
#define PHMASK 0xFFFFFFFFu
#endif
#define PH(k) (((PHMASK) >> (k)) & 1u)
#define RESID_SCALE 1.0f
#ifndef FP8_MOE
#define FP8_MOE 3
#endif
#ifndef FP8_FFN
#define FP8_FFN 2
#endif
#ifndef FP8_ATTO
#define FP8_ATTO 0
#endif
constexpr float W8_SCALE = 32.0f, O8_SCALE = 16.0f;

constexpr size_t MiB = 1u << 20;
constexpr size_t WS_CTL = 0, CTL_ZERO_BYTES = 1 * MiB;
constexpr size_t WS_ROPE = 1 * MiB;
constexpr size_t WS_ROUTE = 2 * MiB;
constexpr size_t WS_GATE = 3 * MiB;
constexpr size_t WS_POS = 4 * MiB;
constexpr size_t WS_CNT = 5 * MiB;
constexpr size_t WS_W = 6 * MiB;
constexpr size_t W_DQKV = 0;
constexpr size_t W_UQ = W_DQKV + (size_t)DOWNP * DM * 2;
constexpr size_t W_UKV = W_UQ + (size_t)NQ * 256 * 2;
constexpr size_t W_MO = W_UKV + (size_t)NKV * 256 * 2;
constexpr size_t W_SQKV = W_MO + (size_t)DM * DM * 2;
constexpr size_t W_SO = W_SQKV + (size_t)SWA_NQKV * DM * 2;
constexpr size_t W_FGU = W_SO + (size_t)DM * DM * 2;
constexpr size_t W_FD = W_FGU + (size_t)2 * FFN * DM * 2;
constexpr size_t W_MGU = W_FD + (size_t)DM * FFN * 2;
constexpr size_t W_MD = W_MGU + (size_t)NE * 2 * ED * DM * 2;
constexpr size_t W_PAIR = W_MD + (size_t)NE * DM * ED * 2;
constexpr size_t WS_ACT = 254 * MiB;
static_assert(WS_W + 2 * W_PAIR <= WS_ACT, "weights fit");
constexpr size_t A_H = 0;
constexpr size_t A_XN = 128 * MiB;
constexpr size_t A_DOWN = 256 * MiB;
constexpr size_t A_Q = 352 * MiB;
constexpr size_t A_FACT = 128 * MiB;
constexpr size_t A_SQKV = 128 * MiB;
constexpr size_t A_SO = 320 * MiB;
constexpr size_t A_MACT = 128 * MiB;
constexpr size_t A_YS = 384 * MiB;
constexpr size_t A_H8 = 480 * MiB;
constexpr size_t A_STAT = 768 * MiB;
constexpr size_t WS_NEED = WS_ACT + 770 * MiB;
static_assert(WS_NEED <= 1024 * MiB, "ws");

constexpr int RING_BYTES = 147456;
constexpr int LDSCTL_OFF = RING_BYTES;
constexpr int MISC_OFF = LDSCTL_OFF + 320;
constexpr int PART_OFF = LDSCTL_OFF + 2048;
constexpr int MOETAB_OFF = LDSCTL_OFF + 1024;
constexpr int LDS_BYTES = 163840;

#define RLX_AGENT __ATOMIC_RELAXED, __HIP_MEMORY_SCOPE_AGENT
#define LDS_WAIT() asm volatile("s_waitcnt lgkmcnt(0)" ::: "memory")
#define VM_WAIT() asm volatile("s_waitcnt vmcnt(0)" ::: "memory")
#define SBAR() __builtin_amdgcn_sched_barrier(0)
__device__ __forceinline__ unsigned f2bf(float f) { unsigned u = __builtin_bit_cast(unsigned, f); return (u + 0x7fffu + ((u >> 16) & 1u)) >> 16; }
__device__ __forceinline__ unsigned pk2(float lo, float hi) { return f2bf(lo) | (f2bf(hi) << 16); }
__device__ __forceinline__ unsigned cvt_pk_bf16(float lo, float hi) { unsigned r; asm volatile("v_cvt_pk_bf16_f32 %0, %1, %2" : "=v"(r) : "v"(lo), "v"(hi)); return r; }
__device__ __forceinline__ u32x2 pk8_fp8(const float (&o)[8]) { int w0 = 0, w1 = 0;
    w0 = __builtin_amdgcn_cvt_pk_fp8_f32(o[0], o[1], w0, false); w0 = __builtin_amdgcn_cvt_pk_fp8_f32(o[2], o[3], w0, true);
    w1 = __builtin_amdgcn_cvt_pk_fp8_f32(o[4], o[5], w1, false); w1 = __builtin_amdgcn_cvt_pk_fp8_f32(o[6], o[7], w1, true);
    u32x2 r; r.x = (unsigned)w0; r.y = (unsigned)w1; return r; }
__device__ __forceinline__ unsigned fp8_1(float v) { return (unsigned)__builtin_amdgcn_cvt_pk_fp8_f32(v, v, 0, false) & 0xffu; }
__device__ __forceinline__ float bf_lo(unsigned w) { return __builtin_bit_cast(float, w << 16); }
__device__ __forceinline__ float bf_hi(unsigned w) { return __builtin_bit_cast(float, w & 0xffff0000u); }
__device__ __forceinline__ int opaque_tid(int wv) { int l; asm volatile("v_mbcnt_lo_u32_b32 %0, -1, 0\n\tv_mbcnt_hi_u32_b32 %0, -1, %0" : "=v"(l)); return wv * 64 + l; }
__device__ __forceinline__ int opaque_lane() { int l; asm volatile("v_mbcnt_lo_u32_b32 %0, -1, 0\n\tv_mbcnt_hi_u32_b32 %0, -1, %0" : "=v"(l)); return l; }
__device__ __forceinline__ void glds16_s(const void* sbase, unsigned voff, unsigned lds_dst) {
    unsigned keep;
    asm volatile("s_mov_b32 %0, m0\n\ts_mov_b32 m0, %3\n\ts_nop 0\n\tglobal_load_lds_dwordx4 %1, %2\n\ts_mov_b32 m0, %0" : "=&s"(keep) : "v"(voff), "s"(sbase), "s"(lds_dst) : "memory");
}
__device__ __forceinline__ float shx(float v, int o, int lane) { return __builtin_bit_cast(float, __builtin_amdgcn_ds_bpermute((lane ^ o) << 2, __builtin_bit_cast(int, v))); }
__device__ __forceinline__ int shxi(int v, int o, int lane) { return __builtin_amdgcn_ds_bpermute((lane ^ o) << 2, v); }
__device__ __forceinline__ float wave_sum(float v, int lane) {
#pragma unroll
    for (int o = 1; o < 64; o <<= 1) v += shx(v, o, lane);
    return v;
}

#define XB_TMO      128
#define XB_XCNT(j)  (256  + 64 * (j))
#define XB_XSUB(j)  (1280 + 64 * (j))
#define XB_XGEN(j)  (2304 + 64 * (j))
#define XB_TOP      3328
#define XB_TOPGEN   3392
#define XCD_BAR_WORDS 3456
#define XB_SPIN_CAP (1u << 18)
__device__ __forceinline__ unsigned xb_ld(unsigned* p)              { return __hip_atomic_load(p, __ATOMIC_RELAXED, __HIP_MEMORY_SCOPE_AGENT); }
__device__ __forceinline__ unsigned xb_add(unsigned* p, unsigned v) { return __hip_atomic_fetch_add(p, v, __ATOMIC_RELAXED, __HIP_MEMORY_SCOPE_AGENT); }
__device__ __forceinline__ unsigned xb_xcc_id() { return (unsigned)__builtin_amdgcn_s_getreg((3 << 11) | 20) & 0xFu; }
#define XB_SPIN(cond, bar) do { unsigned _sp = 0; while (cond) { __builtin_amdgcn_s_sleep(1); \
    if ((++_sp & 255u) == 0u) { if (xb_ld(&(bar)[XB_TMO])) break; if (_sp > XB_SPIN_CAP) { atomicAdd(&(bar)[XB_TMO], 1u); break; } } } } while (0)
struct XcdBarrier { unsigned* bar; unsigned x; volatile LAS unsigned* st; int wv; };
__device__ __forceinline__ XcdBarrier xcd_barrier_post(unsigned* bar, volatile LAS unsigned* st, int wv) {
    XcdBarrier b; b.bar = bar; b.x = xb_xcc_id(); b.st = st; b.wv = wv;
    if (opaque_tid(wv) == 0) (void)xb_add(&bar[XB_XCNT(b.x)], 1u);
    return b;
}
__device__ __forceinline__ void xcd_barrier_complete(unsigned* bar, unsigned x, unsigned& nloc, unsigned& nx) {
    const unsigned G = gridDim.x * gridDim.y * gridDim.z;
    unsigned sum, cnt, mine, sp = 0u;
    for (;;) {
        sum = 0u; cnt = 0u; mine = 0u;
#pragma unroll
        for (unsigned j = 0; j < 16; ++j) { const unsigned c = xb_ld(&bar[XB_XCNT(j)]); sum += c; cnt += (c > 0u) ? 1u : 0u; mine = (j == x) ? c : mine; }
        if (sum == G) break;
        __builtin_amdgcn_s_sleep(1);
        if ((++sp & 255u) == 0u) { if (xb_ld(&bar[XB_TMO])) break; if (sp > XB_SPIN_CAP) { atomicAdd(&bar[XB_TMO], 1u); break; } }
    }
    nloc = mine > 0u ? mine : 1u; nx = cnt > 0u ? cnt : 1u;
}
__device__ __forceinline__ void xcd_barrier(const XcdBarrier& b) {
    asm volatile("s_waitcnt vmcnt(0)" ::: "memory");
    __syncthreads();
    if (opaque_tid(b.wv) == 0) {
        unsigned* bar = b.bar;
        __builtin_amdgcn_s_waitcnt(0);
        unsigned nloc = b.st[0], nx = b.st[1];
        if (nloc == 0u) { xcd_barrier_complete(bar, b.x, nloc, nx); b.st[0] = nloc; b.st[1] = nx; }
        const unsigned old = xb_add(&bar[XB_XSUB(b.x)], 1u);
        const unsigned gen = old / nloc;
        if (old + 1u == (gen + 1u) * nloc) {
            __builtin_amdgcn_fence(__ATOMIC_RELEASE, "agent");
            asm volatile("s_waitcnt vmcnt(0)" ::: "memory");
            const unsigned og = xb_add(&bar[XB_TOP], 1u);
            const unsigned tg = og / nx;
            if (og + 1u == (tg + 1u) * nx) xb_add(&bar[XB_TOPGEN], 1u);
            else XB_SPIN(xb_ld(&bar[XB_TOPGEN]) == tg, bar);
            __builtin_amdgcn_fence(__ATOMIC_ACQUIRE, "agent");
            xb_add(&bar[XB_XGEN(b.x)], 1u);
            asm volatile("s_waitcnt vmcnt(0)" ::: "memory");
        } else {
            XB_SPIN(xb_ld(&bar[XB_XGEN(b.x)]) == gen, bar);
            __builtin_amdgcn_fence(__ATOMIC_ACQUIRE, "agent");
            asm volatile("s_waitcnt vmcnt(0)" ::: "memory");
        }
    }
    __syncthreads();
}

namespace pg8 {
constexpr int BM = 256, BK = 64, HALF = 128, HTB = HALF * BK * 2, STAGE_BYTES = 8 * HTB, NXCD = 8, WGM = 8;
__host__ __device__ __forceinline__ int lds_byte(int r, int c) { const int st = (r >> 4) * 2 + (c >> 5), rr = r & 15, cc = c & 31, ob = rr * 64 + cc * 2; return st * 1024 + (ob ^ (((ob >> 9) & 1) << 5)); }
__host__ __device__ __forceinline__ void stage_rc(int b, int& R, int& C) { const int st = b / 1024, sb = b % 1024, swz = sb ^ (((sb >> 9) & 1) << 5); R = (st >> 1) * 16 + swz / 64; C = (st & 1) * 32 + (swz % 64) / 2; }
__host__ __device__ __forceinline__ int perm32(int rho) { const int n = rho >> 4, i = rho & 15; return 8 * (i >> 2) + 4 * n + (i & 3); }

struct Unit { int arow, brow, col, nvalid, nlo; };
struct Gemm { const bf16_t* A; const bf16_t* Bt; int lda, ldb, K; };

struct DenseOrder {
    int nM, nN, nwg, G, c, colw;
    __device__ void init(int M, int N, int G_, int c_, int colw_) { nM = M / BM; nN = N / BM; nwg = nM * nN; G = G_; c = c_; colw = colw_; }
    __device__ __forceinline__ bool next(int i, Unit& u) const {
        const long L = (long)i * G + c; if (L >= nwg) return false;
        int wgid = (int)L; { const int q = nwg / NXCD, r = nwg % NXCD, xcd = wgid % NXCD, off = wgid / NXCD; wgid = (xcd < r ? xcd * (q + 1) : r * (q + 1) + (xcd - r) * q) + off; }
        const int nig = WGM * nN, gid = wgid / nig, fm = gid * WGM, gsz = (nM - fm) < WGM ? (nM - fm) : WGM;
        const int pm = fm + ((wgid % nig) % gsz), pn = (wgid % nig) / gsz;
        u.arow = pm * BM; u.brow = pn * BM; u.col = pn * colw; u.nvalid = BM; u.nlo = 0; return true;
    }
};
struct GroupedOrder {
    int nM, nN, nwg, G, c, colw, erows; const LAS int* tab;
    __device__ void init(const LAS int* tab_, int N, int G_, int c_, int colw_) { tab = tab_; nM = tab_[8]; nN = N / BM; nwg = nM * nN; G = G_; c = c_; colw = colw_; erows = N; }
    __device__ __forceinline__ bool next(int i, Unit& u) const {
        const long L = (long)i * G + c; if (L >= nwg) return false;
        int wgid = (int)L; { const int q = nwg / NXCD, r = nwg % NXCD, xcd = wgid % NXCD, off = wgid / NXCD; wgid = (xcd < r ? xcd * (q + 1) : r * (q + 1) + (xcd - r) * q) + off; }
        const int nig = WGM * nN, gid = wgid / nig, fm = gid * WGM, gsz = (nM - fm) < WGM ? (nM - fm) : WGM;
        const int T = fm + ((wgid % nig) % gsz), pn = (wgid % nig) / gsz;
        int e = 0;
#pragma unroll
        for (int k = 1; k < 8; ++k) e += (T >= tab[k]) ? 1 : 0;
        const int lt = T - tab[e]; int arow = tab[16 + e] + lt * BM; int nv = tab[16 + e + 1] - arow; nv = nv > BM ? BM : nv;
        int lo = 0; { const int over = arow + BM - tab[24]; if (over > 0) { arow -= over; lo = over; nv += over; } }
        u.arow = __builtin_amdgcn_readfirstlane(arow); u.nvalid = __builtin_amdgcn_readfirstlane(nv); u.nlo = __builtin_amdgcn_readfirstlane(lo);
        u.brow = __builtin_amdgcn_readfirstlane(e * erows + pn * BM); u.col = __builtin_amdgcn_readfirstlane(pn * colw); return true;
    }
};

template <int NS> __device__ __forceinline__ float row_rstd(const float* stat, int row, int slot0, float inv_n) {
    float s;
    if (NS == 4) { const f32x4 a = *(const f32x4*)(stat + (size_t)row * 4); s = (a.x + a.y) + (a.z + a.w); }
    else s = stat[(size_t)row * 4 + slot0];
    return __builtin_amdgcn_rsqf(s + EPS / inv_n) * __builtin_sqrtf(1.0f / inv_n);
}
template <int NS> __device__ __forceinline__ void row_rstd8(float (&rs)[2][4], const float* stat, int row0, int slot0, float inv_n) {
#pragma unroll
    for (int ai = 0; ai < 2; ++ai)
#pragma unroll
        for (int m = 0; m < 4; ++m) rs[ai][m] = NS ? row_rstd<NS ? NS : 1>(stat, row0 + ai * HALF + m * 16, slot0, inv_n) : 1.f;
}
__device__ __forceinline__ void stat_combine(LAS float* part, float* stat, const Unit& u, int slot, int wr, int wc, int fr, int fq) {
    asm volatile("s_waitcnt lgkmcnt(0)" ::: "memory"); __builtin_amdgcn_s_barrier(); asm volatile("" ::: "memory");
    const int t = (wr * 4 + wc) * 64 + fq * 16 + fr;
    if (t < 256) { const float sum = (part[t] + part[256 + t]) + (part[512 + t] + part[768 + t]); stat[(size_t)(u.arow + t) * 4 + slot] = sum; }
}
template <bool MASK, int NS> struct EpiBf16 {
    static constexpr bool PERM = true;
    bf16_t* O; int ldc; const float* stat; int slot0; float inv_n; float oscale;
    __device__ __forceinline__ void operator()(const f32x4 (&acc)[2][2][4][2], const Unit& u, int wr, int wc, int fr, int fq) const {
        const int col0 = u.col + wc * 32 + 8 * fq;
        float rs[2][4]; row_rstd8<NS>(rs, stat, u.arow + wr * 64 + fr, slot0, inv_n);
#pragma unroll
        for (int ai = 0; ai < 2; ++ai)
#pragma unroll
            for (int m = 0; m < 4; ++m) { const int rl = ai * HALF + wr * 64 + m * 16 + fr; if (MASK && (rl >= u.nvalid || rl < u.nlo)) continue;
                const float r = rs[ai][m] * oscale;
                bf16_t* rowp = O + (size_t)(u.arow + rl) * ldc + col0;
#pragma unroll
                for (int bj = 0; bj < 2; ++bj) { const f32x4 v0 = acc[ai][bj][m][0] * r, v1 = acc[ai][bj][m][1] * r;
                    u32x4 w; w.x = cvt_pk_bf16(v0[0], v0[1]); w.y = cvt_pk_bf16(v0[2], v0[3]); w.z = cvt_pk_bf16(v1[0], v1[1]); w.w = cvt_pk_bf16(v1[2], v1[3]);
                    *(u32x4*)(rowp + bj * HALF) = w; } }
    }
};
template <bool MASK, int NS, bool F8OUT = false> struct EpiSwiGLU {
    static constexpr bool PERM = true;
    bf16_t* O; int ldc; const float* stat; float inv_n; float oscale;
    __device__ __forceinline__ void operator()(const f32x4 (&acc)[2][2][4][2], const Unit& u, int wr, int wc, int fr, int fq) const {
        const int col0 = u.col + wc * 32 + 8 * fq;
        float rs[2][4]; row_rstd8<NS>(rs, stat, u.arow + wr * 64 + fr, 0, inv_n);
#pragma unroll
        for (int ai = 0; ai < 2; ++ai)
#pragma unroll
            for (int m = 0; m < 4; ++m) { const int rl = ai * HALF + wr * 64 + m * 16 + fr; if (MASK && (rl >= u.nvalid || rl < u.nlo)) continue;
                const float r = rs[ai][m] * oscale;
                float o[8];
#pragma unroll
                for (int n = 0; n < 2; ++n)
#pragma unroll
                    for (int k = 0; k < 4; ++k) { const float g = acc[ai][0][m][n][k] * r, up = acc[ai][1][m][n][k] * r;
                        const float sg = __builtin_amdgcn_rcpf(1.0f + __builtin_amdgcn_exp2f(-g * LOG2E)); o[n * 4 + k] = g * sg * up; }
                if (F8OUT) { *(u32x2*)((unsigned char*)O + (size_t)(u.arow + rl) * ldc + col0) = pk8_fp8(o); }
                else { u32x4 w; w.x = cvt_pk_bf16(o[0], o[1]); w.y = cvt_pk_bf16(o[2], o[3]); w.z = cvt_pk_bf16(o[4], o[5]); w.w = cvt_pk_bf16(o[6], o[7]);
                    *(u32x4*)(O + (size_t)(u.arow + rl) * ldc + col0) = w; } }
    }
};
template <bool BASE_F32, bool H8OUT = false> struct EpiResid {
    static constexpr bool PERM = true;
    const void* base; bf16_t* out; float* stat; LAS float* part; float scale; unsigned char* h8;
    __device__ __forceinline__ void operator()(f32x4 (&acc)[2][2][4][2], const Unit& u, int wr, int wc, int fr, int fq) const {
        const int col0 = u.col + wc * 32 + 8 * fq; const int lane = fq * 16 + fr;
#pragma unroll
        for (int ai = 0; ai < 2; ++ai)
#pragma unroll
          for (int mh = 0; mh < 2; ++mh) {
            if (BASE_F32) { f32x4 t[2][2][2];
#pragma unroll
                for (int m = 0; m < 2; ++m) { const float* bp = (const float*)base + (size_t)(u.arow + ai * HALF + wr * 64 + (mh * 2 + m) * 16 + fr) * DM + col0;
#pragma unroll
                    for (int bj = 0; bj < 2; ++bj)
#pragma unroll
                        for (int n = 0; n < 2; ++n) t[m][bj][n] = *(const f32x4*)(bp + bj * HALF + n * 4); }
#pragma unroll
                for (int m = 0; m < 2; ++m)
#pragma unroll
                    for (int bj = 0; bj < 2; ++bj)
#pragma unroll
                        for (int n = 0; n < 2; ++n) acc[ai][bj][mh * 2 + m][n] = acc[ai][bj][mh * 2 + m][n] * scale + t[m][bj][n];
            } else { u32x4 t[2][2];
#pragma unroll
                for (int m = 0; m < 2; ++m) { const bf16_t* bp = (const bf16_t*)base + (size_t)(u.arow + ai * HALF + wr * 64 + (mh * 2 + m) * 16 + fr) * DM + col0;
#pragma unroll
                    for (int bj = 0; bj < 2; ++bj) t[m][bj] = *(const u32x4*)(bp + bj * HALF); }
#pragma unroll
                for (int m = 0; m < 2; ++m)
#pragma unroll
                    for (int bj = 0; bj < 2; ++bj) { const u32x4 w = t[m][bj];
                        acc[ai][bj][mh * 2 + m][0] = acc[ai][bj][mh * 2 + m][0] * scale + (f32x4){bf_lo(w.x), bf_hi(w.x), bf_lo(w.y), bf_hi(w.y)};
                        acc[ai][bj][mh * 2 + m][1] = acc[ai][bj][mh * 2 + m][1] * scale + (f32x4){bf_lo(w.z), bf_hi(w.z), bf_lo(w.w), bf_hi(w.w)}; }
            }
#pragma unroll
            for (int m = 0; m < 2; ++m)
                asm volatile("" : "+v"(acc[ai][0][mh * 2 + m][0]), "+v"(acc[ai][0][mh * 2 + m][1]), "+v"(acc[ai][1][mh * 2 + m][0]), "+v"(acc[ai][1][mh * 2 + m][1]) :: "memory"); }
#pragma unroll
        for (int ai = 0; ai < 2; ++ai)
#pragma unroll
            for (int m = 0; m < 4; ++m) { const int rl = ai * HALF + wr * 64 + m * 16 + fr; const size_t off = (size_t)(u.arow + rl) * DM + col0; float ss = 0.f;
#pragma unroll
                for (int bj = 0; bj < 2; ++bj) { const f32x4 h0 = acc[ai][bj][m][0], h1 = acc[ai][bj][m][1];
                    ss += ((h0.x * h0.x + h0.y * h0.y) + (h0.z * h0.z + h0.w * h0.w)) + ((h1.x * h1.x + h1.y * h1.y) + (h1.z * h1.z + h1.w * h1.w));
                    u32x4 w; w.x = cvt_pk_bf16(h0.x, h0.y); w.y = cvt_pk_bf16(h0.z, h0.w); w.z = cvt_pk_bf16(h1.x, h1.y); w.w = cvt_pk_bf16(h1.z, h1.w);
                    *(u32x4*)(out + off + bj * HALF) = w;
                    if (H8OUT) { const float o8[8] = {h0.x, h0.y, h0.z, h0.w, h1.x, h1.y, h1.z, h1.w}; *(u32x2*)(h8 + off + bj * HALF) = pk8_fp8(o8); } }
                ss += shx(ss, 16, lane); ss += shx(ss, 32, lane); if (fq == 0) part[wc * 256 + rl] = ss; }
        stat_combine(part, stat, u, u.col >> 8, wr, wc, fr, fq);
    }
};
__device__ __forceinline__ void rope_inv4(float (&inv)[4], int i0) {
#pragma unroll
    for (int k = 0; k < 4; ++k) inv[k] = __builtin_amdgcn_exp2f(-(float)(i0 + k) * (13.287712379549449f / 32.0f)) * 0.15915494309189535f;
}
__device__ __forceinline__ void rope8(f32x4& v0, f32x4& v1, float pos, const float (&inv)[4]) {
    float c[4], sn[4];
#pragma unroll
    for (int k = 0; k < 4; ++k) { float t = pos * inv[k]; t -= rintf(t); c[k] = __builtin_amdgcn_cosf(t); sn[k] = __builtin_amdgcn_sinf(t); }
    const float a0 = v0[0] * c[0] - v0[1] * sn[0], b0 = v0[1] * c[0] + v0[0] * sn[0];
    const float a1 = v0[2] * c[1] - v0[3] * sn[1], b1 = v0[3] * c[1] + v0[2] * sn[1];
    const float a2 = v1[0] * c[2] - v1[1] * sn[2], b2 = v1[1] * c[2] + v1[0] * sn[2];
    const float a3 = v1[2] * c[3] - v1[3] * sn[3], b3 = v1[3] * c[3] + v1[2] * sn[3];
    v0 = (f32x4){a0, b0, a1, b1}; v1 = (f32x4){a2, b2, a3, b3};
}
struct EpiQRope {
    static constexpr bool PERM = true;
    bf16_t* O;
    __device__ __forceinline__ void operator()(const f32x4 (&acc)[2][2][4][2], const Unit& u, int wr, int wc, int fr, int fq) const {
        const int col0 = u.col + wc * 32 + 8 * fq;
#pragma unroll
        for (int bj = 0; bj < 2; ++bj) { const int c = col0 + bj * HALF, d = c % QKD; const bool isr = d >= 128; float inv[4]; rope_inv4(inv, isr ? ((d - 128) >> 1) : 0);
#pragma unroll
            for (int ai = 0; ai < 2; ++ai)
#pragma unroll
                for (int m = 0; m < 4; ++m) { const int row = u.arow + ai * HALF + wr * 64 + m * 16 + fr;
                    f32x4 v0 = acc[ai][bj][m][0], v1 = acc[ai][bj][m][1];
                    if (isr) rope8(v0, v1, (float)(row & (SEQ - 1)), inv);
                    u32x4 w; w.x = cvt_pk_bf16(v0[0], v0[1]); w.y = cvt_pk_bf16(v0[2], v0[3]); w.z = cvt_pk_bf16(v1[0], v1[1]); w.w = cvt_pk_bf16(v1[2], v1[3]);
                    *(u32x4*)(O + (size_t)row * NQ + c) = w; } }
    }
};
struct EpiDown {
    static constexpr bool PERM = true;
    bf16_t* O; float* stat; LAS float* part;
    __device__ __forceinline__ void operator()(const f32x4 (&acc)[2][2][4][2], const Unit& u, int wr, int wc, int fr, int fq) const {
        const int col0 = u.col + wc * 32 + 8 * fq, pn = u.col >> 8, lane = fq * 16 + fr;
        if (pn < 2) {
#pragma unroll
            for (int ai = 0; ai < 2; ++ai)
#pragma unroll
                for (int m = 0; m < 4; ++m) { const int rl = ai * HALF + wr * 64 + m * 16 + fr; float ss = 0.f;
#pragma unroll
                    for (int bj = 0; bj < 2; ++bj) { const f32x4 v0 = acc[ai][bj][m][0], v1 = acc[ai][bj][m][1];
                        ss += ((v0.x * v0.x + v0.y * v0.y) + (v0.z * v0.z + v0.w * v0.w)) + ((v1.x * v1.x + v1.y * v1.y) + (v1.z * v1.z + v1.w * v1.w));
                        u32x4 w; w.x = cvt_pk_bf16(v0[0], v0[1]); w.y = cvt_pk_bf16(v0[2], v0[3]); w.z = cvt_pk_bf16(v1[0], v1[1]); w.w = cvt_pk_bf16(v1[2], v1[3]);
                        *(u32x4*)(O + (size_t)(u.arow + rl) * DOWNP + col0 + bj * HALF) = w; }
                    ss += shx(ss, 16, lane); ss += shx(ss, 32, lane); if (fq == 0) part[wc * 256 + rl] = ss; }
        } else if (wc < 2) {
            float inv[4]; rope_inv4(inv, wc * 16 + 4 * fq);
#pragma unroll
            for (int ai = 0; ai < 2; ++ai)
#pragma unroll
                for (int m = 0; m < 4; ++m) { const int row = u.arow + ai * HALF + wr * 64 + m * 16 + fr;
                    f32x4 v0 = acc[ai][0][m][0], v1 = acc[ai][0][m][1];
                    rope8(v0, v1, (float)(row & (SEQ - 1)), inv);
                    u32x4 w; w.x = cvt_pk_bf16(v0[0], v0[1]); w.y = cvt_pk_bf16(v0[2], v0[3]); w.z = cvt_pk_bf16(v1[0], v1[1]); w.w = cvt_pk_bf16(v1[2], v1[3]);
                    *(u32x4*)(O + (size_t)row * DOWNP + col0) = w; }
        }
        if (pn < 2) stat_combine(part, stat, u, pn, wr, wc, fr, fq);
        else { asm volatile("s_waitcnt lgkmcnt(0)" ::: "memory"); __builtin_amdgcn_s_barrier(); }
    }
};

template <class Epi, class Sched, bool ALIGN_EPI, bool FP8 = false>
__device__ __forceinline__ void gemm_phase(LAS unsigned char* lds, const Gemm g, const Sched& S, const Epi& E, const int wv) {
    const int tid = opaque_tid(wv), wid = __builtin_amdgcn_readfirstlane(tid >> 6), lane = tid & 63, wr = wid >> 2, wc = wid & 3, fr = lane & 15, fq = lane >> 4;
    const int K = g.K, nt = K / BK;
    unsigned voffA[2], voffB[2];
#pragma unroll
    for (int i = 0; i < 2; ++i) { int R, C; stage_rc(tid * 16 + i * 8192, R, C); const int Rb = Epi::PERM ? ((R & ~31) + perm32(R & 31)) : R;
        voffA[i] = (unsigned)(R * g.lda + C) * 2u; voffB[i] = (unsigned)(Rb * g.ldb + C) * 2u; }
    const size_t kstep = (size_t)(BK * 2);
    const size_t hsA = (size_t)HALF * g.lda * 2, hsB = (size_t)HALF * g.ldb * 2;
    const unsigned ldsw = (unsigned)wid * 1024u, ldsb = (unsigned)(uintptr_t)lds;
    const int aoff = lds_byte(wr * 64 + fr, fq * 8), boff = lds_byte(wc * 32 + fr, fq * 8);
#define PG8_SA(b, h) (((b) * 2 + (h)) * HTB)
#define PG8_SB(b, h) ((4 + (b) * 2 + (h)) * HTB)
#define PG8_STAGE(bufoff, gbase, voff) do { _Pragma("unroll") for (int _i = 0; _i < 2; ++_i) \
        glds16_s((const char*)(gbase), (voff)[_i], ldsb + (unsigned)(bufoff) + ldsw + (unsigned)(_i * 8192)); } while (0)
#define PG8_LDA(dst, b, h) do { _Pragma("unroll") for (int m = 0; m < 4; ++m) _Pragma("unroll") for (int k = 0; k < 2; ++k) dst[m][k] = *(const LAS bf16x8*)(lds + PG8_SA(b, h) + aoff + m * 2048 + k * 1024); } while (0)
#define PG8_LDB(dst, b, h) do { _Pragma("unroll") for (int n = 0; n < 2; ++n) _Pragma("unroll") for (int k = 0; k < 2; ++k) dst[n][k] = *(const LAS bf16x8*)(lds + PG8_SB(b, h) + boff + n * 2048 + k * 1024); } while (0)
#define PG8_MMA(ai, bj, At, Bt) do { __builtin_amdgcn_s_setprio(1); _Pragma("unroll") for (int m = 0; m < 4; ++m) _Pragma("unroll") for (int n = 0; n < 2; ++n) { \
        if constexpr (FP8) { const i32x4 b0_ = __builtin_bit_cast(i32x4, Bt[n][0]), b1_ = __builtin_bit_cast(i32x4, Bt[n][1]), a0_ = __builtin_bit_cast(i32x4, At[m][0]), a1_ = __builtin_bit_cast(i32x4, At[m][1]); \
            acc[ai][bj][m][n] = __builtin_amdgcn_mfma_scale_f32_16x16x128_f8f6f4(__builtin_shufflevector(b0_, b1_, 0, 1, 2, 3, 4, 5, 6, 7), __builtin_shufflevector(a0_, a1_, 0, 1, 2, 3, 4, 5, 6, 7), acc[ai][bj][m][n], 0, 0, 0, 0x7F7F7F7F, 0, 0x7F7F7F7F); } \
        else { _Pragma("unroll") for (int k = 0; k < 2; ++k) acc[ai][bj][m][n] = __builtin_amdgcn_mfma_f32_16x16x32_bf16(Bt[n][k], At[m][k], acc[ai][bj][m][n], 0, 0, 0); } } \
        __builtin_amdgcn_s_setprio(0); } while (0)
#define PG8_WAIT_V(n) asm volatile("s_waitcnt vmcnt(" #n ")" ::: "memory")
#define PG8_WAIT_L(n) asm volatile("s_waitcnt lgkmcnt(" #n ")" ::: "memory")
#define PG8_BAR __builtin_amdgcn_s_barrier()
#define PG8_SCHED __builtin_amdgcn_sched_barrier(0)
    Unit cur, nxt; int ui = 0;
    if (!S.next(0, cur)) return;
    f32x4 acc[2][2][4][2];
#pragma unroll
    for (int a = 0; a < 2; ++a)
#pragma unroll
        for (int b = 0; b < 2; ++b)
#pragma unroll
            for (int m = 0; m < 4; ++m)
#pragma unroll
                for (int n = 0; n < 2; ++n) acc[a][b][m][n] = (f32x4){0.f, 0.f, 0.f, 0.f};
    bf16x8 At[4][2], B0[2][2], B1[2][2];
    const char* cA = (const char*)g.A + (size_t)cur.arow * g.lda * 2; const char* cB = (const char*)g.Bt + (size_t)cur.brow * g.ldb * 2;
    PG8_STAGE(PG8_SB(0, 0), cB, voffB); PG8_STAGE(PG8_SB(0, 1), cB + hsB, voffB); PG8_STAGE(PG8_SA(0, 0), cA, voffA); PG8_STAGE(PG8_SA(0, 1), cA + hsA, voffA);
    if (wr == 1) PG8_BAR;
    PG8_WAIT_V(2); PG8_BAR;
    PG8_STAGE(PG8_SB(1, 0), cB + kstep, voffB); PG8_STAGE(PG8_SA(1, 0), cA + kstep, voffA); PG8_STAGE(PG8_SB(1, 1), cB + hsB + kstep, voffB);
    PG8_WAIT_V(6); PG8_BAR;
    for (;;) {
        const bool has_next = S.next(ui + 1, nxt);
        const char* nA = has_next ? (const char*)g.A + (size_t)nxt.arow * g.lda * 2 : cA; const char* nB = has_next ? (const char*)g.Bt + (size_t)nxt.brow * g.ldb * 2 : cB;
        for (int t = 0; t < nt; t += 2) {
            const bool last = (t == nt - 2);
            const char* a1 = cA + (size_t)(t + 1) * kstep;
            const char* a2 = last ? nA : cA + (size_t)(t + 2) * kstep; const char* b2 = last ? nB : cB + (size_t)(t + 2) * kstep;
            const char* a3 = a2 + kstep; const char* b3 = b2 + kstep;
            PG8_LDB(B0, 0, 0); PG8_LDB(B1, 0, 1); PG8_SCHED; PG8_LDA(At, 0, 0); PG8_STAGE(PG8_SA(1, 1), a1 + hsA, voffA);
            PG8_WAIT_V(8); PG8_WAIT_L(0); PG8_BAR; PG8_MMA(0, 0, At, B0); PG8_MMA(0, 1, At, B1); PG8_BAR; PG8_SCHED;
            PG8_LDA(At, 0, 1); PG8_STAGE(PG8_SB(0, 0), b2, voffB); PG8_STAGE(PG8_SB(0, 1), b2 + hsB, voffB); PG8_STAGE(PG8_SA(0, 0), a2, voffA);
            PG8_WAIT_V(8); PG8_WAIT_L(0); PG8_BAR; PG8_MMA(1, 0, At, B0); PG8_MMA(1, 1, At, B1); PG8_BAR; PG8_SCHED;
            PG8_LDB(B0, 1, 0); PG8_LDB(B1, 1, 1); PG8_SCHED; PG8_LDA(At, 1, 0); PG8_STAGE(PG8_SA(0, 1), a2 + hsA, voffA);
            PG8_WAIT_V(8); PG8_WAIT_L(0); PG8_BAR; PG8_MMA(0, 0, At, B0); PG8_MMA(0, 1, At, B1); PG8_BAR; PG8_SCHED;
            PG8_LDA(At, 1, 1); PG8_STAGE(PG8_SB(1, 0), b3, voffB); PG8_STAGE(PG8_SB(1, 1), b3 + hsB, voffB); PG8_STAGE(PG8_SA(1, 0), a3, voffA);
            PG8_WAIT_V(8); PG8_WAIT_L(0); PG8_BAR; PG8_MMA(1, 0, At, B0); PG8_MMA(1, 1, At, B1); PG8_BAR; PG8_SCHED;
        }
        if constexpr (ALIGN_EPI) { if (wr == 0) PG8_BAR; }
        { const int l2 = opaque_lane(); E(acc, cur, wr, wc, l2 & 15, l2 >> 4); }
        if (!has_next) break;
#pragma unroll
        for (int a = 0; a < 2; ++a)
#pragma unroll
            for (int b = 0; b < 2; ++b)
#pragma unroll
                for (int m = 0; m < 4; ++m)
#pragma unroll
                    for (int n = 0; n < 2; ++n) acc[a][b][m][n] = (f32x4){0.f, 0.f, 0.f, 0.f};
        cur = nxt; cA = nA; cB = nB; ++ui;
        if constexpr (ALIGN_EPI) { if (wr == 1) PG8_BAR; }
    }
    PG8_WAIT_V(0);
    if constexpr (!ALIGN_EPI) { if (wr == 0) PG8_BAR; }
    PG8_BAR;
#undef PG8_SA
#undef PG8_SB
#undef PG8_STAGE
#undef PG8_LDA
#undef PG8_LDB
#undef PG8_MMA
#undef PG8_WAIT_V
#undef PG8_WAIT_L
#undef PG8_BAR
#undef PG8_SCHED
}
}

__device__ __forceinline__ int crow(int r, int hi) { return (r & 3) + 8 * (r >> 2) + 4 * hi; }
__device__ __forceinline__ int v_rd_base(int lane) { return ((lane & 3) << 3) | (((lane >> 2) & 3) << 6) | (((lane >> 4) & 1) << 5) | (((lane >> 5) & 1) << 8); }
template <int NCB> __device__ __forceinline__ int v_st(int k, int c) { const int kk = (k & ~0xC) | ((k & 4) << 1) | ((k & 8) >> 1); return ((kk >> 3) * NCB + (c >> 5)) * 512 + ((kk & 7) * 32 + (c & 31)) * 2; }
template <int OFF> __device__ __forceinline__ s16x4 tr_read(int vb) {
    s16x4 r; asm volatile("ds_read_b64_tr_b16 %0, %1 offset:%2" : "=&v"(r) : "v"(vb), "i"(OFF) : "memory"); return r;
}
template <int D0, int NCB> __device__ __forceinline__ void pv_one(f32x16& od, int vb, bf16x8 pa0, bf16x8 pa1, bf16x8 pa2, bf16x8 pa3) {
    constexpr int KS = NCB * 1024, HF = NCB * 512;
    const s16x4 l0 = tr_read<D0 * 512 + 0 * KS>(vb), h0 = tr_read<D0 * 512 + 0 * KS + HF>(vb), l1 = tr_read<D0 * 512 + 1 * KS>(vb), h1 = tr_read<D0 * 512 + 1 * KS + HF>(vb);
    const s16x4 l2 = tr_read<D0 * 512 + 2 * KS>(vb), h2 = tr_read<D0 * 512 + 2 * KS + HF>(vb), l3 = tr_read<D0 * 512 + 3 * KS>(vb), h3 = tr_read<D0 * 512 + 3 * KS + HF>(vb);
    asm volatile("s_waitcnt lgkmcnt(0)" ::: "memory"); SBAR();
#define PK(L, H) (bf16x8){L[0], L[1], L[2], L[3], H[0], H[1], H[2], H[3]}
    od = __builtin_amdgcn_mfma_f32_32x32x16_bf16(pa0, PK(l0, h0), od, 0, 0, 0);
    od = __builtin_amdgcn_mfma_f32_32x32x16_bf16(pa1, PK(l1, h1), od, 0, 0, 0);
    od = __builtin_amdgcn_mfma_f32_32x32x16_bf16(pa2, PK(l2, h2), od, 0, 0, 0);
    od = __builtin_amdgcn_mfma_f32_32x32x16_bf16(pa3, PK(l3, h3), od, 0, 0, 0);
#undef PK
}
#define PK4(P, BASE, OUT) do { unsigned a0 = cvt_pk_bf16(P[BASE + 0], P[BASE + 1]), a1 = cvt_pk_bf16(P[BASE + 2], P[BASE + 3]);   \
    unsigned b0 = cvt_pk_bf16(P[BASE + 4], P[BASE + 5]), b1 = cvt_pk_bf16(P[BASE + 6], P[BASE + 7]);                              \
    auto r0 = __builtin_amdgcn_permlane32_swap(a0, b0, false, false); auto r1 = __builtin_amdgcn_permlane32_swap(a1, b1, false, false); \
    u32x4 w = {r0[0], r1[0], r0[1], r1[1]}; OUT = __builtin_bit_cast(bf16x8, w); } while (0)

namespace mla {
constexpr int NW = 8, QBLK = 32, KVBLK = 64;
constexpr int KN_B = KVBLK * 256, KR_B = KVBLK * 128, V_B = KVBLK * 256, SLOT = KN_B + KR_B + V_B  , NSLOT = 3;
constexpr int OFF_WS = NSLOT * SLOT  , OFF_END = OFF_WS + NW * 64 * 4;
static_assert(OFF_END <= RING_BYTES, "mla lds");
constexpr int OSTR = 272;
static_assert(NW * 32 * OSTR <= OFF_WS, "O staging aliases the ring");
constexpr float SCALE = 0.07216878364870323f;
constexpr float THR = 8.f;
constexpr int LDQ = NQ, LDKV = NKV, LDR = DOWNP, LDO = DM;

__device__ __forceinline__ void partialSM(f32x16& p0, f32x16& p1, float& m_reg, float& mn, float& alpha, const float C) {
    float pmax = p0[0];
#pragma unroll
    for (int r = 1; r < 16; ++r) pmax = fmaxf(pmax, p0[r]);
#pragma unroll
    for (int r = 0; r < 16; ++r) pmax = fmaxf(pmax, p1[r]);
    { auto rr = __builtin_amdgcn_permlane32_swap(__float_as_uint(pmax), __float_as_uint(pmax), false, false);
      pmax = fmaxf(__uint_as_float(rr[0]), __uint_as_float(rr[1])); }
    if (__builtin_expect(__all((pmax - m_reg) * C <= THR * LOG2E), 1)) { mn = m_reg; alpha = 1.f; }
    else { mn = fmaxf(m_reg, pmax); alpha = __builtin_amdgcn_exp2f((m_reg - mn) * C); m_reg = mn; }
    const float mnC = -mn * C;
#pragma unroll
    for (int r = 0; r < 16; ++r) p0[r] = fmaf(p0[r], C, mnC);
#pragma unroll
    for (int r = 0; r < 16; ++r) p1[r] = fmaf(p1[r], C, mnC);
#pragma unroll
    for (int r = 0; r < 16; ++r) p0[r] = __builtin_amdgcn_exp2f(p0[r]);
}
__device__ __forceinline__ void finishSM(f32x16& p0, f32x16& p1, float alpha, float& l_reg, bf16x8& pa0, bf16x8& pa1, bf16x8& pa2, bf16x8& pa3) {
#pragma unroll
    for (int r = 0; r < 16; ++r) p1[r] = __builtin_amdgcn_exp2f(p1[r]);
    float ps = 0;
#pragma unroll
    for (int r = 0; r < 16; ++r) ps += p0[r];
#pragma unroll
    for (int r = 0; r < 16; ++r) ps += p1[r];
    { auto rr = __builtin_amdgcn_permlane32_swap(__float_as_uint(ps), __float_as_uint(ps), false, false);
      ps = __uint_as_float(rr[0]) + __uint_as_float(rr[1]); }
    l_reg = l_reg * alpha + ps;
    PK4(p0, 0, pa0); PK4(p0, 8, pa1); PK4(p1, 0, pa2); PK4(p1, 8, pa3);
}
__device__ __forceinline__ void qkt(f32x16& p0, f32x16& p1, const LAS unsigned char* slot, const bf16x8* qr, int r32, int hi) {
    p0 = f32x16{}; p1 = f32x16{};
    const LAS unsigned char* kn = slot + r32 * 256; const int xn = (r32 & 7) << 4;
#pragma unroll
    for (int d0 = 0; d0 < 8; ++d0) { const int cb = ((d0 * 16 + hi * 8) * 2) ^ xn;
        const bf16x8 b0 = *(const LAS bf16x8*)(kn + cb), b1 = *(const LAS bf16x8*)(kn + 32 * 256 + cb);
        p0 = __builtin_amdgcn_mfma_f32_32x32x16_bf16(b0, qr[d0], p0, 0, 0, 0);
        p1 = __builtin_amdgcn_mfma_f32_32x32x16_bf16(b1, qr[d0], p1, 0, 0, 0); }
    const LAS unsigned char* kr = slot + KN_B + r32 * 128; const int xr = ((r32 >> 1) & 7) << 4;
#pragma unroll
    for (int d0 = 0; d0 < 4; ++d0) { const int cb = ((d0 * 2 + hi) * 16) ^ xr;
        const bf16x8 b0 = *(const LAS bf16x8*)(kr + cb), b1 = *(const LAS bf16x8*)(kr + 32 * 128 + cb);
        p0 = __builtin_amdgcn_mfma_f32_32x32x16_bf16(b0, qr[8 + d0], p0, 0, 0, 0);
        p1 = __builtin_amdgcn_mfma_f32_32x32x16_bf16(b1, qr[8 + d0], p1, 0, 0, 0); }
}
__device__ __forceinline__ void pv_all(f32x16* o, int vb, bf16x8 pa0, bf16x8 pa1, bf16x8 pa2, bf16x8 pa3) {
    pv_one<0, 4>(o[0], vb, pa0, pa1, pa2, pa3); pv_one<1, 4>(o[1], vb, pa0, pa1, pa2, pa3); pv_one<2, 4>(o[2], vb, pa0, pa1, pa2, pa3); pv_one<3, 4>(o[3], vb, pa0, pa1, pa2, pa3);
}
#define MLA_BAR() asm volatile("s_waitcnt vmcnt(0) lgkmcnt(0)\n\ts_barrier" ::: "memory")
template <bool O8> __device__ __forceinline__ void unit(int b, int h, int qb, const bf16_t* __restrict__ Q, const bf16_t* __restrict__ KV, const bf16_t* __restrict__ DN, const float* __restrict__ stat, bf16_t* __restrict__ O, LAS unsigned char* lds, const int wv) {
    const int tid = opaque_tid(wv), wid = __builtin_amdgcn_readfirstlane(tid >> 6), lane = tid & 63, r32 = lane & 31, hi = lane >> 5;
    const size_t tok0 = (size_t)b * SEQ;
    const bf16_t* Qb = Q + (tok0 + (size_t)qb * 256) * LDQ + h * QKD;
    const char* Kn = (const char*)(KV + tok0 * LDKV + h * 128);
    const char* Vh = (const char*)(KV + tok0 * LDKV + 1024 + h * 128);
    const char* Kr = (const char*)(DN + tok0 * LDR + 512);
    LAS float* ws = (LAS float*)(lds + OFF_WS) + wid * 64; LAS float* li_l = ws; LAS float* al_l = ws + 32;
    const unsigned ldsb = (unsigned)(uintptr_t)lds;
    unsigned vkn[2], vv[2], vkr;
#pragma unroll
    for (int i = 0; i < 2; ++i) { const int L = (wid * 2 + i) * 64 + lane; { const int row = L >> 4, c16 = (L & 15) ^ (row & 7); vkn[i] = (unsigned)(row * (LDKV * 2) + c16 * 16); }
        { const int st = L >> 5, w = L & 31, kk = (st >> 2) * 8 + (w >> 2), k = (kk & ~0xC) | ((kk & 4) << 1) | ((kk & 8) >> 1), c = (st & 3) * 32 + (w & 3) * 8; vv[i] = (unsigned)(k * (LDKV * 2) + c * 2); } }
    { const int L = wid * 64 + lane, row = L >> 3, c16 = (L & 7) ^ ((row >> 1) & 7); vkr = (unsigned)(row * (LDR * 2) + c16 * 16); }
#define MLA_ISSUE(t, sl) do { const size_t ko_ = (size_t)(t) * KVBLK; const unsigned sb_ = ldsb + (unsigned)(sl) * SLOT + (unsigned)wid * 2048u; \
        glds16_s(Kn + ko_ * (LDKV * 2), vkn[0], sb_); glds16_s(Kn + ko_ * (LDKV * 2), vkn[1], sb_ + 1024u); \
        glds16_s(Kr + ko_ * (LDR * 2), vkr, ldsb + (unsigned)(sl) * SLOT + KN_B + (unsigned)wid * 1024u); \
        glds16_s(Vh + ko_ * (LDKV * 2), vv[0], sb_ + KN_B + KR_B); glds16_s(Vh + ko_ * (LDKV * 2), vv[1], sb_ + KN_B + KR_B + 1024u); } while (0)
    MLA_ISSUE(0, 0); MLA_ISSUE(1, 1);
    float m_reg = -1e30f, l_reg = 0; f32x16 o[4] = {}; bf16x8 qr[12];
    const float Cq = SCALE * LOG2E * __builtin_amdgcn_rsqf(stat[(tok0 + (size_t)qb * 256 + wid * QBLK + r32) * 4] * (1.f / 256.f) + EPS);
    const bf16_t* Qw = Qb + (size_t)(wid * QBLK + r32) * LDQ + hi * 8;
#pragma unroll
    for (int d0 = 0; d0 < 12; ++d0) qr[d0] = *(const bf16x8*)(Qw + d0 * 16);
    const int vb0 = (int)ldsb + KN_B + KR_B + v_rd_base(lane);
#define RESC(a) do { if (__any((a) < 1.f)) { if (hi == 0) al_l[r32] = (a); asm volatile("s_waitcnt lgkmcnt(0)" ::: "memory"); \
    _Pragma("unroll") for (int d = 0; d < 4; ++d) _Pragma("unroll") for (int r = 0; r < 16; ++r) o[d][r] *= al_l[crow(r, hi)]; } } while (0)
    f32x16 pA0, pA1, pB0, pB1; float mnA, mnB, alA, alB; bf16x8 pa0, pa1, pa2, pa3; constexpr int NT = SEQ / KVBLK;
    MLA_BAR();
    qkt(pA0, pA1, lds, qr, r32, hi); partialSM(pA0, pA1, m_reg, mnA, alA, Cq);
    int sj = 1, sp = 0;
    for (int j = 1; j + 1 < NT; j += 2) {
        { const int sn = sj == 2 ? 0 : sj + 1; MLA_ISSUE(j + 1, sn);
          SBAR(); qkt(pB0, pB1, lds + sj * SLOT, qr, r32, hi);
          finishSM(pA0, pA1, alA, l_reg, pa0, pa1, pa2, pa3); SBAR();
          pv_all(o, vb0 + sp * SLOT, pa0, pa1, pa2, pa3); partialSM(pB0, pB1, m_reg, mnB, alB, Cq);
          RESC(alB); MLA_BAR(); sp = sj; sj = sn; }
        { const int sn = sj == 2 ? 0 : sj + 1; MLA_ISSUE(j + 2, sn);
          SBAR(); qkt(pA0, pA1, lds + sj * SLOT, qr, r32, hi);
          finishSM(pB0, pB1, alB, l_reg, pa0, pa1, pa2, pa3); SBAR();
          pv_all(o, vb0 + sp * SLOT, pa0, pa1, pa2, pa3); partialSM(pA0, pA1, m_reg, mnA, alA, Cq);
          RESC(alA); MLA_BAR(); sp = sj; sj = sn; }
    }
    SBAR(); qkt(pB0, pB1, lds + sj * SLOT, qr, r32, hi);
    finishSM(pA0, pA1, alA, l_reg, pa0, pa1, pa2, pa3); SBAR();
    pv_all(o, vb0 + sp * SLOT, pa0, pa1, pa2, pa3); partialSM(pB0, pB1, m_reg, mnB, alB, Cq);
    RESC(alB);
    finishSM(pB0, pB1, alB, l_reg, pa0, pa1, pa2, pa3); SBAR();
    pv_all(o, vb0 + sj * SLOT, pa0, pa1, pa2, pa3);
    if (hi == 0) li_l[r32] = l_reg; asm volatile("s_waitcnt lgkmcnt(0)" ::: "memory");
    float rli[16];
#pragma unroll
    for (int r = 0; r < 16; ++r) rli[r] = __builtin_amdgcn_rcpf(li_l[crow(r, hi)]);
    MLA_BAR();
    LAS unsigned char* ost = lds + wid * (32 * OSTR);
    if constexpr (O8) {
#pragma unroll
        for (int r = 0; r < 16; ++r) { const int orow = crow(r, hi);
#pragma unroll
            for (int d0 = 0; d0 < 4; ++d0) *(LAS unsigned char*)(ost + orow * 144 + d0 * 32 + r32) = (unsigned char)fp8_1(o[d0][r] * rli[r] * O8_SCALE); }
        asm volatile("s_waitcnt lgkmcnt(0)" ::: "memory");
        unsigned char* Ow = (unsigned char*)O + (tok0 + (size_t)qb * 256 + wid * QBLK) * LDO + h * 128;
#pragma unroll
        for (int it = 0; it < 4; ++it) { const int ch = it * 64 + lane, row = ch >> 3, c16 = ch & 7;
            const u32x4 v = *(const LAS u32x4*)(ost + row * 144 + c16 * 16); *(u32x4*)(Ow + (size_t)row * LDO + c16 * 16) = v; }
    } else {
#pragma unroll
    for (int r = 0; r < 16; ++r) { const int orow = crow(r, hi);
#pragma unroll
        for (int d0 = 0; d0 < 4; ++d0) *(LAS unsigned short*)(ost + orow * OSTR + (d0 * 32 + r32) * 2) = (unsigned short)f2bf(o[d0][r] * rli[r]); }
    asm volatile("s_waitcnt lgkmcnt(0)" ::: "memory");
    bf16_t* Ow = O + (tok0 + (size_t)qb * 256 + wid * QBLK) * LDO + h * 128;
#pragma unroll
    for (int it = 0; it < 8; ++it) { const int ch = it * 64 + lane, row = ch >> 4, c16 = ch & 15;
        const u32x4 v = *(const LAS u32x4*)(ost + row * OSTR + c16 * 16); *(u32x4*)(Ow + (size_t)row * LDO + c16 * 8) = v; }
    }
    MLA_BAR();
#undef MLA_ISSUE
#undef RESC
}
#undef MLA_BAR
}

namespace swa {
constexpr int KT = 8192, SLOT = 16384, NSLOT = 6, NTILE_SEQ = SEQ / 64;
constexpr int OFF_O = NSLOT * SLOT  , OSTR = 144, OFF_WS = OFF_O + 8 * 32 * OSTR  , OFF_END = OFF_WS + 8 * 64 * 4;
static_assert(OFF_END <= RING_BYTES, "swa lds");
constexpr int LD = SWA_NQKV;
constexpr float C = 0.125f * LOG2E;
template <bool O8> __device__ __forceinline__ void superunit(int b, int g, int qb0, int nqb, const bf16_t* __restrict__ QKV, const float* __restrict__ sink, bf16_t* __restrict__ O, LAS unsigned char* lds, const int wv) {
    const int tid = opaque_tid(wv), wid = __builtin_amdgcn_readfirstlane(tid >> 6), lane = tid & 63, r32 = lane & 31, hi = lane >> 5;
    const size_t tok0 = (size_t)b * SEQ; const unsigned ldsb = (unsigned)(uintptr_t)lds;
    const char* Kg = (const char*)(QKV + tok0 * LD + 1024 + g * 64); const char* Vg = (const char*)(QKV + tok0 * LD + 1280 + g * 64);
    unsigned vk, vv;
    { const int L = wid * 64 + lane; { const int row = L >> 3, c16 = (L & 7) ^ ((row >> 1) & 7); vk = (unsigned)(row * (LD * 2) + c16 * 16); }
      { const int st = L >> 5, w = L & 31, kk = (st >> 1) * 8 + (w >> 2), k = (kk & ~0xC) | ((kk & 4) << 1) | ((kk & 8) >> 1), c = (st & 1) * 32 + (w & 3) * 8; vv = (unsigned)(k * (LD * 2) + c * 2); } }
#define SWA_ISSUE(T) do { const size_t ko_ = (size_t)(T) * 64 * (LD * 2); const unsigned sb_ = ldsb + (unsigned)((T) % NSLOT) * SLOT + (unsigned)wid * 1024u; \
        glds16_s(Kg + ko_, vk, sb_); glds16_s(Vg + ko_, vv, sb_ + KT); } while (0)
    { const int t0 = qb0 - 2 < 0 ? 0 : qb0 - 2, t1 = qb0 + 2 > NTILE_SEQ - 1 ? NTILE_SEQ - 1 : qb0 + 2;
      for (int T = t0; T <= t1; ++T) SWA_ISSUE(T); }
    const int qh = g * 4 + (wid >> 1);
    const float slope2 = __builtin_amdgcn_exp2f(-0.5f * (float)(qh + 1)) * LOG2E;
    const float sink2 = sink[qh] * LOG2E;
    LAS float* al_l = (LAS float*)(lds + OFF_WS) + wid * 64; LAS float* li_l = al_l + 32;
    const int vrb = (int)ldsb + KT + v_rd_base(lane);
    const int xr = ((r32 >> 1) & 7) << 4;
    bf16x8 qr[4], qn[4];
    { const bf16_t* Qw = QKV + (tok0 + (size_t)(qb0 * 64 + (wid & 1) * 32 + r32)) * LD + qh * 64 + hi * 8;
#pragma unroll
      for (int d0 = 0; d0 < 4; ++d0) qr[d0] = *(const bf16x8*)(Qw + d0 * 16); }
    asm volatile("s_waitcnt vmcnt(0) lgkmcnt(0)\n\ts_barrier" ::: "memory");
    for (int qb = qb0; qb < qb0 + nqb; ++qb) {
        const bool more = qb + 1 < qb0 + nqb;
        if (more && qb + 3 < NTILE_SEQ) SWA_ISSUE(qb + 3);
        const int q0 = qb * 64, rowb = q0 + (wid & 1) * 32;
        if (more) { const bf16_t* Qw = QKV + (tok0 + (size_t)(rowb + 64 + r32)) * LD + qh * 64 + hi * 8;
#pragma unroll
            for (int d0 = 0; d0 < 4; ++d0) qn[d0] = *(const bf16x8*)(Qw + d0 * 16); }
        asm volatile("" ::: "memory");
        const int T0 = qb - 2 < 0 ? 0 : qb - 2, T1 = qb + 2 > NTILE_SEQ - 1 ? NTILE_SEQ - 1 : qb + 2;
        float m_reg = -1e30f, l_reg = 0.f; f32x16 o[2] = {};
        for (int T = T0; T <= T1; ++T) {
            const LAS unsigned char* Ks = lds + (T % NSLOT) * SLOT + r32 * 128;
            f32x16 p0 = {}, p1 = {};
#pragma unroll
            for (int d0 = 0; d0 < 4; ++d0) { const int cb = ((d0 * 2 + hi) * 16) ^ xr;
                const bf16x8 b0 = *(const LAS bf16x8*)(Ks + cb), b1 = *(const LAS bf16x8*)(Ks + 32 * 128 + cb);
                p0 = __builtin_amdgcn_mfma_f32_32x32x16_bf16(b0, qr[d0], p0, 0, 0, 0);
                p1 = __builtin_amdgcn_mfma_f32_32x32x16_bf16(b1, qr[d0], p1, 0, 0, 0); }
            const int kb = T * 64 - (rowb + r32);
            float pmax = -INFINITY;
#pragma unroll
            for (int r = 0; r < 16; ++r) { const int rel0 = kb + crow(r, hi), rel1 = rel0 + 32; const int d0 = rel0 < 0 ? -rel0 : rel0, d1 = rel1 < 0 ? -rel1 : rel1;
                float x0 = fmaf(p0[r], C, -slope2 * (float)d0), x1 = fmaf(p1[r], C, -slope2 * (float)d1);
                x0 = d0 > 128 ? -INFINITY : x0; x1 = d1 > 128 ? -INFINITY : x1; p0[r] = x0; p1[r] = x1; pmax = fmaxf(pmax, fmaxf(x0, x1)); }
            { auto rr = __builtin_amdgcn_permlane32_swap(__float_as_uint(pmax), __float_as_uint(pmax), false, false);
              pmax = fmaxf(__uint_as_float(rr[0]), __uint_as_float(rr[1])); }
            const float mn = fmaxf(m_reg, pmax), alpha = __builtin_amdgcn_exp2f(m_reg - mn); m_reg = mn;
            float ps = 0.f;
#pragma unroll
            for (int r = 0; r < 16; ++r) { p0[r] = __builtin_amdgcn_exp2f(p0[r] - mn); p1[r] = __builtin_amdgcn_exp2f(p1[r] - mn); ps += p0[r] + p1[r]; }
            { auto rr = __builtin_amdgcn_permlane32_swap(__float_as_uint(ps), __float_as_uint(ps), false, false);
              ps = __uint_as_float(rr[0]) + __uint_as_float(rr[1]); }
            l_reg = l_reg * alpha + ps;
            if (hi == 0) al_l[r32] = alpha; asm volatile("s_waitcnt lgkmcnt(0)" ::: "memory");
#pragma unroll
            for (int d = 0; d < 2; ++d)
#pragma unroll
                for (int r = 0; r < 16; ++r) o[d][r] *= al_l[crow(r, hi)];
            bf16x8 pa0, pa1, pa2, pa3;
            PK4(p0, 0, pa0); PK4(p0, 8, pa1); PK4(p1, 0, pa2); PK4(p1, 8, pa3);
            const int vb = vrb + (T % NSLOT) * SLOT;
            pv_one<0, 2>(o[0], vb, pa0, pa1, pa2, pa3); pv_one<1, 2>(o[1], vb, pa0, pa1, pa2, pa3);
        }
        l_reg += __builtin_amdgcn_exp2f(sink2 - m_reg);
        if (hi == 0) li_l[r32] = l_reg; asm volatile("s_waitcnt lgkmcnt(0)" ::: "memory");
        LAS unsigned char* ost = lds + OFF_O + wid * (32 * OSTR);
        if constexpr (O8) {
#pragma unroll
            for (int r = 0; r < 16; ++r) { const int orow = crow(r, hi); const float rl = __builtin_amdgcn_rcpf(li_l[orow]) * O8_SCALE;
#pragma unroll
                for (int d0 = 0; d0 < 2; ++d0) *(LAS unsigned char*)(ost + orow * 80 + d0 * 32 + r32) = (unsigned char)fp8_1(o[d0][r] * rl); }
            asm volatile("s_waitcnt lgkmcnt(0)" ::: "memory");
            unsigned char* Ow = (unsigned char*)O + (tok0 + (size_t)rowb) * DM + qh * 64;
#pragma unroll
            for (int it = 0; it < 2; ++it) { const int ch = it * 64 + lane, row = ch >> 2, c16 = ch & 3;
                const u32x4 v = *(const LAS u32x4*)(ost + row * 80 + c16 * 16); *(u32x4*)(Ow + (size_t)row * DM + c16 * 16) = v; }
            asm volatile("s_waitcnt vmcnt(2) lgkmcnt(0)\n\ts_barrier" ::: "memory");
        } else {
#pragma unroll
            for (int r = 0; r < 16; ++r) { const int orow = crow(r, hi); const float rl = __builtin_amdgcn_rcpf(li_l[orow]);
#pragma unroll
                for (int d0 = 0; d0 < 2; ++d0) *(LAS unsigned short*)(ost + orow * OSTR + (d0 * 32 + r32) * 2) = (unsigned short)f2bf(o[d0][r] * rl); }
            asm volatile("s_waitcnt lgkmcnt(0)" ::: "memory");
            bf16_t* Ow = O + (tok0 + (size_t)rowb) * DM + qh * 64;
#pragma unroll
            for (int it = 0; it < 4; ++it) { const int ch = it * 64 + lane, row = ch >> 3, c16 = ch & 7;
                const u32x4 v = *(const LAS u32x4*)(ost + row * OSTR + c16 * 16); *(u32x4*)(Ow + (size_t)row * DM + c16 * 8) = v; }
            asm volatile("s_waitcnt vmcnt(4) lgkmcnt(0)\n\ts_barrier" ::: "memory");
        }
#pragma unroll
        for (int d0 = 0; d0 < 4; ++d0) qr[d0] = qn[d0];
    }
    asm volatile("s_waitcnt vmcnt(0)" ::: "memory");
#undef SWA_ISSUE
}
}

constexpr int NWAVES = 8;
struct Args { const float* in[23]; float* out; unsigned char* ws; };
static_assert(sizeof(Args) == 25 * 8, "no padding");

template <int KIND> __device__ __forceinline__ int map_row(int n) {
    if (KIND == 0) return n;
    if (KIND == 1) return ((n >> 7) << 8) + (n & 127);
    if (KIND == 2) return ((n >> 7) << 8) + 128 + (n & 127);
    if (KIND == 3) { const int h = n / QKD; int d = n - h * QKD; if (d >= 128) { const int i = d - 128; d = 128 + (i < 32 ? 2 * i : 2 * (i - 32) + 1); } return h * QKD + d; }
    if (KIND == 4) { if (n >= 512) { const int i = n - 512; n = 512 + (i < 32 ? 2 * i : 2 * (i - 32) + 1); } return n; }
    return n;
}
template <int KIND> __device__ __forceinline__ void transpose_matrix(const float* W, int K, int N, bf16_t* WT, int row_off, LAS float* scr, int gw, int NGW, int lane, const float* gk = nullptr) {
    const int nblk = N / 32, nitems = (K / 64) * nblk;
    for (int item = gw; item < nitems; item += NGW) {
        const int kb = item / nblk, nb = item % nblk, k0 = 64 * kb, n0 = 32 * nb;
        { f32x4 t[8];
#pragma unroll
          for (int i = 0; i < 8; ++i) t[i] = *(const f32x4*)(W + (size_t)(k0 + (lane >> 3) + 8 * i) * N + n0 + 4 * (lane & 7));
#pragma unroll
          for (int i = 0; i < 8; ++i) { const int kk = (lane >> 3) + 8 * i; f32x4 v = t[i]; if (gk) v = v * gk[k0 + kk];
              LAS float* d = scr + kk * 33 + 4 * (lane & 7); d[0] = v.x; d[1] = v.y; d[2] = v.z; d[3] = v.w; } }
        LDS_WAIT(); asm volatile("" ::: "memory");
        const int c = lane & 7;
#pragma unroll
        for (int j = 0; j < 4; ++j) { const int n = (lane >> 3) + 8 * j; const LAS float* s = scr + (8 * c) * 33 + n;
            u32x4 o; o.x = pk2(s[0 * 33], s[1 * 33]); o.y = pk2(s[2 * 33], s[3 * 33]); o.z = pk2(s[4 * 33], s[5 * 33]); o.w = pk2(s[6 * 33], s[7 * 33]);
            *(u32x4*)(WT + (size_t)(row_off + map_row<KIND>(n0 + n)) * K + k0 + 8 * c) = o; }
        LDS_WAIT(); asm volatile("" ::: "memory");
    }
}
template <int KIND> __device__ __forceinline__ void transpose_matrix_f8(const float* W, int K, int N, unsigned char* WT, int row_off, LAS float* scr, int gw, int NGW, int lane, float scale, const float* gk = nullptr) {
    const int nblk = N / 32, nitems = (K / 64) * nblk;
    for (int item = gw; item < nitems; item += NGW) {
        const int kb = item / nblk, nb = item % nblk, k0 = 64 * kb, n0 = 32 * nb;
        { f32x4 t[8];
#pragma unroll
          for (int i = 0; i < 8; ++i) t[i] = *(const f32x4*)(W + (size_t)(k0 + (lane >> 3) + 8 * i) * N + n0 + 4 * (lane & 7));
#pragma unroll
          for (int i = 0; i < 8; ++i) { const int kk = (lane >> 3) + 8 * i; f32x4 v = t[i] * scale; if (gk) v = v * gk[k0 + kk];
              LAS float* d = scr + kk * 33 + 4 * (lane & 7); d[0] = v.x; d[1] = v.y; d[2] = v.z; d[3] = v.w; } }
        LDS_WAIT(); asm volatile("" ::: "memory");
        const int c = lane & 7;
#pragma unroll
        for (int j = 0; j < 4; ++j) { const int n = (lane >> 3) + 8 * j; const LAS float* sp = scr + (8 * c) * 33 + n;
            const float o[8] = {sp[0 * 33], sp[1 * 33], sp[2 * 33], sp[3 * 33], sp[4 * 33], sp[5 * 33], sp[6 * 33], sp[7 * 33]};
            *(u32x2*)(WT + (size_t)(row_off + map_row<KIND>(n0 + n)) * K + k0 + 8 * c) = pk8_fp8(o); }
        LDS_WAIT(); asm volatile("" ::: "memory");
    }
}
__device__ __forceinline__ void rms_row_to_bf16(const float* xrow, const f32x4 (&gv)[4], bf16_t* orow, int lane) {
    const f32x4* xr = (const f32x4*)xrow + lane; f32x4 v[4]; float s = 0.f;
#pragma unroll
    for (int j = 0; j < 4; ++j) { v[j] = xr[64 * j]; s += (v[j].x * v[j].x + v[j].y * v[j].y) + (v[j].z * v[j].z + v[j].w * v[j].w); }
    const float rstd = 1.0f / sqrtf(wave_sum(s, lane) * (1.f / DM) + EPS);
    unsigned long long* o8 = (unsigned long long*)orow + lane;
#pragma unroll
    for (int j = 0; j < 4; ++j) { const f32x4 y = v[j] * rstd * gv[j]; o8[64 * j] = (unsigned long long)pk2(y.x, y.y) | ((unsigned long long)pk2(y.z, y.w) << 32); }
}

#define PHASE_IDS const int tid = opaque_tid(bar.wv), lane = tid & 63, wave = __builtin_amdgcn_readfirstlane(tid >> 6), gw = vcu * NWAVES + wave; (void)gw; (void)lane
template <int j> __device__ __forceinline__ void pair_body(const Args& args, LAS unsigned char* lds, const XcdBarrier& bar, const int G, const int bx, const int vcu) {
    const int NGW = G * NWAVES;
    unsigned char* ws = args.ws;
    LAS int* moetab = (LAS int*)(lds + MOETAB_OFF);
    const float* x = args.in[0];
    int* route = (int*)(ws + WS_ROUTE); f32x2* gate = (f32x2*)(ws + WS_GATE); int* posb = (int*)(ws + WS_POS); int* cnt = (int*)(ws + WS_CNT);
    unsigned char* act = ws + WS_ACT;
    bf16_t* H = (bf16_t*)(act + A_H); bf16_t* XN = (bf16_t*)(act + A_XN); bf16_t* DOWN = (bf16_t*)(act + A_DOWN); bf16_t* QB = (bf16_t*)(act + A_Q);
    bf16_t* KVB = (bf16_t*)args.out;
    bf16_t* FACT = (bf16_t*)(act + A_FACT); bf16_t* SQKV = (bf16_t*)(act + A_SQKV); bf16_t* SO = (bf16_t*)(act + A_SO); bf16_t* XS = (bf16_t*)args.out; bf16_t* MACT = (bf16_t*)(act + A_MACT);
    float* STAT = (float*)(act + A_STAT); LAS float* PART = (LAS float*)(lds + PART_OFF);
    constexpr bool F8M = ((FP8_MOE >> j) & 1) != 0, F8F = ((FP8_FFN >> j) & 1) != 0;
    unsigned char* H8 = act + A_H8;
    bf16_t* YS = F8M ? (bf16_t*)(act + A_YS) : XS;
    constexpr bool FINAL_DIRECT = (j == 1) && F8M;
    {
        unsigned char* wb = ws + WS_W + (size_t)j * W_PAIR;
        if (PH(1)) { pg8::Gemm g{XN, (const bf16_t*)(wb + W_DQKV), DM, DM, DM}; pg8::DenseOrder S; S.init(NTOK, DOWNP, G, bx, 256);
          pg8::EpiDown E{DOWN, STAT, PART}; pg8::gemm_phase<pg8::EpiDown, pg8::DenseOrder, true>(lds, g, S, E, bar.wv); }
        xcd_barrier(bar);
        if (PH(3)) { pg8::Gemm g{DOWN, (const bf16_t*)(wb + W_UQ), DOWNP, 256, 256}; pg8::DenseOrder S; S.init(NTOK, NQ, G, bx, 256);
          pg8::EpiQRope E{QB}; pg8::gemm_phase<pg8::EpiQRope, pg8::DenseOrder, true>(lds, g, S, E, bar.wv); }
        { pg8::Gemm g{DOWN + 256, (const bf16_t*)(wb + W_UKV), DOWNP, 256, 256}; pg8::DenseOrder S; S.init(NTOK, NKV, G, bx, 256);
          pg8::EpiBf16<false, 1> E{KVB, NKV, STAT, 1, 1.f / 256.f, 1.f}; pg8::gemm_phase<pg8::EpiBf16<false, 1>, pg8::DenseOrder, true>(lds, g, S, E, bar.wv); }
        xcd_barrier(bar);
        if (PH(4)) { const int NU = BATCH * MLA_H * (SEQ / 256);
          for (int u = vcu; u < NU; u += G) { const int bh = u >> 3, qb = u & 7; mla::unit<FP8_ATTO != 0>(bh >> 3, bh & 7, qb, QB, KVB, DOWN, STAT, XN, lds, bar.wv); } }
        xcd_barrier(bar);
        if (PH(5)) { constexpr bool F8 = FP8_ATTO != 0; pg8::Gemm g{XN, (const bf16_t*)(wb + W_MO), F8 ? DM / 2 : DM, F8 ? DM / 2 : DM, F8 ? DM / 2 : DM}; pg8::DenseOrder S; S.init(NTOK, DM, G, bx, 256);
          pg8::EpiResid<j == 0, F8F> E{j == 0 ? (const void*)x : (const void*)H, H, STAT, PART, F8 ? RESID_SCALE / (W8_SCALE * O8_SCALE) : RESID_SCALE, H8}; pg8::gemm_phase<pg8::EpiResid<j == 0, F8F>, pg8::DenseOrder, true, F8>(lds, g, S, E, bar.wv); }
        xcd_barrier(bar);
        if (PH(7)) {
          if constexpr (F8F) { pg8::Gemm g{(const bf16_t*)H8, (const bf16_t*)(wb + W_FGU), DM / 2, DM / 2, DM / 2}; pg8::DenseOrder S; S.init(NTOK, 2 * FFN, G, bx, 128);
            pg8::EpiSwiGLU<false, 4, true> E{FACT, FFN, STAT, 1.f / 1024.f, 1.0f / W8_SCALE}; pg8::gemm_phase<pg8::EpiSwiGLU<false, 4, true>, pg8::DenseOrder, true, true>(lds, g, S, E, bar.wv); }
          else { pg8::Gemm g{H, (const bf16_t*)(wb + W_FGU), DM, DM, DM}; pg8::DenseOrder S; S.init(NTOK, 2 * FFN, G, bx, 128);
            pg8::EpiSwiGLU<false, 4> E{FACT, FFN, STAT, 1.f / 1024.f, 1.f}; pg8::gemm_phase<pg8::EpiSwiGLU<false, 4>, pg8::DenseOrder, true>(lds, g, S, E, bar.wv); } }
        xcd_barrier(bar);
        if (PH(8)) {
          if constexpr (F8F) { pg8::Gemm g{FACT, (const bf16_t*)(wb + W_FD), FFN / 2, FFN / 2, FFN / 2}; pg8::DenseOrder S; S.init(NTOK, DM, G, bx, 256);
            pg8::EpiResid<false> E{H, H, STAT, PART, RESID_SCALE / W8_SCALE, nullptr}; pg8::gemm_phase<pg8::EpiResid<false>, pg8::DenseOrder, true, true>(lds, g, S, E, bar.wv); }
          else { pg8::Gemm g{FACT, (const bf16_t*)(wb + W_FD), FFN, FFN, FFN}; pg8::DenseOrder S; S.init(NTOK, DM, G, bx, 256);
            pg8::EpiResid<false> E{H, H, STAT, PART, RESID_SCALE, nullptr}; pg8::gemm_phase<pg8::EpiResid<false>, pg8::DenseOrder, true>(lds, g, S, E, bar.wv); } }
        xcd_barrier(bar);
        if (PH(10)) { pg8::Gemm g{H, (const bf16_t*)(wb + W_SQKV), DM, DM, DM}; pg8::DenseOrder S; S.init(NTOK, SWA_NQKV, G, bx, 256);
          pg8::EpiBf16<false, 4> E{SQKV, SWA_NQKV, STAT, 0, 1.f / 1024.f, 1.f}; pg8::gemm_phase<pg8::EpiBf16<false, 4>, pg8::DenseOrder, true>(lds, g, S, E, bar.wv); }
        xcd_barrier(bar);
        if (PH(11)) { constexpr int NQB = 16, NSU = BATCH * 4 * (SEQ / 64 / NQB);
          for (int su = vcu; su < NSU; su += G) { const int bg = su >> 1, qb0 = (su & 1) * NQB; swa::superunit<FP8_ATTO != 0>(bg >> 2, bg & 3, qb0, NQB, SQKV, args.in[11] + j * 16, SO, lds, bar.wv); } }
        xcd_barrier(bar);
        if (PH(12)) { constexpr bool F8 = FP8_ATTO != 0; pg8::Gemm g{SO, (const bf16_t*)(wb + W_SO), F8 ? DM / 2 : DM, F8 ? DM / 2 : DM, F8 ? DM / 2 : DM}; pg8::DenseOrder S; S.init(NTOK, DM, G, bx, 256);
          pg8::EpiResid<false> E{H, H, STAT, PART, F8 ? RESID_SCALE / (W8_SCALE * O8_SCALE) : RESID_SCALE, nullptr}; pg8::gemm_phase<pg8::EpiResid<false>, pg8::DenseOrder, true, F8>(lds, g, S, E, bar.wv); }
        xcd_barrier(bar);
        if (PH(13)) { PHASE_IDS; LAS float* rt = (LAS float*)lds;
          LAS int* lcnt = (LAS int*)(lds + 32768);
          const float* router = args.in[18] + (size_t)j * DM * NE; const float* mg = args.in[17] + j * DM;
          for (int i = tid; i < DM * NE; i += NWAVES * 64) rt[(i & 7) * DM + (i >> 3)] = router[i] * mg[i >> 3];
          for (int ck = vcu; ck < NTOK / 256; ck += G) {
              if (tid < 8) lcnt[tid] = 0;
              __syncthreads();
              { const int tokb = ck * 256 + wave * 32;
                u32x2 nx[2][4]; f32x4 nst[2];
#pragma unroll
                for (int q = 0; q < 2; ++q) { const u32x2* hr = (const u32x2*)(H + (size_t)(tokb + q) * DM) + lane;
#pragma unroll
                    for (int k = 0; k < 4; ++k) nx[q][k] = hr[64 * k];
                    nst[q] = *(const f32x4*)(STAT + (size_t)(tokb + q) * 4); }
                for (int r = 0; r < 32; r += 2) {
                  u32x2 cu[2][4]; f32x4 cst[2];
#pragma unroll
                  for (int q = 0; q < 2; ++q) { cst[q] = nst[q];
#pragma unroll
                      for (int k = 0; k < 4; ++k) cu[q][k] = nx[q][k]; }
                  if (r + 2 < 32) {
#pragma unroll
                      for (int q = 0; q < 2; ++q) { const u32x2* hr = (const u32x2*)(H + (size_t)(tokb + r + 2 + q) * DM) + lane;
#pragma unroll
                          for (int k = 0; k < 4; ++k) nx[q][k] = hr[64 * k];
                          nst[q] = *(const f32x4*)(STAT + (size_t)(tokb + r + 2 + q) * 4); } }
#pragma unroll
                  for (int q = 0; q < 2; ++q) { const int tok = tokb + r + q; f32x4 v[4];
#pragma unroll
                      for (int k = 0; k < 4; ++k) { const u32x2 w = cu[q][k]; v[k] = (f32x4){bf_lo(w.x), bf_hi(w.x), bf_lo(w.y), bf_hi(w.y)}; }
                      const f32x4 st4 = cst[q];
                      const float rstd = 1.0f / sqrtf(((st4.x + st4.y) + (st4.z + st4.w)) * (1.f / DM) + EPS);
                      float lg[8];
#pragma unroll
                      for (int e = 0; e < 8; ++e) { float a = 0.f;
#pragma unroll
                          for (int k = 0; k < 4; ++k) { const f32x4 w = *(const LAS f32x4*)(rt + e * DM + 4 * lane + 256 * k); a += (v[k].x * w.x + v[k].y * w.y) + (v[k].z * w.z + v[k].w * w.w); }
                          lg[e] = wave_sum(a, lane) * rstd; }
                      int i0 = 0; float v0 = lg[0];
#pragma unroll
                      for (int e = 1; e < 8; ++e) if (lg[e] > v0) { v0 = lg[e]; i0 = e; }
                      int i1 = -1; float v1 = -INFINITY;
#pragma unroll
                      for (int e = 0; e < 8; ++e) if (e != i0 && lg[e] > v1) { v1 = lg[e]; i1 = e; }
                      const float g0 = 1.0f / (1.0f + __expf(v1 - v0));
                      if (lane == 0) { route[tok] = i0 | (i1 << 8); gate[tok] = (f32x2){g0, 1.0f - g0}; __hip_atomic_fetch_add(lcnt + i0, 1, __ATOMIC_RELAXED, __HIP_MEMORY_SCOPE_WORKGROUP); __hip_atomic_fetch_add(lcnt + i1, 1, __ATOMIC_RELAXED, __HIP_MEMORY_SCOPE_WORKGROUP); } }
                } }
              __syncthreads();
              if (tid < 8) cnt[ck * 8 + tid] = lcnt[tid];
              __syncthreads();
          } }
        xcd_barrier(bar);
        if (PH(14)) { PHASE_IDS; LAS int* red = (LAS int*)lds;
          LAS int* tp = (LAS int*)(lds + 1024);
          LAS int* wcn = (LAS int*)(lds + 2048);
          LAS int* lpos = (LAS int*)(lds + 4096);
          f32x4 gv[4];
#pragma unroll
          for (int k = 0; k < 4; ++k) gv[k] = ((const f32x4*)(args.in[17] + j * DM))[lane + 64 * k];
          int v[8];
          if (tid < 256) { const i32x4 c0 = ((const i32x4*)cnt)[tid * 2], c1 = ((const i32x4*)cnt)[tid * 2 + 1]; v[0] = c0.x; v[1] = c0.y; v[2] = c0.z; v[3] = c0.w; v[4] = c1.x; v[5] = c1.y; v[6] = c1.z; v[7] = c1.w; }
          else {
#pragma unroll
              for (int e = 0; e < 8; ++e) v[e] = 0; }
#pragma unroll
          for (int e = 0; e < 8; ++e) { int tot = v[e];
#pragma unroll
              for (int o = 1; o < 64; o <<= 1) tot += shxi(tot, o, lane);
              if (lane == 0) red[wave * 16 + e] = tot; }
          __syncthreads();
          if (tid < 8) { int sm = 0;
#pragma unroll
              for (int w = 0; w < 8; ++w) sm += red[w * 16 + tid];
              tp[tid] = sm; }
          __syncthreads();
          if (tid == 0) { int rs = 0, ts = 0;
              for (int e = 0; e < 8; ++e) { moetab[e] = ts; moetab[16 + e] = rs; rs += tp[e]; ts += (tp[e] + 255) >> 8; }
              moetab[8] = ts; moetab[24] = rs; }
          __syncthreads();
          for (int ck = vcu; ck < NTOK / 256; ck += G) {
#pragma unroll
              for (int e = 0; e < 8; ++e) { int pre = (tid < ck) ? v[e] : 0;
#pragma unroll
                  for (int o = 1; o < 64; o <<= 1) pre += shxi(pre, o, lane);
                  if (lane == 0) red[wave * 16 + 8 + e] = pre; }
              __syncthreads();
              if (tid < 8) { int sm = 0;
#pragma unroll
                  for (int w = 0; w < 8; ++w) sm += red[w * 16 + 8 + tid];
                  tp[8 + tid] = sm; }
              int e0 = 0, e1 = 0, r0 = 0, r1 = 0;
              if (tid < 256) { const int re = route[ck * 256 + tid]; e0 = re & 255; e1 = re >> 8; }
#pragma unroll
              for (int e = 0; e < 8; ++e) { const bool f = (tid < 256) && (e0 == e || e1 == e); const unsigned long long mk = __ballot(f);
                  const int rk = __popcll(mk & ((1ull << lane) - 1ull));
                  if (e0 == e) r0 = rk; if (e1 == e) r1 = rk;
                  if (lane == 0 && wave < 4) wcn[wave * 8 + e] = __popcll(mk); }
              __syncthreads();
              if (tid < 256) { int p0 = moetab[16 + e0] + tp[8 + e0] + r0, p1 = moetab[16 + e1] + tp[8 + e1] + r1;
                  for (int w = 0; w < wave; ++w) { p0 += wcn[w * 8 + e0]; p1 += wcn[w * 8 + e1]; }
                  lpos[tid * 2] = p0; lpos[tid * 2 + 1] = p1; posb[(size_t)(ck * 256 + tid) * 2] = p0; posb[(size_t)(ck * 256 + tid) * 2 + 1] = p1; }
              __syncthreads();
              { const int tb = wave * 32, tokb = ck * 256 + tb;
                u32x2 nx[2][4]; f32x4 nst[2];
#pragma unroll
                for (int q = 0; q < 2; ++q) { const u32x2* hr = (const u32x2*)(H + (size_t)(tokb + q) * DM) + lane;
#pragma unroll
                    for (int k = 0; k < 4; ++k) nx[q][k] = hr[64 * k];
                    nst[q] = *(const f32x4*)(STAT + (size_t)(tokb + q) * 4); }
                for (int r = 0; r < 32; r += 2) {
                  u32x2 cu[2][4]; f32x4 cst[2];
#pragma unroll
                  for (int q = 0; q < 2; ++q) { cst[q] = nst[q];
#pragma unroll
                      for (int k = 0; k < 4; ++k) cu[q][k] = nx[q][k]; }
                  if (r + 2 < 32) {
#pragma unroll
                      for (int q = 0; q < 2; ++q) { const u32x2* hr = (const u32x2*)(H + (size_t)(tokb + r + 2 + q) * DM) + lane;
#pragma unroll
                          for (int k = 0; k < 4; ++k) nx[q][k] = hr[64 * k];
                          nst[q] = *(const f32x4*)(STAT + (size_t)(tokb + r + 2 + q) * 4); } }
#pragma unroll
                  for (int q = 0; q < 2; ++q) { const int t = tb + r + q; const int p0 = lpos[t * 2], p1 = lpos[t * 2 + 1];
                      const f32x4 st4 = cst[q];
                      const float rstd = 1.0f / sqrtf(((st4.x + st4.y) + (st4.z + st4.w)) * (1.f / DM) + EPS);
                      if (F8M) { unsigned* o0 = (unsigned*)((unsigned char*)XS + (size_t)p0 * DM) + lane; unsigned* o1 = (unsigned*)((unsigned char*)XS + (size_t)p1 * DM) + lane;
#pragma unroll
                          for (int k = 0; k < 4; ++k) { const u32x2 w = cu[q][k]; const f32x4 y = (f32x4){bf_lo(w.x), bf_hi(w.x), bf_lo(w.y), bf_hi(w.y)} * rstd * gv[k];
                              int ow = 0; ow = __builtin_amdgcn_cvt_pk_fp8_f32(y.x, y.y, ow, false); ow = __builtin_amdgcn_cvt_pk_fp8_f32(y.z, y.w, ow, true); o0[64 * k] = (unsigned)ow; o1[64 * k] = (unsigned)ow; } }
                      else { u32x2* o0 = (u32x2*)(XS + (size_t)p0 * DM) + lane; u32x2* o1 = (u32x2*)(XS + (size_t)p1 * DM) + lane;
#pragma unroll
                          for (int k = 0; k < 4; ++k) { const u32x2 w = cu[q][k]; const f32x4 y = (f32x4){bf_lo(w.x), bf_hi(w.x), bf_lo(w.y), bf_hi(w.y)} * rstd * gv[k];
                              u32x2 ow; ow.x = pk2(y.x, y.y); ow.y = pk2(y.z, y.w); o0[64 * k] = ow; o1[64 * k] = ow; } } }
                } }
              __syncthreads();
          } }
        xcd_barrier(bar);
        if (PH(15)) {
          if constexpr (F8M) { pg8::Gemm g{XS, (const bf16_t*)(wb + W_MGU), DM / 2, DM / 2, DM / 2}; pg8::GroupedOrder S; S.init(moetab, 2 * ED, G, bx, 128);
            pg8::EpiSwiGLU<true, 0, true> E{MACT, ED, nullptr, 0.f, 1.0f / W8_SCALE}; pg8::gemm_phase<pg8::EpiSwiGLU<true, 0, true>, pg8::GroupedOrder, true, true>(lds, g, S, E, bar.wv); }
          else { pg8::Gemm g{XS, (const bf16_t*)(wb + W_MGU), DM, DM, DM}; pg8::GroupedOrder S; S.init(moetab, 2 * ED, G, bx, 128);
            pg8::EpiSwiGLU<true, 0> E{MACT, ED, nullptr, 0.f, 1.f}; pg8::gemm_phase<pg8::EpiSwiGLU<true, 0>, pg8::GroupedOrder, true>(lds, g, S, E, bar.wv); } }
        xcd_barrier(bar);
        if (PH(16)) {
          if constexpr (F8M) { pg8::Gemm g{MACT, (const bf16_t*)(wb + W_MD), ED / 2, ED / 2, ED / 2}; pg8::GroupedOrder S; S.init(moetab, DM, G, bx, 256);
            pg8::EpiBf16<true, 0> E{YS, DM, nullptr, 0, 0.f, 1.0f / W8_SCALE}; pg8::gemm_phase<pg8::EpiBf16<true, 0>, pg8::GroupedOrder, true, true>(lds, g, S, E, bar.wv); }
          else { pg8::Gemm g{MACT, (const bf16_t*)(wb + W_MD), ED, ED, ED}; pg8::GroupedOrder S; S.init(moetab, DM, G, bx, 256);
            pg8::EpiBf16<true, 0> E{XS, DM, nullptr, 0, 0.f, 1.f}; pg8::gemm_phase<pg8::EpiBf16<true, 0>, pg8::GroupedOrder, true>(lds, g, S, E, bar.wv); } }
        xcd_barrier(bar);
        if (PH(17)) { PHASE_IDS;
          f32x4 gv[4];
#pragma unroll
          for (int k = 0; k < 4; ++k) gv[k] = ((const f32x4*)(j == 0 ? args.in[1] + DM : args.in[22]))[lane + 64 * k];
          for (int m = gw; m < NTOK; m += NGW) {
              const int p0 = posb[(size_t)m * 2], p1 = posb[(size_t)m * 2 + 1]; const f32x2 gg = gate[m] * RESID_SCALE;
              u32x2* hr = (u32x2*)(H + (size_t)m * DM) + lane;
              const u32x2* y0 = (const u32x2*)(YS + (size_t)p0 * DM) + lane; const u32x2* y1 = (const u32x2*)(YS + (size_t)p1 * DM) + lane;
              f32x4 v[4]; float ss = 0.f;
#pragma unroll
              for (int k = 0; k < 4; ++k) { const u32x2 a = y0[64 * k], b = y1[64 * k], hw = hr[64 * k]; f32x4 hv = (f32x4){bf_lo(hw.x), bf_hi(hw.x), bf_lo(hw.y), bf_hi(hw.y)};
                  hv.x += gg.x * bf_lo(a.x) + gg.y * bf_lo(b.x); hv.y += gg.x * bf_hi(a.x) + gg.y * bf_hi(b.x);
                  hv.z += gg.x * bf_lo(a.y) + gg.y * bf_lo(b.y); hv.w += gg.x * bf_hi(a.y) + gg.y * bf_hi(b.y);
                  v[k] = hv; ss += (hv.x * hv.x + hv.y * hv.y) + (hv.z * hv.z + hv.w * hv.w); }
              if (!FINAL_DIRECT) {
#pragma unroll
                  for (int k = 0; k < 4; ++k) { u32x2 ow; ow.x = pk2(v[k].x, v[k].y); ow.y = pk2(v[k].z, v[k].w); hr[64 * k] = ow; } }
              if (j == 0 || FINAL_DIRECT) { const float rstd = 1.0f / sqrtf(wave_sum(ss, lane) * (1.f / DM) + EPS);
                  if (j == 0) { u32x2* o8 = (u32x2*)(XN + (size_t)m * DM) + lane;
#pragma unroll
                      for (int k = 0; k < 4; ++k) { const f32x4 y = v[k] * rstd * gv[k]; u32x2 ow; ow.x = pk2(y.x, y.y); ow.y = pk2(y.z, y.w); o8[64 * k] = ow; } }
                  else { f32x4* o = (f32x4*)(args.out + (size_t)m * DM) + lane;
#pragma unroll
                      for (int k = 0; k < 4; ++k) o[64 * k] = v[k] * rstd * gv[k]; } }
          } }
        if (j == 0 || !FINAL_DIRECT) xcd_barrier(bar);
        if (j == 1 && !FINAL_DIRECT && PH(18)) { PHASE_IDS; float* outp = args.out;
          f32x4 gv[4];
#pragma unroll
          for (int k = 0; k < 4; ++k) gv[k] = ((const f32x4*)args.in[22])[lane + 64 * k];
          for (int m = gw; m < NTOK; m += NGW) {
              const u32x2* hr = (const u32x2*)(H + (size_t)m * DM) + lane; f32x4 v[4]; float ss = 0.f;
#pragma unroll
              for (int k = 0; k < 4; ++k) { const u32x2 hw = hr[64 * k]; v[k] = (f32x4){bf_lo(hw.x), bf_hi(hw.x), bf_lo(hw.y), bf_hi(hw.y)}; ss += (v[k].x * v[k].x + v[k].y * v[k].y) + (v[k].z * v[k].z + v[k].w * v[k].w); }
              const float rstd = 1.0f / sqrtf(wave_sum(ss, lane) * (1.f / DM) + EPS);
              f32x4* o = (f32x4*)(outp + (size_t)m * DM) + lane;
#pragma unroll
              for (int k = 0; k < 4; ++k) o[64 * k] = v[k] * rstd * gv[k];
          } }
    }
}

__global__ void __launch_bounds__(NWAVES * 64, 2) fwd(Args args) {
    extern __shared__ __attribute__((aligned(16))) unsigned char lds_raw[];
    LAS unsigned char* lds = (LAS unsigned char*)lds_raw;
    const int G = gridDim.x, bx = blockIdx.x, vcu = (G % 8 == 0) ? (bx % 8) * (G / 8) + bx / 8 : bx;
    const int NGW = G * NWAVES;
    unsigned char* ws = args.ws;
    unsigned* ctl = (unsigned*)(ws + WS_CTL);
    const int wv0 = __builtin_amdgcn_readfirstlane((int)threadIdx.x >> 6);
    for (int u = opaque_tid(wv0); u < (LDS_BYTES - LDSCTL_OFF) / 4; u += NWAVES * 64) ((LAS unsigned*)(lds + LDSCTL_OFF))[u] = 0u;
    __syncthreads();
    volatile LAS unsigned* MISC = (volatile LAS unsigned*)(lds + MISC_OFF);
    XcdBarrier bar = xcd_barrier_post(ctl + 4096, MISC + 8, wv0);
    const float* x = args.in[0];
    bf16_t* XN = (bf16_t*)(ws + WS_ACT + A_XN);

    if (PH(0)) { PHASE_IDS;
        LAS float* scr = (LAS float*)(lds + wave * 16384);
        for (int j = 0; j < 2; ++j) {
            unsigned char* wb = ws + WS_W + (size_t)j * W_PAIR;
            transpose_matrix<4>(args.in[2] + (size_t)j * DM * 576, DM, 576, (bf16_t*)(wb + W_DQKV), 0, scr, gw, NGW, lane);
            for (int i = gw * 64 + lane; i < (DOWNP - 576) * DM / 8; i += NGW * 64) ((u32x4*)(wb + W_DQKV + (size_t)576 * DM * 2))[i] = (u32x4){0u, 0u, 0u, 0u};
            transpose_matrix<3>(args.in[4] + (size_t)j * 256 * NQ, 256, NQ, (bf16_t*)(wb + W_UQ), 0, scr, gw, NGW, lane, args.in[3] + j * 256);
            transpose_matrix<0>(args.in[6] + (size_t)j * 256 * 1024, 256, 1024, (bf16_t*)(wb + W_UKV), 0, scr, gw, NGW, lane, args.in[5] + j * 256);
            transpose_matrix<0>(args.in[7] + (size_t)j * 256 * 1024, 256, 1024, (bf16_t*)(wb + W_UKV), 1024, scr, gw, NGW, lane, args.in[5] + j * 256);
            if (FP8_ATTO) transpose_matrix_f8<0>(args.in[8] + (size_t)j * DM * DM, DM, DM, wb + W_MO, 0, scr, gw, NGW, lane, W8_SCALE);
            else transpose_matrix<0>(args.in[8] + (size_t)j * DM * DM, DM, DM, (bf16_t*)(wb + W_MO), 0, scr, gw, NGW, lane);
            transpose_matrix<0>(args.in[10] + (size_t)j * DM * SWA_NQKV, DM, SWA_NQKV, (bf16_t*)(wb + W_SQKV), 0, scr, gw, NGW, lane, args.in[9] + j * DM);
            if (FP8_ATTO) transpose_matrix_f8<0>(args.in[12] + (size_t)j * DM * DM, DM, DM, wb + W_SO, 0, scr, gw, NGW, lane, W8_SCALE);
            else transpose_matrix<0>(args.in[12] + (size_t)j * DM * DM, DM, DM, (bf16_t*)(wb + W_SO), 0, scr, gw, NGW, lane);
            if ((FP8_FFN >> j) & 1) {
            transpose_matrix_f8<1>(args.in[14] + (size_t)j * DM * FFN, DM, FFN, wb + W_FGU, 0, scr, gw, NGW, lane, W8_SCALE, args.in[13] + j * DM);
            transpose_matrix_f8<2>(args.in[15] + (size_t)j * DM * FFN, DM, FFN, wb + W_FGU, 0, scr, gw, NGW, lane, W8_SCALE, args.in[13] + j * DM);
            transpose_matrix_f8<0>(args.in[16] + (size_t)j * FFN * DM, FFN, DM, wb + W_FD, 0, scr, gw, NGW, lane, W8_SCALE);
            } else {
            transpose_matrix<1>(args.in[14] + (size_t)j * DM * FFN, DM, FFN, (bf16_t*)(wb + W_FGU), 0, scr, gw, NGW, lane, args.in[13] + j * DM);
            transpose_matrix<2>(args.in[15] + (size_t)j * DM * FFN, DM, FFN, (bf16_t*)(wb + W_FGU), 0, scr, gw, NGW, lane, args.in[13] + j * DM);
            transpose_matrix<0>(args.in[16] + (size_t)j * FFN * DM, FFN, DM, (bf16_t*)(wb + W_FD), 0, scr, gw, NGW, lane);
            }
            for (int e = 0; e < NE; ++e) {
                if ((FP8_MOE >> j) & 1) {
                    transpose_matrix_f8<1>(args.in[19] + ((size_t)j * NE + e) * DM * ED, DM, ED, wb + W_MGU, e * 2 * ED, scr, gw, NGW, lane, W8_SCALE);
                    transpose_matrix_f8<2>(args.in[20] + ((size_t)j * NE + e) * DM * ED, DM, ED, wb + W_MGU, e * 2 * ED, scr, gw, NGW, lane, W8_SCALE);
                    transpose_matrix_f8<0>(args.in[21] + ((size_t)j * NE + e) * ED * DM, ED, DM, wb + W_MD, e * DM, scr, gw, NGW, lane, W8_SCALE);
                } else {
                transpose_matrix<1>(args.in[19] + ((size_t)j * NE + e) * DM * ED, DM, ED, (bf16_t*)(wb + W_MGU), e * 2 * ED, scr, gw, NGW, lane);
                transpose_matrix<2>(args.in[20] + ((size_t)j * NE + e) * DM * ED, DM, ED, (bf16_t*)(wb + W_MGU), e * 2 * ED, scr, gw, NGW, lane);
                transpose_matrix<0>(args.in[21] + ((size_t)j * NE + e) * ED * DM, ED, DM, (bf16_t*)(wb + W_MD), e * DM, scr, gw, NGW, lane);
                }
            }
        }
        f32x4 gv[4];
#pragma unroll
        for (int j = 0; j < 4; ++j) gv[j] = ((const f32x4*)args.in[1])[lane + 64 * j];
        for (int m = gw; m < NTOK; m += NGW) rms_row_to_bf16(x + (size_t)m * DM, gv, XN + (size_t)m * DM, lane);
    }
    xcd_barrier(bar);

    pair_body<0>(args, lds, bar, G, bx, vcu);
    pair_body<1>(args, lds, bar, G, bx, vcu);
}

extern "C" void kernel_launch(void* const* d_in, const int* in_sizes, int n_in, void* d_out, int out_size, void* d_ws, size_t ws_size, hipStream_t stream) {
    static int grid = 0;
    if (grid == 0) {
        if (n_in != 23 || out_size != NTOK * DM || ws_size < WS_NEED) { fprintf(stderr, "kernel_launch: shape/workspace mismatch (n_in %d out %d ws %zu need %zu)\n", n_in, out_size, ws_size, (size_t)WS_NEED); grid = -1; return; }
        int dev = 0, cus = 0;
        if (hipGetDevice(&dev) != hipSuccess || hipDeviceGetAttribute(&cus, hipDeviceAttributeMultiprocessorCount, dev) != hipSuccess) { grid = -1; return; }
        if (hipFuncSetAttribute((const void*)fwd, hipFuncAttributeMaxDynamicSharedMemorySize, LDS_BYTES) != hipSuccess) { fprintf(stderr, "kernel_launch: hipFuncSetAttribute failed\n"); grid = -1; return; }
        int per_cu = 0;
        if (hipOccupancyMaxActiveBlocksPerMultiprocessor(&per_cu, (const void*)fwd, NWAVES * 64, LDS_BYTES) != hipSuccess || per_cu < 1) fprintf(stderr, "kernel_launch: occupancy query reports %d\n", per_cu);
        (void)hipGetLastError();
        grid = cus;
    }
    if (grid < 0) return;
    if (hipMemsetAsync((char*)d_ws + WS_CTL, 0, CTL_ZERO_BYTES, stream) != hipSuccess) return;
    Args a{};
    for (int i = 0; i < 23; ++i) a.in[i] = (const float*)d_in[i];
    a.out = (float*)d_out; a.ws = (unsigned char*)d_ws;
    hipLaunchKernelGGL(fwd, dim3(grid), dim3(NWAVES * 64), LDS_BYTES, stream, a);
    const hipError_t le = hipPeekAtLastError();
    if (le != hipSuccess) fprintf(stderr, "kernel_launch: launch failed: %s\n", hipGetErrorName(le));
}
```

```cpp
#include <hip/hip_runtime.h>
#include <hip/hip_bf16.h>
#include <cstdio>
#include <cstdint>

#define LAS __attribute__((address_space(3)))
#define GAS __attribute__((address_space(1)))
typedef unsigned short bf16_t;
typedef short bf16x8 __attribute__((ext_vector_type(8)));
typedef short s16x4 __attribute__((ext_vector_type(4)));
typedef float f32x4 __attribute__((ext_vector_type(4)));
typedef float f32x2 __attribute__((ext_vector_type(2)));
typedef float f32x16 __attribute__((ext_vector_type(16)));
typedef unsigned u32x4 __attribute__((ext_vector_type(4)));
typedef unsigned u32x2 __attribute__((ext_vector_type(2)));
typedef int i32x4 __attribute__((ext_vector_type(4)));
typedef int i32x8 __attribute__((ext_vector_type(8)));

constexpr int DM = 1024, BATCH = 32, SEQ = 2048, NTOK = BATCH * SEQ;
constexpr int MLA_H = 8, QKD = 192, DOWNP = 768;
constexpr int NQ = MLA_H * QKD  , NKV = 2048;
constexpr int SWA_NQKV = 1536;
constexpr int FFN = 2816, NE = 8, ED = 2048;
constexpr int NPAIR = NTOK * 2;
constexpr float EPS = 1e-6f;
constexpr float LOG2E = 1.4426950408889634f;
#ifndef PHMASK
#define PHMASK 0xFFFFFFFFu
#endif
#define PH(k) (((PHMASK) >> (k)) & 1u)
#define RESID_SCALE 1.0f
#ifndef FP8_MOE
#define FP8_MOE 3
#endif
#ifndef FP8_YS
#define FP8_YS 3
#endif
#ifndef FP8_S2
#define FP8_S2 2
#endif
#ifndef FP8_FFN
#define FP8_FFN 2
#endif
#ifndef FP8_ATTO
#define FP8_ATTO 1
#endif
#ifndef FP8_QK
#define FP8_QK 1
#endif
#ifndef FP8_PV
#define FP8_PV 1
#endif
#ifndef FP8_UP
#define FP8_UP 1
#endif
#ifndef FP8_DOWN
#define FP8_DOWN 1
#endif
constexpr float W8_SCALE = 32.0f, O8_SCALE = 64.0f;
constexpr float YS8_SCALE = 16.0f;

constexpr size_t MiB = 1u << 20;
constexpr size_t WS_CTL = 0, CTL_ZERO_BYTES = 1 * MiB;
constexpr size_t WS_ROPE = 1 * MiB;
constexpr size_t WS_ROUTE = 2 * MiB;
constexpr size_t WS_GATE = 3 * MiB;
constexpr size_t WS_POS = 4 * MiB;
constexpr size_t WS_CNT = 5 * MiB;
constexpr size_t WS_W = 6 * MiB;
constexpr size_t W_DQKV = 0;
constexpr size_t W_UQ = W_DQKV + (size_t)DOWNP * DM * 2;
constexpr size_t W_UKV = W_UQ + (size_t)NQ * 256 * 2;
constexpr size_t W_MO = W_UKV + (size_t)NKV * 256 * 2;
constexpr size_t W_SQKV = W_MO + (size_t)DM * DM * 2;
constexpr size_t W_SO = W_SQKV + (size_t)SWA_NQKV * DM * 2;
constexpr size_t W_FGU = W_SO + (size_t)DM * DM * 2;
constexpr size_t W_FD = W_FGU + (size_t)2 * FFN * DM * 2;
constexpr size_t W_MGU = W_FD + (size_t)DM * FFN * 2;
constexpr size_t W_MD = W_MGU + (size_t)NE * 2 * ED * DM * 2;
constexpr size_t W_PAIR = W_MD + (size_t)NE * DM * ED * 2;
constexpr size_t WS_ACT = 254 * MiB;
static_assert(WS_W + 2 * W_PAIR <= WS_ACT, "weights fit");
constexpr size_t A_H = 0;
constexpr size_t A_XN = 128 * MiB;
constexpr size_t A_DOWN = 256 * MiB;
constexpr size_t A_Q = 352 * MiB;
constexpr size_t A_K8 = 448 * MiB;
constexpr size_t A_KR8 = 512 * MiB;
constexpr size_t A_FACT = 128 * MiB;
constexpr size_t A_SQKV = 128 * MiB;
constexpr size_t A_SO = 320 * MiB;
constexpr size_t A_MACT = 128 * MiB;
constexpr size_t A_YS = 384 * MiB;
constexpr size_t A_H8 = 480 * MiB;
constexpr size_t A_STAT = 768 * MiB;
constexpr size_t WS_NEED = WS_ACT + 770 * MiB;
static_assert(WS_NEED <= 1024 * MiB, "ws");

constexpr int RING_BYTES = 147456;
constexpr int LDSCTL_OFF = RING_BYTES;
constexpr int MISC_OFF = LDSCTL_OFF + 320;
constexpr int PART_OFF = LDSCTL_OFF + 2048;
constexpr int MOETAB_OFF = LDSCTL_OFF + 1024;
constexpr int LDS_BYTES = 163840;

#define RLX_AGENT __ATOMIC_RELAXED, __HIP_MEMORY_SCOPE_AGENT
#define LDS_WAIT() asm volatile("s_waitcnt lgkmcnt(0)" ::: "memory")
#define VM_WAIT() asm volatile("s_waitcnt vmcnt(0)" ::: "memory")
#define SBAR() __builtin_amdgcn_sched_barrier(0)
__device__ __forceinline__ unsigned f2bf(float f) { unsigned u = __builtin_bit_cast(unsigned, f); return (u + 0x7fffu + ((u >> 16) & 1u)) >> 16; }
__device__ __forceinline__ unsigned pk2(float lo, float hi) { return f2bf(lo) | (f2bf(hi) << 16); }
__device__ __forceinline__ unsigned cvt_pk_bf16(float lo, float hi) { unsigned r; asm volatile("v_cvt_pk_bf16_f32 %0, %1, %2" : "=v"(r) : "v"(lo), "v"(hi)); return r; }
__device__ __forceinline__ u32x2 pk8_fp8(const float (&o)[8]) { int w0 = 0, w1 = 0;
    w0 = __builtin_amdgcn_cvt_pk_fp8_f32(o[0], o[1], w0, false); w0 = __builtin_amdgcn_cvt_pk_fp8_f32(o[2], o[3], w0, true);
    w1 = __builtin_amdgcn_cvt_pk_fp8_f32(o[4], o[5], w1, false); w1 = __builtin_amdgcn_cvt_pk_fp8_f32(o[6], o[7], w1, true);
    u32x2 r; r.x = (unsigned)w0; r.y = (unsigned)w1; return r; }
__device__ __forceinline__ unsigned fp8_1(float v) { return (unsigned)__builtin_amdgcn_cvt_pk_fp8_f32(v, v, 0, false) & 0xffu; }
__device__ __forceinline__ float bf_lo(unsigned w) { return __builtin_bit_cast(float, w << 16); }
__device__ __forceinline__ float bf_hi(unsigned w) { return __builtin_bit_cast(float, w & 0xffff0000u); }
__device__ __forceinline__ int opaque_tid(int wv) { int l; asm volatile("v_mbcnt_lo_u32_b32 %0, -1, 0\n\tv_mbcnt_hi_u32_b32 %0, -1, %0" : "=v"(l)); return wv * 64 + l; }
__device__ __forceinline__ int opaque_lane() { int l; asm volatile("v_mbcnt_lo_u32_b32 %0, -1, 0\n\tv_mbcnt_hi_u32_b32 %0, -1, %0" : "=v"(l)); return l; }
__device__ __forceinline__ void glds16_s(const void* sbase, unsigned voff, unsigned lds_dst) {
    unsigned keep;
    asm volatile("s_mov_b32 %0, m0\n\ts_mov_b32 m0, %3\n\ts_nop 0\n\tglobal_load_lds_dwordx4 %1, %2\n\ts_mov_b32 m0, %0" : "=&s"(keep) : "v"(voff), "s"(sbase), "s"(lds_dst) : "memory");
}
__device__ __forceinline__ float shx(float v, int o, int lane) { return __builtin_bit_cast(float, __builtin_amdgcn_ds_bpermute((lane ^ o) << 2, __builtin_bit_cast(int, v))); }
__device__ __forceinline__ int shxi(int v, int o, int lane) { return __builtin_amdgcn_ds_bpermute((lane ^ o) << 2, v); }
__device__ __forceinline__ float wave_sum(float v, int lane) {
#pragma unroll
    for (int o = 1; o < 64; o <<= 1) v += shx(v, o, lane);
    return v;
}

#define XB_TMO      128
#define XB_XCNT(j)  (256  + 64 * (j))
#define XB_XSUB(j)  (1280 + 64 * (j))
#define XB_XGEN(j)  (2304 + 64 * (j))
#define XB_TOP      3328
#define XB_TOPGEN   3392
#define XCD_BAR_WORDS 3456
#define XB_SPIN_CAP (1u << 18)
__device__ __forceinline__ unsigned xb_ld(unsigned* p)              { return __hip_atomic_load(p, __ATOMIC_RELAXED, __HIP_MEMORY_SCOPE_AGENT); }
__device__ __forceinline__ unsigned xb_add(unsigned* p, unsigned v) { return __hip_atomic_fetch_add(p, v, __ATOMIC_RELAXED, __HIP_MEMORY_SCOPE_AGENT); }
__device__ __forceinline__ unsigned xb_xcc_id() { return (unsigned)__builtin_amdgcn_s_getreg((3 << 11) | 20) & 0xFu; }
#define XB_SPIN(cond, bar) do { unsigned _sp = 0; while (cond) { __builtin_amdgcn_s_sleep(1); \
    if ((++_sp & 255u) == 0u) { if (xb_ld(&(bar)[XB_TMO])) break; if (_sp > XB_SPIN_CAP) { atomicAdd(&(bar)[XB_TMO], 1u); break; } } } } while (0)
struct XcdBarrier { unsigned* bar; unsigned x; volatile LAS unsigned* st; int wv; };
__device__ __forceinline__ XcdBarrier xcd_barrier_post(unsigned* bar, volatile LAS unsigned* st, int wv) {
    XcdBarrier b; b.bar = bar; b.x = xb_xcc_id(); b.st = st; b.wv = wv;
    if (opaque_tid(wv) == 0) (void)xb_add(&bar[XB_XCNT(b.x)], 1u);
    return b;
}
__device__ __forceinline__ void xcd_barrier_complete(unsigned* bar, unsigned x, unsigned& nloc, unsigned& nx) {
    const unsigned G = gridDim.x * gridDim.y * gridDim.z;
    unsigned sum, cnt, mine, sp = 0u;
    for (;;) {
        sum = 0u; cnt = 0u; mine = 0u;
#pragma unroll
        for (unsigned j = 0; j < 16; ++j) { const unsigned c = xb_ld(&bar[XB_XCNT(j)]); sum += c; cnt += (c > 0u) ? 1u : 0u; mine = (j == x) ? c : mine; }
        if (sum == G) break;
        __builtin_amdgcn_s_sleep(1);
        if ((++sp & 255u) == 0u) { if (xb_ld(&bar[XB_TMO])) break; if (sp > XB_SPIN_CAP) { atomicAdd(&bar[XB_TMO], 1u); break; } }
    }
    nloc = mine > 0u ? mine : 1u; nx = cnt > 0u ? cnt : 1u;
}
__device__ __forceinline__ void xcd_barrier(const XcdBarrier& b) {
    asm volatile("s_waitcnt vmcnt(0)" ::: "memory");
    __syncthreads();
    if (opaque_tid(b.wv) == 0) {
        unsigned* bar = b.bar;
        __builtin_amdgcn_s_waitcnt(0);
        unsigned nloc = b.st[0], nx = b.st[1];
        if (nloc == 0u) { xcd_barrier_complete(bar, b.x, nloc, nx); b.st[0] = nloc; b.st[1] = nx; }
        const unsigned old = xb_add(&bar[XB_XSUB(b.x)], 1u);
        const unsigned gen = old / nloc;
        if (old + 1u == (gen + 1u) * nloc) {
            __builtin_amdgcn_fence(__ATOMIC_RELEASE, "agent");
            asm volatile("s_waitcnt vmcnt(0)" ::: "memory");
            const unsigned og = xb_add(&bar[XB_TOP], 1u);
            const unsigned tg = og / nx;
            if (og + 1u == (tg + 1u) * nx) xb_add(&bar[XB_TOPGEN], 1u);
            else XB_SPIN(xb_ld(&bar[XB_TOPGEN]) == tg, bar);
            __builtin_amdgcn_fence(__ATOMIC_ACQUIRE, "agent");
            xb_add(&bar[XB_XGEN(b.x)], 1u);
            asm volatile("s_waitcnt vmcnt(0)" ::: "memory");
        } else {
            XB_SPIN(xb_ld(&bar[XB_XGEN(b.x)]) == gen, bar);
            __builtin_amdgcn_fence(__ATOMIC_ACQUIRE, "agent");
            asm volatile("s_waitcnt vmcnt(0)" ::: "memory");
        }
    }
    __syncthreads();
}

namespace pg8 {
constexpr int BM = 256, BK = 64, HALF = 128, HTB = HALF * BK * 2, STAGE_BYTES = 8 * HTB, NXCD = 8, WGM = 8;
__host__ __device__ __forceinline__ int lds_byte(int r, int c) { const int st = (r >> 4) * 2 + (c >> 5), rr = r & 15, cc = c & 31, ob = rr * 64 + cc * 2; return st * 1024 + (ob ^ (((ob >> 9) & 1) << 5)); }
__host__ __device__ __forceinline__ void stage_rc(int b, int& R, int& C) { const int st = b / 1024, sb = b % 1024, swz = sb ^ (((sb >> 9) & 1) << 5); R = (st >> 1) * 16 + swz / 64; C = (st & 1) * 32 + (swz % 64) / 2; }
__host__ __device__ __forceinline__ int perm32(int rho) { const int n = rho >> 4, i = rho & 15; return 8 * (i >> 2) + 4 * n + (i & 3); }

struct Unit { int arow, brow, col, nvalid, nlo; };
struct Gemm { const bf16_t* A; const bf16_t* Bt; int lda, ldb, K; };

struct DenseOrder {
    int nM, nN, nwg, G, c, colw;
    __device__ void init(int M, int N, int G_, int c_, int colw_) { nM = M / BM; nN = N / BM; nwg = nM * nN; G = G_; c = c_; colw = colw_; }
    __device__ __forceinline__ bool next(int i, Unit& u) const {
        const long L = (long)i * G + c; if (L >= nwg) return false;
        int wgid = (int)L; { const int q = nwg / NXCD, r = nwg % NXCD, xcd = wgid % NXCD, off = wgid / NXCD; wgid = (xcd < r ? xcd * (q + 1) : r * (q + 1) + (xcd - r) * q) + off; }
        const int nig = WGM * nN, gid = wgid / nig, fm = gid * WGM, gsz = (nM - fm) < WGM ? (nM - fm) : WGM;
        const int pm = fm + ((wgid % nig) % gsz), pn = (wgid % nig) / gsz;
        u.arow = pm * BM; u.brow = pn * BM; u.col = pn * colw; u.nvalid = BM; u.nlo = 0; return true;
    }
};
struct GroupedOrder {
    int nM, nN, nwg, G, c, colw, erows; const LAS int* tab;
    __device__ void init(const LAS int* tab_, int N, int G_, int c_, int colw_) { tab = tab_; nM = tab_[8]; nN = N / BM; nwg = nM * nN; G = G_; c = c_; colw = colw_; erows = N; }
    __device__ __forceinline__ bool next(int i, Unit& u) const {
        const long L = (long)i * G + c; if (L >= nwg) return false;
        int wgid = (int)L; { const int q = nwg / NXCD, r = nwg % NXCD, xcd = wgid % NXCD, off = wgid / NXCD; wgid = (xcd < r ? xcd * (q + 1) : r * (q + 1) + (xcd - r) * q) + off; }
        const int nig = WGM * nN, gid = wgid / nig, fm = gid * WGM, gsz = (nM - fm) < WGM ? (nM - fm) : WGM;
        const int T = fm + ((wgid % nig) % gsz), pn = (wgid % nig) / gsz;
        int e = 0;
#pragma unroll
        for (int k = 1; k < 8; ++k) e += (T >= tab[k]) ? 1 : 0;
        const int lt = T - tab[e]; int arow = tab[16 + e] + lt * BM; int nv = tab[16 + e + 1] - arow; nv = nv > BM ? BM : nv;
        int lo = 0; { const int over = arow + BM - tab[24]; if (over > 0) { arow -= over; lo = over; nv += over; } }
        u.arow = __builtin_amdgcn_readfirstlane(arow); u.nvalid = __builtin_amdgcn_readfirstlane(nv); u.nlo = __builtin_amdgcn_readfirstlane(lo);
        u.brow = __builtin_amdgcn_readfirstlane(e * erows + pn * BM); u.col = __builtin_amdgcn_readfirstlane(pn * colw); return true;
    }
};

__device__ __forceinline__ u32x4 widen16(u32x2 a, u32x2 b) {
    auto r0 = __builtin_amdgcn_permlane16_swap(a.x, b.x, false, false); auto r1 = __builtin_amdgcn_permlane16_swap(a.y, b.y, false, false);
    return (u32x4){r0[0], r1[0], r0[1], r1[1]};
}
template <int NS> __device__ __forceinline__ float row_rstd(const float* stat, int row, int slot0, float inv_n) {
    float s;
    if (NS == 4) { const f32x4 a = *(const f32x4*)(stat + (size_t)row * 4); s = (a.x + a.y) + (a.z + a.w); }
    else s = stat[(size_t)row * 4 + slot0];
    return __builtin_amdgcn_rsqf(s + EPS / inv_n) * __builtin_sqrtf(1.0f / inv_n);
}
template <int NS> __device__ __forceinline__ void row_rstd8(float (&rs)[2][4], const float* stat, int row0, int slot0, float inv_n) {
#pragma unroll
    for (int ai = 0; ai < 2; ++ai)
#pragma unroll
        for (int m = 0; m < 4; ++m) rs[ai][m] = NS ? row_rstd<NS ? NS : 1>(stat, row0 + ai * HALF + m * 16, slot0, inv_n) : 1.f;
}
__device__ __forceinline__ void stat_combine(LAS float* part, float* stat, const Unit& u, int slot, int wr, int wc, int fr, int fq) {
    asm volatile("s_waitcnt lgkmcnt(0)" ::: "memory"); __builtin_amdgcn_s_barrier(); asm volatile("" ::: "memory");
    const int t = (wr * 4 + wc) * 64 + fq * 16 + fr;
    if (t < 256) { const float sum = (part[t] + part[256 + t]) + (part[512 + t] + part[768 + t]); stat[(size_t)(u.arow + t) * 4 + slot] = sum; }
}
template <bool MASK, int NS> struct EpiBf16 {
    static constexpr bool PERM = true; static constexpr int NST = 16;
    __device__ __forceinline__ bool full(const Unit& u) const { return !MASK || (u.nvalid == BM && u.nlo == 0); }
    bf16_t* O; int ldc; const float* stat; int slot0; float inv_n; float oscale; int qcols = 0; float qscale = 1.f;
    __device__ __forceinline__ void operator()(const f32x4 (&acc)[2][2][4][2], const Unit& u, int wr, int wc, int fr, int fq) const {
        const int col0 = u.col + wc * 32 + 8 * fq; const float osc = u.col < qcols ? oscale * qscale : oscale;
        float rs[2][4]; row_rstd8<NS>(rs, stat, u.arow + wr * 64 + fr, slot0, inv_n);
#pragma unroll
        for (int ai = 0; ai < 2; ++ai)
#pragma unroll
            for (int m = 0; m < 4; ++m) { const int rl = ai * HALF + wr * 64 + m * 16 + fr; if (MASK && (rl >= u.nvalid || rl < u.nlo)) continue;
                const float r = rs[ai][m] * osc;
                bf16_t* rowp = O + (size_t)(u.arow + rl) * ldc + col0;
#pragma unroll
                for (int bj = 0; bj < 2; ++bj) { const f32x4 v0 = acc[ai][bj][m][0] * r, v1 = acc[ai][bj][m][1] * r;
                    u32x4 w; w.x = cvt_pk_bf16(v0[0], v0[1]); w.y = cvt_pk_bf16(v0[2], v0[3]); w.z = cvt_pk_bf16(v1[0], v1[1]); w.w = cvt_pk_bf16(v1[2], v1[3]);
                    *(u32x4*)(rowp + bj * HALF) = w; } }
    }
};
template <bool MASK> struct EpiF8 {
    static constexpr bool PERM = true; static constexpr int NST = 8;
    __device__ __forceinline__ bool full(const Unit& u) const { return !MASK || (u.nvalid == BM && u.nlo == 0); }
    unsigned char* O; int ldc; float oscale;
    __device__ __forceinline__ void operator()(const f32x4 (&acc)[2][2][4][2], const Unit& u, int wr, int wc, int fr, int fq) const {
        const int col0 = u.col + wc * 32 + 8 * fq, odd = fq & 1;
#pragma unroll
        for (int ai = 0; ai < 2; ++ai)
#pragma unroll
            for (int mp = 0; mp < 2; ++mp) { const int rl = ai * HALF + wr * 64 + (2 * mp + odd) * 16 + fr;
                unsigned char* rowp = O + (size_t)(u.arow + rl) * ldc + col0 - 8 * odd; const bool ok = !MASK || (rl < u.nvalid && rl >= u.nlo);
#pragma unroll
                for (int bj = 0; bj < 2; ++bj) { const f32x4 a0 = acc[ai][bj][2 * mp][0] * oscale, a1 = acc[ai][bj][2 * mp][1] * oscale, b0 = acc[ai][bj][2 * mp + 1][0] * oscale, b1 = acc[ai][bj][2 * mp + 1][1] * oscale;
                    const float oa[8] = {a0[0], a0[1], a0[2], a0[3], a1[0], a1[1], a1[2], a1[3]}, ob[8] = {b0[0], b0[1], b0[2], b0[3], b1[0], b1[1], b1[2], b1[3]};
                    const u32x4 w = widen16(pk8_fp8(oa), pk8_fp8(ob));
                    if (ok) *(u32x4*)(rowp + bj * HALF) = w; } }
    }
};
struct EpiKV8 {
    static constexpr bool PERM = true; static constexpr int NST = 8;
    __device__ __forceinline__ bool full(const Unit&) const { return true; }
    bf16_t* KV; unsigned char* k8; const float* stat; float oscale;
    __device__ __forceinline__ void operator()(const f32x4 (&acc)[2][2][4][2], const Unit& u, int wr, int wc, int fr, int fq) const {
        const int col0 = u.col + wc * 32 + 8 * fq;
        float rs[2][4]; row_rstd8<1>(rs, stat, u.arow + wr * 64 + fr, 1, 1.f / 256.f);
        if (u.col < 1024) {
#pragma unroll
            for (int ai = 0; ai < 2; ++ai)
#pragma unroll
                for (int mp = 0; mp < 2; ++mp) { const int odd = fq & 1; const float ra = rs[ai][2 * mp] * oscale, rb = rs[ai][2 * mp + 1] * oscale;
                    unsigned char* rowp = k8 + (size_t)(u.arow + ai * HALF + wr * 64 + (2 * mp + odd) * 16 + fr) * 1024 + col0 - 8 * odd;
#pragma unroll
                    for (int bj = 0; bj < 2; ++bj) { const f32x4 a0 = acc[ai][bj][2 * mp][0] * ra, a1 = acc[ai][bj][2 * mp][1] * ra, b0 = acc[ai][bj][2 * mp + 1][0] * rb, b1 = acc[ai][bj][2 * mp + 1][1] * rb;
                        const float oa[8] = {a0[0], a0[1], a0[2], a0[3], a1[0], a1[1], a1[2], a1[3]}, ob[8] = {b0[0], b0[1], b0[2], b0[3], b1[0], b1[1], b1[2], b1[3]};
                        *(u32x4*)(rowp + bj * HALF) = widen16(pk8_fp8(oa), pk8_fp8(ob)); } }
        } else {
#pragma unroll
            for (int ai = 0; ai < 2; ++ai)
#pragma unroll
                for (int m = 0; m < 4; ++m) { const float r = rs[ai][m] * oscale; bf16_t* rowp = KV + (size_t)(u.arow + ai * HALF + wr * 64 + m * 16 + fr) * NKV + col0;
#pragma unroll
                    for (int bj = 0; bj < 2; ++bj) { const f32x4 v0 = acc[ai][bj][m][0] * r, v1 = acc[ai][bj][m][1] * r;
                        u32x4 w; w.x = cvt_pk_bf16(v0[0], v0[1]); w.y = cvt_pk_bf16(v0[2], v0[3]); w.z = cvt_pk_bf16(v1[0], v1[1]); w.w = cvt_pk_bf16(v1[2], v1[3]);
                        *(u32x4*)(rowp + bj * HALF) = w; } }
        }
    }
};
struct EpiVT8 {
    static constexpr bool PERM = true; static constexpr int NST = 8;
    __device__ __forceinline__ bool full(const Unit&) const { return true; }
    unsigned char* vt; const float* stat; float oscale;
    __device__ __forceinline__ void operator()(const f32x4 (&acc)[2][2][4][2], const Unit& u, int wr, int wc, int fr, int fq) const {
        const int t0 = u.col + wc * 32 + 8 * fq;
        f32x4 rs[2][2];
#pragma unroll
        for (int bj = 0; bj < 2; ++bj)
#pragma unroll
            for (int n = 0; n < 2; ++n)
#pragma unroll
                for (int k = 0; k < 4; ++k) rs[bj][n][k] = stat[(size_t)(t0 + bj * HALF + 4 * n + k) * 4 + 1];
#pragma unroll
        for (int bj = 0; bj < 2; ++bj)
#pragma unroll
            for (int n = 0; n < 2; ++n)
#pragma unroll
                for (int k = 0; k < 4; ++k) rs[bj][n][k] = __builtin_amdgcn_rsqf(rs[bj][n][k] * (1.f / 256.f) + EPS) * oscale;
#pragma unroll
        for (int bj = 0; bj < 2; ++bj) { const int tw = u.col + bj * HALF + wc * 32, base = (tw & ~63) + 16 * (wc & 1);
#pragma unroll
            for (int ai = 0; ai < 2; ++ai) { unsigned char* p = vt + (size_t)(u.arow + ai * HALF + wr * 64 + fq * 16 + fr) * NTOK + base;
#pragma unroll
                for (int n = 0; n < 2; ++n) { unsigned w[4];
#pragma unroll
                    for (int m = 0; m < 4; ++m) { const f32x4 v = acc[ai][bj][m][n] * rs[bj][n];
                        int x = 0; x = __builtin_amdgcn_cvt_pk_fp8_f32(v[0], v[1], x, false); x = __builtin_amdgcn_cvt_pk_fp8_f32(v[2], v[3], x, true); w[m] = (unsigned)x; }
                    auto x01 = __builtin_amdgcn_permlane16_swap(w[0], w[1], false, false); auto x23 = __builtin_amdgcn_permlane16_swap(w[2], w[3], false, false);
                    auto s0 = __builtin_amdgcn_permlane32_swap(x01[0], x23[0], false, false); auto s1 = __builtin_amdgcn_permlane32_swap(x01[1], x23[1], false, false);
                    *(u32x4*)(p + 32 * n) = (u32x4){s0[0], s1[0], s0[1], s1[1]}; } } }
    }
};
template <bool MASK, int NS, bool F8OUT = false> struct EpiSwiGLU {
    static constexpr bool PERM = true; static constexpr int NST = F8OUT ? 4 : 8;
    __device__ __forceinline__ bool full(const Unit& u) const { return !MASK || (u.nvalid == BM && u.nlo == 0); }
    bf16_t* O; int ldc; const float* stat; float inv_n; float oscale;
    __device__ __forceinline__ void row8(float (&o)[8], const f32x4 (&acc)[2][2][4][2], int ai, int m, float r) const {
        const float rL = -r * LOG2E, c = __builtin_amdgcn_rcpf(r * r);
#pragma unroll
        for (int n = 0; n < 2; ++n)
#pragma unroll
            for (int k = 0; k < 4; ++k) { const float ag = acc[ai][0][m][n][k], au = acc[ai][1][m][n][k];
                o[n * 4 + k] = (ag * au) * __builtin_amdgcn_rcpf(fmaf(__builtin_amdgcn_exp2f(ag * rL), c, c)); }
    }
    __device__ __forceinline__ void operator()(const f32x4 (&acc)[2][2][4][2], const Unit& u, int wr, int wc, int fr, int fq) const {
        const int col0 = u.col + wc * 32 + 8 * fq;
        float rs[2][4]; row_rstd8<NS>(rs, stat, u.arow + wr * 64 + fr, 0, inv_n);
        if constexpr (F8OUT) {
            const int odd = fq & 1;
#pragma unroll
            for (int ai = 0; ai < 2; ++ai)
#pragma unroll
                for (int mp = 0; mp < 2; ++mp) { float oa[8], ob[8]; row8(oa, acc, ai, 2 * mp, rs[ai][2 * mp] * oscale); row8(ob, acc, ai, 2 * mp + 1, rs[ai][2 * mp + 1] * oscale);
                    const u32x4 w = widen16(pk8_fp8(oa), pk8_fp8(ob));
                    const int rl = ai * HALF + wr * 64 + (2 * mp + odd) * 16 + fr;
                    if (!MASK || (rl < u.nvalid && rl >= u.nlo)) *(u32x4*)((unsigned char*)O + (size_t)(u.arow + rl) * ldc + col0 - 8 * odd) = w; }
        } else {
#pragma unroll
        for (int ai = 0; ai < 2; ++ai)
#pragma unroll
            for (int m = 0; m < 4; ++m) { const int rl = ai * HALF + wr * 64 + m * 16 + fr; if (MASK && (rl >= u.nvalid || rl < u.nlo)) continue;
                float o[8]; row8(o, acc, ai, m, rs[ai][m] * oscale);
                u32x4 w; w.x = cvt_pk_bf16(o[0], o[1]); w.y = cvt_pk_bf16(o[2], o[3]); w.z = cvt_pk_bf16(o[4], o[5]); w.w = cvt_pk_bf16(o[6], o[7]);
                *(u32x4*)(O + (size_t)(u.arow + rl) * ldc + col0) = w; }
        }
    }
};
template <bool BASE_F32, bool H8OUT = false> struct EpiResid {
    static constexpr bool PERM = true; static constexpr int NST = H8OUT ? 24 : 16;
    __device__ __forceinline__ bool full(const Unit&) const { return true; }
    const void* base; bf16_t* out; float* stat; LAS float* part; float scale; unsigned char* h8;
    __device__ __forceinline__ void operator()(f32x4 (&acc)[2][2][4][2], const Unit& u, int wr, int wc, int fr, int fq) const {
        const int col0 = u.col + wc * 32 + 8 * fq; const int lane = fq * 16 + fr;
#pragma unroll
        for (int ai = 0; ai < 2; ++ai)
#pragma unroll
          for (int mh = 0; mh < 2; ++mh) {
            if (BASE_F32) { f32x4 t[2][2][2];
#pragma unroll
                for (int m = 0; m < 2; ++m) { const float* bp = (const float*)base + (size_t)(u.arow + ai * HALF + wr * 64 + (mh * 2 + m) * 16 + fr) * DM + col0;
#pragma unroll
                    for (int bj = 0; bj < 2; ++bj)
#pragma unroll
                        for (int n = 0; n < 2; ++n) t[m][bj][n] = *(const f32x4*)(bp + bj * HALF + n * 4); }
#pragma unroll
                for (int m = 0; m < 2; ++m)
#pragma unroll
                    for (int bj = 0; bj < 2; ++bj)
#pragma unroll
                        for (int n = 0; n < 2; ++n) acc[ai][bj][mh * 2 + m][n] = acc[ai][bj][mh * 2 + m][n] * scale + t[m][bj][n];
            } else { u32x4 t[2][2];
#pragma unroll
                for (int m = 0; m < 2; ++m) { const bf16_t* bp = (const bf16_t*)base + (size_t)(u.arow + ai * HALF + wr * 64 + (mh * 2 + m) * 16 + fr) * DM + col0;
#pragma unroll
                    for (int bj = 0; bj < 2; ++bj) t[m][bj] = *(const u32x4*)(bp + bj * HALF); }
#pragma unroll
                for (int m = 0; m < 2; ++m)
#pragma unroll
                    for (int bj = 0; bj < 2; ++bj) { const u32x4 w = t[m][bj];
                        acc[ai][bj][mh * 2 + m][0] = acc[ai][bj][mh * 2 + m][0] * scale + (f32x4){bf_lo(w.x), bf_hi(w.x), bf_lo(w.y), bf_hi(w.y)};
                        acc[ai][bj][mh * 2 + m][1] = acc[ai][bj][mh * 2 + m][1] * scale + (f32x4){bf_lo(w.z), bf_hi(w.z), bf_lo(w.w), bf_hi(w.w)}; }
            }
#pragma unroll
            for (int m = 0; m < 2; ++m)
                asm volatile("" : "+v"(acc[ai][0][mh * 2 + m][0]), "+v"(acc[ai][0][mh * 2 + m][1]), "+v"(acc[ai][1][mh * 2 + m][0]), "+v"(acc[ai][1][mh * 2 + m][1]) :: "memory"); }
        u32x2 pk8s[2][2];
#pragma unroll
        for (int ai = 0; ai < 2; ++ai)
#pragma unroll
            for (int m = 0; m < 4; ++m) { const int rl = ai * HALF + wr * 64 + m * 16 + fr; const size_t off = (size_t)(u.arow + rl) * DM + col0; float ss = 0.f;
#pragma unroll
                for (int bj = 0; bj < 2; ++bj) { const f32x4 h0 = acc[ai][bj][m][0], h1 = acc[ai][bj][m][1];
                    ss += ((h0.x * h0.x + h0.y * h0.y) + (h0.z * h0.z + h0.w * h0.w)) + ((h1.x * h1.x + h1.y * h1.y) + (h1.z * h1.z + h1.w * h1.w));
                    u32x4 w; w.x = cvt_pk_bf16(h0.x, h0.y); w.y = cvt_pk_bf16(h0.z, h0.w); w.z = cvt_pk_bf16(h1.x, h1.y); w.w = cvt_pk_bf16(h1.z, h1.w);
                    *(u32x4*)(out + off + bj * HALF) = w;
                    if (H8OUT) { const float o8[8] = {h0.x, h0.y, h0.z, h0.w, h1.x, h1.y, h1.z, h1.w}; pk8s[m & 1][bj] = pk8_fp8(o8);
                        if (m & 1) { const int odd = fq & 1;
                            *(u32x4*)(h8 + (size_t)(u.arow + rl - 16 + 16 * odd) * DM + col0 - 8 * odd + bj * HALF) = widen16(pk8s[0][bj], pk8s[1][bj]); } } }
                ss += shx(ss, 16, lane); ss += shx(ss, 32, lane); if (fq == 0) part[wc * 256 + rl] = ss; }
        stat_combine(part, stat, u, u.col >> 8, wr, wc, fr, fq);
    }
};
__device__ __forceinline__ void rope_inv4(float (&inv)[4], int i0) {
#pragma unroll
    for (int k = 0; k < 4; ++k) inv[k] = __builtin_amdgcn_exp2f(-(float)(i0 + k) * (13.287712379549449f / 32.0f)) * 0.15915494309189535f;
}
__device__ __forceinline__ void rope8(f32x4& v0, f32x4& v1, float pos, const float (&inv)[4]) {
    float c[4], sn[4];
#pragma unroll
    for (int k = 0; k < 4; ++k) { float t = pos * inv[k]; t -= rintf(t); c[k] = __builtin_amdgcn_cosf(t); sn[k] = __builtin_amdgcn_sinf(t); }
    const float a0 = v0[0] * c[0] - v0[1] * sn[0], b0 = v0[1] * c[0] + v0[0] * sn[0];
    const float a1 = v0[2] * c[1] - v0[3] * sn[1], b1 = v0[3] * c[1] + v0[2] * sn[1];
    const float a2 = v1[0] * c[2] - v1[1] * sn[2], b2 = v1[1] * c[2] + v1[0] * sn[2];
    const float a3 = v1[2] * c[3] - v1[3] * sn[3], b3 = v1[3] * c[3] + v1[2] * sn[3];
    v0 = (f32x4){a0, b0, a1, b1}; v1 = (f32x4){a2, b2, a3, b3};
}
template <bool F8, bool QPRE = false> struct EpiQRope {
    static constexpr bool PERM = true; static constexpr int NST = F8 ? 8 : 16;
    __device__ __forceinline__ bool full(const Unit&) const { return true; }
    bf16_t* O; float oscale; const float* stat; float qpre;
    __device__ __forceinline__ void operator()(const f32x4 (&acc)[2][2][4][2], const Unit& u, int wr, int wc, int fr, int fq) const {
        const int col0 = u.col + wc * 32 + 8 * fq, odd = fq & 1;
        float rs[2][4];
        if (QPRE) { row_rstd8<1>(rs, stat, u.arow + wr * 64 + fr, 0, 1.f / 256.f);
#pragma unroll
            for (int ai = 0; ai < 2; ++ai)
#pragma unroll
                for (int m = 0; m < 4; ++m) rs[ai][m] *= qpre * oscale; }
#pragma unroll
        for (int bj = 0; bj < 2; ++bj) { const int c = col0 + bj * HALF, d = c % QKD; const bool isr = d >= 128; float inv[4]; rope_inv4(inv, isr ? ((d - 128) >> 1) : 0);
#pragma unroll
            for (int ai = 0; ai < 2; ++ai)
#pragma unroll
                for (int mp = 0; mp < 2; ++mp) { u32x2 pk[2];
#pragma unroll
                    for (int q = 0; q < 2; ++q) { const int m = 2 * mp + q, row = u.arow + ai * HALF + wr * 64 + m * 16 + fr; const float rsc = QPRE ? rs[ai][m] : oscale;
                        f32x4 v0 = acc[ai][bj][m][0] * rsc, v1 = acc[ai][bj][m][1] * rsc;
                        if (isr) rope8(v0, v1, (float)(row & (SEQ - 1)), inv);
                        if (F8) { const float o8[8] = {v0[0], v0[1], v0[2], v0[3], v1[0], v1[1], v1[2], v1[3]}; pk[q] = pk8_fp8(o8); }
                        else { u32x4 w; w.x = cvt_pk_bf16(v0[0], v0[1]); w.y = cvt_pk_bf16(v0[2], v0[3]); w.z = cvt_pk_bf16(v1[0], v1[1]); w.w = cvt_pk_bf16(v1[2], v1[3]);
                            *(u32x4*)(O + (size_t)row * NQ + c) = w; } }
                    if (F8) { const int row = u.arow + ai * HALF + wr * 64 + (2 * mp + odd) * 16 + fr;
                        *(u32x4*)((unsigned char*)O + (size_t)row * NQ + c - 8 * odd) = widen16(pk[0], pk[1]); } } }
    }
};
template <bool F8, bool F8UP = false> struct EpiDown {
    static constexpr bool PERM = true; static constexpr int NST = 0;
    __device__ __forceinline__ bool full(const Unit&) const { return false; }
    bf16_t* O; float* stat; LAS float* part; unsigned char* kr8; float oscale;
    __device__ __forceinline__ void operator()(const f32x4 (&acc)[2][2][4][2], const Unit& u, int wr, int wc, int fr, int fq) const {
        const int col0 = u.col + wc * 32 + 8 * fq, pn = u.col >> 8, lane = fq * 16 + fr;
        u32x2 pk8[2][2];
        if (pn < 2) {
#pragma unroll
            for (int ai = 0; ai < 2; ++ai)
#pragma unroll
                for (int m = 0; m < 4; ++m) { const int rl = ai * HALF + wr * 64 + m * 16 + fr; float ss = 0.f;
#pragma unroll
                    for (int bj = 0; bj < 2; ++bj) { const f32x4 v0 = acc[ai][bj][m][0] * oscale, v1 = acc[ai][bj][m][1] * oscale;
                        ss += ((v0.x * v0.x + v0.y * v0.y) + (v0.z * v0.z + v0.w * v0.w)) + ((v1.x * v1.x + v1.y * v1.y) + (v1.z * v1.z + v1.w * v1.w));
                        if (F8UP) { const float o8[8] = {v0[0], v0[1], v0[2], v0[3], v1[0], v1[1], v1[2], v1[3]}; pk8[m & 1][bj] = pk8_fp8(o8);
                            if (m & 1) { const int odd = fq & 1;
                                *(u32x4*)((unsigned char*)O + (size_t)(u.arow + rl - 16 + 16 * odd) * DOWNP + col0 - 8 * odd + bj * HALF) = widen16(pk8[0][bj], pk8[1][bj]); } }
                        else { u32x4 w; w.x = cvt_pk_bf16(v0[0], v0[1]); w.y = cvt_pk_bf16(v0[2], v0[3]); w.z = cvt_pk_bf16(v1[0], v1[1]); w.w = cvt_pk_bf16(v1[2], v1[3]);
                        *(u32x4*)(O + (size_t)(u.arow + rl) * DOWNP + col0 + bj * HALF) = w; } }
                    ss += shx(ss, 16, lane); ss += shx(ss, 32, lane); if (fq == 0) part[wc * 256 + rl] = ss; }
        } else if (wc < 2) {
            float inv[4]; rope_inv4(inv, wc * 16 + 4 * fq);
#pragma unroll
            for (int ai = 0; ai < 2; ++ai)
#pragma unroll
                for (int m = 0; m < 4; ++m) { const int row = u.arow + ai * HALF + wr * 64 + m * 16 + fr;
                    f32x4 v0 = acc[ai][0][m][0] * oscale, v1 = acc[ai][0][m][1] * oscale;
                    rope8(v0, v1, (float)(row & (SEQ - 1)), inv);
                    if (F8) { const float o8[8] = {v0[0], v0[1], v0[2], v0[3], v1[0], v1[1], v1[2], v1[3]}; *(u32x2*)(kr8 + (size_t)row * 64 + (col0 - 512)) = pk8_fp8(o8); }
                    else { u32x4 w; w.x = cvt_pk_bf16(v0[0], v0[1]); w.y = cvt_pk_bf16(v0[2], v0[3]); w.z = cvt_pk_bf16(v1[0], v1[1]); w.w = cvt_pk_bf16(v1[2], v1[3]);
                    *(u32x4*)(O + (size_t)row * DOWNP + col0) = w; } }
        }
        if (pn < 2) stat_combine(part, stat, u, pn, wr, wc, fr, fq);
        else { asm volatile("s_waitcnt lgkmcnt(0)" ::: "memory"); __builtin_amdgcn_s_barrier(); }
    }
};

template <class Epi, class Sched, bool ALIGN_EPI, bool FP8 = false>
__device__ __forceinline__ void gemm_phase(LAS unsigned char* lds, const Gemm g, const Sched& S, const Epi& E, const int wv) {
    const int tid = opaque_tid(wv), wid = __builtin_amdgcn_readfirstlane(tid >> 6), lane = tid & 63, wr = wid >> 2, wc = wid & 3, fr = lane & 15, fq = lane >> 4;
    const int K = g.K; int nt = K / BK; asm volatile("" : "+s"(nt));
    unsigned voffA[2], voffB[2];
#pragma unroll
    for (int i = 0; i < 2; ++i) { int R, C; stage_rc(tid * 16 + i * 8192, R, C); const int Rb = Epi::PERM ? ((R & ~31) + perm32(R & 31)) : R;
        voffA[i] = (unsigned)(R * g.lda + C) * 2u; voffB[i] = (unsigned)(Rb * g.ldb + C) * 2u; }
    const size_t kstep = (size_t)(BK * 2);
    const size_t hsA = (size_t)HALF * g.lda * 2, hsB = (size_t)HALF * g.ldb * 2;
    const unsigned ldsw = (unsigned)wid * 1024u, ldsb = (unsigned)(uintptr_t)lds;
    const int aoff = lds_byte(wr * 64 + fr, fq * 8), boff = lds_byte(wc * 32 + fr, fq * 8);
#define PG8_SA(b, h) (((b) * 2 + (h)) * HTB)
#define PG8_SB(b, h) ((4 + (b) * 2 + (h)) * HTB)
#define PG8_STAGE(bufoff, gbase, voff) do { _Pragma("unroll") for (int _i = 0; _i < 2; ++_i) \
        glds16_s((const char*)(gbase), (voff)[_i], ldsb + (unsigned)(bufoff) + ldsw + (unsigned)(_i * 8192)); } while (0)
#define PG8_LDA(dst, b, h) do { _Pragma("unroll") for (int m = 0; m < 4; ++m) _Pragma("unroll") for (int k = 0; k < 2; ++k) dst[m][k] = *(const LAS bf16x8*)(lds + PG8_SA(b, h) + aoff + m * 2048 + k * 1024); } while (0)
#define PG8_LDB(dst, b, h) do { _Pragma("unroll") for (int n = 0; n < 2; ++n) _Pragma("unroll") for (int k = 0; k < 2; ++k) dst[n][k] = *(const LAS bf16x8*)(lds + PG8_SB(b, h) + boff + n * 2048 + k * 1024); } while (0)
#define PG8_MMA(ai, bj, At, Bt) do { __builtin_amdgcn_s_setprio(1); _Pragma("unroll") for (int m = 0; m < 4; ++m) _Pragma("unroll") for (int n = 0; n < 2; ++n) { \
        if constexpr (FP8) { const i32x4 b0_ = __builtin_bit_cast(i32x4, Bt[n][0]), b1_ = __builtin_bit_cast(i32x4, Bt[n][1]), a0_ = __builtin_bit_cast(i32x4, At[m][0]), a1_ = __builtin_bit_cast(i32x4, At[m][1]); \
            acc[ai][bj][m][n] = __builtin_amdgcn_mfma_scale_f32_16x16x128_f8f6f4(__builtin_shufflevector(b0_, b1_, 0, 1, 2, 3, 4, 5, 6, 7), __builtin_shufflevector(a0_, a1_, 0, 1, 2, 3, 4, 5, 6, 7), acc[ai][bj][m][n], 0, 0, 0, 0x7F7F7F7F, 0, 0x7F7F7F7F); } \
        else { _Pragma("unroll") for (int k = 0; k < 2; ++k) acc[ai][bj][m][n] = __builtin_amdgcn_mfma_f32_16x16x32_bf16(Bt[n][k], At[m][k], acc[ai][bj][m][n], 0, 0, 0); } } \
        __builtin_amdgcn_s_setprio(0); } while (0)
#define PG8_WAIT_V(n) asm volatile("s_waitcnt vmcnt(" #n ")" ::: "memory")
#define PG8_WAIT_V8R(rx) asm volatile("s_cmp_eq_u32 %0, 0\n\ts_cbranch_scc1 .Lrxa%=\n\ts_waitcnt vmcnt(%1)\n\ts_branch .Lrxb%=\n.Lrxa%=:\n\ts_waitcnt vmcnt(8)\n.Lrxb%=:" :: "s"(__builtin_amdgcn_readfirstlane((int)(rx))), "n"(8 + Epi::NST) : "memory", "scc")
#define PG8_WAIT_L(n) asm volatile("s_waitcnt lgkmcnt(" #n ")" ::: "memory")
#define PG8_BAR __builtin_amdgcn_s_barrier()
#define PG8_SCHED __builtin_amdgcn_sched_barrier(0)
    Unit cur, nxt; int ui = 0; bool relax = false;
    if (!S.next(0, cur)) return;
    f32x4 acc[2][2][4][2];
#pragma unroll
    for (int a = 0; a < 2; ++a)
#pragma unroll
        for (int b = 0; b < 2; ++b)
#pragma unroll
            for (int m = 0; m < 4; ++m)
#pragma unroll
                for (int n = 0; n < 2; ++n) acc[a][b][m][n] = (f32x4){0.f, 0.f, 0.f, 0.f};
    bf16x8 At[4][2], B0[2][2], B1[2][2];
    const char* cA = (const char*)g.A + (size_t)cur.arow * g.lda * 2; const char* cB = (const char*)g.Bt + (size_t)cur.brow * g.ldb * 2;
    PG8_STAGE(PG8_SB(0, 0), cB, voffB); PG8_STAGE(PG8_SB(0, 1), cB + hsB, voffB); PG8_STAGE(PG8_SA(0, 0), cA, voffA); PG8_STAGE(PG8_SA(0, 1), cA + hsA, voffA);
    if (wr == 1) PG8_BAR;
    PG8_WAIT_V(2); PG8_BAR;
    PG8_STAGE(PG8_SB(1, 0), cB + kstep, voffB); PG8_STAGE(PG8_SA(1, 0), cA + kstep, voffA); PG8_STAGE(PG8_SB(1, 1), cB + hsB + kstep, voffB);
    PG8_WAIT_V(6); PG8_BAR;
    for (;;) {
        const bool has_next = S.next(ui + 1, nxt);
        const char* nA = has_next ? (const char*)g.A + (size_t)nxt.arow * g.lda * 2 : cA; const char* nB = has_next ? (const char*)g.Bt + (size_t)nxt.brow * g.ldb * 2 : cB;
        for (int t = 0; t < nt; t += 2) {
            const bool last = (t == nt - 2); const bool rx = relax && t == 0;
            const char* a1 = cA + (size_t)(t + 1) * kstep;
            const char* a2 = last ? nA : cA + (size_t)(t + 2) * kstep; const char* b2 = last ? nB : cB + (size_t)(t + 2) * kstep;
            const char* a3 = a2 + kstep; const char* b3 = b2 + kstep;
            PG8_LDB(B0, 0, 0); PG8_LDB(B1, 0, 1); PG8_SCHED; PG8_LDA(At, 0, 0); PG8_STAGE(PG8_SA(1, 1), a1 + hsA, voffA);
            PG8_WAIT_V8R(rx); PG8_WAIT_L(0); PG8_BAR; PG8_MMA(0, 0, At, B0); PG8_MMA(0, 1, At, B1); PG8_BAR; PG8_SCHED;
            PG8_LDA(At, 0, 1); PG8_STAGE(PG8_SB(0, 0), b2, voffB); PG8_STAGE(PG8_SB(0, 1), b2 + hsB, voffB); PG8_STAGE(PG8_SA(0, 0), a2, voffA);
            PG8_WAIT_V8R(rx); PG8_WAIT_L(0); PG8_BAR; PG8_MMA(1, 0, At, B0); PG8_MMA(1, 1, At, B1); PG8_BAR; PG8_SCHED;
            PG8_LDB(B0, 1, 0); PG8_LDB(B1, 1, 1); PG8_SCHED; PG8_LDA(At, 1, 0); PG8_STAGE(PG8_SA(0, 1), a2 + hsA, voffA);
            PG8_WAIT_V(8); PG8_WAIT_L(0); PG8_BAR; PG8_MMA(0, 0, At, B0); PG8_MMA(0, 1, At, B1); PG8_BAR; PG8_SCHED;
            PG8_LDA(At, 1, 1); PG8_STAGE(PG8_SB(1, 0), b3, voffB); PG8_STAGE(PG8_SB(1, 1), b3 + hsB, voffB); PG8_STAGE(PG8_SA(1, 0), a3, voffA);
            PG8_WAIT_V(8); PG8_WAIT_L(0); PG8_BAR; PG8_MMA(1, 0, At, B0); PG8_MMA(1, 1, At, B1); PG8_BAR; PG8_SCHED;
        }
        if constexpr (ALIGN_EPI) { if (wr == 0) PG8_BAR; }
        { const int l2 = opaque_lane(); E(acc, cur, wr, wc, l2 & 15, l2 >> 4); relax = Epi::NST > 0 && E.full(cur); }
        if (!has_next) break;
#pragma unroll
        for (int a = 0; a < 2; ++a)
#pragma unroll
            for (int b = 0; b < 2; ++b)
#pragma unroll
                for (int m = 0; m < 4; ++m)
#pragma unroll
                    for (int n = 0; n < 2; ++n) acc[a][b][m][n] = (f32x4){0.f, 0.f, 0.f, 0.f};
        cur = nxt; cA = nA; cB = nB; ++ui;
        if constexpr (ALIGN_EPI) { if (wr == 1) PG8_BAR; }
    }
    PG8_WAIT_V(0);
    if constexpr (!ALIGN_EPI) { if (wr == 0) PG8_BAR; }
    PG8_BAR;
#undef PG8_SA
#undef PG8_SB
#undef PG8_STAGE
#undef PG8_LDA
#undef PG8_LDB
#undef PG8_MMA
#undef PG8_WAIT_V
#undef PG8_WAIT_V8R
#undef PG8_WAIT_L
#undef PG8_BAR
#undef PG8_SCHED
}
}

__device__ __forceinline__ int crow(int r, int hi) { return (r & 3) + 8 * (r >> 2) + 4 * hi; }
__device__ __forceinline__ int v_rd_base(int lane) { return ((lane & 3) << 3) | (((lane >> 2) & 3) << 6) | (((lane >> 4) & 1) << 5) | (((lane >> 5) & 1) << 8); }
template <int NCB> __device__ __forceinline__ int v_st(int k, int c) { const int kk = (k & ~0xC) | ((k & 4) << 1) | ((k & 8) >> 1); return ((kk >> 3) * NCB + (c >> 5)) * 512 + ((kk & 7) * 32 + (c & 31)) * 2; }
template <int OFF> __device__ __forceinline__ s16x4 tr_read(int vb) {
    s16x4 r; asm volatile("ds_read_b64_tr_b16 %0, %1 offset:%2" : "=&v"(r) : "v"(vb), "i"(OFF) : "memory"); return r;
}
template <int D0, int NCB> __device__ __forceinline__ void pv_one(f32x16& od, int vb, bf16x8 pa0, bf16x8 pa1, bf16x8 pa2, bf16x8 pa3) {
    constexpr int KS = NCB * 1024, HF = NCB * 512;
    const s16x4 l0 = tr_read<D0 * 512 + 0 * KS>(vb), h0 = tr_read<D0 * 512 + 0 * KS + HF>(vb), l1 = tr_read<D0 * 512 + 1 * KS>(vb), h1 = tr_read<D0 * 512 + 1 * KS + HF>(vb);
    const s16x4 l2 = tr_read<D0 * 512 + 2 * KS>(vb), h2 = tr_read<D0 * 512 + 2 * KS + HF>(vb), l3 = tr_read<D0 * 512 + 3 * KS>(vb), h3 = tr_read<D0 * 512 + 3 * KS + HF>(vb);
    asm volatile("s_waitcnt lgkmcnt(0)" ::: "memory"); SBAR();
#define PK(L, H) (bf16x8){L[0], L[1], L[2], L[3], H[0], H[1], H[2], H[3]}
    od = __builtin_amdgcn_mfma_f32_32x32x16_bf16(pa0, PK(l0, h0), od, 0, 0, 0);
    od = __builtin_amdgcn_mfma_f32_32x32x16_bf16(pa1, PK(l1, h1), od, 0, 0, 0);
    od = __builtin_amdgcn_mfma_f32_32x32x16_bf16(pa2, PK(l2, h2), od, 0, 0, 0);
    od = __builtin_amdgcn_mfma_f32_32x32x16_bf16(pa3, PK(l3, h3), od, 0, 0, 0);
#undef PK
}
#define PK4(P, BASE, OUT) do { unsigned a0 = cvt_pk_bf16(P[BASE + 0], P[BASE + 1]), a1 = cvt_pk_bf16(P[BASE + 2], P[BASE + 3]);   \
    unsigned b0 = cvt_pk_bf16(P[BASE + 4], P[BASE + 5]), b1 = cvt_pk_bf16(P[BASE + 6], P[BASE + 7]);                              \
    auto r0 = __builtin_amdgcn_permlane32_swap(a0, b0, false, false); auto r1 = __builtin_amdgcn_permlane32_swap(a1, b1, false, false); \
    u32x4 w = {r0[0], r1[0], r0[1], r1[1]}; OUT = __builtin_bit_cast(bf16x8, w); } while (0)

namespace mla {
constexpr int NW = 8, QBLK = 32, KVBLK = 64;
constexpr int KN_B = KVBLK * 256, KR_B = KVBLK * 128, V_B = KVBLK * 256, SLOT = KN_B + KR_B + V_B  , NSLOT = 3;
constexpr int OFF_WS = NSLOT * SLOT  , OFF_END = OFF_WS + NW * 64 * 4;
static_assert(OFF_END <= RING_BYTES, "mla lds");
constexpr int OSTR = 272;
static_assert(NW * 32 * OSTR <= OFF_WS, "O staging aliases the ring");
constexpr float SCALE = 0.07216878364870323f;
constexpr float THR = 8.f;
constexpr int LDQ = NQ, LDKV = NKV, LDR = DOWNP, LDO = DM;

__device__ __forceinline__ void partialSM(f32x16& p0, f32x16& p1, float& m_reg, float& mn, float& alpha, const float C) {
    float pmax = p0[0];
#pragma unroll
    for (int r = 1; r < 16; ++r) pmax = fmaxf(pmax, p0[r]);
#pragma unroll
    for (int r = 0; r < 16; ++r) pmax = fmaxf(pmax, p1[r]);
    { auto rr = __builtin_amdgcn_permlane32_swap(__float_as_uint(pmax), __float_as_uint(pmax), false, false);
      pmax = fmaxf(__uint_as_float(rr[0]), __uint_as_float(rr[1])); }
    if (__builtin_expect(__all((pmax - m_reg) * C <= THR * LOG2E), 1)) { mn = m_reg; alpha = 1.f; }
    else { mn = fmaxf(m_reg, pmax); alpha = __builtin_amdgcn_exp2f((m_reg - mn) * C); m_reg = mn; }
    const float mnC = -mn * C;
#pragma unroll
    for (int r = 0; r < 16; ++r) p0[r] = fmaf(p0[r], C, mnC);
#pragma unroll
    for (int r = 0; r < 16; ++r) p1[r] = fmaf(p1[r], C, mnC);
#pragma unroll
    for (int r = 0; r < 16; ++r) p0[r] = __builtin_amdgcn_exp2f(p0[r]);
}
__device__ __forceinline__ void finishSM(f32x16& p0, f32x16& p1, float alpha, float& l_reg, bf16x8& pa0, bf16x8& pa1, bf16x8& pa2, bf16x8& pa3) {
#pragma unroll
    for (int r = 0; r < 16; ++r) p1[r] = __builtin_amdgcn_exp2f(p1[r]);
    float ps = 0;
#pragma unroll
    for (int r = 0; r < 16; ++r) ps += p0[r];
#pragma unroll
    for (int r = 0; r < 16; ++r) ps += p1[r];
    { auto rr = __builtin_amdgcn_permlane32_swap(__float_as_uint(ps), __float_as_uint(ps), false, false);
      ps = __uint_as_float(rr[0]) + __uint_as_float(rr[1]); }
    l_reg = l_reg * alpha + ps;
    PK4(p0, 0, pa0); PK4(p0, 8, pa1); PK4(p1, 0, pa2); PK4(p1, 8, pa3);
}
__device__ __forceinline__ void qkt(f32x16& p0, f32x16& p1, const LAS unsigned char* slot, const bf16x8* qr, int r32, int hi) {
    p0 = f32x16{}; p1 = f32x16{};
    const LAS unsigned char* kn = slot + r32 * 256; const int xn = (r32 & 7) << 4;
    const LAS unsigned char* kr = slot + KN_B + r32 * 128; const int xr = ((r32 >> 1) & 7) << 4;
    bf16x8 f0[3], f1[3];
#define MLA_LDK(d0) do { if ((d0) < 8) { const int cb_ = (((d0) * 16 + hi * 8) * 2) ^ xn; f0[(d0) % 3] = *(const LAS bf16x8*)(kn + cb_); f1[(d0) % 3] = *(const LAS bf16x8*)(kn + 32 * 256 + cb_); } \
        else { const int cb_ = ((((d0) - 8) * 2 + hi) * 16) ^ xr; f0[(d0) % 3] = *(const LAS bf16x8*)(kr + cb_); f1[(d0) % 3] = *(const LAS bf16x8*)(kr + 32 * 128 + cb_); } } while (0)
    MLA_LDK(0); MLA_LDK(1);
#pragma unroll
    for (int d0 = 0; d0 < 12; ++d0) {
        if (d0 + 2 < 12) MLA_LDK(d0 + 2);
        SBAR();
        p0 = __builtin_amdgcn_mfma_f32_32x32x16_bf16(f0[d0 % 3], qr[d0], p0, 0, 0, 0);
        p1 = __builtin_amdgcn_mfma_f32_32x32x16_bf16(f1[d0 % 3], qr[d0], p1, 0, 0, 0);
        SBAR();
    }
#undef MLA_LDK
}
__device__ __forceinline__ void pv_all(f32x16* o, int vb, bf16x8 pa0, bf16x8 pa1, bf16x8 pa2, bf16x8 pa3) {
    s16x4 la[4], ha[4], lb[4], hb[4];
#define PV_RD(L, H, ks) do { L[0] = tr_read<0 * 512 + (ks) * 4096>(vb); H[0] = tr_read<0 * 512 + (ks) * 4096 + 2048>(vb); L[1] = tr_read<1 * 512 + (ks) * 4096>(vb); H[1] = tr_read<1 * 512 + (ks) * 4096 + 2048>(vb); \
        L[2] = tr_read<2 * 512 + (ks) * 4096>(vb); H[2] = tr_read<2 * 512 + (ks) * 4096 + 2048>(vb); L[3] = tr_read<3 * 512 + (ks) * 4096>(vb); H[3] = tr_read<3 * 512 + (ks) * 4096 + 2048>(vb); } while (0)
#define PV_PK(L, H) (bf16x8){L[0], L[1], L[2], L[3], H[0], H[1], H[2], H[3]}
#define PV_MM(L, H, pa) do { _Pragma("unroll") for (int d = 0; d < 4; ++d) o[d] = __builtin_amdgcn_mfma_f32_32x32x16_bf16(pa, PV_PK(L[d], H[d]), o[d], 0, 0, 0); } while (0)
    PV_RD(la, ha, 0); PV_RD(lb, hb, 1);
    asm volatile("s_waitcnt lgkmcnt(8)" ::: "memory"); SBAR(); PV_MM(la, ha, pa0); SBAR();
    PV_RD(la, ha, 2);
    asm volatile("s_waitcnt lgkmcnt(8)" ::: "memory"); SBAR(); PV_MM(lb, hb, pa1); SBAR();
    PV_RD(lb, hb, 3);
    asm volatile("s_waitcnt lgkmcnt(8)" ::: "memory"); SBAR(); PV_MM(la, ha, pa2); SBAR();
    asm volatile("s_waitcnt lgkmcnt(0)" ::: "memory"); SBAR(); PV_MM(lb, hb, pa3); SBAR();
#undef PV_RD
#undef PV_PK
#undef PV_MM
}
#define MLA_BAR() asm volatile("s_waitcnt vmcnt(0) lgkmcnt(0)\n\ts_barrier" ::: "memory")
template <bool O8> __device__ __forceinline__ void unit(int b, int h, int qb, const bf16_t* __restrict__ Q, const bf16_t* __restrict__ KV, const bf16_t* __restrict__ DN, const float* __restrict__ stat, bf16_t* __restrict__ O, LAS unsigned char* lds, const int wv) {
    const int tid = opaque_tid(wv), wid = __builtin_amdgcn_readfirstlane(tid >> 6), lane = tid & 63, r32 = lane & 31, hi = lane >> 5;
    const size_t tok0 = (size_t)b * SEQ;
    const bf16_t* Qb = Q + (tok0 + (size_t)qb * 256) * LDQ + h * QKD;
    const char* Kn = (const char*)(KV + tok0 * LDKV + h * 128);
    const char* Vh = (const char*)(KV + tok0 * LDKV + 1024 + h * 128);
    const char* Kr = (const char*)(DN + tok0 * LDR + 512);
    LAS float* ws = (LAS float*)(lds + OFF_WS) + wid * 64; LAS float* li_l = ws; LAS float* al_l = ws + 32;
    const unsigned ldsb = (unsigned)(uintptr_t)lds;
    unsigned vkn[2], vv[2], vkr;
#pragma unroll
    for (int i = 0; i < 2; ++i) { const int L = (wid * 2 + i) * 64 + lane; { const int row = L >> 4, c16 = (L & 15) ^ (row & 7); vkn[i] = (unsigned)(row * (LDKV * 2) + c16 * 16); }
        { const int st = L >> 5, w = L & 31, kk = (st >> 2) * 8 + (w >> 2), k = (kk & ~0xC) | ((kk & 4) << 1) | ((kk & 8) >> 1), c = (st & 3) * 32 + (w & 3) * 8; vv[i] = (unsigned)(k * (LDKV * 2) + c * 2); } }
    { const int L = wid * 64 + lane, row = L >> 3, c16 = (L & 7) ^ ((row >> 1) & 7); vkr = (unsigned)(row * (LDR * 2) + c16 * 16); }
#define MLA_ISSUE(t, sl) do { const size_t ko_ = (size_t)(t) * KVBLK; const unsigned sb_ = ldsb + (unsigned)(sl) * SLOT + (unsigned)wid * 2048u; \
        glds16_s(Kn + ko_ * (LDKV * 2), vkn[0], sb_); glds16_s(Kn + ko_ * (LDKV * 2), vkn[1], sb_ + 1024u); \
        glds16_s(Kr + ko_ * (LDR * 2), vkr, ldsb + (unsigned)(sl) * SLOT + KN_B + (unsigned)wid * 1024u); \
        glds16_s(Vh + ko_ * (LDKV * 2), vv[0], sb_ + KN_B + KR_B); glds16_s(Vh + ko_ * (LDKV * 2), vv[1], sb_ + KN_B + KR_B + 1024u); } while (0)
    MLA_ISSUE(0, 0); MLA_ISSUE(1, 1);
    float m_reg = -1e30f, l_reg = 0; f32x16 o[4] = {}; bf16x8 qr[12];
    const float Cq = SCALE * LOG2E * __builtin_amdgcn_rsqf(stat[(tok0 + (size_t)qb * 256 + wid * QBLK + r32) * 4] * (1.f / 256.f) + EPS);
    const bf16_t* Qw = Qb + (size_t)(wid * QBLK + r32) * LDQ + hi * 8;
#pragma unroll
    for (int d0 = 0; d0 < 12; ++d0) qr[d0] = *(const bf16x8*)(Qw + d0 * 16);
    const int vb0 = (int)ldsb + KN_B + KR_B + v_rd_base(lane);
#define RESC(a) do { if (__any((a) < 1.f)) { if (hi == 0) al_l[r32] = (a); asm volatile("s_waitcnt lgkmcnt(0)" ::: "memory"); \
    _Pragma("unroll") for (int d = 0; d < 4; ++d) _Pragma("unroll") for (int r = 0; r < 16; ++r) o[d][r] *= al_l[crow(r, hi)]; } } while (0)
    f32x16 p0, p1; float mn, al; bf16x8 pa0, pa1, pa2, pa3; constexpr int NT = SEQ / KVBLK;
    MLA_BAR();
#define MLA_BARC(j) asm volatile("s_cmp_lt_i32 %0, %1\n\ts_cbranch_scc1 .Lmb%=\n\ts_waitcnt vmcnt(0)\n\ts_branch .Lme%=\n.Lmb%=:\n\ts_waitcnt vmcnt(5)\n.Lme%=:\n\ts_waitcnt lgkmcnt(0)\n\ts_barrier" :: "s"(__builtin_amdgcn_readfirstlane((j) + 2)), "n"(SEQ / KVBLK) : "memory", "scc")
    const bool halfB = wid >= 4;
    if (halfB) { MLA_BARC(0); MLA_ISSUE(2, 2); }
    int sj = 0;
    for (int j = 0; j < NT; ++j) {
        const int s1 = sj == 2 ? 0 : sj + 1, s2 = s1 == 2 ? 0 : s1 + 1;
        qkt(p0, p1, lds + sj * SLOT, qr, r32, hi);
        MLA_BARC(j);
        if (!halfB && j + 2 < NT) MLA_ISSUE(j + 2, s2);
        partialSM(p0, p1, m_reg, mn, al, Cq); RESC(al);
        finishSM(p0, p1, al, l_reg, pa0, pa1, pa2, pa3); SBAR();
        pv_all(o, vb0 + sj * SLOT, pa0, pa1, pa2, pa3);
        MLA_BARC(j);
        if (halfB && j + 3 < NT) MLA_ISSUE(j + 3, sj);
        sj = s1;
    }
    if (!halfB) MLA_BARC(NT);
#undef MLA_BARC
    if (hi == 0) li_l[r32] = l_reg; asm volatile("s_waitcnt lgkmcnt(0)" ::: "memory");
    float rli[16];
#pragma unroll
    for (int r = 0; r < 16; ++r) rli[r] = __builtin_amdgcn_rcpf(li_l[crow(r, hi)]);
    MLA_BAR();
    LAS unsigned char* ost = lds + wid * (32 * OSTR);
    if constexpr (O8) {
#pragma unroll
        for (int r = 0; r < 16; ++r) { const int orow = crow(r, hi);
#pragma unroll
            for (int d0 = 0; d0 < 4; ++d0) *(LAS unsigned char*)(ost + orow * 144 + d0 * 32 + r32) = (unsigned char)fp8_1(o[d0][r] * rli[r] * O8_SCALE); }
        asm volatile("s_waitcnt lgkmcnt(0)" ::: "memory");
        unsigned char* Ow = (unsigned char*)O + (tok0 + (size_t)qb * 256 + wid * QBLK) * LDO + h * 128;
#pragma unroll
        for (int it = 0; it < 4; ++it) { const int ch = it * 64 + lane, row = ch >> 3, c16 = ch & 7;
            const u32x4 v = *(const LAS u32x4*)(ost + row * 144 + c16 * 16); *(u32x4*)(Ow + (size_t)row * LDO + c16 * 16) = v; }
    } else {
#pragma unroll
    for (int r = 0; r < 16; ++r) { const int orow = crow(r, hi);
#pragma unroll
        for (int d0 = 0; d0 < 4; ++d0) *(LAS unsigned short*)(ost + orow * OSTR + (d0 * 32 + r32) * 2) = (unsigned short)f2bf(o[d0][r] * rli[r]); }
    asm volatile("s_waitcnt lgkmcnt(0)" ::: "memory");
    bf16_t* Ow = O + (tok0 + (size_t)qb * 256 + wid * QBLK) * LDO + h * 128;
#pragma unroll
    for (int it = 0; it < 8; ++it) { const int ch = it * 64 + lane, row = ch >> 4, c16 = ch & 15;
        const u32x4 v = *(const LAS u32x4*)(ost + row * OSTR + c16 * 16); *(u32x4*)(Ow + (size_t)row * LDO + c16 * 8) = v; }
    }
    MLA_BAR();
#undef MLA_ISSUE
#undef RESC
}
#undef MLA_BAR
}

namespace mla8 {
using mla::partialSM; using mla::finishSM; using mla::pv_all;
constexpr int NW = 8, QBLK = 32, KVBLK = 64;
constexpr int KN_B = KVBLK * 128, KR_B = KVBLK * 64, V_B = KVBLK * 256, SLOT = KN_B + KR_B + V_B  , NSLOT = 3;
constexpr int OFF_WS = 3 * 40960, OSTR = 272;
static_assert(NSLOT * SLOT <= OFF_WS && OFF_WS + NW * 64 * 4 <= RING_BYTES && NW * 32 * OSTR <= OFF_WS, "mla8 lds");
constexpr float SCALE = 0.07216878364870323f;
constexpr int LDKV = NKV, LDO = DM;
__device__ __forceinline__ i32x8 cat8(bf16x8 a, bf16x8 b) { return __builtin_shufflevector(__builtin_bit_cast(i32x4, a), __builtin_bit_cast(i32x4, b), 0, 1, 2, 3, 4, 5, 6, 7); }
__device__ __forceinline__ void qkt(f32x16& p0, f32x16& p1, const LAS unsigned char* slot, const i32x8* qr, int r32, int hi) {
    p0 = f32x16{}; p1 = f32x16{};
    const LAS unsigned char* kn = slot + r32 * 128; const int xn = ((r32 >> 1) & 7) << 4;
    const LAS unsigned char* kr = slot + KN_B + r32 * 64; const int xr = ((r32 >> 2) & 3) << 4;
    bf16x8 a0[3], a1[3], b0[3], b1[3];
#pragma unroll
    for (int s = 0; s < 2; ++s) { const int c0 = ((s * 4 + hi * 2) * 16) ^ xn, c1 = ((s * 4 + hi * 2 + 1) * 16) ^ xn;
        a0[s] = *(const LAS bf16x8*)(kn + c0); a1[s] = *(const LAS bf16x8*)(kn + c1); b0[s] = *(const LAS bf16x8*)(kn + 32 * 128 + c0); b1[s] = *(const LAS bf16x8*)(kn + 32 * 128 + c1); }
    { const int c0 = ((hi * 2) * 16) ^ xr, c1 = ((hi * 2 + 1) * 16) ^ xr;
        a0[2] = *(const LAS bf16x8*)(kr + c0); a1[2] = *(const LAS bf16x8*)(kr + c1); b0[2] = *(const LAS bf16x8*)(kr + 32 * 64 + c0); b1[2] = *(const LAS bf16x8*)(kr + 32 * 64 + c1); }
#pragma unroll
    for (int s = 0; s < 3; ++s) {
        p0 = __builtin_amdgcn_mfma_scale_f32_32x32x64_f8f6f4(cat8(a0[s], a1[s]), qr[s], p0, 0, 0, 0, 0x7F7F7F7F, 0, 0x7F7F7F7F);
        p1 = __builtin_amdgcn_mfma_scale_f32_32x32x64_f8f6f4(cat8(b0[s], b1[s]), qr[s], p1, 0, 0, 0, 0x7F7F7F7F, 0, 0x7F7F7F7F); }
}
#define MLA_BAR() asm volatile("s_waitcnt vmcnt(0) lgkmcnt(0)\n\ts_barrier" ::: "memory")
template <bool O8> __device__ __forceinline__ void unit(int b, int h, int qb, const unsigned char* __restrict__ Q8, const unsigned char* __restrict__ K8, const unsigned char* __restrict__ KR8, const bf16_t* __restrict__ KV, const float* __restrict__ stat, bf16_t* __restrict__ O, LAS unsigned char* lds, const int wv) {
    const int tid = opaque_tid(wv), wid = __builtin_amdgcn_readfirstlane(tid >> 6), lane = tid & 63, r32 = lane & 31, hi = lane >> 5;
    const size_t tok0 = (size_t)b * SEQ;
    const char* Kn = (const char*)(K8 + tok0 * 1024 + h * 128);
    const char* Kr = (const char*)(KR8 + tok0 * 64);
    const char* Vh = (const char*)(KV + tok0 * LDKV + 1024 + h * 128);
    LAS float* ws = (LAS float*)(lds + OFF_WS) + wid * 64; LAS float* li_l = ws; LAS float* al_l = ws + 32;
    const unsigned ldsb = (unsigned)(uintptr_t)lds;
    unsigned vkn, vkr, vv[2];
    { const int L = wid * 64 + lane, row = L >> 3, c16 = (L & 7) ^ ((row >> 1) & 7); vkn = (unsigned)(row * 1024 + c16 * 16); }
    { const int L = (wid & 3) * 64 + lane, row = L >> 2, c16 = (L & 3) ^ ((row >> 2) & 3); vkr = (unsigned)(row * 64 + c16 * 16); }
#pragma unroll
    for (int i = 0; i < 2; ++i) { const int L = (wid * 2 + i) * 64 + lane; const int st = L >> 5, w = L & 31, kk = (st >> 2) * 8 + (w >> 2), k = (kk & ~0xC) | ((kk & 4) << 1) | ((kk & 8) >> 1), c = (st & 3) * 32 + (w & 3) * 8; vv[i] = (unsigned)(k * (LDKV * 2) + c * 2); }
#define MLA_ISSUE(t, sl) do { const size_t ko_ = (size_t)(t) * KVBLK; const unsigned sb_ = ldsb + (unsigned)(sl) * SLOT; \
        glds16_s(Kn + ko_ * 1024, vkn, sb_ + (unsigned)wid * 1024u); glds16_s(Kr + ko_ * 64, vkr, sb_ + KN_B + (unsigned)(wid & 3) * 1024u); \
        glds16_s(Vh + ko_ * (LDKV * 2), vv[0], sb_ + KN_B + KR_B + (unsigned)wid * 2048u); glds16_s(Vh + ko_ * (LDKV * 2), vv[1], sb_ + KN_B + KR_B + (unsigned)wid * 2048u + 1024u); } while (0)
    MLA_ISSUE(0, 0); MLA_ISSUE(1, 1);
    float m_reg = -1e30f, l_reg = 0; f32x16 o[4] = {}; i32x8 qr[3];
    const float Cq = SCALE * LOG2E * __builtin_amdgcn_rsqf(stat[(tok0 + (size_t)qb * 256 + wid * QBLK + r32) * 4] * (1.f / 256.f) + EPS);
    { const unsigned char* Qw = Q8 + (tok0 + (size_t)qb * 256 + wid * QBLK + r32) * NQ + h * QKD + hi * 32;
#pragma unroll
      for (int s = 0; s < 3; ++s) qr[s] = cat8(*(const bf16x8*)(Qw + s * 64), *(const bf16x8*)(Qw + s * 64 + 16)); }
    const int vb0 = (int)ldsb + KN_B + KR_B + v_rd_base(lane);
#define RESC(a) do { if (__any((a) < 1.f)) { if (hi == 0) al_l[r32] = (a); asm volatile("s_waitcnt lgkmcnt(0)" ::: "memory"); \
    _Pragma("unroll") for (int d = 0; d < 4; ++d) _Pragma("unroll") for (int r = 0; r < 16; ++r) o[d][r] *= al_l[crow(r, hi)]; } } while (0)
    f32x16 p0, p1; float mn, al; bf16x8 pa0, pa1, pa2, pa3; constexpr int NT = SEQ / KVBLK;
    MLA_BAR();
#define MLA_BARC(j) asm volatile("s_cmp_lt_i32 %0, %1\n\ts_cbranch_scc1 .Lnb%=\n\ts_waitcnt vmcnt(0)\n\ts_branch .Lne%=\n.Lnb%=:\n\ts_waitcnt vmcnt(4)\n.Lne%=:\n\ts_waitcnt lgkmcnt(0)\n\ts_barrier" :: "s"(__builtin_amdgcn_readfirstlane((j) + 2)), "n"(SEQ / KVBLK) : "memory", "scc")
    const bool halfB = wid >= 4;
    if (halfB) { MLA_BARC(0); MLA_ISSUE(2, 2); }
    int sj = 0;
    for (int j = 0; j < NT; ++j) {
        const int s1 = sj == 2 ? 0 : sj + 1, s2 = s1 == 2 ? 0 : s1 + 1;
        qkt(p0, p1, lds + sj * SLOT, qr, r32, hi);
        MLA_BARC(j);
        if (!halfB && j + 2 < NT) MLA_ISSUE(j + 2, s2);
        partialSM(p0, p1, m_reg, mn, al, Cq); RESC(al);
        finishSM(p0, p1, al, l_reg, pa0, pa1, pa2, pa3); SBAR();
        pv_all(o, vb0 + sj * SLOT, pa0, pa1, pa2, pa3);
        MLA_BARC(j);
        if (halfB && j + 3 < NT) MLA_ISSUE(j + 3, sj);
        sj = s1;
    }
    if (!halfB) MLA_BARC(NT);
#undef MLA_BARC
    if (hi == 0) li_l[r32] = l_reg; asm volatile("s_waitcnt lgkmcnt(0)" ::: "memory");
    float rli[16];
#pragma unroll
    for (int r = 0; r < 16; ++r) rli[r] = __builtin_amdgcn_rcpf(li_l[crow(r, hi)]);
    MLA_BAR();
    LAS unsigned char* ost = lds + wid * (32 * OSTR);
    if constexpr (O8) {
#pragma unroll
        for (int r = 0; r < 16; ++r) { const int orow = crow(r, hi);
#pragma unroll
            for (int d0 = 0; d0 < 4; ++d0) *(LAS unsigned char*)(ost + orow * 144 + d0 * 32 + r32) = (unsigned char)fp8_1(o[d0][r] * rli[r] * O8_SCALE); }
        asm volatile("s_waitcnt lgkmcnt(0)" ::: "memory");
        unsigned char* Ow = (unsigned char*)O + (tok0 + (size_t)qb * 256 + wid * QBLK) * LDO + h * 128;
#pragma unroll
        for (int it = 0; it < 4; ++it) { const int ch = it * 64 + lane, row = ch >> 3, c16 = ch & 7;
            const u32x4 v = *(const LAS u32x4*)(ost + row * 144 + c16 * 16); *(u32x4*)(Ow + (size_t)row * LDO + c16 * 16) = v; }
    } else {
#pragma unroll
        for (int r = 0; r < 16; ++r) { const int orow = crow(r, hi);
#pragma unroll
            for (int d0 = 0; d0 < 4; ++d0) *(LAS unsigned short*)(ost + orow * OSTR + (d0 * 32 + r32) * 2) = (unsigned short)f2bf(o[d0][r] * rli[r]); }
        asm volatile("s_waitcnt lgkmcnt(0)" ::: "memory");
        bf16_t* Ow = O + (tok0 + (size_t)qb * 256 + wid * QBLK) * LDO + h * 128;
#pragma unroll
        for (int it = 0; it < 8; ++it) { const int ch = it * 64 + lane, row = ch >> 4, c16 = ch & 15;
            const u32x4 v = *(const LAS u32x4*)(ost + row * OSTR + c16 * 16); *(u32x4*)(Ow + (size_t)row * LDO + c16 * 8) = v; }
    }
    MLA_BAR();
#undef MLA_ISSUE
#undef RESC
}
#undef MLA_BAR
}

namespace mla9 {
using mla8::cat8;
constexpr float QPRE = 0.07216878364870323f * LOG2E * 8.0f;
constexpr int NW = 8, QBLK = 32, KVBLK = 64;
constexpr int KN_B = mla8::KN_B, KR_B = mla8::KR_B, V_B = 128 * 64, SLOT = KN_B + KR_B + V_B  , NSLOT = 3;
constexpr int OFF_WS = 3 * 40960, OSTR = 272;
static_assert(NSLOT * SLOT <= OFF_WS && OFF_WS + NW * 64 * 4 <= RING_BYTES && NW * 32 * OSTR <= OFF_WS, "mla9 lds");
constexpr float SCALE = 0.07216878364870323f, THR = 6.f;
constexpr int LDO = DM;
__device__ __forceinline__ void qkt(f32x16& p0, f32x16& p1, const f32x16& negm, const LAS unsigned char* slot, const i32x8* qr, int r32, int hi) {
    const LAS unsigned char* kn = slot + r32 * 128; const int xn = ((r32 >> 1) & 7) << 4;
    const LAS unsigned char* kr = slot + KN_B + r32 * 64; const int xr = ((r32 >> 2) & 3) << 4;
    bf16x8 a0[3], a1[3], b0[3], b1[3];
#pragma unroll
    for (int s = 0; s < 2; ++s) { const int c0 = ((s * 4 + hi * 2) * 16) ^ xn, c1 = ((s * 4 + hi * 2 + 1) * 16) ^ xn;
        a0[s] = *(const LAS bf16x8*)(kn + c0); a1[s] = *(const LAS bf16x8*)(kn + c1); b0[s] = *(const LAS bf16x8*)(kn + 32 * 128 + c0); b1[s] = *(const LAS bf16x8*)(kn + 32 * 128 + c1); }
    { const int c0 = ((hi * 2) * 16) ^ xr, c1 = ((hi * 2 + 1) * 16) ^ xr;
        a0[2] = *(const LAS bf16x8*)(kr + c0); a1[2] = *(const LAS bf16x8*)(kr + c1); b0[2] = *(const LAS bf16x8*)(kr + 32 * 64 + c0); b1[2] = *(const LAS bf16x8*)(kr + 32 * 64 + c1); }
    p0 = __builtin_amdgcn_mfma_scale_f32_32x32x64_f8f6f4(cat8(a0[0], a1[0]), qr[0], negm, 0, 0, 0, 0x7F7F7F7F, 0, 0x7C7C7C7C);
    p1 = __builtin_amdgcn_mfma_scale_f32_32x32x64_f8f6f4(cat8(b0[0], b1[0]), qr[0], negm, 0, 0, 0, 0x7F7F7F7F, 0, 0x7C7C7C7C);
#pragma unroll
    for (int s = 1; s < 3; ++s) {
        p0 = __builtin_amdgcn_mfma_scale_f32_32x32x64_f8f6f4(cat8(a0[s], a1[s]), qr[s], p0, 0, 0, 0, 0x7F7F7F7F, 0, 0x7C7C7C7C);
        p1 = __builtin_amdgcn_mfma_scale_f32_32x32x64_f8f6f4(cat8(b0[s], b1[s]), qr[s], p1, 0, 0, 0, 0x7F7F7F7F, 0, 0x7C7C7C7C); }
}
__device__ __forceinline__ void partialSM(f32x16& p0, f32x16& p1, f32x16& negm, float& alpha, const bool first) {
    float pmax = p0[0];
#pragma unroll
    for (int r = 1; r < 16; ++r) pmax = fmaxf(pmax, p0[r]);
#pragma unroll
    for (int r = 0; r < 16; ++r) pmax = fmaxf(pmax, p1[r]);
    { auto rr = __builtin_amdgcn_permlane32_swap(__float_as_uint(pmax), __float_as_uint(pmax), false, false);
      pmax = fmaxf(__uint_as_float(rr[0]), __uint_as_float(rr[1])); }
    if (__builtin_expect(!first && __all(pmax <= THR * LOG2E), 1)) { alpha = 1.f; }
    else { const float delta = first ? pmax : fmaxf(pmax, 0.f); alpha = first ? 1.f : __builtin_amdgcn_exp2f(-delta);
#pragma unroll
        for (int r = 0; r < 16; ++r) { p0[r] -= delta; p1[r] -= delta; negm[r] -= delta; } }
#pragma unroll
    for (int r = 0; r < 16; ++r) p0[r] = __builtin_amdgcn_exp2f(p0[r]);
}
__device__ __forceinline__ void finishSM(f32x16& p0, f32x16& p1, i32x8& p8) {
#pragma unroll
    for (int r = 0; r < 16; ++r) p1[r] = __builtin_amdgcn_exp2f(p1[r]);
#pragma unroll
    for (int j = 0; j < 4; ++j) { int w = p8[j]; w = __builtin_amdgcn_cvt_pk_fp8_f32(p0[4 * j], p0[4 * j + 1], w, false); w = __builtin_amdgcn_cvt_pk_fp8_f32(p0[4 * j + 2], p0[4 * j + 3], w, true); p8[j] = w;
        int x = p8[4 + j]; x = __builtin_amdgcn_cvt_pk_fp8_f32(p1[4 * j], p1[4 * j + 1], x, false); x = __builtin_amdgcn_cvt_pk_fp8_f32(p1[4 * j + 2], p1[4 * j + 3], x, true); p8[4 + j] = x; }
}
__device__ __forceinline__ void pv_all(f32x16* o, const LAS unsigned char* vs, int c0, int c1, const i32x8& p8) {
    bf16x8 a[4], b[4];
#pragma unroll
    for (int d0 = 0; d0 < 4; ++d0) { a[d0] = *(const LAS bf16x8*)(vs + d0 * 2048 + c0); b[d0] = *(const LAS bf16x8*)(vs + d0 * 2048 + c1); }
#pragma unroll
    for (int d0 = 0; d0 < 4; ++d0) o[d0] = __builtin_amdgcn_mfma_scale_f32_32x32x64_f8f6f4(p8, cat8(a[d0], b[d0]), o[d0], 0, 0, 0, 0x7F7F7F7F, 0, 0x7F7F7F7F);
    const i32x8 ones = {0x38383838, 0x38383838, 0x38383838, 0x38383838, 0x38383838, 0x38383838, 0x38383838, 0x38383838};
    o[4] = __builtin_amdgcn_mfma_scale_f32_32x32x64_f8f6f4(p8, ones, o[4], 0, 0, 0, 0x7F7F7F7F, 0, 0x7F7F7F7F);
}
#define MLA_BAR() asm volatile("s_waitcnt vmcnt(0) lgkmcnt(0)\n\ts_barrier" ::: "memory")
template <bool O8> __device__ __forceinline__ void unit(int b, int h, int qb, const unsigned char* __restrict__ Q8, const unsigned char* __restrict__ K8, const unsigned char* __restrict__ KR8, const unsigned char* __restrict__ VT, const float* __restrict__ stat, bf16_t* __restrict__ O, LAS unsigned char* lds, const int wv) {
    const int tid = opaque_tid(wv), wid = __builtin_amdgcn_readfirstlane(tid >> 6), lane = tid & 63, r32 = lane & 31, hi = lane >> 5;
    const size_t tok0 = (size_t)b * SEQ;
    const char* Kn = (const char*)(K8 + tok0 * 1024 + h * 128);
    const char* Kr = (const char*)(KR8 + tok0 * 64);
    const char* Vt = (const char*)(VT + (size_t)h * 128 * NTOK + tok0);
    LAS float* ws = (LAS float*)(lds + OFF_WS) + wid * 64; LAS float* al_l = ws + 32;
    const unsigned ldsb = (unsigned)(uintptr_t)lds;
    unsigned vkn, vkr, vv;
    { const int L = wid * 64 + lane, row = L >> 3, c16 = (L & 7) ^ ((row >> 1) & 7); vkn = (unsigned)(row * 1024 + c16 * 16); }
    { const int L = (wid & 3) * 64 + lane, row = L >> 2, c16 = (L & 3) ^ ((row >> 2) & 3); vkr = (unsigned)(row * 64 + c16 * 16); }
    { const int L = wid * 64 + lane, c = L >> 2, q = (L & 3) ^ ((c >> 2) & 3); vv = (unsigned)c * (unsigned)NTOK + (unsigned)(q * 16); }
#define MLA_ISSUE(t, sl) do { const size_t ko_ = (size_t)(t) * KVBLK; const unsigned sb_ = ldsb + (unsigned)(sl) * SLOT; \
        glds16_s(Kn + ko_ * 1024, vkn, sb_ + (unsigned)wid * 1024u); glds16_s(Kr + ko_ * 64, vkr, sb_ + KN_B + (unsigned)(wid & 3) * 1024u); \
        glds16_s(Vt + ko_, vv, sb_ + KN_B + KR_B + (unsigned)wid * 1024u); } while (0)
    MLA_ISSUE(0, 0); MLA_ISSUE(1, 1);
    f32x16 o[5] = {}; f32x16 negm = {}; i32x8 qr[3];
    { const unsigned char* Qw = Q8 + (tok0 + (size_t)qb * 256 + wid * QBLK + r32) * NQ + h * QKD + hi * 32;
#pragma unroll
      for (int s = 0; s < 3; ++s) qr[s] = cat8(*(const bf16x8*)(Qw + s * 64), *(const bf16x8*)(Qw + s * 64 + 16)); }
    const int xv = ((r32 >> 2) & 3) << 4, vc0 = ((hi * 2) * 16) ^ xv, vc1 = ((hi * 2 + 1) * 16) ^ xv;
    const LAS unsigned char* vbase = lds + KN_B + KR_B + r32 * 64;
#define RESC(a) do { if (__any((a) < 1.f)) { if (hi == 0) al_l[r32] = (a); asm volatile("s_waitcnt lgkmcnt(0)" ::: "memory"); \
    _Pragma("unroll") for (int d = 0; d < 5; ++d) _Pragma("unroll") for (int r = 0; r < 16; ++r) o[d][r] *= al_l[crow(r, hi)]; } } while (0)
    f32x16 p0, p1; float al; i32x8 p8 = {}; constexpr int NT = SEQ / KVBLK;
    MLA_BAR();
#define MLA_BARC(j) asm volatile("s_cmp_lt_i32 %0, %1\n\ts_cbranch_scc1 .Lpb%=\n\ts_waitcnt vmcnt(0)\n\ts_branch .Lpe%=\n.Lpb%=:\n\ts_waitcnt vmcnt(3)\n.Lpe%=:\n\ts_waitcnt lgkmcnt(0)\n\ts_barrier" :: "s"(__builtin_amdgcn_readfirstlane((j) + 2)), "n"(SEQ / KVBLK) : "memory", "scc")
    const bool halfB = wid >= 4;
    if (halfB) { MLA_BARC(0); MLA_ISSUE(2, 2); }
    int sj = 0;
    for (int j = 0; j < NT; ++j) {
        const int s1 = sj == 2 ? 0 : sj + 1, s2 = s1 == 2 ? 0 : s1 + 1;
        qkt(p0, p1, negm, lds + sj * SLOT, qr, r32, hi);
        MLA_BARC(j);
        if (!halfB && j + 2 < NT) MLA_ISSUE(j + 2, s2);
        partialSM(p0, p1, negm, al, j == 0); RESC(al);
        finishSM(p0, p1, p8); SBAR();
        pv_all(o, vbase + sj * SLOT, vc0, vc1, p8);
        MLA_BARC(j);
        if (halfB && j + 3 < NT) MLA_ISSUE(j + 3, sj);
        sj = s1;
    }
    if (!halfB) MLA_BARC(NT);
#undef MLA_BARC
    float rli[16];
#pragma unroll
    for (int r = 0; r < 16; ++r) rli[r] = __builtin_amdgcn_rcpf(o[4][r]);
    MLA_BAR();
    LAS unsigned char* ost = lds + wid * (32 * OSTR);
    if constexpr (O8) {
#pragma unroll
        for (int r = 0; r < 16; ++r) { const int orow = crow(r, hi);
#pragma unroll
            for (int d0 = 0; d0 < 4; ++d0) *(LAS unsigned char*)(ost + orow * 144 + d0 * 32 + r32) = (unsigned char)fp8_1(o[d0][r] * rli[r] * O8_SCALE); }
        asm volatile("s_waitcnt lgkmcnt(0)" ::: "memory");
        unsigned char* Ow = (unsigned char*)O + (tok0 + (size_t)qb * 256 + wid * QBLK) * LDO + h * 128;
#pragma unroll
        for (int it = 0; it < 4; ++it) { const int ch = it * 64 + lane, row = ch >> 3, c16 = ch & 7;
            const u32x4 v = *(const LAS u32x4*)(ost + row * 144 + c16 * 16); *(u32x4*)(Ow + (size_t)row * LDO + c16 * 16) = v; }
    } else {
#pragma unroll
        for (int r = 0; r < 16; ++r) { const int orow = crow(r, hi);
#pragma unroll
            for (int d0 = 0; d0 < 4; ++d0) *(LAS unsigned short*)(ost + orow * OSTR + (d0 * 32 + r32) * 2) = (unsigned short)f2bf(o[d0][r] * rli[r]); }
        asm volatile("s_waitcnt lgkmcnt(0)" ::: "memory");
        bf16_t* Ow = O + (tok0 + (size_t)qb * 256 + wid * QBLK) * LDO + h * 128;
#pragma unroll
        for (int it = 0; it < 8; ++it) { const int ch = it * 64 + lane, row = ch >> 4, c16 = ch & 15;
            const u32x4 v = *(const LAS u32x4*)(ost + row * OSTR + c16 * 16); *(u32x4*)(Ow + (size_t)row * LDO + c16 * 8) = v; }
    }
    MLA_BAR();
#undef MLA_ISSUE
#undef RESC
}
#undef MLA_BAR
}

namespace swa {
constexpr int KT = 8192, SLOT = 16384, NSLOT = 6, NTILE_SEQ = SEQ / 64;
constexpr int OFF_O = NSLOT * SLOT  , OSTR = 144, OFF_WS = OFF_O + 8 * 32 * OSTR  , OFF_END = OFF_WS + 8 * 64 * 4;
static_assert(OFF_END <= RING_BYTES, "swa lds");
constexpr int LD = SWA_NQKV;
constexpr float C = 0.125f * LOG2E, THRL = 24.f;
template <bool O8> __device__ __forceinline__ void superunit(int b, int g, int qb0, int nqb, const bf16_t* __restrict__ QKV, const float* __restrict__ sink, bf16_t* __restrict__ O, LAS unsigned char* lds, const int wv) {
    const int tid = opaque_tid(wv), wid = __builtin_amdgcn_readfirstlane(tid >> 6), lane = tid & 63, r32 = lane & 31, hi = lane >> 5;
    const size_t tok0 = (size_t)b * SEQ; const unsigned ldsb = (unsigned)(uintptr_t)lds;
    const char* Kg = (const char*)(QKV + tok0 * LD + 1024 + g * 64); const char* Vg = (const char*)(QKV + tok0 * LD + 1280 + g * 64);
    unsigned vk, vv;
    { const int L = wid * 64 + lane; { const int row = L >> 3, c16 = (L & 7) ^ ((row >> 1) & 7); vk = (unsigned)(row * (LD * 2) + c16 * 16); }
      { const int st = L >> 5, w = L & 31, kk = (st >> 1) * 8 + (w >> 2), k = (kk & ~0xC) | ((kk & 4) << 1) | ((kk & 8) >> 1), c = (st & 1) * 32 + (w & 3) * 8; vv = (unsigned)(k * (LD * 2) + c * 2); } }
#define SWA_ISSUE(T) do { const size_t ko_ = (size_t)(T) * 64 * (LD * 2); const unsigned sb_ = ldsb + (unsigned)((T) % NSLOT) * SLOT + (unsigned)wid * 1024u; \
        glds16_s(Kg + ko_, vk, sb_); glds16_s(Vg + ko_, vv, sb_ + KT); } while (0)
    { const int t0 = qb0 - 2 < 0 ? 0 : qb0 - 2, t1 = qb0 + 2 > NTILE_SEQ - 1 ? NTILE_SEQ - 1 : qb0 + 2;
      for (int T = t0; T <= t1; ++T) SWA_ISSUE(T); }
    const int qh = g * 4 + (wid >> 1);
    const float slope2 = __builtin_amdgcn_exp2f(-0.5f * (float)(qh + 1)) * LOG2E;
    const float sink2 = sink[qh] * LOG2E, nslope2 = -slope2, rbf = (float)(4 * hi - (wid & 1) * 32 - r32);
    const bf16x8 ones8 = {0x3F80, 0x3F80, 0x3F80, 0x3F80, 0x3F80, 0x3F80, 0x3F80, 0x3F80};
    LAS float* al_l = (LAS float*)(lds + OFF_WS) + wid * 64; LAS float* li_l = al_l + 32;
    const int vrb = (int)ldsb + KT + v_rd_base(lane);
    const int xr = ((r32 >> 1) & 7) << 4;
    bf16x8 qr[4], qn[4];
    { const bf16_t* Qw = QKV + (tok0 + (size_t)(qb0 * 64 + (wid & 1) * 32 + r32)) * LD + qh * 64 + hi * 8;
#pragma unroll
      for (int d0 = 0; d0 < 4; ++d0) qr[d0] = *(const bf16x8*)(Qw + d0 * 16); }
    asm volatile("s_waitcnt vmcnt(0) lgkmcnt(0)\n\ts_barrier" ::: "memory");
    for (int qb = qb0; qb < qb0 + nqb; ++qb) {
        const bool more = qb + 1 < qb0 + nqb;
        if (more && qb + 3 < NTILE_SEQ) SWA_ISSUE(qb + 3);
        const int q0 = qb * 64, rowb = q0 + (wid & 1) * 32;
        if (more) { const bf16_t* Qw = QKV + (tok0 + (size_t)(rowb + 64 + r32)) * LD + qh * 64 + hi * 8;
#pragma unroll
            for (int d0 = 0; d0 < 4; ++d0) qn[d0] = *(const bf16x8*)(Qw + d0 * 16); }
        asm volatile("" ::: "memory");
        const int T0 = qb - 2 < 0 ? 0 : qb - 2, T1 = qb + 2 > NTILE_SEQ - 1 ? NTILE_SEQ - 1 : qb + 2;
        float rbq = rbf; asm volatile("" : "+v"(rbq));
        float m_reg = 0.f; f32x16 o[2] = {}, osum = {};
#define SWA_RAMP(p0, p1, A, S) do { const float s2_ = (S) + (S), s8_ = 8.f * (S), s32_ = 32.f * (S); \
            p0[0] = (A); p0[1] = (A) + (S); p0[2] = (A) + s2_; p0[3] = p0[1] + s2_; \
            _Pragma("unroll") for (int r = 4; r < 16; ++r) p0[r] = p0[r - 4] + s8_; \
            _Pragma("unroll") for (int r = 0; r < 16; ++r) p1[r] = p0[r] + s32_; } while (0)
        for (int T = T0; T <= T1; ++T) {
            const LAS unsigned char* Ks = lds + (T % NSLOT) * SLOT + r32 * 128; f32x16 p0, p1;
            { const int dt = T - qb; const float base = rbq + (float)(dt * 64);
              SWA_RAMP(p0, p1, base, 1.0f);
              if (dt == -2 || dt == 2) {
#pragma unroll
                  for (int r = 0; r < 16; ++r) { const float a0 = __builtin_fabsf(p0[r]), a1 = __builtin_fabsf(p1[r]);
                      p0[r] = a0 > 128.f ? -INFINITY : fmaf(nslope2, a0, -m_reg); p1[r] = a1 > 128.f ? -INFINITY : fmaf(nslope2, a1, -m_reg); } }
              else {
#pragma unroll
                  for (int r = 0; r < 16; ++r) { p0[r] = fmaf(nslope2, __builtin_fabsf(p0[r]), -m_reg); p1[r] = fmaf(nslope2, __builtin_fabsf(p1[r]), -m_reg); } } }
#pragma unroll
            for (int d0 = 0; d0 < 4; ++d0) { const int cb = ((d0 * 2 + hi) * 16) ^ xr;
                const bf16x8 b0 = *(const LAS bf16x8*)(Ks + cb), b1 = *(const LAS bf16x8*)(Ks + 32 * 128 + cb);
                p0 = __builtin_amdgcn_mfma_f32_32x32x16_bf16(b0, qr[d0], p0, 0, 0, 0);
                p1 = __builtin_amdgcn_mfma_f32_32x32x16_bf16(b1, qr[d0], p1, 0, 0, 0); }
            float pmax = p0[0];
#pragma unroll
            for (int r = 1; r < 16; ++r) pmax = fmaxf(pmax, p0[r]);
#pragma unroll
            for (int r = 0; r < 16; ++r) pmax = fmaxf(pmax, p1[r]);
            { auto rr = __builtin_amdgcn_permlane32_swap(__float_as_uint(pmax), __float_as_uint(pmax), false, false);
              pmax = fmaxf(__uint_as_float(rr[0]), __uint_as_float(rr[1])); }
            const bool first = (T == T0);
            if (__builtin_expect(!first && __all(pmax <= THRL), 1)) { }
            else { const float delta = first ? pmax : fmaxf(pmax, 0.f); m_reg += delta;
#pragma unroll
                for (int r = 0; r < 16; ++r) { p0[r] -= delta; p1[r] -= delta; }
                if (!first) { if (hi == 0) al_l[r32] = __builtin_amdgcn_exp2f(-delta); asm volatile("s_waitcnt lgkmcnt(0)" ::: "memory");
#pragma unroll
                    for (int r = 0; r < 16; ++r) { const float a = al_l[crow(r, hi)]; o[0][r] *= a; o[1][r] *= a; osum[r] *= a; } } }
#pragma unroll
            for (int r = 0; r < 16; ++r) { p0[r] = __builtin_amdgcn_exp2f(p0[r]); p1[r] = __builtin_amdgcn_exp2f(p1[r]); }
            bf16x8 pa0, pa1, pa2, pa3;
            PK4(p0, 0, pa0); PK4(p0, 8, pa1); PK4(p1, 0, pa2); PK4(p1, 8, pa3);
            const int vb = vrb + (T % NSLOT) * SLOT;
            pv_one<0, 2>(o[0], vb, pa0, pa1, pa2, pa3); pv_one<1, 2>(o[1], vb, pa0, pa1, pa2, pa3);
            osum = __builtin_amdgcn_mfma_f32_32x32x16_bf16(pa0, ones8, osum, 0, 0, 0); osum = __builtin_amdgcn_mfma_f32_32x32x16_bf16(pa1, ones8, osum, 0, 0, 0);
            osum = __builtin_amdgcn_mfma_f32_32x32x16_bf16(pa2, ones8, osum, 0, 0, 0); osum = __builtin_amdgcn_mfma_f32_32x32x16_bf16(pa3, ones8, osum, 0, 0, 0);
        }
#undef SWA_RAMP
        { const float e = __builtin_amdgcn_exp2f(sink2 - m_reg);
          if (hi == 0) li_l[r32] = e; asm volatile("s_waitcnt lgkmcnt(0)" ::: "memory"); }
        LAS unsigned char* ost = lds + OFF_O + wid * (32 * OSTR);
        if constexpr (O8) {
#pragma unroll
            for (int r = 0; r < 16; ++r) { const int orow = crow(r, hi); const float rl = __builtin_amdgcn_rcpf(osum[r] + li_l[orow]) * O8_SCALE;
#pragma unroll
                for (int d0 = 0; d0 < 2; ++d0) *(LAS unsigned char*)(ost + orow * 80 + d0 * 32 + r32) = (unsigned char)fp8_1(o[d0][r] * rl); }
            asm volatile("s_waitcnt lgkmcnt(0)" ::: "memory");
            unsigned char* Ow = (unsigned char*)O + (tok0 + (size_t)rowb) * DM + qh * 64;
#pragma unroll
            for (int it = 0; it < 2; ++it) { const int ch = it * 64 + lane, row = ch >> 2, c16 = ch & 3;
                const u32x4 v = *(const LAS u32x4*)(ost + row * 80 + c16 * 16); *(u32x4*)(Ow + (size_t)row * DM + c16 * 16) = v; }
            asm volatile("s_waitcnt vmcnt(2) lgkmcnt(0)\n\ts_barrier" ::: "memory");
        } else {
#pragma unroll
            for (int r = 0; r < 16; ++r) { const int orow = crow(r, hi); const float rl = __builtin_amdgcn_rcpf(osum[r] + li_l[orow]);
#pragma unroll
                for (int d0 = 0; d0 < 2; ++d0) *(LAS unsigned short*)(ost + orow * OSTR + (d0 * 32 + r32) * 2) = (unsigned short)f2bf(o[d0][r] * rl); }
            asm volatile("s_waitcnt lgkmcnt(0)" ::: "memory");
            bf16_t* Ow = O + (tok0 + (size_t)rowb) * DM + qh * 64;
#pragma unroll
            for (int it = 0; it < 4; ++it) { const int ch = it * 64 + lane, row = ch >> 3, c16 = ch & 7;
                const u32x4 v = *(const LAS u32x4*)(ost + row * OSTR + c16 * 16); *(u32x4*)(Ow + (size_t)row * DM + c16 * 8) = v; }
            asm volatile("s_waitcnt vmcnt(4) lgkmcnt(0)\n\ts_barrier" ::: "memory");
        }
#pragma unroll
        for (int d0 = 0; d0 < 4; ++d0) qr[d0] = qn[d0];
    }
    asm volatile("s_waitcnt vmcnt(0)" ::: "memory");
#undef SWA_ISSUE
}
}

constexpr int NWAVES = 8;
struct Args { const float* in[23]; float* out; unsigned char* ws; };
static_assert(sizeof(Args) == 25 * 8, "no padding");

template <int KIND> __device__ __forceinline__ int map_row(int n) {
    if (KIND == 0) return n;
    if (KIND == 1) return ((n >> 7) << 8) + (n & 127);
    if (KIND == 2) return ((n >> 7) << 8) + 128 + (n & 127);
    if (KIND == 3) { const int h = n / QKD; int d = n - h * QKD; if (d >= 128) { const int i = d - 128; d = 128 + (i < 32 ? 2 * i : 2 * (i - 32) + 1); } return h * QKD + d; }
    if (KIND == 4) { if (n >= 512) { const int i = n - 512; n = 512 + (i < 32 ? 2 * i : 2 * (i - 32) + 1); } return n; }
    return n;
}
template <int KIND, bool F8> __device__ __forceinline__ void transpose_any(const float* W, int K, int N, void* WTv, int row_off, LAS float* scr, int gw, int NGW, int lane, float scale, const float* gk) {
    const int nblk = N / 32, nitems = (K / 64) * nblk;
    f32x4 t[8];
#define TR_LOAD(item) do { const int kb_ = (item) / nblk, nb_ = (item) % nblk; _Pragma("unroll") for (int i = 0; i < 8; ++i) t[i] = *(const f32x4*)(W + (size_t)(64 * kb_ + (lane >> 3) + 8 * i) * N + 32 * nb_ + 4 * (lane & 7)); } while (0)
    int item = gw;
    if (item < nitems) TR_LOAD(item);
    for (; item < nitems; item += NGW) {
        const int kb = item / nblk, nb = item % nblk, k0 = 64 * kb, n0 = 32 * nb;
#pragma unroll
        for (int i = 0; i < 8; ++i) { const int kk = (lane >> 3) + 8 * i; f32x4 v = t[i]; if (F8) v = v * scale; if (gk) v = v * gk[k0 + kk];
            LAS float* d = scr + kk * 33 + 4 * (lane & 7); d[0] = v.x; d[1] = v.y; d[2] = v.z; d[3] = v.w; }
        if (item + NGW < nitems) TR_LOAD(item + NGW);
        LDS_WAIT(); asm volatile("" ::: "memory");
        const int c = lane & 7;
#pragma unroll
        for (int j = 0; j < 4; ++j) { const int n = (lane >> 3) + 8 * j; const LAS float* sp = scr + (8 * c) * 33 + n;
            if (F8) { const float o[8] = {sp[0 * 33], sp[1 * 33], sp[2 * 33], sp[3 * 33], sp[4 * 33], sp[5 * 33], sp[6 * 33], sp[7 * 33]};
                *(u32x2*)((unsigned char*)WTv + (size_t)(row_off + map_row<KIND>(n0 + n)) * K + k0 + 8 * c) = pk8_fp8(o); }
            else { u32x4 o; o.x = pk2(sp[0 * 33], sp[1 * 33]); o.y = pk2(sp[2 * 33], sp[3 * 33]); o.z = pk2(sp[4 * 33], sp[5 * 33]); o.w = pk2(sp[6 * 33], sp[7 * 33]);
                *(u32x4*)((bf16_t*)WTv + (size_t)(row_off + map_row<KIND>(n0 + n)) * K + k0 + 8 * c) = o; } }
        LDS_WAIT(); asm volatile("" ::: "memory");
    }
#undef TR_LOAD
}
template <int KIND> __device__ __forceinline__ void transpose_matrix(const float* W, int K, int N, bf16_t* WT, int row_off, LAS float* scr, int gw, int NGW, int lane, const float* gk = nullptr) {
    transpose_any<KIND, false>(W, K, N, WT, row_off, scr, gw, NGW, lane, 1.f, gk);
}
template <int KIND> __device__ __forceinline__ void transpose_matrix_f8(const float* W, int K, int N, unsigned char* WT, int row_off, LAS float* scr, int gw, int NGW, int lane, float scale, const float* gk = nullptr) {
    transpose_any<KIND, true>(W, K, N, WT, row_off, scr, gw, NGW, lane, scale, gk);
}
template <bool F8> __device__ __forceinline__ void rms_row_to_bf16(const float* xrow, const f32x4 (&gv)[4], bf16_t* orow, int lane) {
    const f32x4* xr = (const f32x4*)xrow + lane; f32x4 v[4]; float s = 0.f;
#pragma unroll
    for (int j = 0; j < 4; ++j) { v[j] = xr[64 * j]; s += (v[j].x * v[j].x + v[j].y * v[j].y) + (v[j].z * v[j].z + v[j].w * v[j].w); }
    const float rstd = 1.0f / sqrtf(wave_sum(s, lane) * (1.f / DM) + EPS);
    if (F8) { unsigned* o4 = (unsigned*)orow + lane;
#pragma unroll
        for (int j = 0; j < 4; ++j) { const f32x4 y = v[j] * rstd * gv[j]; int w = 0; w = __builtin_amdgcn_cvt_pk_fp8_f32(y.x, y.y, w, false); w = __builtin_amdgcn_cvt_pk_fp8_f32(y.z, y.w, w, true); o4[64 * j] = (unsigned)w; } }
    else { unsigned long long* o8 = (unsigned long long*)orow + lane;
#pragma unroll
    for (int j = 0; j < 4; ++j) { const f32x4 y = v[j] * rstd * gv[j]; o8[64 * j] = (unsigned long long)pk2(y.x, y.y) | ((unsigned long long)pk2(y.z, y.w) << 32); } }
}

#define PHASE_IDS const int tid = opaque_tid(bar.wv), lane = tid & 63, wave = __builtin_amdgcn_readfirstlane(tid >> 6), gw = vcu * NWAVES + wave; (void)gw; (void)lane
template <int j> __device__ __forceinline__ void pair_body(const Args& args, LAS unsigned char* lds, const XcdBarrier& bar, const int G, const int bx, const int vcu) {
    const int NGW = G * NWAVES;
    unsigned char* ws = args.ws;
    LAS int* moetab = (LAS int*)(lds + MOETAB_OFF);
    const float* x = args.in[0];
    int* route = (int*)(ws + WS_ROUTE); f32x2* gate = (f32x2*)(ws + WS_GATE); int* posb = (int*)(ws + WS_POS); int* cnt = (int*)(ws + WS_CNT);
    unsigned char* act = ws + WS_ACT;
    bf16_t* H = (bf16_t*)(act + A_H); bf16_t* XN = (bf16_t*)(act + A_XN); bf16_t* DOWN = (bf16_t*)(act + A_DOWN); bf16_t* QB = (bf16_t*)(act + A_Q);
    bf16_t* KVB = (bf16_t*)args.out;
    bf16_t* FACT = (bf16_t*)(act + A_FACT); bf16_t* SQKV = (bf16_t*)(act + A_SQKV); bf16_t* SO = (bf16_t*)(act + A_SO); bf16_t* XS = (bf16_t*)args.out; bf16_t* MACT = (bf16_t*)(act + A_MACT);
    float* STAT = (float*)(act + A_STAT); LAS float* PART = (LAS float*)(lds + PART_OFF);
    constexpr bool F8M = ((FP8_MOE >> j) & 1) != 0, F8F = ((FP8_FFN >> j) & 1) != 0, S8 = ((FP8_S2 >> j) & 1) != 0, Y8 = F8M && ((FP8_YS >> j) & 1) != 0;
    unsigned char* H8 = act + A_H8;
    bf16_t* YS = F8M ? (bf16_t*)(act + A_YS) : XS;
    constexpr bool FINAL_DIRECT = (j == 1) && F8M;
    {
        unsigned char* wb = ws + WS_W + (size_t)j * W_PAIR;
        if (PH(1)) { constexpr bool D8 = FP8_DOWN != 0; pg8::Gemm g{XN, (const bf16_t*)(wb + W_DQKV), D8 ? DM / 2 : DM, D8 ? DM / 2 : DM, D8 ? DM / 2 : DM}; pg8::DenseOrder S; S.init(NTOK, DOWNP, G, bx, 256);
          pg8::EpiDown<FP8_QK != 0, FP8_UP != 0> E{DOWN, STAT, PART, act + A_KR8, D8 ? 1.0f / W8_SCALE : 1.0f}; pg8::gemm_phase<pg8::EpiDown<FP8_QK != 0, FP8_UP != 0>, pg8::DenseOrder, true, D8>(lds, g, S, E, bar.wv); }
        xcd_barrier(bar);
        if (PH(3)) { constexpr bool U8 = FP8_UP != 0; constexpr int KU = U8 ? 128 : 256, LDD = U8 ? DOWNP / 2 : DOWNP; const float us = U8 ? 1.0f / W8_SCALE : 1.0f;
          const bf16_t* CQ = DOWN; const bf16_t* CKV = U8 ? (const bf16_t*)((const unsigned char*)DOWN + 256) : DOWN + 256;
          { pg8::Gemm g{CQ, (const bf16_t*)(wb + W_UQ), LDD, KU, KU}; pg8::DenseOrder S; S.init(NTOK, NQ, G, bx, 256);
            pg8::EpiQRope<FP8_QK != 0, FP8_PV != 0> E{QB, us, STAT, mla9::QPRE}; pg8::gemm_phase<pg8::EpiQRope<FP8_QK != 0, FP8_PV != 0>, pg8::DenseOrder, true, U8>(lds, g, S, E, bar.wv); }
          if constexpr (FP8_PV != 0) {
            { pg8::Gemm g{CKV, (const bf16_t*)(wb + W_UKV), LDD, KU, KU}; pg8::DenseOrder Sk; Sk.init(NTOK, 1024, G, bx, 256);
              pg8::EpiKV8 Ek{KVB, act + A_K8, STAT, us}; pg8::gemm_phase<pg8::EpiKV8, pg8::DenseOrder, true, U8>(lds, g, Sk, Ek, bar.wv); }
            { pg8::Gemm gv{U8 ? (const bf16_t*)(wb + W_UKV + (size_t)1024 * 256) : (const bf16_t*)(wb + W_UKV) + (size_t)1024 * 256, CKV, KU, LDD, KU}; pg8::DenseOrder Sv; Sv.init(1024, NTOK, G, bx, 256);
              pg8::EpiVT8 Ev{(unsigned char*)args.out, STAT, us}; pg8::gemm_phase<pg8::EpiVT8, pg8::DenseOrder, true, U8>(lds, gv, Sv, Ev, bar.wv); } }
          else { pg8::Gemm g{CKV, (const bf16_t*)(wb + W_UKV), LDD, KU, KU}; pg8::DenseOrder S; S.init(NTOK, NKV, G, bx, 256);
            if constexpr (FP8_QK != 0) { pg8::EpiKV8 E{KVB, act + A_K8, STAT, us}; pg8::gemm_phase<pg8::EpiKV8, pg8::DenseOrder, true, U8>(lds, g, S, E, bar.wv); }
            else { pg8::EpiBf16<false, 1> E{KVB, NKV, STAT, 1, 1.f / 256.f, 1.f}; pg8::gemm_phase<pg8::EpiBf16<false, 1>, pg8::DenseOrder, true>(lds, g, S, E, bar.wv); } } }
        xcd_barrier(bar);
        if (PH(4)) { const int NU = BATCH * MLA_H * (SEQ / 256);
          for (int u = vcu; u < NU; u += G) { const int bh = u >> 3, qb = u & 7;
              if constexpr (FP8_PV != 0) mla9::unit<FP8_ATTO != 0>(bh >> 3, bh & 7, qb, (const unsigned char*)QB, act + A_K8, act + A_KR8, (const unsigned char*)args.out, STAT, XN, lds, bar.wv);
              else if constexpr (FP8_QK != 0) mla8::unit<FP8_ATTO != 0>(bh >> 3, bh & 7, qb, (const unsigned char*)QB, act + A_K8, act + A_KR8, KVB, STAT, XN, lds, bar.wv);
              else mla::unit<FP8_ATTO != 0>(bh >> 3, bh & 7, qb, QB, KVB, DOWN, STAT, XN, lds, bar.wv); } }
        xcd_barrier(bar);
        if (PH(5)) { constexpr bool F8 = FP8_ATTO != 0; pg8::Gemm g{XN, (const bf16_t*)(wb + W_MO), F8 ? DM / 2 : DM, F8 ? DM / 2 : DM, F8 ? DM / 2 : DM}; pg8::DenseOrder S; S.init(NTOK, DM, G, bx, 256);
          pg8::EpiResid<j == 0, F8F> E{j == 0 ? (const void*)x : (const void*)H, H, STAT, PART, F8 ? RESID_SCALE / (W8_SCALE * O8_SCALE) : RESID_SCALE, H8}; pg8::gemm_phase<pg8::EpiResid<j == 0, F8F>, pg8::DenseOrder, true, F8>(lds, g, S, E, bar.wv); }
        xcd_barrier(bar);
        if (PH(7)) {
          if constexpr (F8F) { pg8::Gemm g{(const bf16_t*)H8, (const bf16_t*)(wb + W_FGU), DM / 2, DM / 2, DM / 2}; pg8::DenseOrder S; S.init(NTOK, 2 * FFN, G, bx, 128);
            pg8::EpiSwiGLU<false, 4, true> E{FACT, FFN, STAT, 1.f / 1024.f, 1.0f / W8_SCALE}; pg8::gemm_phase<pg8::EpiSwiGLU<false, 4, true>, pg8::DenseOrder, true, true>(lds, g, S, E, bar.wv); }
          else { pg8::Gemm g{H, (const bf16_t*)(wb + W_FGU), DM, DM, DM}; pg8::DenseOrder S; S.init(NTOK, 2 * FFN, G, bx, 128);
            pg8::EpiSwiGLU<false, 4> E{FACT, FFN, STAT, 1.f / 1024.f, 1.f}; pg8::gemm_phase<pg8::EpiSwiGLU<false, 4>, pg8::DenseOrder, true>(lds, g, S, E, bar.wv); } }
        xcd_barrier(bar);
        if (PH(8)) {
          if constexpr (F8F) { pg8::Gemm g{FACT, (const bf16_t*)(wb + W_FD), FFN / 2, FFN / 2, FFN / 2}; pg8::DenseOrder S; S.init(NTOK, DM, G, bx, 256);
            pg8::EpiResid<false, S8> E{H, H, STAT, PART, RESID_SCALE / W8_SCALE, H8}; pg8::gemm_phase<pg8::EpiResid<false, S8>, pg8::DenseOrder, true, true>(lds, g, S, E, bar.wv); }
          else { pg8::Gemm g{FACT, (const bf16_t*)(wb + W_FD), FFN, FFN, FFN}; pg8::DenseOrder S; S.init(NTOK, DM, G, bx, 256);
            pg8::EpiResid<false, S8> E{H, H, STAT, PART, RESID_SCALE, H8}; pg8::gemm_phase<pg8::EpiResid<false, S8>, pg8::DenseOrder, true>(lds, g, S, E, bar.wv); } }
        xcd_barrier(bar);
        if (PH(10)) { pg8::Gemm g{S8 ? (const bf16_t*)H8 : H, (const bf16_t*)(wb + W_SQKV), S8 ? DM / 2 : DM, S8 ? DM / 2 : DM, S8 ? DM / 2 : DM}; pg8::DenseOrder S; S.init(NTOK, SWA_NQKV, G, bx, 256);
          pg8::EpiBf16<false, 4> E{SQKV, SWA_NQKV, STAT, 0, 1.f / 1024.f, S8 ? 1.0f / W8_SCALE : 1.f, 1024, swa::C}; pg8::gemm_phase<pg8::EpiBf16<false, 4>, pg8::DenseOrder, true, S8>(lds, g, S, E, bar.wv); }
        xcd_barrier(bar);
        if (PH(11)) { constexpr int NQB = 16, NSU = BATCH * 4 * (SEQ / 64 / NQB);
          for (int su = vcu; su < NSU; su += G) { const int bg = su >> 1, qb0 = (su & 1) * NQB; swa::superunit<FP8_ATTO != 0>(bg >> 2, bg & 3, qb0, NQB, SQKV, args.in[11] + j * 16, SO, lds, bar.wv); } }
        xcd_barrier(bar);
        if (PH(12)) { constexpr bool F8 = FP8_ATTO != 0; pg8::Gemm g{SO, (const bf16_t*)(wb + W_SO), F8 ? DM / 2 : DM, F8 ? DM / 2 : DM, F8 ? DM / 2 : DM}; pg8::DenseOrder S; S.init(NTOK, DM, G, bx, 256);
          pg8::EpiResid<false> E{H, H, STAT, PART, F8 ? RESID_SCALE / (W8_SCALE * O8_SCALE) : RESID_SCALE, nullptr}; pg8::gemm_phase<pg8::EpiResid<false>, pg8::DenseOrder, true, F8>(lds, g, S, E, bar.wv); }
        xcd_barrier(bar);
        if (PH(13)) { PHASE_IDS; constexpr int WSTR = 1032;
          LAS bf16_t* wsp = (LAS bf16_t*)lds;
          LAS int* lcnt = (LAS int*)(lds + 65536);
          const float* router = args.in[18] + (size_t)j * DM * NE; const float* mg = args.in[17] + j * DM;
          for (int i = tid; i < DM * NE; i += NWAVES * 64) { const int e = i & 7, k = i >> 3; const float w = router[i] * mg[k];
              const unsigned w1 = f2bf(w); const float r1 = w - __uint_as_float(w1 << 16); const unsigned w2 = f2bf(r1); const float r2 = r1 - __uint_as_float(w2 << 16); const unsigned w3 = f2bf(r2);
              wsp[(0 * 8 + e) * WSTR + k] = (bf16_t)w1; wsp[(1 * 8 + e) * WSTR + k] = (bf16_t)w2; wsp[(2 * 8 + e) * WSTR + k] = (bf16_t)w3; }
          __syncthreads();
          const int n16 = lane & 15, kg = lane >> 4;
          const LAS bf16_t* wl = wsp + (n16 & 7) * WSTR + 8 * kg;
          for (int ck = vcu; ck < NTOK / 256; ck += G) {
              if (tid < 8) lcnt[tid] = 0;
              __syncthreads();
              const int tokb = ck * 256 + wave * 32;
              const bf16_t* h0 = H + (size_t)(tokb + n16) * DM + 8 * kg; const bf16_t* h1 = h0 + (size_t)16 * DM;
              f32x4 acc0 = {0.f, 0.f, 0.f, 0.f}, acc1 = {0.f, 0.f, 0.f, 0.f};
              bf16x8 ha[8], hb[8], na[8], nb[8];
#pragma unroll
              for (int i = 0; i < 8; ++i) { na[i] = *(const bf16x8*)(h0 + i * 32); nb[i] = *(const bf16x8*)(h1 + i * 32); }
              const f32x4 st0 = *(const f32x4*)(STAT + (size_t)(tokb + n16) * 4), st1 = *(const f32x4*)(STAT + (size_t)(tokb + 16 + n16) * 4);
              for (int g8 = 0; g8 < 4; ++g8) {
#pragma unroll
                  for (int i = 0; i < 8; ++i) { ha[i] = na[i]; hb[i] = nb[i]; }
                  if (g8 < 3) {
#pragma unroll
                      for (int i = 0; i < 8; ++i) { na[i] = *(const bf16x8*)(h0 + ((g8 + 1) * 8 + i) * 32); nb[i] = *(const bf16x8*)(h1 + ((g8 + 1) * 8 + i) * 32); } }
#pragma unroll
                  for (int i = 0; i < 8; ++i) { const int kk = g8 * 8 + i;
#pragma unroll
                      for (int sp = 0; sp < 3; ++sp) { const bf16x8 wf = *(const LAS bf16x8*)(wl + sp * 8 * WSTR + kk * 32);
                          acc0 = __builtin_amdgcn_mfma_f32_16x16x32_bf16(wf, ha[i], acc0, 0, 0, 0); acc1 = __builtin_amdgcn_mfma_f32_16x16x32_bf16(wf, hb[i], acc1, 0, 0, 0); } } }
#pragma unroll
              for (int bt = 0; bt < 2; ++bt) { const f32x4 ac = bt ? acc1 : acc0; const f32x4 st4 = bt ? st1 : st0; const int tok = tokb + bt * 16 + n16;
                  const float rstd = 1.0f / sqrtf(((st4.x + st4.y) + (st4.z + st4.w)) * (1.f / DM) + EPS);
                  float lg[8];
#pragma unroll
                  for (int q4 = 0; q4 < 4; ++q4) { auto rr = __builtin_amdgcn_permlane16_swap(__float_as_uint(ac[q4]), __float_as_uint(ac[q4]), false, false);
                      lg[q4] = __uint_as_float(rr[0]) * rstd; lg[4 + q4] = __uint_as_float(rr[1]) * rstd; }
                  int i0 = 0; float v0 = lg[0];
#pragma unroll
                  for (int e = 1; e < 8; ++e) if (lg[e] > v0) { v0 = lg[e]; i0 = e; }
                  int i1 = -1; float v1 = -INFINITY;
#pragma unroll
                  for (int e = 0; e < 8; ++e) if (e != i0 && lg[e] > v1) { v1 = lg[e]; i1 = e; }
                  const float g0 = 1.0f / (1.0f + __expf(v1 - v0));
                  if (lane < 16) { route[tok] = i0 | (i1 << 8); gate[tok] = (f32x2){g0, 1.0f - g0}; __hip_atomic_fetch_add(lcnt + i0, 1, __ATOMIC_RELAXED, __HIP_MEMORY_SCOPE_WORKGROUP); __hip_atomic_fetch_add(lcnt + i1, 1, __ATOMIC_RELAXED, __HIP_MEMORY_SCOPE_WORKGROUP); } }
              __syncthreads();
              if (tid < 8) cnt[ck * 8 + tid] = lcnt[tid];
              __syncthreads();
          } }
        xcd_barrier(bar);
        if (PH(14)) { PHASE_IDS; LAS int* red = (LAS int*)lds;
          LAS int* tp = (LAS int*)(lds + 1024);
          LAS int* wcn = (LAS int*)(lds + 2048);
          LAS int* lpos = (LAS int*)(lds + 4096);
          f32x4 gv[4];
#pragma unroll
          for (int k = 0; k < 4; ++k) gv[k] = ((const f32x4*)(args.in[17] + j * DM))[F8M ? 4 * lane + k : lane + 64 * k];
          int v[8];
          if (tid < 256) { const i32x4 c0 = ((const i32x4*)cnt)[tid * 2], c1 = ((const i32x4*)cnt)[tid * 2 + 1]; v[0] = c0.x; v[1] = c0.y; v[2] = c0.z; v[3] = c0.w; v[4] = c1.x; v[5] = c1.y; v[6] = c1.z; v[7] = c1.w; }
          else {
#pragma unroll
              for (int e = 0; e < 8; ++e) v[e] = 0; }
#pragma unroll
          for (int e = 0; e < 8; ++e) { int tot = v[e];
#pragma unroll
              for (int o = 1; o < 64; o <<= 1) tot += shxi(tot, o, lane);
              if (lane == 0) red[wave * 16 + e] = tot; }
          __syncthreads();
          if (tid < 8) { int sm = 0;
#pragma unroll
              for (int w = 0; w < 8; ++w) sm += red[w * 16 + tid];
              tp[tid] = sm; }
          __syncthreads();
          if (tid == 0) { int rs = 0, ts = 0;
              for (int e = 0; e < 8; ++e) { moetab[e] = ts; moetab[16 + e] = rs; rs += tp[e]; ts += (tp[e] + 255) >> 8; }
              moetab[8] = ts; moetab[24] = rs; }
          __syncthreads();
          for (int ck = vcu; ck < NTOK / 256; ck += G) {
#pragma unroll
              for (int e = 0; e < 8; ++e) { int pre = (tid < ck) ? v[e] : 0;
#pragma unroll
                  for (int o = 1; o < 64; o <<= 1) pre += shxi(pre, o, lane);
                  if (lane == 0) red[wave * 16 + 8 + e] = pre; }
              __syncthreads();
              if (tid < 8) { int sm = 0;
#pragma unroll
                  for (int w = 0; w < 8; ++w) sm += red[w * 16 + 8 + tid];
                  tp[8 + tid] = sm; }
              int e0 = 0, e1 = 0, r0 = 0, r1 = 0;
              if (tid < 256) { const int re = route[ck * 256 + tid]; e0 = re & 255; e1 = re >> 8; }
#pragma unroll
              for (int e = 0; e < 8; ++e) { const bool f = (tid < 256) && (e0 == e || e1 == e); const unsigned long long mk = __ballot(f);
                  const int rk = __popcll(mk & ((1ull << lane) - 1ull));
                  if (e0 == e) r0 = rk; if (e1 == e) r1 = rk;
                  if (lane == 0 && wave < 4) wcn[wave * 8 + e] = __popcll(mk); }
              __syncthreads();
              if (tid < 256) { int p0 = moetab[16 + e0] + tp[8 + e0] + r0, p1 = moetab[16 + e1] + tp[8 + e1] + r1;
                  for (int w = 0; w < wave; ++w) { p0 += wcn[w * 8 + e0]; p1 += wcn[w * 8 + e1]; }
                  lpos[tid * 2] = p0; lpos[tid * 2 + 1] = p1; posb[(size_t)(ck * 256 + tid) * 2] = p0; posb[(size_t)(ck * 256 + tid) * 2 + 1] = p1; }
              __syncthreads();
              { const int tb = wave * 32, tokb = ck * 256 + tb;
                u32x2 nx[2][4]; f32x4 nst[2];
#pragma unroll
                for (int q = 0; q < 2; ++q) { const u32x2* hr = (const u32x2*)(H + (size_t)(tokb + q) * DM) + (F8M ? 4 * lane : lane);
#pragma unroll
                    for (int k = 0; k < 4; ++k) nx[q][k] = hr[F8M ? k : 64 * k];
                    nst[q] = *(const f32x4*)(STAT + (size_t)(tokb + q) * 4); }
                for (int r = 0; r < 32; r += 2) {
                  u32x2 cu[2][4]; f32x4 cst[2];
#pragma unroll
                  for (int q = 0; q < 2; ++q) { cst[q] = nst[q];
#pragma unroll
                      for (int k = 0; k < 4; ++k) cu[q][k] = nx[q][k]; }
                  if (r + 2 < 32) {
#pragma unroll
                      for (int q = 0; q < 2; ++q) { const u32x2* hr = (const u32x2*)(H + (size_t)(tokb + r + 2 + q) * DM) + (F8M ? 4 * lane : lane);
#pragma unroll
                          for (int k = 0; k < 4; ++k) nx[q][k] = hr[F8M ? k : 64 * k];
                          nst[q] = *(const f32x4*)(STAT + (size_t)(tokb + r + 2 + q) * 4); } }
#pragma unroll
                  for (int q = 0; q < 2; ++q) { const int t = tb + r + q; const int p0 = lpos[t * 2], p1 = lpos[t * 2 + 1];
                      const f32x4 st4 = cst[q];
                      const float rstd = 1.0f / sqrtf(((st4.x + st4.y) + (st4.z + st4.w)) * (1.f / DM) + EPS);
                      if (F8M) { unsigned pk[4];
#pragma unroll
                          for (int k = 0; k < 4; ++k) { const u32x2 w = cu[q][k]; const f32x4 y = (f32x4){bf_lo(w.x), bf_hi(w.x), bf_lo(w.y), bf_hi(w.y)} * rstd * gv[k];
                              int ow = 0; ow = __builtin_amdgcn_cvt_pk_fp8_f32(y.x, y.y, ow, false); ow = __builtin_amdgcn_cvt_pk_fp8_f32(y.z, y.w, ow, true); pk[k] = (unsigned)ow; }
                          const u32x4 pw = {pk[0], pk[1], pk[2], pk[3]};
                          *((u32x4*)((unsigned char*)XS + (size_t)p0 * DM) + lane) = pw; *((u32x4*)((unsigned char*)XS + (size_t)p1 * DM) + lane) = pw; }
                      else { u32x2* o0 = (u32x2*)(XS + (size_t)p0 * DM) + lane; u32x2* o1 = (u32x2*)(XS + (size_t)p1 * DM) + lane;
#pragma unroll
                          for (int k = 0; k < 4; ++k) { const u32x2 w = cu[q][k]; const f32x4 y = (f32x4){bf_lo(w.x), bf_hi(w.x), bf_lo(w.y), bf_hi(w.y)} * rstd * gv[k];
                              u32x2 ow; ow.x = pk2(y.x, y.y); ow.y = pk2(y.z, y.w); o0[64 * k] = ow; o1[64 * k] = ow; } } }
                } }
              __syncthreads();
          } }
        xcd_barrier(bar);
        if (PH(15)) {
          if constexpr (F8M) { pg8::Gemm g{XS, (const bf16_t*)(wb + W_MGU), DM / 2, DM / 2, DM / 2}; pg8::GroupedOrder S; S.init(moetab, 2 * ED, G, bx, 128);
            pg8::EpiSwiGLU<true, 0, true> E{MACT, ED, nullptr, 0.f, 1.0f / W8_SCALE}; pg8::gemm_phase<pg8::EpiSwiGLU<true, 0, true>, pg8::GroupedOrder, true, true>(lds, g, S, E, bar.wv); }
          else { pg8::Gemm g{XS, (const bf16_t*)(wb + W_MGU), DM, DM, DM}; pg8::GroupedOrder S; S.init(moetab, 2 * ED, G, bx, 128);
            pg8::EpiSwiGLU<true, 0> E{MACT, ED, nullptr, 0.f, 1.f}; pg8::gemm_phase<pg8::EpiSwiGLU<true, 0>, pg8::GroupedOrder, true>(lds, g, S, E, bar.wv); } }
        xcd_barrier(bar);
        if (PH(16)) {
          if constexpr (F8M) { pg8::Gemm g{MACT, (const bf16_t*)(wb + W_MD), ED / 2, ED / 2, ED / 2}; pg8::GroupedOrder S; S.init(moetab, DM, G, bx, 256);
            if constexpr (Y8) { pg8::EpiF8<true> E{(unsigned char*)YS, DM, YS8_SCALE / W8_SCALE}; pg8::gemm_phase<pg8::EpiF8<true>, pg8::GroupedOrder, true, true>(lds, g, S, E, bar.wv); }
            else { pg8::EpiBf16<true, 0> E{YS, DM, nullptr, 0, 0.f, 1.0f / W8_SCALE}; pg8::gemm_phase<pg8::EpiBf16<true, 0>, pg8::GroupedOrder, true, true>(lds, g, S, E, bar.wv); } }
          else { pg8::Gemm g{MACT, (const bf16_t*)(wb + W_MD), ED, ED, ED}; pg8::GroupedOrder S; S.init(moetab, DM, G, bx, 256);
            pg8::EpiBf16<true, 0> E{XS, DM, nullptr, 0, 0.f, 1.f}; pg8::gemm_phase<pg8::EpiBf16<true, 0>, pg8::GroupedOrder, true>(lds, g, S, E, bar.wv); } }
        xcd_barrier(bar);
        if (PH(17)) { PHASE_IDS;
          f32x4 gv[4];
#pragma unroll
          for (int k = 0; k < 4; ++k) gv[k] = ((const f32x4*)(j == 0 ? args.in[1] + DM : args.in[22]))[lane + 64 * k];
          for (int m = gw; m < NTOK; m += NGW) {
              const int p0 = posb[(size_t)m * 2], p1 = posb[(size_t)m * 2 + 1]; const f32x2 gg = gate[m] * (Y8 ? RESID_SCALE / YS8_SCALE : RESID_SCALE);
              u32x2* hr = (u32x2*)(H + (size_t)m * DM) + lane;
              f32x4 v[4]; float ss = 0.f;
              if constexpr (Y8) { const unsigned* y0 = (const unsigned*)((const unsigned char*)YS + (size_t)p0 * DM) + lane; const unsigned* y1 = (const unsigned*)((const unsigned char*)YS + (size_t)p1 * DM) + lane;
#pragma unroll
                for (int k = 0; k < 4; ++k) { const unsigned a = y0[64 * k], b = y1[64 * k]; const u32x2 hw = hr[64 * k]; f32x4 hv = (f32x4){bf_lo(hw.x), bf_hi(hw.x), bf_lo(hw.y), bf_hi(hw.y)};
                  const auto al = __builtin_amdgcn_cvt_pk_f32_fp8((int)a, false), ah = __builtin_amdgcn_cvt_pk_f32_fp8((int)a, true), bl = __builtin_amdgcn_cvt_pk_f32_fp8((int)b, false), bh = __builtin_amdgcn_cvt_pk_f32_fp8((int)b, true);
                  hv.x += gg.x * al[0] + gg.y * bl[0]; hv.y += gg.x * al[1] + gg.y * bl[1]; hv.z += gg.x * ah[0] + gg.y * bh[0]; hv.w += gg.x * ah[1] + gg.y * bh[1];
                  v[k] = hv; ss += (hv.x * hv.x + hv.y * hv.y) + (hv.z * hv.z + hv.w * hv.w); } }
              else { const u32x2* y0 = (const u32x2*)(YS + (size_t)p0 * DM) + lane; const u32x2* y1 = (const u32x2*)(YS + (size_t)p1 * DM) + lane;
#pragma unroll
              for (int k = 0; k < 4; ++k) { const u32x2 a = y0[64 * k], b = y1[64 * k], hw = hr[64 * k]; f32x4 hv = (f32x4){bf_lo(hw.x), bf_hi(hw.x), bf_lo(hw.y), bf_hi(hw.y)};
                  hv.x += gg.x * bf_lo(a.x) + gg.y * bf_lo(b.x); hv.y += gg.x * bf_hi(a.x) + gg.y * bf_hi(b.x);
                  hv.z += gg.x * bf_lo(a.y) + gg.y * bf_lo(b.y); hv.w += gg.x * bf_hi(a.y) + gg.y * bf_hi(b.y);
                  v[k] = hv; ss += (hv.x * hv.x + hv.y * hv.y) + (hv.z * hv.z + hv.w * hv.w); } }
              if (!FINAL_DIRECT) {
#pragma unroll
                  for (int k = 0; k < 4; ++k) { u32x2 ow; ow.x = pk2(v[k].x, v[k].y); ow.y = pk2(v[k].z, v[k].w); hr[64 * k] = ow; } }
              if (j == 0 || FINAL_DIRECT) { const float rstd = 1.0f / sqrtf(wave_sum(ss, lane) * (1.f / DM) + EPS);
                  if (j == 0) { if (FP8_DOWN) { unsigned* o4 = (unsigned*)((unsigned char*)XN + (size_t)m * DM) + lane;
#pragma unroll
                      for (int k = 0; k < 4; ++k) { const f32x4 y = v[k] * rstd * gv[k]; int w = 0; w = __builtin_amdgcn_cvt_pk_fp8_f32(y.x, y.y, w, false); w = __builtin_amdgcn_cvt_pk_fp8_f32(y.z, y.w, w, true); o4[64 * k] = (unsigned)w; } }
                    else { u32x2* o8 = (u32x2*)(XN + (size_t)m * DM) + lane;
#pragma unroll
                      for (int k = 0; k < 4; ++k) { const f32x4 y = v[k] * rstd * gv[k]; u32x2 ow; ow.x = pk2(y.x, y.y); ow.y = pk2(y.z, y.w); o8[64 * k] = ow; } } }
                  else { f32x4* o = (f32x4*)(args.out + (size_t)m * DM) + lane;
#pragma unroll
                      for (int k = 0; k < 4; ++k) o[64 * k] = v[k] * rstd * gv[k]; } }
          } }
        if (j == 0 || !FINAL_DIRECT) xcd_barrier(bar);
        if (j == 1 && !FINAL_DIRECT && PH(18)) { PHASE_IDS; float* outp = args.out;
          f32x4 gv[4];
#pragma unroll
          for (int k = 0; k < 4; ++k) gv[k] = ((const f32x4*)args.in[22])[lane + 64 * k];
          for (int m = gw; m < NTOK; m += NGW) {
              const u32x2* hr = (const u32x2*)(H + (size_t)m * DM) + lane; f32x4 v[4]; float ss = 0.f;
#pragma unroll
              for (int k = 0; k < 4; ++k) { const u32x2 hw = hr[64 * k]; v[k] = (f32x4){bf_lo(hw.x), bf_hi(hw.x), bf_lo(hw.y), bf_hi(hw.y)}; ss += (v[k].x * v[k].x + v[k].y * v[k].y) + (v[k].z * v[k].z + v[k].w * v[k].w); }
              const float rstd = 1.0f / sqrtf(wave_sum(ss, lane) * (1.f / DM) + EPS);
              f32x4* o = (f32x4*)(outp + (size_t)m * DM) + lane;
#pragma unroll
              for (int k = 0; k < 4; ++k) o[64 * k] = v[k] * rstd * gv[k];
          } }
    }
}

__global__ void __launch_bounds__(NWAVES * 64, 2) fwd(Args args) {
    extern __shared__ __attribute__((aligned(16))) unsigned char lds_raw[];
    LAS unsigned char* lds = (LAS unsigned char*)lds_raw;
    const int G = gridDim.x, bx = blockIdx.x, vcu = (G % 8 == 0) ? (bx % 8) * (G / 8) + bx / 8 : bx;
    const int NGW = G * NWAVES;
    unsigned char* ws = args.ws;
    unsigned* ctl = (unsigned*)(ws + WS_CTL);
    const int wv0 = __builtin_amdgcn_readfirstlane((int)threadIdx.x >> 6);
    for (int u = opaque_tid(wv0); u < (LDS_BYTES - LDSCTL_OFF) / 4; u += NWAVES * 64) ((LAS unsigned*)(lds + LDSCTL_OFF))[u] = 0u;
    __syncthreads();
    volatile LAS unsigned* MISC = (volatile LAS unsigned*)(lds + MISC_OFF);
    XcdBarrier bar = xcd_barrier_post(ctl + 4096, MISC + 8, wv0);
    const float* x = args.in[0];
    bf16_t* XN = (bf16_t*)(ws + WS_ACT + A_XN);

    if (PH(0)) { PHASE_IDS;
        LAS float* scr = (LAS float*)(lds + wave * 16384);
        for (int j = 0; j < 2; ++j) {
            unsigned char* wb = ws + WS_W + (size_t)j * W_PAIR;
            if (FP8_DOWN) { transpose_matrix_f8<4>(args.in[2] + (size_t)j * DM * 576, DM, 576, wb + W_DQKV, 0, scr, gw, NGW, lane, W8_SCALE);
              for (int i = gw * 64 + lane; i < (DOWNP - 576) * DM / 16; i += NGW * 64) ((u32x4*)(wb + W_DQKV + (size_t)576 * DM))[i] = (u32x4){0u, 0u, 0u, 0u}; }
            else { transpose_matrix<4>(args.in[2] + (size_t)j * DM * 576, DM, 576, (bf16_t*)(wb + W_DQKV), 0, scr, gw, NGW, lane);
            for (int i = gw * 64 + lane; i < (DOWNP - 576) * DM / 8; i += NGW * 64) ((u32x4*)(wb + W_DQKV + (size_t)576 * DM * 2))[i] = (u32x4){0u, 0u, 0u, 0u}; }
            if (FP8_UP) {
            transpose_matrix_f8<3>(args.in[4] + (size_t)j * 256 * NQ, 256, NQ, wb + W_UQ, 0, scr, gw, NGW, lane, W8_SCALE, args.in[3] + j * 256);
            transpose_matrix_f8<0>(args.in[6] + (size_t)j * 256 * 1024, 256, 1024, wb + W_UKV, 0, scr, gw, NGW, lane, W8_SCALE, args.in[5] + j * 256);
            transpose_matrix_f8<0>(args.in[7] + (size_t)j * 256 * 1024, 256, 1024, wb + W_UKV, 1024, scr, gw, NGW, lane, W8_SCALE, args.in[5] + j * 256);
            } else {
            transpose_matrix<3>(args.in[4] + (size_t)j * 256 * NQ, 256, NQ, (bf16_t*)(wb + W_UQ), 0, scr, gw, NGW, lane, args.in[3] + j * 256);
            transpose_matrix<0>(args.in[6] + (size_t)j * 256 * 1024, 256, 1024, (bf16_t*)(wb + W_UKV), 0, scr, gw, NGW, lane, args.in[5] + j * 256);
            transpose_matrix<0>(args.in[7] + (size_t)j * 256 * 1024, 256, 1024, (bf16_t*)(wb + W_UKV), 1024, scr, gw, NGW, lane, args.in[5] + j * 256);
            }
            if (FP8_ATTO) transpose_matrix_f8<0>(args.in[8] + (size_t)j * DM * DM, DM, DM, wb + W_MO, 0, scr, gw, NGW, lane, W8_SCALE);
            else transpose_matrix<0>(args.in[8] + (size_t)j * DM * DM, DM, DM, (bf16_t*)(wb + W_MO), 0, scr, gw, NGW, lane);
            if ((FP8_S2 >> j) & 1) transpose_matrix_f8<0>(args.in[10] + (size_t)j * DM * SWA_NQKV, DM, SWA_NQKV, wb + W_SQKV, 0, scr, gw, NGW, lane, W8_SCALE, args.in[9] + j * DM);
            else transpose_matrix<0>(args.in[10] + (size_t)j * DM * SWA_NQKV, DM, SWA_NQKV, (bf16_t*)(wb + W_SQKV), 0, scr, gw, NGW, lane, args.in[9] + j * DM);
            if (FP8_ATTO) transpose_matrix_f8<0>(args.in[12] + (size_t)j * DM * DM, DM, DM, wb + W_SO, 0, scr, gw, NGW, lane, W8_SCALE);
            else transpose_matrix<0>(args.in[12] + (size_t)j * DM * DM, DM, DM, (bf16_t*)(wb + W_SO), 0, scr, gw, NGW, lane);
            if ((FP8_FFN >> j) & 1) {
            transpose_matrix_f8<1>(args.in[14] + (size_t)j * DM * FFN, DM, FFN, wb + W_FGU, 0, scr, gw, NGW, lane, W8_SCALE, args.in[13] + j * DM);
            transpose_matrix_f8<2>(args.in[15] + (size_t)j * DM * FFN, DM, FFN, wb + W_FGU, 0, scr, gw, NGW, lane, W8_SCALE, args.in[13] + j * DM);
            transpose_matrix_f8<0>(args.in[16] + (size_t)j * FFN * DM, FFN, DM, wb + W_FD, 0, scr, gw, NGW, lane, W8_SCALE);
            } else {
            transpose_matrix<1>(args.in[14] + (size_t)j * DM * FFN, DM, FFN, (bf16_t*)(wb + W_FGU), 0, scr, gw, NGW, lane, args.in[13] + j * DM);
            transpose_matrix<2>(args.in[15] + (size_t)j * DM * FFN, DM, FFN, (bf16_t*)(wb + W_FGU), 0, scr, gw, NGW, lane, args.in[13] + j * DM);
            transpose_matrix<0>(args.in[16] + (size_t)j * FFN * DM, FFN, DM, (bf16_t*)(wb + W_FD), 0, scr, gw, NGW, lane);
            }
            for (int e = 0; e < NE; ++e) {
                if ((FP8_MOE >> j) & 1) {
                    transpose_matrix_f8<1>(args.in[19] + ((size_t)j * NE + e) * DM * ED, DM, ED, wb + W_MGU, e * 2 * ED, scr, gw, NGW, lane, W8_SCALE);
                    transpose_matrix_f8<2>(args.in[20] + ((size_t)j * NE + e) * DM * ED, DM, ED, wb + W_MGU, e * 2 * ED, scr, gw, NGW, lane, W8_SCALE);
                    transpose_matrix_f8<0>(args.in[21] + ((size_t)j * NE + e) * ED * DM, ED, DM, wb + W_MD, e * DM, scr, gw, NGW, lane, W8_SCALE);
                } else {
                transpose_matrix<1>(args.in[19] + ((size_t)j * NE + e) * DM * ED, DM, ED, (bf16_t*)(wb + W_MGU), e * 2 * ED, scr, gw, NGW, lane);
                transpose_matrix<2>(args.in[20] + ((size_t)j * NE + e) * DM * ED, DM, ED, (bf16_t*)(wb + W_MGU), e * 2 * ED, scr, gw, NGW, lane);
                transpose_matrix<0>(args.in[21] + ((size_t)j * NE + e) * ED * DM, ED, DM, (bf16_t*)(wb + W_MD), e * DM, scr, gw, NGW, lane);
                }
            }
        }
        f32x4 gv[4];
#pragma unroll
        for (int j = 0; j < 4; ++j) gv[j] = ((const f32x4*)args.in[1])[lane + 64 * j];
        for (int m = gw; m < NTOK; m += NGW) rms_row_to_bf16<FP8_DOWN != 0>(x + (size_t)m * DM, gv, FP8_DOWN ? (bf16_t*)((unsigned char*)XN + (size_t)m * DM) : XN + (size_t)m * DM, lane);
    }
    xcd_barrier(bar);

    pair_body<0>(args, lds, bar, G, bx, vcu);
    pair_body<1>(args, lds, bar, G, bx, vcu);
}

extern "C" void kernel_launch(void* const* d_in, const int* in_sizes, int n_in, void* d_out, int out_size, void* d_ws, size_t ws_size, hipStream_t stream) {
    static int grid = 0;
    if (grid == 0) {
        if (n_in != 23 || out_size != NTOK * DM || ws_size < WS_NEED) { fprintf(stderr, "kernel_launch: shape/workspace mismatch (n_in %d out %d ws %zu need %zu)\n", n_in, out_size, ws_size, (size_t)WS_NEED); grid = -1; return; }
        int dev = 0, cus = 0;
        if (hipGetDevice(&dev) != hipSuccess || hipDeviceGetAttribute(&cus, hipDeviceAttributeMultiprocessorCount, dev) != hipSuccess) { grid = -1; return; }
        if (hipFuncSetAttribute((const void*)fwd, hipFuncAttributeMaxDynamicSharedMemorySize, LDS_BYTES) != hipSuccess) { fprintf(stderr, "kernel_launch: hipFuncSetAttribute failed\n"); grid = -1; return; }
        int per_cu = 0;
        if (hipOccupancyMaxActiveBlocksPerMultiprocessor(&per_cu, (const void*)fwd, NWAVES * 64, LDS_BYTES) != hipSuccess || per_cu < 1) fprintf(stderr, "kernel_launch: occupancy query reports %d\n", per_cu);
        (void)hipGetLastError();
        grid = cus;
    }
    if (grid < 0) return;
    if (hipMemsetAsync((char*)d_ws + WS_CTL, 0, CTL_ZERO_BYTES, stream) != hipSuccess) return;
    Args a{};
    for (int i = 0; i < 23; ++i) a.in[i] = (const float*)d_in[i];
    a.out = (float*)d_out; a.ws = (unsigned char*)d_ws;
    hipLaunchKernelGGL(fwd, dim3(grid), dim3(NWAVES * 64), LDS_BYTES, stream, a);
    const hipError_t le = hipPeekAtLastError();
    if (le != hipSuccess) fprintf(stderr, "kernel_launch: launch failed: %s\n", hipGetErrorName(le));
}
```

```cpp
#include <hip/hip_runtime.h>
#include <hip/hip_bf16.h>
#include <cstdio>
#include <cstdint>

#define LAS __attribute__((address_space(3)))
#define GAS __attribute__((address_space(1)))
typedef unsigned short bf16_t;
typedef short bf16x8 __attribute__((ext_vector_type(8)));
typedef short s16x4 __attribute__((ext_vector_type(4)));
typedef float f32x4 __attribute__((ext_vector_type(4)));
typedef float f32x2 __attribute__((ext_vector_type(2)));
typedef float f32x16 __attribute__((ext_vector_type(16)));
typedef unsigned u32x4 __attribute__((ext_vector_type(4)));
typedef unsigned u32x2 __attribute__((ext_vector_type(2)));
typedef int i32x4 __attribute__((ext_vector_type(4)));
typedef int i32x8 __attribute__((ext_vector_type(8)));

constexpr int DM = 1024, BATCH = 32, SEQ = 2048, NTOK = BATCH * SEQ;
constexpr int MLA_H = 8, QKD = 192, DOWNP = 768;
constexpr int NQ = MLA_H * QKD  , NKV = 2048;
constexpr int SWA_NQKV = 1536;
constexpr int FFN = 2816, NE = 8, ED = 2048;
constexpr int NPAIR = NTOK * 2;
constexpr float EPS = 1e-6f;
constexpr float LOG2E = 1.4426950408889634f;
#ifndef PHMASK
#define PHMASK 0xFFFFFFFFu
#endif
#define PH(k) (((PHMASK) >> (k)) & 1u)
#define RESID_SCALE 1.0f
#ifndef FP8_MOE
#define FP8_MOE 3
#endif
#ifndef FP8_YS
#define FP8_YS 3
#endif
#ifndef FP8_S2
#define FP8_S2 2
#endif
#ifndef FP8_FFN
#define FP8_FFN 2
#endif
#ifndef FP8_ATTO
#define FP8_ATTO 1
#endif
#ifndef FP8_QK
#define FP8_QK 1
#endif
#ifndef FP8_PV
#define FP8_PV 1
#endif
#ifndef FP8_UP
#define FP8_UP 1
#endif
#ifndef FP8_DOWN
#define FP8_DOWN 1
#endif
constexpr float W8_SCALE = 32.0f, O8_SCALE = 64.0f;
constexpr float YS8_SCALE = 16.0f;

constexpr size_t MiB = 1u << 20;
constexpr size_t WS_CTL = 0, CTL_ZERO_BYTES = 1 * MiB;
constexpr size_t WS_ROPE = 1 * MiB;
constexpr size_t WS_ROUTE = 2 * MiB;
constexpr size_t WS_GATE = 3 * MiB;
constexpr size_t WS_POS = 4 * MiB;
constexpr size_t WS_CNT = 5 * MiB;
constexpr size_t WS_W = 6 * MiB;
constexpr size_t W_DQKV = 0;
constexpr size_t W_UQ = W_DQKV + (size_t)DOWNP * DM * 2;
constexpr size_t W_UKV = W_UQ + (size_t)NQ * 256 * 2;
constexpr size_t W_MO = W_UKV + (size_t)NKV * 256 * 2;
constexpr size_t W_SQKV = W_MO + (size_t)DM * DM * 2;
constexpr size_t W_SO = W_SQKV + (size_t)SWA_NQKV * DM * 2;
constexpr size_t W_FGU = W_SO + (size_t)DM * DM * 2;
constexpr size_t W_FD = W_FGU + (size_t)2 * FFN * DM * 2;
constexpr size_t W_MGU = W_FD + (size_t)DM * FFN * 2;
constexpr size_t W_MD = W_MGU + (size_t)NE * 2 * ED * DM * 2;
constexpr size_t W_PAIR = W_MD + (size_t)NE * DM * ED * 2;
constexpr size_t WS_ACT = 254 * MiB;
static_assert(WS_W + 2 * W_PAIR <= WS_ACT, "weights fit");
constexpr size_t A_H = 0;
constexpr size_t A_XN = 128 * MiB;
constexpr size_t A_DOWN = 256 * MiB;
constexpr size_t A_Q = 352 * MiB;
constexpr size_t A_K8 = 448 * MiB;
constexpr size_t A_KR8 = 512 * MiB;
constexpr size_t A_FACT = 128 * MiB;
constexpr size_t A_SQKV = 128 * MiB;
constexpr size_t A_SO = 320 * MiB;
constexpr size_t A_MACT = 128 * MiB;
constexpr size_t A_YS = 384 * MiB;
constexpr size_t A_H8 = 480 * MiB;
constexpr size_t A_STAT = 768 * MiB;
constexpr size_t WS_NEED = WS_ACT + 770 * MiB;
static_assert(WS_NEED <= 1024 * MiB, "ws");

constexpr int RING_BYTES = 147456;
constexpr int LDSCTL_OFF = RING_BYTES;
constexpr int MISC_OFF = LDSCTL_OFF + 320;
constexpr int PART_OFF = LDSCTL_OFF + 2048;
constexpr int MOETAB_OFF = LDSCTL_OFF + 1024;
constexpr int LDS_BYTES = 163840;

#define RLX_AGENT __ATOMIC_RELAXED, __HIP_MEMORY_SCOPE_AGENT
#define LDS_WAIT() asm volatile("s_waitcnt lgkmcnt(0)" ::: "memory")
#define VM_WAIT() asm volatile("s_waitcnt vmcnt(0)" ::: "memory")
#define SBAR() __builtin_amdgcn_sched_barrier(0)
__device__ __forceinline__ unsigned f2bf(float f) { unsigned u = __builtin_bit_cast(unsigned, f); return (u + 0x7fffu + ((u >> 16) & 1u)) >> 16; }
__device__ __forceinline__ unsigned pk2(float lo, float hi) { return f2bf(lo) | (f2bf(hi) << 16); }
__device__ __forceinline__ unsigned cvt_pk_bf16(float lo, float hi) { unsigned r; asm volatile("v_cvt_pk_bf16_f32 %0, %1, %2" : "=v"(r) : "v"(lo), "v"(hi)); return r; }
__device__ __forceinline__ u32x2 pk8_fp8(const float (&o)[8]) { int w0 = 0, w1 = 0;
    w0 = __builtin_amdgcn_cvt_pk_fp8_f32(o[0], o[1], w0, false); w0 = __builtin_amdgcn_cvt_pk_fp8_f32(o[2], o[3], w0, true);
    w1 = __builtin_amdgcn_cvt_pk_fp8_f32(o[4], o[5], w1, false); w1 = __builtin_amdgcn_cvt_pk_fp8_f32(o[6], o[7], w1, true);
    u32x2 r; r.x = (unsigned)w0; r.y = (unsigned)w1; return r; }
__device__ __forceinline__ unsigned fp8_1(float v) { return (unsigned)__builtin_amdgcn_cvt_pk_fp8_f32(v, v, 0, false) & 0xffu; }
__device__ __forceinline__ float bf_lo(unsigned w) { return __builtin_bit_cast(float, w << 16); }
__device__ __forceinline__ float bf_hi(unsigned w) { return __builtin_bit_cast(float, w & 0xffff0000u); }
__device__ __forceinline__ int opaque_tid(int wv) { int l; asm volatile("v_mbcnt_lo_u32_b32 %0, -1, 0\n\tv_mbcnt_hi_u32_b32 %0, -1, %0" : "=v"(l)); return wv * 64 + l; }
__device__ __forceinline__ int opaque_lane() { int l; asm volatile("v_mbcnt_lo_u32_b32 %0, -1, 0\n\tv_mbcnt_hi_u32_b32 %0, -1, %0" : "=v"(l)); return l; }
__device__ __forceinline__ void glds16_s(const void* sbase, unsigned voff, unsigned lds_dst) {
    unsigned keep;
    asm volatile("s_mov_b32 %0, m0\n\ts_mov_b32 m0, %3\n\ts_nop 0\n\tglobal_load_lds_dwordx4 %1, %2\n\ts_mov_b32 m0, %0" : "=&s"(keep) : "v"(voff), "s"(sbase), "s"(lds_dst) : "memory");
}
__device__ __forceinline__ float shx(float v, int o, int lane) { return __builtin_bit_cast(float, __builtin_amdgcn_ds_bpermute((lane ^ o) << 2, __builtin_bit_cast(int, v))); }
__device__ __forceinline__ int shxi(int v, int o, int lane) { return __builtin_amdgcn_ds_bpermute((lane ^ o) << 2, v); }
__device__ __forceinline__ float wave_sum(float v, int lane) {
#pragma unroll
    for (int o = 1; o < 64; o <<= 1) v += shx(v, o, lane);
    return v;
}

#define XB_TMO      128
#define XB_XCNT(j)  (256  + 64 * (j))
#define XB_XSUB(j)  (1280 + 64 * (j))
#define XB_XGEN(j)  (2304 + 64 * (j))
#define XB_TOP      3328
#define XB_TOPGEN   3392
#define XCD_BAR_WORDS 3456
#define XB_SPIN_CAP (1u << 18)
__device__ __forceinline__ unsigned xb_ld(unsigned* p)              { return __hip_atomic_load(p, __ATOMIC_RELAXED, __HIP_MEMORY_SCOPE_AGENT); }
__device__ __forceinline__ unsigned xb_add(unsigned* p, unsigned v) { return __hip_atomic_fetch_add(p, v, __ATOMIC_RELAXED, __HIP_MEMORY_SCOPE_AGENT); }
__device__ __forceinline__ unsigned xb_xcc_id() { return (unsigned)__builtin_amdgcn_s_getreg((3 << 11) | 20) & 0xFu; }
#define XB_SPIN(cond, bar) do { unsigned _sp = 0; while (cond) { __builtin_amdgcn_s_sleep(1); \
    if ((++_sp & 255u) == 0u) { if (xb_ld(&(bar)[XB_TMO])) break; if (_sp > XB_SPIN_CAP) { atomicAdd(&(bar)[XB_TMO], 1u); break; } } } } while (0)
struct XcdBarrier { unsigned* bar; unsigned x; volatile LAS unsigned* st; int wv; };
__device__ __forceinline__ XcdBarrier xcd_barrier_post(unsigned* bar, volatile LAS unsigned* st, int wv) {
    XcdBarrier b; b.bar = bar; b.x = xb_xcc_id(); b.st = st; b.wv = wv;
    if (opaque_tid(wv) == 0) (void)xb_add(&bar[XB_XCNT(b.x)], 1u);
    return b;
}
__device__ __forceinline__ void xcd_barrier_complete(unsigned* bar, unsigned x, unsigned& nloc, unsigned& nx) {
    const unsigned G = gridDim.x * gridDim.y * gridDim.z;
    unsigned sum, cnt, mine, sp = 0u;
    for (;;) {
        sum = 0u; cnt = 0u; mine = 0u;
#pragma unroll
        for (unsigned j = 0; j < 16; ++j) { const unsigned c = xb_ld(&bar[XB_XCNT(j)]); sum += c; cnt += (c > 0u) ? 1u : 0u; mine = (j == x) ? c : mine; }
        if (sum == G) break;
        __builtin_amdgcn_s_sleep(1);
        if ((++sp & 255u) == 0u) { if (xb_ld(&bar[XB_TMO])) break; if (sp > XB_SPIN_CAP) { atomicAdd(&bar[XB_TMO], 1u); break; } }
    }
    nloc = mine > 0u ? mine : 1u; nx = cnt > 0u ? cnt : 1u;
}
__device__ __forceinline__ void xcd_barrier(const XcdBarrier& b) {
    asm volatile("s_waitcnt vmcnt(0)" ::: "memory");
    __syncthreads();
    if (opaque_tid(b.wv) == 0) {
        unsigned* bar = b.bar;
        __builtin_amdgcn_s_waitcnt(0);
        unsigned nloc = b.st[0], nx = b.st[1];
        if (nloc == 0u) { xcd_barrier_complete(bar, b.x, nloc, nx); b.st[0] = nloc; b.st[1] = nx; }
        const unsigned old = xb_add(&bar[XB_XSUB(b.x)], 1u);
        const unsigned gen = old / nloc;
        if (old + 1u == (gen + 1u) * nloc) {
            __builtin_amdgcn_fence(__ATOMIC_RELEASE, "agent");
            asm volatile("s_waitcnt vmcnt(0)" ::: "memory");
            const unsigned og = xb_add(&bar[XB_TOP], 1u);
            const unsigned tg = og / nx;
            if (og + 1u == (tg + 1u) * nx) xb_add(&bar[XB_TOPGEN], 1u);
            else XB_SPIN(xb_ld(&bar[XB_TOPGEN]) == tg, bar);
            __builtin_amdgcn_fence(__ATOMIC_ACQUIRE, "agent");
            xb_add(&bar[XB_XGEN(b.x)], 1u);
            asm volatile("s_waitcnt vmcnt(0)" ::: "memory");
        } else {
            XB_SPIN(xb_ld(&bar[XB_XGEN(b.x)]) == gen, bar);
            __builtin_amdgcn_fence(__ATOMIC_ACQUIRE, "agent");
            asm volatile("s_waitcnt vmcnt(0)" ::: "memory");
        }
    }
    __syncthreads();
}

namespace pg8 {
constexpr int BM = 256, BK = 64, HALF = 128, HTB = HALF * BK * 2, STAGE_BYTES = 8 * HTB, NXCD = 8, WGM = 8;
__host__ __device__ __forceinline__ int lds_byte(int r, int c) { const int st = (r >> 4) * 2 + (c >> 5), rr = r & 15, cc = c & 31, ob = rr * 64 + cc * 2; return st * 1024 + (ob ^ (((ob >> 9) & 1) << 5)); }
__host__ __device__ __forceinline__ void stage_rc(int b, int& R, int& C) { const int st = b / 1024, sb = b % 1024, swz = sb ^ (((sb >> 9) & 1) << 5); R = (st >> 1) * 16 + swz / 64; C = (st & 1) * 32 + (swz % 64) / 2; }
__host__ __device__ __forceinline__ int perm32(int rho) { const int n = rho >> 4, i = rho & 15; return 8 * (i >> 2) + 4 * n + (i & 3); }

struct Unit { int arow, brow, col, nvalid, nlo; };
struct Gemm { const bf16_t* A; const bf16_t* Bt; int lda, ldb, K; };

struct DenseOrder {
    int nM, nN, nwg, G, c, colw;
    __device__ void init(int M, int N, int G_, int c_, int colw_) { nM = M / BM; nN = N / BM; nwg = nM * nN; G = G_; c = c_; colw = colw_; }
    __device__ __forceinline__ bool next(int i, Unit& u) const {
        const long L = (long)i * G + c; if (L >= nwg) return false;
        int wgid = (int)L; { const int q = nwg / NXCD, r = nwg % NXCD, xcd = wgid % NXCD, off = wgid / NXCD; wgid = (xcd < r ? xcd * (q + 1) : r * (q + 1) + (xcd - r) * q) + off; }
        const int nig = WGM * nN, gid = wgid / nig, fm = gid * WGM, gsz = (nM - fm) < WGM ? (nM - fm) : WGM;
        const int pm = fm + ((wgid % nig) % gsz), pn = (wgid % nig) / gsz;
        u.arow = pm * BM; u.brow = pn * BM; u.col = pn * colw; u.nvalid = BM; u.nlo = 0; return true;
    }
};
struct GroupedOrder {
    int nM, nN, nwg, G, c, colw, erows; const LAS int* tab;
    __device__ void init(const LAS int* tab_, int N, int G_, int c_, int colw_) { tab = tab_; nM = tab_[8]; nN = N / BM; nwg = nM * nN; G = G_; c = c_; colw = colw_; erows = N; }
    __device__ __forceinline__ bool next(int i, Unit& u) const {
        const long L = (long)i * G + c; if (L >= nwg) return false;
        int wgid = (int)L; { const int q = nwg / NXCD, r = nwg % NXCD, xcd = wgid % NXCD, off = wgid / NXCD; wgid = (xcd < r ? xcd * (q + 1) : r * (q + 1) + (xcd - r) * q) + off; }
        const int nig = WGM * nN, gid = wgid / nig, fm = gid * WGM, gsz = (nM - fm) < WGM ? (nM - fm) : WGM;
        const int T = fm + ((wgid % nig) % gsz), pn = (wgid % nig) / gsz;
        int e = 0;
#pragma unroll
        for (int k = 1; k < 8; ++k) e += (T >= tab[k]) ? 1 : 0;
        const int lt = T - tab[e]; int arow = tab[16 + e] + lt * BM; int nv = tab[16 + e + 1] - arow; nv = nv > BM ? BM : nv;
        int lo = 0; { const int over = arow + BM - tab[24]; if (over > 0) { arow -= over; lo = over; nv += over; } }
        u.arow = __builtin_amdgcn_readfirstlane(arow); u.nvalid = __builtin_amdgcn_readfirstlane(nv); u.nlo = __builtin_amdgcn_readfirstlane(lo);
        u.brow = __builtin_amdgcn_readfirstlane(e * erows + pn * BM); u.col = __builtin_amdgcn_readfirstlane(pn * colw); return true;
    }
};

__device__ __forceinline__ u32x4 widen16(u32x2 a, u32x2 b) {
    auto r0 = __builtin_amdgcn_permlane16_swap(a.x, b.x, false, false); auto r1 = __builtin_amdgcn_permlane16_swap(a.y, b.y, false, false);
    return (u32x4){r0[0], r1[0], r0[1], r1[1]};
}
template <int NS> __device__ __forceinline__ float row_rstd(const float* stat, int row, int slot0, float inv_n) {
    float s;
    if (NS == 4) { const f32x4 a = *(const f32x4*)(stat + (size_t)row * 4); s = (a.x + a.y) + (a.z + a.w); }
    else s = stat[(size_t)row * 4 + slot0];
    return __builtin_amdgcn_rsqf(s + EPS / inv_n) * __builtin_sqrtf(1.0f / inv_n);
}
template <int NS> __device__ __forceinline__ void row_rstd8(float (&rs)[2][4], const float* stat, int row0, int slot0, float inv_n) {
#pragma unroll
    for (int ai = 0; ai < 2; ++ai)
#pragma unroll
        for (int m = 0; m < 4; ++m) rs[ai][m] = NS ? row_rstd<NS ? NS : 1>(stat, row0 + ai * HALF + m * 16, slot0, inv_n) : 1.f;
}
__device__ __forceinline__ void stat_combine(LAS float* part, float* stat, const Unit& u, int slot, int wr, int wc, int fr, int fq) {
    asm volatile("s_waitcnt lgkmcnt(0)" ::: "memory"); __builtin_amdgcn_s_barrier(); asm volatile("" ::: "memory");
    const int t = (wr * 4 + wc) * 64 + fq * 16 + fr;
    if (t < 256) { const float sum = (part[t] + part[256 + t]) + (part[512 + t] + part[768 + t]); stat[(size_t)(u.arow + t) * 4 + slot] = sum; }
}
template <bool MASK, int NS> struct EpiBf16 {
    static constexpr bool PERM = true; static constexpr int NST = 16;
    __device__ __forceinline__ bool full(const Unit& u) const { return !MASK || (u.nvalid == BM && u.nlo == 0); }
    bf16_t* O; int ldc; const float* stat; int slot0; float inv_n; float oscale; int qcols = 0; float qscale = 1.f;
    __device__ __forceinline__ void operator()(const f32x4 (&acc)[2][2][4][2], const Unit& u, int wr, int wc, int fr, int fq) const {
        const int col0 = u.col + wc * 32 + 8 * fq; const float osc = u.col < qcols ? oscale * qscale : oscale;
        float rs[2][4]; row_rstd8<NS>(rs, stat, u.arow + wr * 64 + fr, slot0, inv_n);
#pragma unroll
        for (int ai = 0; ai < 2; ++ai)
#pragma unroll
            for (int m = 0; m < 4; ++m) { const int rl = ai * HALF + wr * 64 + m * 16 + fr; if (MASK && (rl >= u.nvalid || rl < u.nlo)) continue;
                const float r = rs[ai][m] * osc;
                bf16_t* rowp = O + (size_t)(u.arow + rl) * ldc + col0;
#pragma unroll
                for (int bj = 0; bj < 2; ++bj) { const f32x4 v0 = acc[ai][bj][m][0] * r, v1 = acc[ai][bj][m][1] * r;
                    u32x4 w; w.x = cvt_pk_bf16(v0[0], v0[1]); w.y = cvt_pk_bf16(v0[2], v0[3]); w.z = cvt_pk_bf16(v1[0], v1[1]); w.w = cvt_pk_bf16(v1[2], v1[3]);
                    *(u32x4*)(rowp + bj * HALF) = w; } }
    }
};
template <bool MASK> struct EpiF8 {
    static constexpr bool PERM = true; static constexpr int NST = 8;
    __device__ __forceinline__ bool full(const Unit& u) const { return !MASK || (u.nvalid == BM && u.nlo == 0); }
    unsigned char* O; int ldc; float oscale;
    __device__ __forceinline__ void operator()(const f32x4 (&acc)[2][2][4][2], const Unit& u, int wr, int wc, int fr, int fq) const {
        const int col0 = u.col + wc * 32 + 8 * fq, odd = fq & 1;
#pragma unroll
        for (int ai = 0; ai < 2; ++ai)
#pragma unroll
            for (int mp = 0; mp < 2; ++mp) { const int rl = ai * HALF + wr * 64 + (2 * mp + odd) * 16 + fr;
                unsigned char* rowp = O + (size_t)(u.arow + rl) * ldc + col0 - 8 * odd; const bool ok = !MASK || (rl < u.nvalid && rl >= u.nlo);
#pragma unroll
                for (int bj = 0; bj < 2; ++bj) { const f32x4 a0 = acc[ai][bj][2 * mp][0] * oscale, a1 = acc[ai][bj][2 * mp][1] * oscale, b0 = acc[ai][bj][2 * mp + 1][0] * oscale, b1 = acc[ai][bj][2 * mp + 1][1] * oscale;
                    const float oa[8] = {a0[0], a0[1], a0[2], a0[3], a1[0], a1[1], a1[2], a1[3]}, ob[8] = {b0[0], b0[1], b0[2], b0[3], b1[0], b1[1], b1[2], b1[3]};
                    const u32x4 w = widen16(pk8_fp8(oa), pk8_fp8(ob));
                    if (ok) *(u32x4*)(rowp + bj * HALF) = w; } }
    }
};
struct EpiKV8 {
    static constexpr bool PERM = true; static constexpr int NST = 8;
    __device__ __forceinline__ bool full(const Unit&) const { return true; }
    bf16_t* KV; unsigned char* k8; const float* stat; float oscale;
    __device__ __forceinline__ void operator()(const f32x4 (&acc)[2][2][4][2], const Unit& u, int wr, int wc, int fr, int fq) const {
        const int col0 = u.col + wc * 32 + 8 * fq;
        float rs[2][4]; row_rstd8<1>(rs, stat, u.arow + wr * 64 + fr, 1, 1.f / 256.f);
        if (u.col < 1024) {
#pragma unroll
            for (int ai = 0; ai < 2; ++ai)
#pragma unroll
                for (int mp = 0; mp < 2; ++mp) { const int odd = fq & 1; const float ra = rs[ai][2 * mp] * oscale, rb = rs[ai][2 * mp + 1] * oscale;
                    unsigned char* rowp = k8 + (size_t)(u.arow + ai * HALF + wr * 64 + (2 * mp + odd) * 16 + fr) * 1024 + col0 - 8 * odd;
#pragma unroll
                    for (int bj = 0; bj < 2; ++bj) { const f32x4 a0 = acc[ai][bj][2 * mp][0] * ra, a1 = acc[ai][bj][2 * mp][1] * ra, b0 = acc[ai][bj][2 * mp + 1][0] * rb, b1 = acc[ai][bj][2 * mp + 1][1] * rb;
                        const float oa[8] = {a0[0], a0[1], a0[2], a0[3], a1[0], a1[1], a1[2], a1[3]}, ob[8] = {b0[0], b0[1], b0[2], b0[3], b1[0], b1[1], b1[2], b1[3]};
                        *(u32x4*)(rowp + bj * HALF) = widen16(pk8_fp8(oa), pk8_fp8(ob)); } }
        } else {
#pragma unroll
            for (int ai = 0; ai < 2; ++ai)
#pragma unroll
                for (int m = 0; m < 4; ++m) { const float r = rs[ai][m] * oscale; bf16_t* rowp = KV + (size_t)(u.arow + ai * HALF + wr * 64 + m * 16 + fr) * NKV + col0;
#pragma unroll
                    for (int bj = 0; bj < 2; ++bj) { const f32x4 v0 = acc[ai][bj][m][0] * r, v1 = acc[ai][bj][m][1] * r;
                        u32x4 w; w.x = cvt_pk_bf16(v0[0], v0[1]); w.y = cvt_pk_bf16(v0[2], v0[3]); w.z = cvt_pk_bf16(v1[0], v1[1]); w.w = cvt_pk_bf16(v1[2], v1[3]);
                        *(u32x4*)(rowp + bj * HALF) = w; } }
        }
    }
};
struct EpiVT8 {
    static constexpr bool PERM = true; static constexpr int NST = 8;
    __device__ __forceinline__ bool full(const Unit&) const { return true; }
    unsigned char* vt; const float* stat; float oscale;
    __device__ __forceinline__ void operator()(const f32x4 (&acc)[2][2][4][2], const Unit& u, int wr, int wc, int fr, int fq) const {
        const int t0 = u.col + wc * 32 + 8 * fq;
        f32x4 rs[2][2];
#pragma unroll
        for (int bj = 0; bj < 2; ++bj)
#pragma unroll
            for (int n = 0; n < 2; ++n)
#pragma unroll
                for (int k = 0; k < 4; ++k) rs[bj][n][k] = stat[(size_t)(t0 + bj * HALF + 4 * n + k) * 4 + 1];
#pragma unroll
        for (int bj = 0; bj < 2; ++bj)
#pragma unroll
            for (int n = 0; n < 2; ++n)
#pragma unroll
                for (int k = 0; k < 4; ++k) rs[bj][n][k] = __builtin_amdgcn_rsqf(rs[bj][n][k] * (1.f / 256.f) + EPS) * oscale;
#pragma unroll
        for (int bj = 0; bj < 2; ++bj) { const int tw = u.col + bj * HALF + wc * 32, base = (tw & ~63) + 16 * (wc & 1);
#pragma unroll
            for (int ai = 0; ai < 2; ++ai) { unsigned char* p = vt + (size_t)(u.arow + ai * HALF + wr * 64 + fq * 16 + fr) * NTOK + base;
#pragma unroll
                for (int n = 0; n < 2; ++n) { unsigned w[4];
#pragma unroll
                    for (int m = 0; m < 4; ++m) { const f32x4 v = acc[ai][bj][m][n] * rs[bj][n];
                        int x = 0; x = __builtin_amdgcn_cvt_pk_fp8_f32(v[0], v[1], x, false); x = __builtin_amdgcn_cvt_pk_fp8_f32(v[2], v[3], x, true); w[m] = (unsigned)x; }
                    auto x01 = __builtin_amdgcn_permlane16_swap(w[0], w[1], false, false); auto x23 = __builtin_amdgcn_permlane16_swap(w[2], w[3], false, false);
                    auto s0 = __builtin_amdgcn_permlane32_swap(x01[0], x23[0], false, false); auto s1 = __builtin_amdgcn_permlane32_swap(x01[1], x23[1], false, false);
                    *(u32x4*)(p + 32 * n) = (u32x4){s0[0], s1[0], s0[1], s1[1]}; } } }
    }
};
template <bool MASK, int NS, bool F8OUT = false> struct EpiSwiGLU {
    static constexpr bool PERM = true; static constexpr int NST = F8OUT ? 4 : 8;
    __device__ __forceinline__ bool full(const Unit& u) const { return !MASK || (u.nvalid == BM && u.nlo == 0); }
    bf16_t* O; int ldc; const float* stat; float inv_n; float oscale;
    __device__ __forceinline__ void row8(float (&o)[8], const f32x4 (&acc)[2][2][4][2], int ai, int m, float r) const {
        const float rL = -r * LOG2E, c = __builtin_amdgcn_rcpf(r * r);
#pragma unroll
        for (int n = 0; n < 2; ++n)
#pragma unroll
            for (int k = 0; k < 4; ++k) { const float ag = acc[ai][0][m][n][k], au = acc[ai][1][m][n][k];
                o[n * 4 + k] = (ag * au) * __builtin_amdgcn_rcpf(fmaf(__builtin_amdgcn_exp2f(ag * rL), c, c)); }
    }
    __device__ __forceinline__ void operator()(const f32x4 (&acc)[2][2][4][2], const Unit& u, int wr, int wc, int fr, int fq) const {
        const int col0 = u.col + wc * 32 + 8 * fq;
        float rs[2][4]; row_rstd8<NS>(rs, stat, u.arow + wr * 64 + fr, 0, inv_n);
        if constexpr (F8OUT) {
            const int odd = fq & 1;
#pragma unroll
            for (int ai = 0; ai < 2; ++ai)
#pragma unroll
                for (int mp = 0; mp < 2; ++mp) { float oa[8], ob[8]; row8(oa, acc, ai, 2 * mp, rs[ai][2 * mp] * oscale); row8(ob, acc, ai, 2 * mp + 1, rs[ai][2 * mp + 1] * oscale);
                    const u32x4 w = widen16(pk8_fp8(oa), pk8_fp8(ob));
                    const int rl = ai * HALF + wr * 64 + (2 * mp + odd) * 16 + fr;
                    if (!MASK || (rl < u.nvalid && rl >= u.nlo)) *(u32x4*)((unsigned char*)O + (size_t)(u.arow + rl) * ldc + col0 - 8 * odd) = w; }
        } else {
#pragma unroll
        for (int ai = 0; ai < 2; ++ai)
#pragma unroll
            for (int m = 0; m < 4; ++m) { const int rl = ai * HALF + wr * 64 + m * 16 + fr; if (MASK && (rl >= u.nvalid || rl < u.nlo)) continue;
                float o[8]; row8(o, acc, ai, m, rs[ai][m] * oscale);
                u32x4 w; w.x = cvt_pk_bf16(o[0], o[1]); w.y = cvt_pk_bf16(o[2], o[3]); w.z = cvt_pk_bf16(o[4], o[5]); w.w = cvt_pk_bf16(o[6], o[7]);
                *(u32x4*)(O + (size_t)(u.arow + rl) * ldc + col0) = w; }
        }
    }
};
template <bool BASE_F32, bool H8OUT = false> struct EpiResid {
    static constexpr bool PERM = true; static constexpr int NST = H8OUT ? 24 : 16;
    __device__ __forceinline__ bool full(const Unit&) const { return true; }
    const void* base; bf16_t* out; float* stat; LAS float* part; float scale; unsigned char* h8;
    __device__ __forceinline__ void operator()(f32x4 (&acc)[2][2][4][2], const Unit& u, int wr, int wc, int fr, int fq) const {
        const int col0 = u.col + wc * 32 + 8 * fq; const int lane = fq * 16 + fr;
#pragma unroll
        for (int ai = 0; ai < 2; ++ai)
#pragma unroll
          for (int mh = 0; mh < 2; ++mh) {
            if (BASE_F32) { f32x4 t[2][2][2];
#pragma unroll
                for (int m = 0; m < 2; ++m) { const float* bp = (const float*)base + (size_t)(u.arow + ai * HALF + wr * 64 + (mh * 2 + m) * 16 + fr) * DM + col0;
#pragma unroll
                    for (int bj = 0; bj < 2; ++bj)
#pragma unroll
                        for (int n = 0; n < 2; ++n) t[m][bj][n] = *(const f32x4*)(bp + bj * HALF + n * 4); }
#pragma unroll
                for (int m = 0; m < 2; ++m)
#pragma unroll
                    for (int bj = 0; bj < 2; ++bj)
#pragma unroll
                        for (int n = 0; n < 2; ++n) acc[ai][bj][mh * 2 + m][n] = acc[ai][bj][mh * 2 + m][n] * scale + t[m][bj][n];
            } else { u32x4 t[2][2];
#pragma unroll
                for (int m = 0; m < 2; ++m) { const bf16_t* bp = (const bf16_t*)base + (size_t)(u.arow + ai * HALF + wr * 64 + (mh * 2 + m) * 16 + fr) * DM + col0;
#pragma unroll
                    for (int bj = 0; bj < 2; ++bj) t[m][bj] = *(const u32x4*)(bp + bj * HALF); }
#pragma unroll
                for (int m = 0; m < 2; ++m)
#pragma unroll
                    for (int bj = 0; bj < 2; ++bj) { const u32x4 w = t[m][bj];
                        acc[ai][bj][mh * 2 + m][0] = acc[ai][bj][mh * 2 + m][0] * scale + (f32x4){bf_lo(w.x), bf_hi(w.x), bf_lo(w.y), bf_hi(w.y)};
                        acc[ai][bj][mh * 2 + m][1] = acc[ai][bj][mh * 2 + m][1] * scale + (f32x4){bf_lo(w.z), bf_hi(w.z), bf_lo(w.w), bf_hi(w.w)}; }
            }
#pragma unroll
            for (int m = 0; m < 2; ++m)
                asm volatile("" : "+v"(acc[ai][0][mh * 2 + m][0]), "+v"(acc[ai][0][mh * 2 + m][1]), "+v"(acc[ai][1][mh * 2 + m][0]), "+v"(acc[ai][1][mh * 2 + m][1]) :: "memory"); }
        u32x2 pk8s[2][2];
#pragma unroll
        for (int ai = 0; ai < 2; ++ai)
#pragma unroll
            for (int m = 0; m < 4; ++m) { const int rl = ai * HALF + wr * 64 + m * 16 + fr; const size_t off = (size_t)(u.arow + rl) * DM + col0; float ss = 0.f;
#pragma unroll
                for (int bj = 0; bj < 2; ++bj) { const f32x4 h0 = acc[ai][bj][m][0], h1 = acc[ai][bj][m][1];
                    ss += ((h0.x * h0.x + h0.y * h0.y) + (h0.z * h0.z + h0.w * h0.w)) + ((h1.x * h1.x + h1.y * h1.y) + (h1.z * h1.z + h1.w * h1.w));
                    u32x4 w; w.x = cvt_pk_bf16(h0.x, h0.y); w.y = cvt_pk_bf16(h0.z, h0.w); w.z = cvt_pk_bf16(h1.x, h1.y); w.w = cvt_pk_bf16(h1.z, h1.w);
                    *(u32x4*)(out + off + bj * HALF) = w;
                    if (H8OUT) { const float o8[8] = {h0.x, h0.y, h0.z, h0.w, h1.x, h1.y, h1.z, h1.w}; pk8s[m & 1][bj] = pk8_fp8(o8);
                        if (m & 1) { const int odd = fq & 1;
                            *(u32x4*)(h8 + (size_t)(u.arow + rl - 16 + 16 * odd) * DM + col0 - 8 * odd + bj * HALF) = widen16(pk8s[0][bj], pk8s[1][bj]); } } }
                ss += shx(ss, 16, lane); ss += shx(ss, 32, lane); if (fq == 0) part[wc * 256 + rl] = ss; }
        stat_combine(part, stat, u, u.col >> 8, wr, wc, fr, fq);
    }
};
__device__ __forceinline__ void rope_inv4(float (&inv)[4], int i0) {
#pragma unroll
    for (int k = 0; k < 4; ++k) inv[k] = __builtin_amdgcn_exp2f(-(float)(i0 + k) * (13.287712379549449f / 32.0f)) * 0.15915494309189535f;
}
__device__ __forceinline__ void rope8(f32x4& v0, f32x4& v1, float pos, const float (&inv)[4]) {
    float c[4], sn[4];
#pragma unroll
    for (int k = 0; k < 4; ++k) { float t = pos * inv[k]; t -= rintf(t); c[k] = __builtin_amdgcn_cosf(t); sn[k] = __builtin_amdgcn_sinf(t); }
    const float a0 = v0[0] * c[0] - v0[1] * sn[0], b0 = v0[1] * c[0] + v0[0] * sn[0];
    const float a1 = v0[2] * c[1] - v0[3] * sn[1], b1 = v0[3] * c[1] + v0[2] * sn[1];
    const float a2 = v1[0] * c[2] - v1[1] * sn[2], b2 = v1[1] * c[2] + v1[0] * sn[2];
    const float a3 = v1[2] * c[3] - v1[3] * sn[3], b3 = v1[3] * c[3] + v1[2] * sn[3];
    v0 = (f32x4){a0, b0, a1, b1}; v1 = (f32x4){a2, b2, a3, b3};
}
template <bool F8, bool QPRE = false> struct EpiQRope {
    static constexpr bool PERM = true; static constexpr int NST = F8 ? 8 : 16;
    __device__ __forceinline__ bool full(const Unit&) const { return true; }
    bf16_t* O; float oscale; const float* stat; float qpre;
    __device__ __forceinline__ void operator()(const f32x4 (&acc)[2][2][4][2], const Unit& u, int wr, int wc, int fr, int fq) const {
        const int col0 = u.col + wc * 32 + 8 * fq, odd = fq & 1;
        float rs[2][4];
        if (QPRE) { row_rstd8<1>(rs, stat, u.arow + wr * 64 + fr, 0, 1.f / 256.f);
#pragma unroll
            for (int ai = 0; ai < 2; ++ai)
#pragma unroll
                for (int m = 0; m < 4; ++m) rs[ai][m] *= qpre * oscale; }
#pragma unroll
        for (int bj = 0; bj < 2; ++bj) { const int c = col0 + bj * HALF, d = c % QKD; const bool isr = d >= 128; float inv[4]; rope_inv4(inv, isr ? ((d - 128) >> 1) : 0);
#pragma unroll
            for (int ai = 0; ai < 2; ++ai)
#pragma unroll
                for (int mp = 0; mp < 2; ++mp) { u32x2 pk[2];
#pragma unroll
                    for (int q = 0; q < 2; ++q) { const int m = 2 * mp + q, row = u.arow + ai * HALF + wr * 64 + m * 16 + fr; const float rsc = QPRE ? rs[ai][m] : oscale;
                        f32x4 v0 = acc[ai][bj][m][0] * rsc, v1 = acc[ai][bj][m][1] * rsc;
                        if (isr) rope8(v0, v1, (float)(row & (SEQ - 1)), inv);
                        if (F8) { const float o8[8] = {v0[0], v0[1], v0[2], v0[3], v1[0], v1[1], v1[2], v1[3]}; pk[q] = pk8_fp8(o8); }
                        else { u32x4 w; w.x = cvt_pk_bf16(v0[0], v0[1]); w.y = cvt_pk_bf16(v0[2], v0[3]); w.z = cvt_pk_bf16(v1[0], v1[1]); w.w = cvt_pk_bf16(v1[2], v1[3]);
                            *(u32x4*)(O + (size_t)row * NQ + c) = w; } }
                    if (F8) { const int row = u.arow + ai * HALF + wr * 64 + (2 * mp + odd) * 16 + fr;
                        *(u32x4*)((unsigned char*)O + (size_t)row * NQ + c - 8 * odd) = widen16(pk[0], pk[1]); } } }
    }
};
template <bool F8, bool F8UP = false> struct EpiDown {
    static constexpr bool PERM = true; static constexpr int NST = 0;
    __device__ __forceinline__ bool full(const Unit&) const { return false; }
    bf16_t* O; float* stat; LAS float* part; unsigned char* kr8; float oscale;
    __device__ __forceinline__ void operator()(const f32x4 (&acc)[2][2][4][2], const Unit& u, int wr, int wc, int fr, int fq) const {
        const int col0 = u.col + wc * 32 + 8 * fq, pn = u.col >> 8, lane = fq * 16 + fr;
        u32x2 pk8[2][2];
        if (pn < 2) {
#pragma unroll
            for (int ai = 0; ai < 2; ++ai)
#pragma unroll
                for (int m = 0; m < 4; ++m) { const int rl = ai * HALF + wr * 64 + m * 16 + fr; float ss = 0.f;
#pragma unroll
                    for (int bj = 0; bj < 2; ++bj) { const f32x4 v0 = acc[ai][bj][m][0] * oscale, v1 = acc[ai][bj][m][1] * oscale;
                        ss += ((v0.x * v0.x + v0.y * v0.y) + (v0.z * v0.z + v0.w * v0.w)) + ((v1.x * v1.x + v1.y * v1.y) + (v1.z * v1.z + v1.w * v1.w));
                        if (F8UP) { const float o8[8] = {v0[0], v0[1], v0[2], v0[3], v1[0], v1[1], v1[2], v1[3]}; pk8[m & 1][bj] = pk8_fp8(o8);
                            if (m & 1) { const int odd = fq & 1;
                                *(u32x4*)((unsigned char*)O + (size_t)(u.arow + rl - 16 + 16 * odd) * DOWNP + col0 - 8 * odd + bj * HALF) = widen16(pk8[0][bj], pk8[1][bj]); } }
                        else { u32x4 w; w.x = cvt_pk_bf16(v0[0], v0[1]); w.y = cvt_pk_bf16(v0[2], v0[3]); w.z = cvt_pk_bf16(v1[0], v1[1]); w.w = cvt_pk_bf16(v1[2], v1[3]);
                        *(u32x4*)(O + (size_t)(u.arow + rl) * DOWNP + col0 + bj * HALF) = w; } }
                    ss += shx(ss, 16, lane); ss += shx(ss, 32, lane); if (fq == 0) part[wc * 256 + rl] = ss; }
        } else if (wc < 2) {
            float inv[4]; rope_inv4(inv, wc * 16 + 4 * fq);
#pragma unroll
            for (int ai = 0; ai < 2; ++ai)
#pragma unroll
                for (int m = 0; m < 4; ++m) { const int row = u.arow + ai * HALF + wr * 64 + m * 16 + fr;
                    f32x4 v0 = acc[ai][0][m][0] * oscale, v1 = acc[ai][0][m][1] * oscale;
                    rope8(v0, v1, (float)(row & (SEQ - 1)), inv);
                    if (F8) { const float o8[8] = {v0[0], v0[1], v0[2], v0[3], v1[0], v1[1], v1[2], v1[3]}; *(u32x2*)(kr8 + (size_t)row * 64 + (col0 - 512)) = pk8_fp8(o8); }
                    else { u32x4 w; w.x = cvt_pk_bf16(v0[0], v0[1]); w.y = cvt_pk_bf16(v0[2], v0[3]); w.z = cvt_pk_bf16(v1[0], v1[1]); w.w = cvt_pk_bf16(v1[2], v1[3]);
                    *(u32x4*)(O + (size_t)row * DOWNP + col0) = w; } }
        }
        if (pn < 2) stat_combine(part, stat, u, pn, wr, wc, fr, fq);
        else { asm volatile("s_waitcnt lgkmcnt(0)" ::: "memory"); __builtin_amdgcn_s_barrier(); }
    }
};

template <class Epi, class Sched, bool ALIGN_EPI, bool FP8 = false>
__device__ __forceinline__ void gemm_phase(LAS unsigned char* lds, const Gemm g, const Sched& S, const Epi& E, const int wv) {
    const int tid = opaque_tid(wv), wid = __builtin_amdgcn_readfirstlane(tid >> 6), lane = tid & 63, wr = wid >> 2, wc = wid & 3, fr = lane & 15, fq = lane >> 4;
    const int K = g.K; int nt = K / BK; asm volatile("" : "+s"(nt));
    unsigned voffA[2], voffB[2];
#pragma unroll
    for (int i = 0; i < 2; ++i) { int R, C; stage_rc(tid * 16 + i * 8192, R, C); const int Rb = Epi::PERM ? ((R & ~31) + perm32(R & 31)) : R;
        voffA[i] = (unsigned)(R * g.lda + C) * 2u; voffB[i] = (unsigned)(Rb * g.ldb + C) * 2u; }
    const size_t kstep = (size_t)(BK * 2);
    const size_t hsA = (size_t)HALF * g.lda * 2, hsB = (size_t)HALF * g.ldb * 2;
    const unsigned ldsw = (unsigned)wid * 1024u, ldsb = (unsigned)(uintptr_t)lds;
    const int aoff = lds_byte(wr * 64 + fr, fq * 8), boff = lds_byte(wc * 32 + fr, fq * 8);
#define PG8_SA(b, h) (((b) * 2 + (h)) * HTB)
#define PG8_SB(b, h) ((4 + (b) * 2 + (h)) * HTB)
#define PG8_STAGE(bufoff, gbase, voff) do { _Pragma("unroll") for (int _i = 0; _i < 2; ++_i) \
        glds16_s((const char*)(gbase), (voff)[_i], ldsb + (unsigned)(bufoff) + ldsw + (unsigned)(_i * 8192)); } while (0)
#define PG8_LDA(dst, b, h) do { _Pragma("unroll") for (int m = 0; m < 4; ++m) _Pragma("unroll") for (int k = 0; k < 2; ++k) dst[m][k] = *(const LAS bf16x8*)(lds + PG8_SA(b, h) + aoff + m * 2048 + k * 1024); } while (0)
#define PG8_LDB(dst, b, h) do { _Pragma("unroll") for (int n = 0; n < 2; ++n) _Pragma("unroll") for (int k = 0; k < 2; ++k) dst[n][k] = *(const LAS bf16x8*)(lds + PG8_SB(b, h) + boff + n * 2048 + k * 1024); } while (0)
#define PG8_MMA(ai, bj, At, Bt) do { __builtin_amdgcn_s_setprio(1); _Pragma("unroll") for (int m = 0; m < 4; ++m) _Pragma("unroll") for (int n = 0; n < 2; ++n) { \
        if constexpr (FP8) { const i32x4 b0_ = __builtin_bit_cast(i32x4, Bt[n][0]), b1_ = __builtin_bit_cast(i32x4, Bt[n][1]), a0_ = __builtin_bit_cast(i32x4, At[m][0]), a1_ = __builtin_bit_cast(i32x4, At[m][1]); \
            acc[ai][bj][m][n] = __builtin_amdgcn_mfma_scale_f32_16x16x128_f8f6f4(__builtin_shufflevector(b0_, b1_, 0, 1, 2, 3, 4, 5, 6, 7), __builtin_shufflevector(a0_, a1_, 0, 1, 2, 3, 4, 5, 6, 7), acc[ai][bj][m][n], 0, 0, 0, 0x7F7F7F7F, 0, 0x7F7F7F7F); } \
        else { _Pragma("unroll") for (int k = 0; k < 2; ++k) acc[ai][bj][m][n] = __builtin_amdgcn_mfma_f32_16x16x32_bf16(Bt[n][k], At[m][k], acc[ai][bj][m][n], 0, 0, 0); } } \
        __builtin_amdgcn_s_setprio(0); } while (0)
#define PG8_WAIT_V(n) asm volatile("s_waitcnt vmcnt(" #n ")" ::: "memory")
#define PG8_WAIT_V8R(rx) asm volatile("s_cmp_eq_u32 %0, 0\n\ts_cbranch_scc1 .Lrxa%=\n\ts_waitcnt vmcnt(%1)\n\ts_branch .Lrxb%=\n.Lrxa%=:\n\ts_waitcnt vmcnt(8)\n.Lrxb%=:" :: "s"(__builtin_amdgcn_readfirstlane((int)(rx))), "n"(8 + Epi::NST) : "memory", "scc")
#define PG8_WAIT_L(n) asm volatile("s_waitcnt lgkmcnt(" #n ")" ::: "memory")
#define PG8_BAR __builtin_amdgcn_s_barrier()
#define PG8_SCHED __builtin_amdgcn_sched_barrier(0)
    Unit cur, nxt; int ui = 0; bool relax = false;
    if (!S.next(0, cur)) return;
    f32x4 acc[2][2][4][2];
#pragma unroll
    for (int a = 0; a < 2; ++a)
#pragma unroll
        for (int b = 0; b < 2; ++b)
#pragma unroll
            for (int m = 0; m < 4; ++m)
#pragma unroll
                for (int n = 0; n < 2; ++n) acc[a][b][m][n] = (f32x4){0.f, 0.f, 0.f, 0.f};
    bf16x8 At[4][2], B0[2][2], B1[2][2];
    const char* cA = (const char*)g.A + (size_t)cur.arow * g.lda * 2; const char* cB = (const char*)g.Bt + (size_t)cur.brow * g.ldb * 2;
    PG8_STAGE(PG8_SB(0, 0), cB, voffB); PG8_STAGE(PG8_SB(0, 1), cB + hsB, voffB); PG8_STAGE(PG8_SA(0, 0), cA, voffA); PG8_STAGE(PG8_SA(0, 1), cA + hsA, voffA);
    if (wr == 1) PG8_BAR;
    PG8_WAIT_V(2); PG8_BAR;
    PG8_STAGE(PG8_SB(1, 0), cB + kstep, voffB); PG8_STAGE(PG8_SA(1, 0), cA + kstep, voffA); PG8_STAGE(PG8_SB(1, 1), cB + hsB + kstep, voffB);
    PG8_WAIT_V(6); PG8_BAR;
    for (;;) {
        const bool has_next = S.next(ui + 1, nxt);
        const char* nA = has_next ? (const char*)g.A + (size_t)nxt.arow * g.lda * 2 : cA; const char* nB = has_next ? (const char*)g.Bt + (size_t)nxt.brow * g.ldb * 2 : cB;
        for (int t = 0; t < nt; t += 2) {
            const bool last = (t == nt - 2); const bool rx = relax && t == 0;
            const char* a1 = cA + (size_t)(t + 1) * kstep;
            const char* a2 = last ? nA : cA + (size_t)(t + 2) * kstep; const char* b2 = last ? nB : cB + (size_t)(t + 2) * kstep;
            const char* a3 = a2 + kstep; const char* b3 = b2 + kstep;
            PG8_LDB(B0, 0, 0); PG8_LDB(B1, 0, 1); PG8_SCHED; PG8_LDA(At, 0, 0); PG8_STAGE(PG8_SA(1, 1), a1 + hsA, voffA);
            PG8_WAIT_V8R(rx); PG8_WAIT_L(0); PG8_BAR; PG8_MMA(0, 0, At, B0); PG8_MMA(0, 1, At, B1); PG8_BAR; PG8_SCHED;
            PG8_LDA(At, 0, 1); PG8_STAGE(PG8_SB(0, 0), b2, voffB); PG8_STAGE(PG8_SB(0, 1), b2 + hsB, voffB); PG8_STAGE(PG8_SA(0, 0), a2, voffA);
            PG8_WAIT_V8R(rx); PG8_WAIT_L(0); PG8_BAR; PG8_MMA(1, 0, At, B0); PG8_MMA(1, 1, At, B1); PG8_BAR; PG8_SCHED;
            PG8_LDB(B0, 1, 0); PG8_LDB(B1, 1, 1); PG8_SCHED; PG8_LDA(At, 1, 0); PG8_STAGE(PG8_SA(0, 1), a2 + hsA, voffA);
            PG8_WAIT_V(8); PG8_WAIT_L(0); PG8_BAR; PG8_MMA(0, 0, At, B0); PG8_MMA(0, 1, At, B1); PG8_BAR; PG8_SCHED;
            PG8_LDA(At, 1, 1); PG8_STAGE(PG8_SB(1, 0), b3, voffB); PG8_STAGE(PG8_SB(1, 1), b3 + hsB, voffB); PG8_STAGE(PG8_SA(1, 0), a3, voffA);
            PG8_WAIT_V(8); PG8_WAIT_L(0); PG8_BAR; PG8_MMA(1, 0, At, B0); PG8_MMA(1, 1, At, B1); PG8_BAR; PG8_SCHED;
        }
        if constexpr (ALIGN_EPI) { if (wr == 0) PG8_BAR; }
        { const int l2 = opaque_lane(); E(acc, cur, wr, wc, l2 & 15, l2 >> 4); relax = Epi::NST > 0 && E.full(cur); }
        if (!has_next) break;
#pragma unroll
        for (int a = 0; a < 2; ++a)
#pragma unroll
            for (int b = 0; b < 2; ++b)
#pragma unroll
                for (int m = 0; m < 4; ++m)
#pragma unroll
                    for (int n = 0; n < 2; ++n) acc[a][b][m][n] = (f32x4){0.f, 0.f, 0.f, 0.f};
        cur = nxt; cA = nA; cB = nB; ++ui;
        if constexpr (ALIGN_EPI) { if (wr == 1) PG8_BAR; }
    }
    PG8_WAIT_V(0);
    if constexpr (!ALIGN_EPI) { if (wr == 0) PG8_BAR; }
    PG8_BAR;
#undef PG8_SA
#undef PG8_SB
#undef PG8_STAGE
#undef PG8_LDA
#undef PG8_LDB
#undef PG8_MMA
#undef PG8_WAIT_V
#undef PG8_WAIT_V8R
#undef PG8_WAIT_L
#undef PG8_BAR
#undef PG8_SCHED
}
}

__device__ __forceinline__ int crow(int r, int hi) { return (r & 3) + 8 * (r >> 2) + 4 * hi; }
__device__ __forceinline__ int v_rd_base(int lane) { return ((lane & 3) << 3) | (((lane >> 2) & 3) << 6) | (((lane >> 4) & 1) << 5) | (((lane >> 5) & 1) << 8); }
template <int NCB> __device__ __forceinline__ int v_st(int k, int c) { const int kk = (k & ~0xC) | ((k & 4) << 1) | ((k & 8) >> 1); return ((kk >> 3) * NCB + (c >> 5)) * 512 + ((kk & 7) * 32 + (c & 31)) * 2; }
template <int OFF> __device__ __forceinline__ s16x4 tr_read(int vb) {
    s16x4 r; asm volatile("ds_read_b64_tr_b16 %0, %1 offset:%2" : "=&v"(r) : "v"(vb), "i"(OFF) : "memory"); return r;
}
template <int D0, int NCB> __device__ __forceinline__ void pv_one(f32x16& od, int vb, bf16x8 pa0, bf16x8 pa1, bf16x8 pa2, bf16x8 pa3) {
    constexpr int KS = NCB * 1024, HF = NCB * 512;
    const s16x4 l0 = tr_read<D0 * 512 + 0 * KS>(vb), h0 = tr_read<D0 * 512 + 0 * KS + HF>(vb), l1 = tr_read<D0 * 512 + 1 * KS>(vb), h1 = tr_read<D0 * 512 + 1 * KS + HF>(vb);
    const s16x4 l2 = tr_read<D0 * 512 + 2 * KS>(vb), h2 = tr_read<D0 * 512 + 2 * KS + HF>(vb), l3 = tr_read<D0 * 512 + 3 * KS>(vb), h3 = tr_read<D0 * 512 + 3 * KS + HF>(vb);
    asm volatile("s_waitcnt lgkmcnt(0)" ::: "memory"); SBAR();
#define PK(L, H) (bf16x8){L[0], L[1], L[2], L[3], H[0], H[1], H[2], H[3]}
    od = __builtin_amdgcn_mfma_f32_32x32x16_bf16(pa0, PK(l0, h0), od, 0, 0, 0);
    od = __builtin_amdgcn_mfma_f32_32x32x16_bf16(pa1, PK(l1, h1), od, 0, 0, 0);
    od = __builtin_amdgcn_mfma_f32_32x32x16_bf16(pa2, PK(l2, h2), od, 0, 0, 0);
    od = __builtin_amdgcn_mfma_f32_32x32x16_bf16(pa3, PK(l3, h3), od, 0, 0, 0);
#undef PK
}
#define PK4(P, BASE, OUT) do { unsigned a0 = cvt_pk_bf16(P[BASE + 0], P[BASE + 1]), a1 = cvt_pk_bf16(P[BASE + 2], P[BASE + 3]);   \
    unsigned b0 = cvt_pk_bf16(P[BASE + 4], P[BASE + 5]), b1 = cvt_pk_bf16(P[BASE + 6], P[BASE + 7]);                              \
    auto r0 = __builtin_amdgcn_permlane32_swap(a0, b0, false, false); auto r1 = __builtin_amdgcn_permlane32_swap(a1, b1, false, false); \
    u32x4 w = {r0[0], r1[0], r0[1], r1[1]}; OUT = __builtin_bit_cast(bf16x8, w); } while (0)

namespace mla {
constexpr int NW = 8, QBLK = 32, KVBLK = 64;
constexpr int KN_B = KVBLK * 256, KR_B = KVBLK * 128, V_B = KVBLK * 256, SLOT = KN_B + KR_B + V_B  , NSLOT = 3;
constexpr int OFF_WS = NSLOT * SLOT  , OFF_END = OFF_WS + NW * 64 * 4;
static_assert(OFF_END <= RING_BYTES, "mla lds");
constexpr int OSTR = 272;
static_assert(NW * 32 * OSTR <= OFF_WS, "O staging aliases the ring");
constexpr float SCALE = 0.07216878364870323f;
constexpr float THR = 8.f;
constexpr int LDQ = NQ, LDKV = NKV, LDR = DOWNP, LDO = DM;

__device__ __forceinline__ void partialSM(f32x16& p0, f32x16& p1, float& m_reg, float& mn, float& alpha, const float C) {
    float pmax = p0[0];
#pragma unroll
    for (int r = 1; r < 16; ++r) pmax = fmaxf(pmax, p0[r]);
#pragma unroll
    for (int r = 0; r < 16; ++r) pmax = fmaxf(pmax, p1[r]);
    { auto rr = __builtin_amdgcn_permlane32_swap(__float_as_uint(pmax), __float_as_uint(pmax), false, false);
      pmax = fmaxf(__uint_as_float(rr[0]), __uint_as_float(rr[1])); }
    if (__builtin_expect(__all((pmax - m_reg) * C <= THR * LOG2E), 1)) { mn = m_reg; alpha = 1.f; }
    else { mn = fmaxf(m_reg, pmax); alpha = __builtin_amdgcn_exp2f((m_reg - mn) * C); m_reg = mn; }
    const float mnC = -mn * C;
#pragma unroll
    for (int r = 0; r < 16; ++r) p0[r] = fmaf(p0[r], C, mnC);
#pragma unroll
    for (int r = 0; r < 16; ++r) p1[r] = fmaf(p1[r], C, mnC);
#pragma unroll
    for (int r = 0; r < 16; ++r) p0[r] = __builtin_amdgcn_exp2f(p0[r]);
}
__device__ __forceinline__ void finishSM(f32x16& p0, f32x16& p1, float alpha, float& l_reg, bf16x8& pa0, bf16x8& pa1, bf16x8& pa2, bf16x8& pa3) {
#pragma unroll
    for (int r = 0; r < 16; ++r) p1[r] = __builtin_amdgcn_exp2f(p1[r]);
    float ps = 0;
#pragma unroll
    for (int r = 0; r < 16; ++r) ps += p0[r];
#pragma unroll
    for (int r = 0; r < 16; ++r) ps += p1[r];
    { auto rr = __builtin_amdgcn_permlane32_swap(__float_as_uint(ps), __float_as_uint(ps), false, false);
      ps = __uint_as_float(rr[0]) + __uint_as_float(rr[1]); }
    l_reg = l_reg * alpha + ps;
    PK4(p0, 0, pa0); PK4(p0, 8, pa1); PK4(p1, 0, pa2); PK4(p1, 8, pa3);
}
__device__ __forceinline__ void qkt(f32x16& p0, f32x16& p1, const LAS unsigned char* slot, const bf16x8* qr, int r32, int hi) {
    p0 = f32x16{}; p1 = f32x16{};
    const LAS unsigned char* kn = slot + r32 * 256; const int xn = (r32 & 7) << 4;
    const LAS unsigned char* kr = slot + KN_B + r32 * 128; const int xr = ((r32 >> 1) & 7) << 4;
    bf16x8 f0[3], f1[3];
#define MLA_LDK(d0) do { if ((d0) < 8) { const int cb_ = (((d0) * 16 + hi * 8) * 2) ^ xn; f0[(d0) % 3] = *(const LAS bf16x8*)(kn + cb_); f1[(d0) % 3] = *(const LAS bf16x8*)(kn + 32 * 256 + cb_); } \
        else { const int cb_ = ((((d0) - 8) * 2 + hi) * 16) ^ xr; f0[(d0) % 3] = *(const LAS bf16x8*)(kr + cb_); f1[(d0) % 3] = *(const LAS bf16x8*)(kr + 32 * 128 + cb_); } } while (0)
    MLA_LDK(0); MLA_LDK(1);
#pragma unroll
    for (int d0 = 0; d0 < 12; ++d0) {
        if (d0 + 2 < 12) MLA_LDK(d0 + 2);
        SBAR();
        p0 = __builtin_amdgcn_mfma_f32_32x32x16_bf16(f0[d0 % 3], qr[d0], p0, 0, 0, 0);
        p1 = __builtin_amdgcn_mfma_f32_32x32x16_bf16(f1[d0 % 3], qr[d0], p1, 0, 0, 0);
        SBAR();
    }
#undef MLA_LDK
}
__device__ __forceinline__ void pv_all(f32x16* o, int vb, bf16x8 pa0, bf16x8 pa1, bf16x8 pa2, bf16x8 pa3) {
    s16x4 la[4], ha[4], lb[4], hb[4];
#define PV_RD(L, H, ks) do { L[0] = tr_read<0 * 512 + (ks) * 4096>(vb); H[0] = tr_read<0 * 512 + (ks) * 4096 + 2048>(vb); L[1] = tr_read<1 * 512 + (ks) * 4096>(vb); H[1] = tr_read<1 * 512 + (ks) * 4096 + 2048>(vb); \
        L[2] = tr_read<2 * 512 + (ks) * 4096>(vb); H[2] = tr_read<2 * 512 + (ks) * 4096 + 2048>(vb); L[3] = tr_read<3 * 512 + (ks) * 4096>(vb); H[3] = tr_read<3 * 512 + (ks) * 4096 + 2048>(vb); } while (0)
#define PV_PK(L, H) (bf16x8){L[0], L[1], L[2], L[3], H[0], H[1], H[2], H[3]}
#define PV_MM(L, H, pa) do { _Pragma("unroll") for (int d = 0; d < 4; ++d) o[d] = __builtin_amdgcn_mfma_f32_32x32x16_bf16(pa, PV_PK(L[d], H[d]), o[d], 0, 0, 0); } while (0)
    PV_RD(la, ha, 0); PV_RD(lb, hb, 1);
    asm volatile("s_waitcnt lgkmcnt(8)" ::: "memory"); SBAR(); PV_MM(la, ha, pa0); SBAR();
    PV_RD(la, ha, 2);
    asm volatile("s_waitcnt lgkmcnt(8)" ::: "memory"); SBAR(); PV_MM(lb, hb, pa1); SBAR();
    PV_RD(lb, hb, 3);
    asm volatile("s_waitcnt lgkmcnt(8)" ::: "memory"); SBAR(); PV_MM(la, ha, pa2); SBAR();
    asm volatile("s_waitcnt lgkmcnt(0)" ::: "memory"); SBAR(); PV_MM(lb, hb, pa3); SBAR();
#undef PV_RD
#undef PV_PK
#undef PV_MM
}
#define MLA_BAR() asm volatile("s_waitcnt vmcnt(0) lgkmcnt(0)\n\ts_barrier" ::: "memory")
template <bool O8> __device__ __forceinline__ void unit(int b, int h, int qb, const bf16_t* __restrict__ Q, const bf16_t* __restrict__ KV, const bf16_t* __restrict__ DN, const float* __restrict__ stat, bf16_t* __restrict__ O, LAS unsigned char* lds, const int wv) {
    const int tid = opaque_tid(wv), wid = __builtin_amdgcn_readfirstlane(tid >> 6), lane = tid & 63, r32 = lane & 31, hi = lane >> 5;
    const size_t tok0 = (size_t)b * SEQ;
    const bf16_t* Qb = Q + (tok0 + (size_t)qb * 256) * LDQ + h * QKD;
    const char* Kn = (const char*)(KV + tok0 * LDKV + h * 128);
    const char* Vh = (const char*)(KV + tok0 * LDKV + 1024 + h * 128);
    const char* Kr = (const char*)(DN + tok0 * LDR + 512);
    LAS float* ws = (LAS float*)(lds + OFF_WS) + wid * 64; LAS float* li_l = ws; LAS float* al_l = ws + 32;
    const unsigned ldsb = (unsigned)(uintptr_t)lds;
    unsigned vkn[2], vv[2], vkr;
#pragma unroll
    for (int i = 0; i < 2; ++i) { const int L = (wid * 2 + i) * 64 + lane; { const int row = L >> 4, c16 = (L & 15) ^ (row & 7); vkn[i] = (unsigned)(row * (LDKV * 2) + c16 * 16); }
        { const int st = L >> 5, w = L & 31, kk = (st >> 2) * 8 + (w >> 2), k = (kk & ~0xC) | ((kk & 4) << 1) | ((kk & 8) >> 1), c = (st & 3) * 32 + (w & 3) * 8; vv[i] = (unsigned)(k * (LDKV * 2) + c * 2); } }
    { const int L = wid * 64 + lane, row = L >> 3, c16 = (L & 7) ^ ((row >> 1) & 7); vkr = (unsigned)(row * (LDR * 2) + c16 * 16); }
#define MLA_ISSUE(t, sl) do { const size_t ko_ = (size_t)(t) * KVBLK; const unsigned sb_ = ldsb + (unsigned)(sl) * SLOT + (unsigned)wid * 2048u; \
        glds16_s(Kn + ko_ * (LDKV * 2), vkn[0], sb_); glds16_s(Kn + ko_ * (LDKV * 2), vkn[1], sb_ + 1024u); \
        glds16_s(Kr + ko_ * (LDR * 2), vkr, ldsb + (unsigned)(sl) * SLOT + KN_B + (unsigned)wid * 1024u); \
        glds16_s(Vh + ko_ * (LDKV * 2), vv[0], sb_ + KN_B + KR_B); glds16_s(Vh + ko_ * (LDKV * 2), vv[1], sb_ + KN_B + KR_B + 1024u); } while (0)
    MLA_ISSUE(0, 0); MLA_ISSUE(1, 1);
    float m_reg = -1e30f, l_reg = 0; f32x16 o[4] = {}; bf16x8 qr[12];
    const float Cq = SCALE * LOG2E * __builtin_amdgcn_rsqf(stat[(tok0 + (size_t)qb * 256 + wid * QBLK + r32) * 4] * (1.f / 256.f) + EPS);
    const bf16_t* Qw = Qb + (size_t)(wid * QBLK + r32) * LDQ + hi * 8;
#pragma unroll
    for (int d0 = 0; d0 < 12; ++d0) qr[d0] = *(const bf16x8*)(Qw + d0 * 16);
    const int vb0 = (int)ldsb + KN_B + KR_B + v_rd_base(lane);
#define RESC(a) do { if (__any((a) < 1.f)) { if (hi == 0) al_l[r32] = (a); asm volatile("s_waitcnt lgkmcnt(0)" ::: "memory"); \
    _Pragma("unroll") for (int d = 0; d < 4; ++d) _Pragma("unroll") for (int r = 0; r < 16; ++r) o[d][r] *= al_l[crow(r, hi)]; } } while (0)
    f32x16 p0, p1; float mn, al; bf16x8 pa0, pa1, pa2, pa3; constexpr int NT = SEQ / KVBLK;
    MLA_BAR();
#define MLA_BARC(j) asm volatile("s_cmp_lt_i32 %0, %1\n\ts_cbranch_scc1 .Lmb%=\n\ts_waitcnt vmcnt(0)\n\ts_branch .Lme%=\n.Lmb%=:\n\ts_waitcnt vmcnt(5)\n.Lme%=:\n\ts_waitcnt lgkmcnt(0)\n\ts_barrier" :: "s"(__builtin_amdgcn_readfirstlane((j) + 2)), "n"(SEQ / KVBLK) : "memory", "scc")
    const bool halfB = wid >= 4;
    if (halfB) { MLA_BARC(0); MLA_ISSUE(2, 2); }
    int sj = 0;
    for (int j = 0; j < NT; ++j) {
        const int s1 = sj == 2 ? 0 : sj + 1, s2 = s1 == 2 ? 0 : s1 + 1;
        qkt(p0, p1, lds + sj * SLOT, qr, r32, hi);
        MLA_BARC(j);
        if (!halfB && j + 2 < NT) MLA_ISSUE(j + 2, s2);
        partialSM(p0, p1, m_reg, mn, al, Cq); RESC(al);
        finishSM(p0, p1, al, l_reg, pa0, pa1, pa2, pa3); SBAR();
        pv_all(o, vb0 + sj * SLOT, pa0, pa1, pa2, pa3);
        MLA_BARC(j);
        if (halfB && j + 3 < NT) MLA_ISSUE(j + 3, sj);
        sj = s1;
    }
    if (!halfB) MLA_BARC(NT);
#undef MLA_BARC
    if (hi == 0) li_l[r32] = l_reg; asm volatile("s_waitcnt lgkmcnt(0)" ::: "memory");
    float rli[16];
#pragma unroll
    for (int r = 0; r < 16; ++r) rli[r] = __builtin_amdgcn_rcpf(li_l[crow(r, hi)]);
    MLA_BAR();
    LAS unsigned char* ost = lds + wid * (32 * OSTR);
    if constexpr (O8) {
#pragma unroll
        for (int r = 0; r < 16; ++r) { const int orow = crow(r, hi);
#pragma unroll
            for (int d0 = 0; d0 < 4; ++d0) *(LAS unsigned char*)(ost + orow * 144 + d0 * 32 + r32) = (unsigned char)fp8_1(o[d0][r] * rli[r] * O8_SCALE); }
        asm volatile("s_waitcnt lgkmcnt(0)" ::: "memory");
        unsigned char* Ow = (unsigned char*)O + (tok0 + (size_t)qb * 256 + wid * QBLK) * LDO + h * 128;
#pragma unroll
        for (int it = 0; it < 4; ++it) { const int ch = it * 64 + lane, row = ch >> 3, c16 = ch & 7;
            const u32x4 v = *(const LAS u32x4*)(ost + row * 144 + c16 * 16); *(u32x4*)(Ow + (size_t)row * LDO + c16 * 16) = v; }
    } else {
#pragma unroll
    for (int r = 0; r < 16; ++r) { const int orow = crow(r, hi);
#pragma unroll
        for (int d0 = 0; d0 < 4; ++d0) *(LAS unsigned short*)(ost + orow * OSTR + (d0 * 32 + r32) * 2) = (unsigned short)f2bf(o[d0][r] * rli[r]); }
    asm volatile("s_waitcnt lgkmcnt(0)" ::: "memory");
    bf16_t* Ow = O + (tok0 + (size_t)qb * 256 + wid * QBLK) * LDO + h * 128;
#pragma unroll
    for (int it = 0; it < 8; ++it) { const int ch = it * 64 + lane, row = ch >> 4, c16 = ch & 15;
        const u32x4 v = *(const LAS u32x4*)(ost + row * OSTR + c16 * 16); *(u32x4*)(Ow + (size_t)row * LDO + c16 * 8) = v; }
    }
    MLA_BAR();
#undef MLA_ISSUE
#undef RESC
}
#undef MLA_BAR
}

namespace mla8 {
using mla::partialSM; using mla::finishSM; using mla::pv_all;
constexpr int NW = 8, QBLK = 32, KVBLK = 64;
constexpr int KN_B = KVBLK * 128, KR_B = KVBLK * 64, V_B = KVBLK * 256, SLOT = KN_B + KR_B + V_B  , NSLOT = 3;
constexpr int OFF_WS = 3 * 40960, OSTR = 272;
static_assert(NSLOT * SLOT <= OFF_WS && OFF_WS + NW * 64 * 4 <= RING_BYTES && NW * 32 * OSTR <= OFF_WS, "mla8 lds");
constexpr float SCALE = 0.07216878364870323f;
constexpr int LDKV = NKV, LDO = DM;
__device__ __forceinline__ i32x8 cat8(bf16x8 a, bf16x8 b) { return __builtin_shufflevector(__builtin_bit_cast(i32x4, a), __builtin_bit_cast(i32x4, b), 0, 1, 2, 3, 4, 5, 6, 7); }
__device__ __forceinline__ void qkt(f32x16& p0, f32x16& p1, const LAS unsigned char* slot, const i32x8* qr, int r32, int hi) {
    p0 = f32x16{}; p1 = f32x16{};
    const LAS unsigned char* kn = slot + r32 * 128; const int xn = ((r32 >> 1) & 7) << 4;
    const LAS unsigned char* kr = slot + KN_B + r32 * 64; const int xr = ((r32 >> 2) & 3) << 4;
    bf16x8 a0[3], a1[3], b0[3], b1[3];
#pragma unroll
    for (int s = 0; s < 2; ++s) { const int c0 = ((s * 4 + hi * 2) * 16) ^ xn, c1 = ((s * 4 + hi * 2 + 1) * 16) ^ xn;
        a0[s] = *(const LAS bf16x8*)(kn + c0); a1[s] = *(const LAS bf16x8*)(kn + c1); b0[s] = *(const LAS bf16x8*)(kn + 32 * 128 + c0); b1[s] = *(const LAS bf16x8*)(kn + 32 * 128 + c1); }
    { const int c0 = ((hi * 2) * 16) ^ xr, c1 = ((hi * 2 + 1) * 16) ^ xr;
        a0[2] = *(const LAS bf16x8*)(kr + c0); a1[2] = *(const LAS bf16x8*)(kr + c1); b0[2] = *(const LAS bf16x8*)(kr + 32 * 64 + c0); b1[2] = *(const LAS bf16x8*)(kr + 32 * 64 + c1); }
#pragma unroll
    for (int s = 0; s < 3; ++s) {
        p0 = __builtin_amdgcn_mfma_scale_f32_32x32x64_f8f6f4(cat8(a0[s], a1[s]), qr[s], p0, 0, 0, 0, 0x7F7F7F7F, 0, 0x7F7F7F7F);
        p1 = __builtin_amdgcn_mfma_scale_f32_32x32x64_f8f6f4(cat8(b0[s], b1[s]), qr[s], p1, 0, 0, 0, 0x7F7F7F7F, 0, 0x7F7F7F7F); }
}
#define MLA_BAR() asm volatile("s_waitcnt vmcnt(0) lgkmcnt(0)\n\ts_barrier" ::: "memory")
template <bool O8> __device__ __forceinline__ void unit(int b, int h, int qb, const unsigned char* __restrict__ Q8, const unsigned char* __restrict__ K8, const unsigned char* __restrict__ KR8, const bf16_t* __restrict__ KV, const float* __restrict__ stat, bf16_t* __restrict__ O, LAS unsigned char* lds, const int wv) {
    const int tid = opaque_tid(wv), wid = __builtin_amdgcn_readfirstlane(tid >> 6), lane = tid & 63, r32 = lane & 31, hi = lane >> 5;
    const size_t tok0 = (size_t)b * SEQ;
    const char* Kn = (const char*)(K8 + tok0 * 1024 + h * 128);
    const char* Kr = (const char*)(KR8 + tok0 * 64);
    const char* Vh = (const char*)(KV + tok0 * LDKV + 1024 + h * 128);
    LAS float* ws = (LAS float*)(lds + OFF_WS) + wid * 64; LAS float* li_l = ws; LAS float* al_l = ws + 32;
    const unsigned ldsb = (unsigned)(uintptr_t)lds;
    unsigned vkn, vkr, vv[2];
    { const int L = wid * 64 + lane, row = L >> 3, c16 = (L & 7) ^ ((row >> 1) & 7); vkn = (unsigned)(row * 1024 + c16 * 16); }
    { const int L = (wid & 3) * 64 + lane, row = L >> 2, c16 = (L & 3) ^ ((row >> 2) & 3); vkr = (unsigned)(row * 64 + c16 * 16); }
#pragma unroll
    for (int i = 0; i < 2; ++i) { const int L = (wid * 2 + i) * 64 + lane; const int st = L >> 5, w = L & 31, kk = (st >> 2) * 8 + (w >> 2), k = (kk & ~0xC) | ((kk & 4) << 1) | ((kk & 8) >> 1), c = (st & 3) * 32 + (w & 3) * 8; vv[i] = (unsigned)(k * (LDKV * 2) + c * 2); }
#define MLA_ISSUE(t, sl) do { const size_t ko_ = (size_t)(t) * KVBLK; const unsigned sb_ = ldsb + (unsigned)(sl) * SLOT; \
        glds16_s(Kn + ko_ * 1024, vkn, sb_ + (unsigned)wid * 1024u); glds16_s(Kr + ko_ * 64, vkr, sb_ + KN_B + (unsigned)(wid & 3) * 1024u); \
        glds16_s(Vh + ko_ * (LDKV * 2), vv[0], sb_ + KN_B + KR_B + (unsigned)wid * 2048u); glds16_s(Vh + ko_ * (LDKV * 2), vv[1], sb_ + KN_B + KR_B + (unsigned)wid * 2048u + 1024u); } while (0)
    MLA_ISSUE(0, 0); MLA_ISSUE(1, 1);
    float m_reg = -1e30f, l_reg = 0; f32x16 o[4] = {}; i32x8 qr[3];
    const float Cq = SCALE * LOG2E * __builtin_amdgcn_rsqf(stat[(tok0 + (size_t)qb * 256 + wid * QBLK + r32) * 4] * (1.f / 256.f) + EPS);
    { const unsigned char* Qw = Q8 + (tok0 + (size_t)qb * 256 + wid * QBLK + r32) * NQ + h * QKD + hi * 32;
#pragma unroll
      for (int s = 0; s < 3; ++s) qr[s] = cat8(*(const bf16x8*)(Qw + s * 64), *(const bf16x8*)(Qw + s * 64 + 16)); }
    const int vb0 = (int)ldsb + KN_B + KR_B + v_rd_base(lane);
#define RESC(a) do { if (__any((a) < 1.f)) { if (hi == 0) al_l[r32] = (a); asm volatile("s_waitcnt lgkmcnt(0)" ::: "memory"); \
    _Pragma("unroll") for (int d = 0; d < 4; ++d) _Pragma("unroll") for (int r = 0; r < 16; ++r) o[d][r] *= al_l[crow(r, hi)]; } } while (0)
    f32x16 p0, p1; float mn, al; bf16x8 pa0, pa1, pa2, pa3; constexpr int NT = SEQ / KVBLK;
    MLA_BAR();
#define MLA_BARC(j) asm volatile("s_cmp_lt_i32 %0, %1\n\ts_cbranch_scc1 .Lnb%=\n\ts_waitcnt vmcnt(0)\n\ts_branch .Lne%=\n.Lnb%=:\n\ts_waitcnt vmcnt(4)\n.Lne%=:\n\ts_waitcnt lgkmcnt(0)\n\ts_barrier" :: "s"(__builtin_amdgcn_readfirstlane((j) + 2)), "n"(SEQ / KVBLK) : "memory", "scc")
    const bool halfB = wid >= 4;
    if (halfB) { MLA_BARC(0); MLA_ISSUE(2, 2); }
    int sj = 0;
    for (int j = 0; j < NT; ++j) {
        const int s1 = sj == 2 ? 0 : sj + 1, s2 = s1 == 2 ? 0 : s1 + 1;
        qkt(p0, p1, lds + sj * SLOT, qr, r32, hi);
        MLA_BARC(j);
        if (!halfB && j + 2 < NT) MLA_ISSUE(j + 2, s2);
        partialSM(p0, p1, m_reg, mn, al, Cq); RESC(al);
        finishSM(p0, p1, al, l_reg, pa0, pa1, pa2, pa3); SBAR();
        pv_all(o, vb0 + sj * SLOT, pa0, pa1, pa2, pa3);
        MLA_BARC(j);
        if (halfB && j + 3 < NT) MLA_ISSUE(j + 3, sj);
        sj = s1;
    }
    if (!halfB) MLA_BARC(NT);
#undef MLA_BARC
    if (hi == 0) li_l[r32] = l_reg; asm volatile("s_waitcnt lgkmcnt(0)" ::: "memory");
    float rli[16];
#pragma unroll
    for (int r = 0; r < 16; ++r) rli[r] = __builtin_amdgcn_rcpf(li_l[crow(r, hi)]);
    MLA_BAR();
    LAS unsigned char* ost = lds + wid * (32 * OSTR);
    if constexpr (O8) {
#pragma unroll
        for (int r = 0; r < 16; ++r) { const int orow = crow(r, hi);
#pragma unroll
            for (int d0 = 0; d0 < 4; ++d0) *(LAS unsigned char*)(ost + orow * 144 + d0 * 32 + r32) = (unsigned char)fp8_1(o[d0][r] * rli[r] * O8_SCALE); }
        asm volatile("s_waitcnt lgkmcnt(0)" ::: "memory");
        unsigned char* Ow = (unsigned char*)O + (tok0 + (size_t)qb * 256 + wid * QBLK) * LDO + h * 128;
#pragma unroll
        for (int it = 0; it < 4; ++it) { const int ch = it * 64 + lane, row = ch >> 3, c16 = ch & 7;
            const u32x4 v = *(const LAS u32x4*)(ost + row * 144 + c16 * 16); *(u32x4*)(Ow + (size_t)row * LDO + c16 * 16) = v; }
    } else {
#pragma unroll
        for (int r = 0; r < 16; ++r) { const int orow = crow(r, hi);
#pragma unroll
            for (int d0 = 0; d0 < 4; ++d0) *(LAS unsigned short*)(ost + orow * OSTR + (d0 * 32 + r32) * 2) = (unsigned short)f2bf(o[d0][r] * rli[r]); }
        asm volatile("s_waitcnt lgkmcnt(0)" ::: "memory");
        bf16_t* Ow = O + (tok0 + (size_t)qb * 256 + wid * QBLK) * LDO + h * 128;
#pragma unroll
        for (int it = 0; it < 8; ++it) { const int ch = it * 64 + lane, row = ch >> 4, c16 = ch & 15;
            const u32x4 v = *(const LAS u32x4*)(ost + row * OSTR + c16 * 16); *(u32x4*)(Ow + (size_t)row * LDO + c16 * 8) = v; }
    }
    MLA_BAR();
#undef MLA_ISSUE
#undef RESC
}
#undef MLA_BAR
}

namespace mla9 {
using mla8::cat8;
constexpr float QPRE = 0.07216878364870323f * LOG2E * 8.0f;
constexpr int NW = 8, QBLK = 32, KVBLK = 64;
constexpr int KN_B = mla8::KN_B, KR_B = mla8::KR_B, V_B = 128 * 64, SLOT = KN_B + KR_B + V_B  , NSLOT = 3;
constexpr int OFF_WS = 3 * 40960, OSTR = 272, OFF_O8 = NSLOT * SLOT;
static_assert(NSLOT * SLOT <= OFF_WS && OFF_WS + NW * 64 * 4 <= RING_BYTES && NW * 32 * OSTR <= OFF_WS && OFF_O8 + NW * 32 * 144 <= OFF_WS, "mla9 lds");
constexpr float SCALE = 0.07216878364870323f, THR = 6.f;
constexpr int LDO = DM;
__device__ __forceinline__ void qkt(f32x16& p0, f32x16& p1, const f32x16& negm, const LAS unsigned char* slot, const i32x8* qr, int r32, int hi) {
    const LAS unsigned char* kn = slot + r32 * 128; const int xn = ((r32 >> 1) & 7) << 4;
    const LAS unsigned char* kr = slot + KN_B + r32 * 64; const int xr = ((r32 >> 2) & 3) << 4;
    bf16x8 a0[3], a1[3], b0[3], b1[3];
#pragma unroll
    for (int s = 0; s < 2; ++s) { const int c0 = ((s * 4 + hi * 2) * 16) ^ xn, c1 = ((s * 4 + hi * 2 + 1) * 16) ^ xn;
        a0[s] = *(const LAS bf16x8*)(kn + c0); a1[s] = *(const LAS bf16x8*)(kn + c1); b0[s] = *(const LAS bf16x8*)(kn + 32 * 128 + c0); b1[s] = *(const LAS bf16x8*)(kn + 32 * 128 + c1); }
    { const int c0 = ((hi * 2) * 16) ^ xr, c1 = ((hi * 2 + 1) * 16) ^ xr;
        a0[2] = *(const LAS bf16x8*)(kr + c0); a1[2] = *(const LAS bf16x8*)(kr + c1); b0[2] = *(const LAS bf16x8*)(kr + 32 * 64 + c0); b1[2] = *(const LAS bf16x8*)(kr + 32 * 64 + c1); }
    p0 = __builtin_amdgcn_mfma_scale_f32_32x32x64_f8f6f4(cat8(a0[0], a1[0]), qr[0], negm, 0, 0, 0, 0x7F7F7F7F, 0, 0x7C7C7C7C);
    p1 = __builtin_amdgcn_mfma_scale_f32_32x32x64_f8f6f4(cat8(b0[0], b1[0]), qr[0], negm, 0, 0, 0, 0x7F7F7F7F, 0, 0x7C7C7C7C);
#pragma unroll
    for (int s = 1; s < 3; ++s) {
        p0 = __builtin_amdgcn_mfma_scale_f32_32x32x64_f8f6f4(cat8(a0[s], a1[s]), qr[s], p0, 0, 0, 0, 0x7F7F7F7F, 0, 0x7C7C7C7C);
        p1 = __builtin_amdgcn_mfma_scale_f32_32x32x64_f8f6f4(cat8(b0[s], b1[s]), qr[s], p1, 0, 0, 0, 0x7F7F7F7F, 0, 0x7C7C7C7C); }
}
__device__ __forceinline__ void partialSM(f32x16& p0, f32x16& p1, f32x16& negm, float& alpha, const bool first) {
    float pmax = p0[0];
#pragma unroll
    for (int r = 1; r < 16; ++r) pmax = fmaxf(pmax, p0[r]);
#pragma unroll
    for (int r = 0; r < 16; ++r) pmax = fmaxf(pmax, p1[r]);
    { auto rr = __builtin_amdgcn_permlane32_swap(__float_as_uint(pmax), __float_as_uint(pmax), false, false);
      pmax = fmaxf(__uint_as_float(rr[0]), __uint_as_float(rr[1])); }
    if (__builtin_expect(!first && __all(pmax <= THR * LOG2E), 1)) { alpha = 1.f; }
    else { const float delta = first ? pmax : fmaxf(pmax, 0.f); alpha = first ? 1.f : __builtin_amdgcn_exp2f(-delta);
#pragma unroll
        for (int r = 0; r < 16; ++r) { p0[r] -= delta; p1[r] -= delta; negm[r] -= delta; } }
#pragma unroll
    for (int r = 0; r < 16; ++r) p0[r] = __builtin_amdgcn_exp2f(p0[r]);
}
__device__ __forceinline__ void finishSM(f32x16& p0, f32x16& p1, i32x8& p8) {
#pragma unroll
    for (int r = 0; r < 16; ++r) p1[r] = __builtin_amdgcn_exp2f(p1[r]);
#pragma unroll
    for (int j = 0; j < 4; ++j) { int w = p8[j]; w = __builtin_amdgcn_cvt_pk_fp8_f32(p0[4 * j], p0[4 * j + 1], w, false); w = __builtin_amdgcn_cvt_pk_fp8_f32(p0[4 * j + 2], p0[4 * j + 3], w, true); p8[j] = w;
        int x = p8[4 + j]; x = __builtin_amdgcn_cvt_pk_fp8_f32(p1[4 * j], p1[4 * j + 1], x, false); x = __builtin_amdgcn_cvt_pk_fp8_f32(p1[4 * j + 2], p1[4 * j + 3], x, true); p8[4 + j] = x; }
}
__device__ __forceinline__ void pv_all(f32x16* o, const LAS unsigned char* vs, int c0, int c1, const i32x8& p8) {
    bf16x8 a[4], b[4];
#pragma unroll
    for (int d0 = 0; d0 < 4; ++d0) { a[d0] = *(const LAS bf16x8*)(vs + d0 * 2048 + c0); b[d0] = *(const LAS bf16x8*)(vs + d0 * 2048 + c1); }
#pragma unroll
    for (int d0 = 0; d0 < 4; ++d0) o[d0] = __builtin_amdgcn_mfma_scale_f32_32x32x64_f8f6f4(p8, cat8(a[d0], b[d0]), o[d0], 0, 0, 0, 0x7F7F7F7F, 0, 0x7F7F7F7F);
    const i32x8 ones = {0x38383838, 0x38383838, 0x38383838, 0x38383838, 0x38383838, 0x38383838, 0x38383838, 0x38383838};
    o[4] = __builtin_amdgcn_mfma_scale_f32_32x32x64_f8f6f4(p8, ones, o[4], 0, 0, 0, 0x7F7F7F7F, 0, 0x7F7F7F7F);
}
#define MLA_BAR() asm volatile("s_waitcnt vmcnt(0) lgkmcnt(0)\n\ts_barrier" ::: "memory")
template <bool O8> __device__ __forceinline__ void unit(int b, int h, int qb, const unsigned char* __restrict__ Q8, const unsigned char* __restrict__ K8, const unsigned char* __restrict__ KR8, const unsigned char* __restrict__ VT, const float* __restrict__ stat, bf16_t* __restrict__ O, LAS unsigned char* lds, const int wv, const bool pre, const int nb, const int nh) {
    const int tid = opaque_tid(wv), wid = __builtin_amdgcn_readfirstlane(tid >> 6), lane = tid & 63, r32 = lane & 31, hi = lane >> 5;
    const size_t tok0 = (size_t)b * SEQ;
    const char* Kn = (const char*)(K8 + tok0 * 1024 + h * 128);
    const char* Kr = (const char*)(KR8 + tok0 * 64);
    const char* Vt = (const char*)(VT + (size_t)h * 128 * NTOK + tok0);
    LAS float* ws = (LAS float*)(lds + OFF_WS) + wid * 64; LAS float* al_l = ws + 32;
    const unsigned ldsb = (unsigned)(uintptr_t)lds;
    unsigned vkn, vkr, vv;
    { const int L = wid * 64 + lane, row = L >> 3, c16 = (L & 7) ^ ((row >> 1) & 7); vkn = (unsigned)(row * 1024 + c16 * 16); }
    { const int L = (wid & 3) * 64 + lane, row = L >> 2, c16 = (L & 3) ^ ((row >> 2) & 3); vkr = (unsigned)(row * 64 + c16 * 16); }
    { const int L = wid * 64 + lane, c = L >> 2, q = (L & 3) ^ ((c >> 2) & 3); vv = (unsigned)c * (unsigned)NTOK + (unsigned)(q * 16); }
#define MLA_ISSUE_AT(KnX, KrX, VtX, t, sl) do { const size_t ko_ = (size_t)(t) * KVBLK; const unsigned sb_ = ldsb + (unsigned)(sl) * SLOT; \
        glds16_s((KnX) + ko_ * 1024, vkn, sb_ + (unsigned)wid * 1024u); glds16_s((KrX) + ko_ * 64, vkr, sb_ + KN_B + (unsigned)(wid & 3) * 1024u); \
        glds16_s((VtX) + ko_, vv, sb_ + KN_B + KR_B + (unsigned)wid * 1024u); } while (0)
#define MLA_ISSUE(t, sl) MLA_ISSUE_AT(Kn, Kr, Vt, t, sl)
    if (!pre) { MLA_ISSUE(0, 0); MLA_ISSUE(1, 1); }
    f32x16 o[5] = {}; f32x16 negm = {}; i32x8 qr[3];
    { const unsigned char* Qw = Q8 + (tok0 + (size_t)qb * 256 + wid * QBLK + r32) * NQ + h * QKD + hi * 32;
#pragma unroll
      for (int s = 0; s < 3; ++s) qr[s] = cat8(*(const bf16x8*)(Qw + s * 64), *(const bf16x8*)(Qw + s * 64 + 16)); }
    const int xv = ((r32 >> 2) & 3) << 4, vc0 = ((hi * 2) * 16) ^ xv, vc1 = ((hi * 2 + 1) * 16) ^ xv;
    const LAS unsigned char* vbase = lds + KN_B + KR_B + r32 * 64;
#define RESC(a) do { if (__any((a) < 1.f)) { if (hi == 0) al_l[r32] = (a); asm volatile("s_waitcnt lgkmcnt(0)" ::: "memory"); \
    _Pragma("unroll") for (int d = 0; d < 5; ++d) _Pragma("unroll") for (int r = 0; r < 16; ++r) o[d][r] *= al_l[crow(r, hi)]; } } while (0)
    f32x16 p0, p1; float al; i32x8 p8 = {}; constexpr int NT = SEQ / KVBLK;
    MLA_BAR();
#define MLA_BARC(j) asm volatile("s_cmp_lt_i32 %0, %1\n\ts_cbranch_scc1 .Lpb%=\n\ts_waitcnt vmcnt(0)\n\ts_branch .Lpe%=\n.Lpb%=:\n\ts_waitcnt vmcnt(3)\n.Lpe%=:\n\ts_waitcnt lgkmcnt(0)\n\ts_barrier" :: "s"(__builtin_amdgcn_readfirstlane((j) + 2)), "n"(SEQ / KVBLK) : "memory", "scc")
    const bool halfB = wid >= 4;
    if (halfB) { MLA_BARC(0); MLA_ISSUE(2, 2); }
    int sj = 0;
    for (int j = 0; j < NT; ++j) {
        const int s1 = sj == 2 ? 0 : sj + 1, s2 = s1 == 2 ? 0 : s1 + 1;
        qkt(p0, p1, negm, lds + sj * SLOT, qr, r32, hi);
        MLA_BARC(j);
        if (!halfB && j + 2 < NT) MLA_ISSUE(j + 2, s2);
        partialSM(p0, p1, negm, al, j == 0); RESC(al);
        finishSM(p0, p1, p8); SBAR();
        pv_all(o, vbase + sj * SLOT, vc0, vc1, p8);
        MLA_BARC(j);
        if (halfB && j + 3 < NT) MLA_ISSUE(j + 3, sj);
        sj = s1;
    }
    if (!halfB) MLA_BARC(NT);
#undef MLA_BARC
    float rli[16];
#pragma unroll
    for (int r = 0; r < 16; ++r) rli[r] = __builtin_amdgcn_rcpf(o[4][r]);
    MLA_BAR();
    if constexpr (O8) { if (nb >= 0) { const size_t tokn = (size_t)nb * SEQ; const char* KnN = (const char*)(K8 + tokn * 1024 + nh * 128); const char* KrN = (const char*)(KR8 + tokn * 64); const char* VtN = (const char*)(VT + (size_t)nh * 128 * NTOK + tokn);
        MLA_ISSUE_AT(KnN, KrN, VtN, 0, 0); MLA_ISSUE_AT(KnN, KrN, VtN, 1, 1); } }
    LAS unsigned char* ost = O8 ? lds + OFF_O8 + wid * (32 * 144) : lds + wid * (32 * OSTR);
    if constexpr (O8) {
#pragma unroll
        for (int r = 0; r < 16; ++r) { const int orow = crow(r, hi);
#pragma unroll
            for (int d0 = 0; d0 < 4; ++d0) *(LAS unsigned char*)(ost + orow * 144 + d0 * 32 + r32) = (unsigned char)fp8_1(o[d0][r] * rli[r] * O8_SCALE); }
        asm volatile("s_waitcnt lgkmcnt(0)" ::: "memory");
        unsigned char* Ow = (unsigned char*)O + (tok0 + (size_t)qb * 256 + wid * QBLK) * LDO + h * 128;
#pragma unroll
        for (int it = 0; it < 4; ++it) { const int ch = it * 64 + lane, row = ch >> 3, c16 = ch & 7;
            const u32x4 v = *(const LAS u32x4*)(ost + row * 144 + c16 * 16); *(u32x4*)(Ow + (size_t)row * LDO + c16 * 16) = v; }
    } else {
#pragma unroll
        for (int r = 0; r < 16; ++r) { const int orow = crow(r, hi);
#pragma unroll
            for (int d0 = 0; d0 < 4; ++d0) *(LAS unsigned short*)(ost + orow * OSTR + (d0 * 32 + r32) * 2) = (unsigned short)f2bf(o[d0][r] * rli[r]); }
        asm volatile("s_waitcnt lgkmcnt(0)" ::: "memory");
        bf16_t* Ow = O + (tok0 + (size_t)qb * 256 + wid * QBLK) * LDO + h * 128;
#pragma unroll
        for (int it = 0; it < 8; ++it) { const int ch = it * 64 + lane, row = ch >> 4, c16 = ch & 15;
            const u32x4 v = *(const LAS u32x4*)(ost + row * OSTR + c16 * 16); *(u32x4*)(Ow + (size_t)row * LDO + c16 * 8) = v; }
        MLA_BAR();
    }
#undef MLA_ISSUE_AT
#undef MLA_ISSUE
#undef RESC
}
#undef MLA_BAR
}

namespace swa {
constexpr int KT = 8192, SLOT = 16384, NSLOT = 6, NTILE_SEQ = SEQ / 64;
constexpr int OFF_O = NSLOT * SLOT  , OSTR = 144, OFF_WS = OFF_O + 8 * 32 * OSTR  , OFF_END = OFF_WS + 8 * 64 * 4;
static_assert(OFF_END <= RING_BYTES, "swa lds");
constexpr int LD = SWA_NQKV;
constexpr float C = 0.125f * LOG2E, THRL = 24.f;
template <bool O8> __device__ __forceinline__ void superunit(int b, int g, int qb0, int nqb, const bf16_t* __restrict__ QKV, const float* __restrict__ sink, bf16_t* __restrict__ O, LAS unsigned char* lds, const int wv) {
    const int tid = opaque_tid(wv), wid = __builtin_amdgcn_readfirstlane(tid >> 6), lane = tid & 63, r32 = lane & 31, hi = lane >> 5;
    const size_t tok0 = (size_t)b * SEQ; const unsigned ldsb = (unsigned)(uintptr_t)lds;
    const char* Kg = (const char*)(QKV + tok0 * LD + 1024 + g * 64); const char* Vg = (const char*)(QKV + tok0 * LD + 1280 + g * 64);
    unsigned vk, vv;
    { const int L = wid * 64 + lane; { const int row = L >> 3, c16 = (L & 7) ^ ((row >> 1) & 7); vk = (unsigned)(row * (LD * 2) + c16 * 16); }
      { const int st = L >> 5, w = L & 31, kk = (st >> 1) * 8 + (w >> 2), k = (kk & ~0xC) | ((kk & 4) << 1) | ((kk & 8) >> 1), c = (st & 1) * 32 + (w & 3) * 8; vv = (unsigned)(k * (LD * 2) + c * 2); } }
#define SWA_ISSUE(T) do { const size_t ko_ = (size_t)(T) * 64 * (LD * 2); const unsigned sb_ = ldsb + (unsigned)((T) % NSLOT) * SLOT + (unsigned)wid * 1024u; \
        glds16_s(Kg + ko_, vk, sb_); glds16_s(Vg + ko_, vv, sb_ + KT); } while (0)
    { const int t0 = qb0 - 2 < 0 ? 0 : qb0 - 2, t1 = qb0 + 2 > NTILE_SEQ - 1 ? NTILE_SEQ - 1 : qb0 + 2;
      for (int T = t0; T <= t1; ++T) SWA_ISSUE(T); }
    const int qh = g * 4 + (wid >> 1);
    const float slope2 = __builtin_amdgcn_exp2f(-0.5f * (float)(qh + 1)) * LOG2E;
    const float sink2 = sink[qh] * LOG2E, nslope2 = -slope2, rbf = (float)(4 * hi - (wid & 1) * 32 - r32);
    const bf16x8 ones8 = {0x3F80, 0x3F80, 0x3F80, 0x3F80, 0x3F80, 0x3F80, 0x3F80, 0x3F80};
    LAS float* al_l = (LAS float*)(lds + OFF_WS) + wid * 64; LAS float* li_l = al_l + 32;
    const int vrb = (int)ldsb + KT + v_rd_base(lane);
    const int xr = ((r32 >> 1) & 7) << 4;
    bf16x8 qr[4], qn[4];
    { const bf16_t* Qw = QKV + (tok0 + (size_t)(qb0 * 64 + (wid & 1) * 32 + r32)) * LD + qh * 64 + hi * 8;
#pragma unroll
      for (int d0 = 0; d0 < 4; ++d0) qr[d0] = *(const bf16x8*)(Qw + d0 * 16); }
    asm volatile("s_waitcnt vmcnt(0) lgkmcnt(0)\n\ts_barrier" ::: "memory");
    for (int qb = qb0; qb < qb0 + nqb; ++qb) {
        const bool more = qb + 1 < qb0 + nqb;
        if (more && qb + 3 < NTILE_SEQ) SWA_ISSUE(qb + 3);
        const int q0 = qb * 64, rowb = q0 + (wid & 1) * 32;
        if (more) { const bf16_t* Qw = QKV + (tok0 + (size_t)(rowb + 64 + r32)) * LD + qh * 64 + hi * 8;
#pragma unroll
            for (int d0 = 0; d0 < 4; ++d0) qn[d0] = *(const bf16x8*)(Qw + d0 * 16); }
        asm volatile("" ::: "memory");
        const int T0 = qb - 2 < 0 ? 0 : qb - 2, T1 = qb + 2 > NTILE_SEQ - 1 ? NTILE_SEQ - 1 : qb + 2;
        float rbq = rbf; asm volatile("" : "+v"(rbq));
        float m_reg = 0.f; f32x16 o[2] = {}, osum = {};
#define SWA_RAMP(p0, p1, A, S) do { const float s2_ = (S) + (S), s8_ = 8.f * (S), s32_ = 32.f * (S); \
            p0[0] = (A); p0[1] = (A) + (S); p0[2] = (A) + s2_; p0[3] = p0[1] + s2_; \
            _Pragma("unroll") for (int r = 4; r < 16; ++r) p0[r] = p0[r - 4] + s8_; \
            _Pragma("unroll") for (int r = 0; r < 16; ++r) p1[r] = p0[r] + s32_; } while (0)
        for (int T = T0; T <= T1; ++T) {
            const LAS unsigned char* Ks = lds + (T % NSLOT) * SLOT + r32 * 128; f32x16 p0, p1;
            { const int dt = T - qb; const float base = rbq + (float)(dt * 64);
              SWA_RAMP(p0, p1, base, 1.0f);
              if (dt == -2 || dt == 2) {
#pragma unroll
                  for (int r = 0; r < 16; ++r) { const float a0 = __builtin_fabsf(p0[r]), a1 = __builtin_fabsf(p1[r]);
                      p0[r] = a0 > 128.f ? -INFINITY : fmaf(nslope2, a0, -m_reg); p1[r] = a1 > 128.f ? -INFINITY : fmaf(nslope2, a1, -m_reg); } }
              else {
#pragma unroll
                  for (int r = 0; r < 16; ++r) { p0[r] = fmaf(nslope2, __builtin_fabsf(p0[r]), -m_reg); p1[r] = fmaf(nslope2, __builtin_fabsf(p1[r]), -m_reg); } } }
#pragma unroll
            for (int d0 = 0; d0 < 4; ++d0) { const int cb = ((d0 * 2 + hi) * 16) ^ xr;
                const bf16x8 b0 = *(const LAS bf16x8*)(Ks + cb), b1 = *(const LAS bf16x8*)(Ks + 32 * 128 + cb);
                p0 = __builtin_amdgcn_mfma_f32_32x32x16_bf16(b0, qr[d0], p0, 0, 0, 0);
                p1 = __builtin_amdgcn_mfma_f32_32x32x16_bf16(b1, qr[d0], p1, 0, 0, 0); }
            float pmax = p0[0];
#pragma unroll
            for (int r = 1; r < 16; ++r) pmax = fmaxf(pmax, p0[r]);
#pragma unroll
            for (int r = 0; r < 16; ++r) pmax = fmaxf(pmax, p1[r]);
            { auto rr = __builtin_amdgcn_permlane32_swap(__float_as_uint(pmax), __float_as_uint(pmax), false, false);
              pmax = fmaxf(__uint_as_float(rr[0]), __uint_as_float(rr[1])); }
            const bool first = (T == T0);
            if (__builtin_expect(!first && __all(pmax <= THRL), 1)) { }
            else { const float delta = first ? pmax : fmaxf(pmax, 0.f); m_reg += delta;
#pragma unroll
                for (int r = 0; r < 16; ++r) { p0[r] -= delta; p1[r] -= delta; }
                if (!first) { if (hi == 0) al_l[r32] = __builtin_amdgcn_exp2f(-delta); asm volatile("s_waitcnt lgkmcnt(0)" ::: "memory");
#pragma unroll
                    for (int r = 0; r < 16; ++r) { const float a = al_l[crow(r, hi)]; o[0][r] *= a; o[1][r] *= a; osum[r] *= a; } } }
#pragma unroll
            for (int r = 0; r < 16; ++r) { p0[r] = __builtin_amdgcn_exp2f(p0[r]); p1[r] = __builtin_amdgcn_exp2f(p1[r]); }
            bf16x8 pa0, pa1, pa2, pa3;
            PK4(p0, 0, pa0); PK4(p0, 8, pa1); PK4(p1, 0, pa2); PK4(p1, 8, pa3);
            const int vb = vrb + (T % NSLOT) * SLOT;
            pv_one<0, 2>(o[0], vb, pa0, pa1, pa2, pa3); pv_one<1, 2>(o[1], vb, pa0, pa1, pa2, pa3);
            osum = __builtin_amdgcn_mfma_f32_32x32x16_bf16(pa0, ones8, osum, 0, 0, 0); osum = __builtin_amdgcn_mfma_f32_32x32x16_bf16(pa1, ones8, osum, 0, 0, 0);
            osum = __builtin_amdgcn_mfma_f32_32x32x16_bf16(pa2, ones8, osum, 0, 0, 0); osum = __builtin_amdgcn_mfma_f32_32x32x16_bf16(pa3, ones8, osum, 0, 0, 0);
        }
#undef SWA_RAMP
        { const float e = __builtin_amdgcn_exp2f(sink2 - m_reg);
          if (hi == 0) li_l[r32] = e; asm volatile("s_waitcnt lgkmcnt(0)" ::: "memory"); }
        LAS unsigned char* ost = lds + OFF_O + wid * (32 * OSTR);
        if constexpr (O8) {
#pragma unroll
            for (int r = 0; r < 16; ++r) { const int orow = crow(r, hi); const float rl = __builtin_amdgcn_rcpf(osum[r] + li_l[orow]) * O8_SCALE;
#pragma unroll
                for (int d0 = 0; d0 < 2; ++d0) *(LAS unsigned char*)(ost + orow * 80 + d0 * 32 + r32) = (unsigned char)fp8_1(o[d0][r] * rl); }
            asm volatile("s_waitcnt lgkmcnt(0)" ::: "memory");
            unsigned char* Ow = (unsigned char*)O + (tok0 + (size_t)rowb) * DM + qh * 64;
#pragma unroll
            for (int it = 0; it < 2; ++it) { const int ch = it * 64 + lane, row = ch >> 2, c16 = ch & 3;
                const u32x4 v = *(const LAS u32x4*)(ost + row * 80 + c16 * 16); *(u32x4*)(Ow + (size_t)row * DM + c16 * 16) = v; }
            asm volatile("s_waitcnt vmcnt(2) lgkmcnt(0)\n\ts_barrier" ::: "memory");
        } else {
#pragma unroll
            for (int r = 0; r < 16; ++r) { const int orow = crow(r, hi); const float rl = __builtin_amdgcn_rcpf(osum[r] + li_l[orow]);
#pragma unroll
                for (int d0 = 0; d0 < 2; ++d0) *(LAS unsigned short*)(ost + orow * OSTR + (d0 * 32 + r32) * 2) = (unsigned short)f2bf(o[d0][r] * rl); }
            asm volatile("s_waitcnt lgkmcnt(0)" ::: "memory");
            bf16_t* Ow = O + (tok0 + (size_t)rowb) * DM + qh * 64;
#pragma unroll
            for (int it = 0; it < 4; ++it) { const int ch = it * 64 + lane, row = ch >> 3, c16 = ch & 7;
                const u32x4 v = *(const LAS u32x4*)(ost + row * OSTR + c16 * 16); *(u32x4*)(Ow + (size_t)row * DM + c16 * 8) = v; }
            asm volatile("s_waitcnt vmcnt(4) lgkmcnt(0)\n\ts_barrier" ::: "memory");
        }
#pragma unroll
        for (int d0 = 0; d0 < 4; ++d0) qr[d0] = qn[d0];
    }
    asm volatile("s_waitcnt vmcnt(0)" ::: "memory");
#undef SWA_ISSUE
}
}

constexpr int NWAVES = 8;
struct Args { const float* in[23]; float* out; unsigned char* ws; };
static_assert(sizeof(Args) == 25 * 8, "no padding");

template <int KIND> __device__ __forceinline__ int map_row(int n) {
    if (KIND == 0) return n;
    if (KIND == 1) return ((n >> 7) << 8) + (n & 127);
    if (KIND == 2) return ((n >> 7) << 8) + 128 + (n & 127);
    if (KIND == 3) { const int h = n / QKD; int d = n - h * QKD; if (d >= 128) { const int i = d - 128; d = 128 + (i < 32 ? 2 * i : 2 * (i - 32) + 1); } return h * QKD + d; }
    if (KIND == 4) { if (n >= 512) { const int i = n - 512; n = 512 + (i < 32 ? 2 * i : 2 * (i - 32) + 1); } return n; }
    return n;
}
template <int KIND, bool F8> __device__ __forceinline__ void transpose_any(const float* W, int K, int N, void* WTv, int row_off, LAS float* scr, int gw, int NGW, int lane, float scale, const float* gk) {
    const int nblk = N / 32, nitems = (K / 64) * nblk;
    f32x4 t[8];
#define TR_LOAD(item) do { const int kb_ = (item) / nblk, nb_ = (item) % nblk; _Pragma("unroll") for (int i = 0; i < 8; ++i) t[i] = *(const f32x4*)(W + (size_t)(64 * kb_ + (lane >> 3) + 8 * i) * N + 32 * nb_ + 4 * (lane & 7)); } while (0)
    int item = gw;
    if (item < nitems) TR_LOAD(item);
    for (; item < nitems; item += NGW) {
        const int kb = item / nblk, nb = item % nblk, k0 = 64 * kb, n0 = 32 * nb;
#pragma unroll
        for (int i = 0; i < 8; ++i) { const int kk = (lane >> 3) + 8 * i; f32x4 v = t[i]; if (F8) v = v * scale; if (gk) v = v * gk[k0 + kk];
            LAS float* d = scr + kk * 33 + 4 * (lane & 7); d[0] = v.x; d[1] = v.y; d[2] = v.z; d[3] = v.w; }
        if (item + NGW < nitems) TR_LOAD(item + NGW);
        LDS_WAIT(); asm volatile("" ::: "memory");
        const int c = lane & 7;
#pragma unroll
        for (int j = 0; j < 4; ++j) { const int n = (lane >> 3) + 8 * j; const LAS float* sp = scr + (8 * c) * 33 + n;
            if (F8) { const float o[8] = {sp[0 * 33], sp[1 * 33], sp[2 * 33], sp[3 * 33], sp[4 * 33], sp[5 * 33], sp[6 * 33], sp[7 * 33]};
                *(u32x2*)((unsigned char*)WTv + (size_t)(row_off + map_row<KIND>(n0 + n)) * K + k0 + 8 * c) = pk8_fp8(o); }
            else { u32x4 o; o.x = pk2(sp[0 * 33], sp[1 * 33]); o.y = pk2(sp[2 * 33], sp[3 * 33]); o.z = pk2(sp[4 * 33], sp[5 * 33]); o.w = pk2(sp[6 * 33], sp[7 * 33]);
                *(u32x4*)((bf16_t*)WTv + (size_t)(row_off + map_row<KIND>(n0 + n)) * K + k0 + 8 * c) = o; } }
        LDS_WAIT(); asm volatile("" ::: "memory");
    }
#undef TR_LOAD
}
template <int KIND> __device__ __forceinline__ void transpose_matrix(const float* W, int K, int N, bf16_t* WT, int row_off, LAS float* scr, int gw, int NGW, int lane, const float* gk = nullptr) {
    transpose_any<KIND, false>(W, K, N, WT, row_off, scr, gw, NGW, lane, 1.f, gk);
}
template <int KIND> __device__ __forceinline__ void transpose_matrix_f8(const float* W, int K, int N, unsigned char* WT, int row_off, LAS float* scr, int gw, int NGW, int lane, float scale, const float* gk = nullptr) {
    transpose_any<KIND, true>(W, K, N, WT, row_off, scr, gw, NGW, lane, scale, gk);
}
template <bool F8> __device__ __forceinline__ void rms_row_to_bf16(const float* xrow, const f32x4 (&gv)[4], bf16_t* orow, int lane) {
    const f32x4* xr = (const f32x4*)xrow + lane; f32x4 v[4]; float s = 0.f;
#pragma unroll
    for (int j = 0; j < 4; ++j) { v[j] = xr[64 * j]; s += (v[j].x * v[j].x + v[j].y * v[j].y) + (v[j].z * v[j].z + v[j].w * v[j].w); }
    const float rstd = 1.0f / sqrtf(wave_sum(s, lane) * (1.f / DM) + EPS);
    if (F8) { unsigned* o4 = (unsigned*)orow + lane;
#pragma unroll
        for (int j = 0; j < 4; ++j) { const f32x4 y = v[j] * rstd * gv[j]; int w = 0; w = __builtin_amdgcn_cvt_pk_fp8_f32(y.x, y.y, w, false); w = __builtin_amdgcn_cvt_pk_fp8_f32(y.z, y.w, w, true); o4[64 * j] = (unsigned)w; } }
    else { unsigned long long* o8 = (unsigned long long*)orow + lane;
#pragma unroll
    for (int j = 0; j < 4; ++j) { const f32x4 y = v[j] * rstd * gv[j]; o8[64 * j] = (unsigned long long)pk2(y.x, y.y) | ((unsigned long long)pk2(y.z, y.w) << 32); } }
}

#define PHASE_IDS const int tid = opaque_tid(bar.wv), lane = tid & 63, wave = __builtin_amdgcn_readfirstlane(tid >> 6), gw = vcu * NWAVES + wave; (void)gw; (void)lane
template <int j> __device__ __forceinline__ void pair_body(const Args& args, LAS unsigned char* lds, const XcdBarrier& bar, const int G, const int bx, const int vcu) {
    const int NGW = G * NWAVES;
    unsigned char* ws = args.ws;
    LAS int* moetab = (LAS int*)(lds + MOETAB_OFF);
    const float* x = args.in[0];
    int* route = (int*)(ws + WS_ROUTE); f32x2* gate = (f32x2*)(ws + WS_GATE); int* posb = (int*)(ws + WS_POS); int* cnt = (int*)(ws + WS_CNT);
    unsigned char* act = ws + WS_ACT;
    bf16_t* H = (bf16_t*)(act + A_H); bf16_t* XN = (bf16_t*)(act + A_XN); bf16_t* DOWN = (bf16_t*)(act + A_DOWN); bf16_t* QB = (bf16_t*)(act + A_Q);
    bf16_t* KVB = (bf16_t*)args.out;
    bf16_t* FACT = (bf16_t*)(act + A_FACT); bf16_t* SQKV = (bf16_t*)(act + A_SQKV); bf16_t* SO = (bf16_t*)(act + A_SO); bf16_t* XS = (bf16_t*)args.out; bf16_t* MACT = (bf16_t*)(act + A_MACT);
    float* STAT = (float*)(act + A_STAT); LAS float* PART = (LAS float*)(lds + PART_OFF);
    constexpr bool F8M = ((FP8_MOE >> j) & 1) != 0, F8F = ((FP8_FFN >> j) & 1) != 0, S8 = ((FP8_S2 >> j) & 1) != 0, Y8 = F8M && ((FP8_YS >> j) & 1) != 0;
    unsigned char* H8 = act + A_H8;
    bf16_t* YS = F8M ? (bf16_t*)(act + A_YS) : XS;
    constexpr bool FINAL_DIRECT = (j == 1) && F8M;
    {
        unsigned char* wb = ws + WS_W + (size_t)j * W_PAIR;
        if (PH(1)) { constexpr bool D8 = FP8_DOWN != 0; pg8::Gemm g{XN, (const bf16_t*)(wb + W_DQKV), D8 ? DM / 2 : DM, D8 ? DM / 2 : DM, D8 ? DM / 2 : DM}; pg8::DenseOrder S; S.init(NTOK, DOWNP, G, bx, 256);
          pg8::EpiDown<FP8_QK != 0, FP8_UP != 0> E{DOWN, STAT, PART, act + A_KR8, D8 ? 1.0f / W8_SCALE : 1.0f}; pg8::gemm_phase<pg8::EpiDown<FP8_QK != 0, FP8_UP != 0>, pg8::DenseOrder, true, D8>(lds, g, S, E, bar.wv); }
        xcd_barrier(bar);
        if (PH(3)) { constexpr bool U8 = FP8_UP != 0; constexpr int KU = U8 ? 128 : 256, LDD = U8 ? DOWNP / 2 : DOWNP; const float us = U8 ? 1.0f / W8_SCALE : 1.0f;
          const bf16_t* CQ = DOWN; const bf16_t* CKV = U8 ? (const bf16_t*)((const unsigned char*)DOWN + 256) : DOWN + 256;
          { pg8::Gemm g{CQ, (const bf16_t*)(wb + W_UQ), LDD, KU, KU}; pg8::DenseOrder S; S.init(NTOK, NQ, G, bx, 256);
            pg8::EpiQRope<FP8_QK != 0, FP8_PV != 0> E{QB, us, STAT, mla9::QPRE}; pg8::gemm_phase<pg8::EpiQRope<FP8_QK != 0, FP8_PV != 0>, pg8::DenseOrder, true, U8>(lds, g, S, E, bar.wv); }
          if constexpr (FP8_PV != 0) {
            { pg8::Gemm g{CKV, (const bf16_t*)(wb + W_UKV), LDD, KU, KU}; pg8::DenseOrder Sk; Sk.init(NTOK, 1024, G, bx, 256);
              pg8::EpiKV8 Ek{KVB, act + A_K8, STAT, us}; pg8::gemm_phase<pg8::EpiKV8, pg8::DenseOrder, true, U8>(lds, g, Sk, Ek, bar.wv); }
            { pg8::Gemm gv{U8 ? (const bf16_t*)(wb + W_UKV + (size_t)1024 * 256) : (const bf16_t*)(wb + W_UKV) + (size_t)1024 * 256, CKV, KU, LDD, KU}; pg8::DenseOrder Sv; Sv.init(1024, NTOK, G, bx, 256);
              pg8::EpiVT8 Ev{(unsigned char*)args.out, STAT, us}; pg8::gemm_phase<pg8::EpiVT8, pg8::DenseOrder, true, U8>(lds, gv, Sv, Ev, bar.wv); } }
          else { pg8::Gemm g{CKV, (const bf16_t*)(wb + W_UKV), LDD, KU, KU}; pg8::DenseOrder S; S.init(NTOK, NKV, G, bx, 256);
            if constexpr (FP8_QK != 0) { pg8::EpiKV8 E{KVB, act + A_K8, STAT, us}; pg8::gemm_phase<pg8::EpiKV8, pg8::DenseOrder, true, U8>(lds, g, S, E, bar.wv); }
            else { pg8::EpiBf16<false, 1> E{KVB, NKV, STAT, 1, 1.f / 256.f, 1.f}; pg8::gemm_phase<pg8::EpiBf16<false, 1>, pg8::DenseOrder, true>(lds, g, S, E, bar.wv); } } }
        xcd_barrier(bar);
        if (PH(4)) { const int NU = BATCH * MLA_H * (SEQ / 256);
          for (int u = vcu; u < NU; u += G) { const int bh = u >> 3, qb = u & 7;
              if constexpr (FP8_PV != 0) { const int un = u + G, nbh = un >> 3; mla9::unit<FP8_ATTO != 0>(bh >> 3, bh & 7, qb, (const unsigned char*)QB, act + A_K8, act + A_KR8, (const unsigned char*)args.out, STAT, XN, lds, bar.wv, (FP8_ATTO != 0) && u != vcu, un < NU ? (nbh >> 3) : -1, nbh & 7); }
              else if constexpr (FP8_QK != 0) mla8::unit<FP8_ATTO != 0>(bh >> 3, bh & 7, qb, (const unsigned char*)QB, act + A_K8, act + A_KR8, KVB, STAT, XN, lds, bar.wv);
              else mla::unit<FP8_ATTO != 0>(bh >> 3, bh & 7, qb, QB, KVB, DOWN, STAT, XN, lds, bar.wv); } }
        xcd_barrier(bar);
        if (PH(5)) { constexpr bool F8 = FP8_ATTO != 0; pg8::Gemm g{XN, (const bf16_t*)(wb + W_MO), F8 ? DM / 2 : DM, F8 ? DM / 2 : DM, F8 ? DM / 2 : DM}; pg8::DenseOrder S; S.init(NTOK, DM, G, bx, 256);
          pg8::EpiResid<j == 0, F8F> E{j == 0 ? (const void*)x : (const void*)H, H, STAT, PART, F8 ? RESID_SCALE / (W8_SCALE * O8_SCALE) : RESID_SCALE, H8}; pg8::gemm_phase<pg8::EpiResid<j == 0, F8F>, pg8::DenseOrder, true, F8>(lds, g, S, E, bar.wv); }
        xcd_barrier(bar);
        if (PH(7)) {
          if constexpr (F8F) { pg8::Gemm g{(const bf16_t*)H8, (const bf16_t*)(wb + W_FGU), DM / 2, DM / 2, DM / 2}; pg8::DenseOrder S; S.init(NTOK, 2 * FFN, G, bx, 128);
            pg8::EpiSwiGLU<false, 4, true> E{FACT, FFN, STAT, 1.f / 1024.f, 1.0f / W8_SCALE}; pg8::gemm_phase<pg8::EpiSwiGLU<false, 4, true>, pg8::DenseOrder, true, true>(lds, g, S, E, bar.wv); }
          else { pg8::Gemm g{H, (const bf16_t*)(wb + W_FGU), DM, DM, DM}; pg8::DenseOrder S; S.init(NTOK, 2 * FFN, G, bx, 128);
            pg8::EpiSwiGLU<false, 4> E{FACT, FFN, STAT, 1.f / 1024.f, 1.f}; pg8::gemm_phase<pg8::EpiSwiGLU<false, 4>, pg8::DenseOrder, true>(lds, g, S, E, bar.wv); } }
        xcd_barrier(bar);
        if (PH(8)) {
          if constexpr (F8F) { pg8::Gemm g{FACT, (const bf16_t*)(wb + W_FD), FFN / 2, FFN / 2, FFN / 2}; pg8::DenseOrder S; S.init(NTOK, DM, G, bx, 256);
            pg8::EpiResid<false, S8> E{H, H, STAT, PART, RESID_SCALE / W8_SCALE, H8}; pg8::gemm_phase<pg8::EpiResid<false, S8>, pg8::DenseOrder, true, true>(lds, g, S, E, bar.wv); }
          else { pg8::Gemm g{FACT, (const bf16_t*)(wb + W_FD), FFN, FFN, FFN}; pg8::DenseOrder S; S.init(NTOK, DM, G, bx, 256);
            pg8::EpiResid<false, S8> E{H, H, STAT, PART, RESID_SCALE, H8}; pg8::gemm_phase<pg8::EpiResid<false, S8>, pg8::DenseOrder, true>(lds, g, S, E, bar.wv); } }
        xcd_barrier(bar);
        if (PH(10)) { pg8::Gemm g{S8 ? (const bf16_t*)H8 : H, (const bf16_t*)(wb + W_SQKV), S8 ? DM / 2 : DM, S8 ? DM / 2 : DM, S8 ? DM / 2 : DM}; pg8::DenseOrder S; S.init(NTOK, SWA_NQKV, G, bx, 256);
          pg8::EpiBf16<false, 4> E{SQKV, SWA_NQKV, STAT, 0, 1.f / 1024.f, S8 ? 1.0f / W8_SCALE : 1.f, 1024, swa::C}; pg8::gemm_phase<pg8::EpiBf16<false, 4>, pg8::DenseOrder, true, S8>(lds, g, S, E, bar.wv); }
        xcd_barrier(bar);
        if (PH(11)) { constexpr int NQB = 16, NSU = BATCH * 4 * (SEQ / 64 / NQB);
          for (int su = vcu; su < NSU; su += G) { const int bg = su >> 1, qb0 = (su & 1) * NQB; swa::superunit<FP8_ATTO != 0>(bg >> 2, bg & 3, qb0, NQB, SQKV, args.in[11] + j * 16, SO, lds, bar.wv); } }
        xcd_barrier(bar);
        if (PH(12)) { constexpr bool F8 = FP8_ATTO != 0; pg8::Gemm g{SO, (const bf16_t*)(wb + W_SO), F8 ? DM / 2 : DM, F8 ? DM / 2 : DM, F8 ? DM / 2 : DM}; pg8::DenseOrder S; S.init(NTOK, DM, G, bx, 256);
          pg8::EpiResid<false> E{H, H, STAT, PART, F8 ? RESID_SCALE / (W8_SCALE * O8_SCALE) : RESID_SCALE, nullptr}; pg8::gemm_phase<pg8::EpiResid<false>, pg8::DenseOrder, true, F8>(lds, g, S, E, bar.wv); }
        xcd_barrier(bar);
        if (PH(13)) { PHASE_IDS; constexpr int WSTR = 1032;
          LAS bf16_t* wsp = (LAS bf16_t*)lds;
          LAS int* lcnt = (LAS int*)(lds + 65536);
          const float* router = args.in[18] + (size_t)j * DM * NE; const float* mg = args.in[17] + j * DM;
          for (int i = tid; i < DM * NE; i += NWAVES * 64) { const int e = i & 7, k = i >> 3; const float w = router[i] * mg[k];
              const unsigned w1 = f2bf(w); const float r1 = w - __uint_as_float(w1 << 16); const unsigned w2 = f2bf(r1); const float r2 = r1 - __uint_as_float(w2 << 16); const unsigned w3 = f2bf(r2);
              wsp[(0 * 8 + e) * WSTR + k] = (bf16_t)w1; wsp[(1 * 8 + e) * WSTR + k] = (bf16_t)w2; wsp[(2 * 8 + e) * WSTR + k] = (bf16_t)w3; }
          __syncthreads();
          const int n16 = lane & 15, kg = lane >> 4;
          const LAS bf16_t* wl = wsp + (n16 & 7) * WSTR + 8 * kg;
          for (int ck = vcu; ck < NTOK / 256; ck += G) {
              if (tid < 8) lcnt[tid] = 0;
              __syncthreads();
              const int tokb = ck * 256 + wave * 32;
              const bf16_t* h0 = H + (size_t)(tokb + n16) * DM + 8 * kg; const bf16_t* h1 = h0 + (size_t)16 * DM;
              f32x4 acc0 = {0.f, 0.f, 0.f, 0.f}, acc1 = {0.f, 0.f, 0.f, 0.f};
              bf16x8 ha[8], hb[8], na[8], nb[8];
#pragma unroll
              for (int i = 0; i < 8; ++i) { na[i] = *(const bf16x8*)(h0 + i * 32); nb[i] = *(const bf16x8*)(h1 + i * 32); }
              const f32x4 st0 = *(const f32x4*)(STAT + (size_t)(tokb + n16) * 4), st1 = *(const f32x4*)(STAT + (size_t)(tokb + 16 + n16) * 4);
              for (int g8 = 0; g8 < 4; ++g8) {
#pragma unroll
                  for (int i = 0; i < 8; ++i) { ha[i] = na[i]; hb[i] = nb[i]; }
                  if (g8 < 3) {
#pragma unroll
                      for (int i = 0; i < 8; ++i) { na[i] = *(const bf16x8*)(h0 + ((g8 + 1) * 8 + i) * 32); nb[i] = *(const bf16x8*)(h1 + ((g8 + 1) * 8 + i) * 32); } }
#pragma unroll
                  for (int i = 0; i < 8; ++i) { const int kk = g8 * 8 + i;
#pragma unroll
                      for (int sp = 0; sp < 3; ++sp) { const bf16x8 wf = *(const LAS bf16x8*)(wl + sp * 8 * WSTR + kk * 32);
                          acc0 = __builtin_amdgcn_mfma_f32_16x16x32_bf16(wf, ha[i], acc0, 0, 0, 0); acc1 = __builtin_amdgcn_mfma_f32_16x16x32_bf16(wf, hb[i], acc1, 0, 0, 0); } } }
#pragma unroll
              for (int bt = 0; bt < 2; ++bt) { const f32x4 ac = bt ? acc1 : acc0; const f32x4 st4 = bt ? st1 : st0; const int tok = tokb + bt * 16 + n16;
                  const float rstd = 1.0f / sqrtf(((st4.x + st4.y) + (st4.z + st4.w)) * (1.f / DM) + EPS);
                  float lg[8];
#pragma unroll
                  for (int q4 = 0; q4 < 4; ++q4) { auto rr = __builtin_amdgcn_permlane16_swap(__float_as_uint(ac[q4]), __float_as_uint(ac[q4]), false, false);
                      lg[q4] = __uint_as_float(rr[0]) * rstd; lg[4 + q4] = __uint_as_float(rr[1]) * rstd; }
                  int i0 = 0; float v0 = lg[0];
#pragma unroll
                  for (int e = 1; e < 8; ++e) if (lg[e] > v0) { v0 = lg[e]; i0 = e; }
                  int i1 = -1; float v1 = -INFINITY;
#pragma unroll
                  for (int e = 0; e < 8; ++e) if (e != i0 && lg[e] > v1) { v1 = lg[e]; i1 = e; }
                  const float g0 = 1.0f / (1.0f + __expf(v1 - v0));
                  if (lane < 16) { route[tok] = i0 | (i1 << 8); gate[tok] = (f32x2){g0, 1.0f - g0}; __hip_atomic_fetch_add(lcnt + i0, 1, __ATOMIC_RELAXED, __HIP_MEMORY_SCOPE_WORKGROUP); __hip_atomic_fetch_add(lcnt + i1, 1, __ATOMIC_RELAXED, __HIP_MEMORY_SCOPE_WORKGROUP); } }
              __syncthreads();
              if (tid < 8) cnt[ck * 8 + tid] = lcnt[tid];
              __syncthreads();
          } }
        xcd_barrier(bar);
        if (PH(14)) { PHASE_IDS; LAS int* red = (LAS int*)lds;
          LAS int* tp = (LAS int*)(lds + 1024);
          LAS int* wcn = (LAS int*)(lds + 2048);
          LAS int* lpos = (LAS int*)(lds + 4096);
          f32x4 gv[4];
#pragma unroll
          for (int k = 0; k < 4; ++k) gv[k] = ((const f32x4*)(args.in[17] + j * DM))[F8M ? 4 * lane + k : lane + 64 * k];
          int v[8];
          if (tid < 256) { const i32x4 c0 = ((const i32x4*)cnt)[tid * 2], c1 = ((const i32x4*)cnt)[tid * 2 + 1]; v[0] = c0.x; v[1] = c0.y; v[2] = c0.z; v[3] = c0.w; v[4] = c1.x; v[5] = c1.y; v[6] = c1.z; v[7] = c1.w; }
          else {
#pragma unroll
              for (int e = 0; e < 8; ++e) v[e] = 0; }
#pragma unroll
          for (int e = 0; e < 8; ++e) { int tot = v[e];
#pragma unroll
              for (int o = 1; o < 64; o <<= 1) tot += shxi(tot, o, lane);
              if (lane == 0) red[wave * 16 + e] = tot; }
          __syncthreads();
          if (tid < 8) { int sm = 0;
#pragma unroll
              for (int w = 0; w < 8; ++w) sm += red[w * 16 + tid];
              tp[tid] = sm; }
          __syncthreads();
          if (tid == 0) { int rs = 0, ts = 0;
              for (int e = 0; e < 8; ++e) { moetab[e] = ts; moetab[16 + e] = rs; rs += tp[e]; ts += (tp[e] + 255) >> 8; }
              moetab[8] = ts; moetab[24] = rs; }
          __syncthreads();
          for (int ck = vcu; ck < NTOK / 256; ck += G) {
#pragma unroll
              for (int e = 0; e < 8; ++e) { int pre = (tid < ck) ? v[e] : 0;
#pragma unroll
                  for (int o = 1; o < 64; o <<= 1) pre += shxi(pre, o, lane);
                  if (lane == 0) red[wave * 16 + 8 + e] = pre; }
              __syncthreads();
              if (tid < 8) { int sm = 0;
#pragma unroll
                  for (int w = 0; w < 8; ++w) sm += red[w * 16 + 8 + tid];
                  tp[8 + tid] = sm; }
              int e0 = 0, e1 = 0, r0 = 0, r1 = 0;
              if (tid < 256) { const int re = route[ck * 256 + tid]; e0 = re & 255; e1 = re >> 8; }
#pragma unroll
              for (int e = 0; e < 8; ++e) { const bool f = (tid < 256) && (e0 == e || e1 == e); const unsigned long long mk = __ballot(f);
                  const int rk = __popcll(mk & ((1ull << lane) - 1ull));
                  if (e0 == e) r0 = rk; if (e1 == e) r1 = rk;
                  if (lane == 0 && wave < 4) wcn[wave * 8 + e] = __popcll(mk); }
              __syncthreads();
              if (tid < 256) { int p0 = moetab[16 + e0] + tp[8 + e0] + r0, p1 = moetab[16 + e1] + tp[8 + e1] + r1;
                  for (int w = 0; w < wave; ++w) { p0 += wcn[w * 8 + e0]; p1 += wcn[w * 8 + e1]; }
                  lpos[tid * 2] = p0; lpos[tid * 2 + 1] = p1; posb[(size_t)(ck * 256 + tid) * 2] = p0; posb[(size_t)(ck * 256 + tid) * 2 + 1] = p1; }
              __syncthreads();
              { const int tb = wave * 32, tokb = ck * 256 + tb;
                u32x2 nx[2][4]; f32x4 nst[2];
#pragma unroll
                for (int q = 0; q < 2; ++q) { const u32x2* hr = (const u32x2*)(H + (size_t)(tokb + q) * DM) + (F8M ? 4 * lane : lane);
#pragma unroll
                    for (int k = 0; k < 4; ++k) nx[q][k] = hr[F8M ? k : 64 * k];
                    nst[q] = *(const f32x4*)(STAT + (size_t)(tokb + q) * 4); }
                for (int r = 0; r < 32; r += 2) {
                  u32x2 cu[2][4]; f32x4 cst[2];
#pragma unroll
                  for (int q = 0; q < 2; ++q) { cst[q] = nst[q];
#pragma unroll
                      for (int k = 0; k < 4; ++k) cu[q][k] = nx[q][k]; }
                  if (r + 2 < 32) {
#pragma unroll
                      for (int q = 0; q < 2; ++q) { const u32x2* hr = (const u32x2*)(H + (size_t)(tokb + r + 2 + q) * DM) + (F8M ? 4 * lane : lane);
#pragma unroll
                          for (int k = 0; k < 4; ++k) nx[q][k] = hr[F8M ? k : 64 * k];
                          nst[q] = *(const f32x4*)(STAT + (size_t)(tokb + r + 2 + q) * 4); } }
#pragma unroll
                  for (int q = 0; q < 2; ++q) { const int t = tb + r + q; const int p0 = lpos[t * 2], p1 = lpos[t * 2 + 1];
                      const f32x4 st4 = cst[q];
                      const float rstd = 1.0f / sqrtf(((st4.x + st4.y) + (st4.z + st4.w)) * (1.f / DM) + EPS);
                      if (F8M) { unsigned pk[4];
#pragma unroll
                          for (int k = 0; k < 4; ++k) { const u32x2 w = cu[q][k]; const f32x4 y = (f32x4){bf_lo(w.x), bf_hi(w.x), bf_lo(w.y), bf_hi(w.y)} * rstd * gv[k];
                              int ow = 0; ow = __builtin_amdgcn_cvt_pk_fp8_f32(y.x, y.y, ow, false); ow = __builtin_amdgcn_cvt_pk_fp8_f32(y.z, y.w, ow, true); pk[k] = (unsigned)ow; }
                          const u32x4 pw = {pk[0], pk[1], pk[2], pk[3]};
                          *((u32x4*)((unsigned char*)XS + (size_t)p0 * DM) + lane) = pw; *((u32x4*)((unsigned char*)XS + (size_t)p1 * DM) + lane) = pw; }
                      else { u32x2* o0 = (u32x2*)(XS + (size_t)p0 * DM) + lane; u32x2* o1 = (u32x2*)(XS + (size_t)p1 * DM) + lane;
#pragma unroll
                          for (int k = 0; k < 4; ++k) { const u32x2 w = cu[q][k]; const f32x4 y = (f32x4){bf_lo(w.x), bf_hi(w.x), bf_lo(w.y), bf_hi(w.y)} * rstd * gv[k];
                              u32x2 ow; ow.x = pk2(y.x, y.y); ow.y = pk2(y.z, y.w); o0[64 * k] = ow; o1[64 * k] = ow; } } }
                } }
              __syncthreads();
          } }
        xcd_barrier(bar);
        if (PH(15)) {
          if constexpr (F8M) { pg8::Gemm g{XS, (const bf16_t*)(wb + W_MGU), DM / 2, DM / 2, DM / 2}; pg8::GroupedOrder S; S.init(moetab, 2 * ED, G, bx, 128);
            pg8::EpiSwiGLU<true, 0, true> E{MACT, ED, nullptr, 0.f, 1.0f / W8_SCALE}; pg8::gemm_phase<pg8::EpiSwiGLU<true, 0, true>, pg8::GroupedOrder, true, true>(lds, g, S, E, bar.wv); }
          else { pg8::Gemm g{XS, (const bf16_t*)(wb + W_MGU), DM, DM, DM}; pg8::GroupedOrder S; S.init(moetab, 2 * ED, G, bx, 128);
            pg8::EpiSwiGLU<true, 0> E{MACT, ED, nullptr, 0.f, 1.f}; pg8::gemm_phase<pg8::EpiSwiGLU<true, 0>, pg8::GroupedOrder, true>(lds, g, S, E, bar.wv); } }
        xcd_barrier(bar);
        if (PH(16)) {
          if constexpr (F8M) { pg8::Gemm g{MACT, (const bf16_t*)(wb + W_MD), ED / 2, ED / 2, ED / 2}; pg8::GroupedOrder S; S.init(moetab, DM, G, bx, 256);
            if constexpr (Y8) { pg8::EpiF8<true> E{(unsigned char*)YS, DM, YS8_SCALE / W8_SCALE}; pg8::gemm_phase<pg8::EpiF8<true>, pg8::GroupedOrder, true, true>(lds, g, S, E, bar.wv); }
            else { pg8::EpiBf16<true, 0> E{YS, DM, nullptr, 0, 0.f, 1.0f / W8_SCALE}; pg8::gemm_phase<pg8::EpiBf16<true, 0>, pg8::GroupedOrder, true, true>(lds, g, S, E, bar.wv); } }
          else { pg8::Gemm g{MACT, (const bf16_t*)(wb + W_MD), ED, ED, ED}; pg8::GroupedOrder S; S.init(moetab, DM, G, bx, 256);
            pg8::EpiBf16<true, 0> E{XS, DM, nullptr, 0, 0.f, 1.f}; pg8::gemm_phase<pg8::EpiBf16<true, 0>, pg8::GroupedOrder, true>(lds, g, S, E, bar.wv); } }
        xcd_barrier(bar);
        if (PH(17)) { PHASE_IDS;
          f32x4 gv[4];
#pragma unroll
          for (int k = 0; k < 4; ++k) gv[k] = ((const f32x4*)(j == 0 ? args.in[1] + DM : args.in[22]))[lane + 64 * k];
          for (int m = gw; m < NTOK; m += NGW) {
              const int p0 = posb[(size_t)m * 2], p1 = posb[(size_t)m * 2 + 1]; const f32x2 gg = gate[m] * (Y8 ? RESID_SCALE / YS8_SCALE : RESID_SCALE);
              u32x2* hr = (u32x2*)(H + (size_t)m * DM) + lane;
              f32x4 v[4]; float ss = 0.f;
              if constexpr (Y8) { const unsigned* y0 = (const unsigned*)((const unsigned char*)YS + (size_t)p0 * DM) + lane; const unsigned* y1 = (const unsigned*)((const unsigned char*)YS + (size_t)p1 * DM) + lane;
#pragma unroll
                for (int k = 0; k < 4; ++k) { const unsigned a = y0[64 * k], b = y1[64 * k]; const u32x2 hw = hr[64 * k]; f32x4 hv = (f32x4){bf_lo(hw.x), bf_hi(hw.x), bf_lo(hw.y), bf_hi(hw.y)};
                  const auto al = __builtin_amdgcn_cvt_pk_f32_fp8((int)a, false), ah = __builtin_amdgcn_cvt_pk_f32_fp8((int)a, true), bl = __builtin_amdgcn_cvt_pk_f32_fp8((int)b, false), bh = __builtin_amdgcn_cvt_pk_f32_fp8((int)b, true);
                  hv.x += gg.x * al[0] + gg.y * bl[0]; hv.y += gg.x * al[1] + gg.y * bl[1]; hv.z += gg.x * ah[0] + gg.y * bh[0]; hv.w += gg.x * ah[1] + gg.y * bh[1];
                  v[k] = hv; ss += (hv.x * hv.x + hv.y * hv.y) + (hv.z * hv.z + hv.w * hv.w); } }
              else { const u32x2* y0 = (const u32x2*)(YS + (size_t)p0 * DM) + lane; const u32x2* y1 = (const u32x2*)(YS + (size_t)p1 * DM) + lane;
#pragma unroll
              for (int k = 0; k < 4; ++k) { const u32x2 a = y0[64 * k], b = y1[64 * k], hw = hr[64 * k]; f32x4 hv = (f32x4){bf_lo(hw.x), bf_hi(hw.x), bf_lo(hw.y), bf_hi(hw.y)};
                  hv.x += gg.x * bf_lo(a.x) + gg.y * bf_lo(b.x); hv.y += gg.x * bf_hi(a.x) + gg.y * bf_hi(b.x);
                  hv.z += gg.x * bf_lo(a.y) + gg.y * bf_lo(b.y); hv.w += gg.x * bf_hi(a.y) + gg.y * bf_hi(b.y);
                  v[k] = hv; ss += (hv.x * hv.x + hv.y * hv.y) + (hv.z * hv.z + hv.w * hv.w); } }
              if (!FINAL_DIRECT) {
#pragma unroll
                  for (int k = 0; k < 4; ++k) { u32x2 ow; ow.x = pk2(v[k].x, v[k].y); ow.y = pk2(v[k].z, v[k].w); hr[64 * k] = ow; } }
              if (j == 0 || FINAL_DIRECT) { const float rstd = 1.0f / sqrtf(wave_sum(ss, lane) * (1.f / DM) + EPS);
                  if (j == 0) { if (FP8_DOWN) { unsigned* o4 = (unsigned*)((unsigned char*)XN + (size_t)m * DM) + lane;
#pragma unroll
                      for (int k = 0; k < 4; ++k) { const f32x4 y = v[k] * rstd * gv[k]; int w = 0; w = __builtin_amdgcn_cvt_pk_fp8_f32(y.x, y.y, w, false); w = __builtin_amdgcn_cvt_pk_fp8_f32(y.z, y.w, w, true); o4[64 * k] = (unsigned)w; } }
                    else { u32x2* o8 = (u32x2*)(XN + (size_t)m * DM) + lane;
#pragma unroll
                      for (int k = 0; k < 4; ++k) { const f32x4 y = v[k] * rstd * gv[k]; u32x2 ow; ow.x = pk2(y.x, y.y); ow.y = pk2(y.z, y.w); o8[64 * k] = ow; } } }
                  else { f32x4* o = (f32x4*)(args.out + (size_t)m * DM) + lane;
#pragma unroll
                      for (int k = 0; k < 4; ++k) o[64 * k] = v[k] * rstd * gv[k]; } }
          } }
        if (j == 0 || !FINAL_DIRECT) xcd_barrier(bar);
        if (j == 1 && !FINAL_DIRECT && PH(18)) { PHASE_IDS; float* outp = args.out;
          f32x4 gv[4];
#pragma unroll
          for (int k = 0; k < 4; ++k) gv[k] = ((const f32x4*)args.in[22])[lane + 64 * k];
          for (int m = gw; m < NTOK; m += NGW) {
              const u32x2* hr = (const u32x2*)(H + (size_t)m * DM) + lane; f32x4 v[4]; float ss = 0.f;
#pragma unroll
              for (int k = 0; k < 4; ++k) { const u32x2 hw = hr[64 * k]; v[k] = (f32x4){bf_lo(hw.x), bf_hi(hw.x), bf_lo(hw.y), bf_hi(hw.y)}; ss += (v[k].x * v[k].x + v[k].y * v[k].y) + (v[k].z * v[k].z + v[k].w * v[k].w); }
              const float rstd = 1.0f / sqrtf(wave_sum(ss, lane) * (1.f / DM) + EPS);
              f32x4* o = (f32x4*)(outp + (size_t)m * DM) + lane;
#pragma unroll
              for (int k = 0; k < 4; ++k) o[64 * k] = v[k] * rstd * gv[k];
          } }
    }
}

__global__ void __launch_bounds__(NWAVES * 64, 2) fwd(Args args) {
    extern __shared__ __attribute__((aligned(16))) unsigned char lds_raw[];
    LAS unsigned char* lds = (LAS unsigned char*)lds_raw;
    const int G = gridDim.x, bx = blockIdx.x, vcu = (G % 8 == 0) ? (bx % 8) * (G / 8) + bx / 8 : bx;
    const int NGW = G * NWAVES;
    unsigned char* ws = args.ws;
    unsigned* ctl = (unsigned*)(ws + WS_CTL);
    const int wv0 = __builtin_amdgcn_readfirstlane((int)threadIdx.x >> 6);
    for (int u = opaque_tid(wv0); u < (LDS_BYTES - LDSCTL_OFF) / 4; u += NWAVES * 64) ((LAS unsigned*)(lds + LDSCTL_OFF))[u] = 0u;
    __syncthreads();
    volatile LAS unsigned* MISC = (volatile LAS unsigned*)(lds + MISC_OFF);
    XcdBarrier bar = xcd_barrier_post(ctl + 4096, MISC + 8, wv0);
    const float* x = args.in[0];
    bf16_t* XN = (bf16_t*)(ws + WS_ACT + A_XN);

    if (PH(0)) { PHASE_IDS;
        LAS float* scr = (LAS float*)(lds + wave * 16384);
        for (int j = 0; j < 2; ++j) {
            unsigned char* wb = ws + WS_W + (size_t)j * W_PAIR;
            if (FP8_DOWN) { transpose_matrix_f8<4>(args.in[2] + (size_t)j * DM * 576, DM, 576, wb + W_DQKV, 0, scr, gw, NGW, lane, W8_SCALE);
              for (int i = gw * 64 + lane; i < (DOWNP - 576) * DM / 16; i += NGW * 64) ((u32x4*)(wb + W_DQKV + (size_t)576 * DM))[i] = (u32x4){0u, 0u, 0u, 0u}; }
            else { transpose_matrix<4>(args.in[2] + (size_t)j * DM * 576, DM, 576, (bf16_t*)(wb + W_DQKV), 0, scr, gw, NGW, lane);
            for (int i = gw * 64 + lane; i < (DOWNP - 576) * DM / 8; i += NGW * 64) ((u32x4*)(wb + W_DQKV + (size_t)576 * DM * 2))[i] = (u32x4){0u, 0u, 0u, 0u}; }
            if (FP8_UP) {
            transpose_matrix_f8<3>(args.in[4] + (size_t)j * 256 * NQ, 256, NQ, wb + W_UQ, 0, scr, gw, NGW, lane, W8_SCALE, args.in[3] + j * 256);
            transpose_matrix_f8<0>(args.in[6] + (size_t)j * 256 * 1024, 256, 1024, wb + W_UKV, 0, scr, gw, NGW, lane, W8_SCALE, args.in[5] + j * 256);
            transpose_matrix_f8<0>(args.in[7] + (size_t)j * 256 * 1024, 256, 1024, wb + W_UKV, 1024, scr, gw, NGW, lane, W8_SCALE, args.in[5] + j * 256);
            } else {
            transpose_matrix<3>(args.in[4] + (size_t)j * 256 * NQ, 256, NQ, (bf16_t*)(wb + W_UQ), 0, scr, gw, NGW, lane, args.in[3] + j * 256);
            transpose_matrix<0>(args.in[6] + (size_t)j * 256 * 1024, 256, 1024, (bf16_t*)(wb + W_UKV), 0, scr, gw, NGW, lane, args.in[5] + j * 256);
            transpose_matrix<0>(args.in[7] + (size_t)j * 256 * 1024, 256, 1024, (bf16_t*)(wb + W_UKV), 1024, scr, gw, NGW, lane, args.in[5] + j * 256);
            }
            if (FP8_ATTO) transpose_matrix_f8<0>(args.in[8] + (size_t)j * DM * DM, DM, DM, wb + W_MO, 0, scr, gw, NGW, lane, W8_SCALE);
            else transpose_matrix<0>(args.in[8] + (size_t)j * DM * DM, DM, DM, (bf16_t*)(wb + W_MO), 0, scr, gw, NGW, lane);
            if ((FP8_S2 >> j) & 1) transpose_matrix_f8<0>(args.in[10] + (size_t)j * DM * SWA_NQKV, DM, SWA_NQKV, wb + W_SQKV, 0, scr, gw, NGW, lane, W8_SCALE, args.in[9] + j * DM);
            else transpose_matrix<0>(args.in[10] + (size_t)j * DM * SWA_NQKV, DM, SWA_NQKV, (bf16_t*)(wb + W_SQKV), 0, scr, gw, NGW, lane, args.in[9] + j * DM);
            if (FP8_ATTO) transpose_matrix_f8<0>(args.in[12] + (size_t)j * DM * DM, DM, DM, wb + W_SO, 0, scr, gw, NGW, lane, W8_SCALE);
            else transpose_matrix<0>(args.in[12] + (size_t)j * DM * DM, DM, DM, (bf16_t*)(wb + W_SO), 0, scr, gw, NGW, lane);
            if ((FP8_FFN >> j) & 1) {
            transpose_matrix_f8<1>(args.in[14] + (size_t)j * DM * FFN, DM, FFN, wb + W_FGU, 0, scr, gw, NGW, lane, W8_SCALE, args.in[13] + j * DM);
            transpose_matrix_f8<2>(args.in[15] + (size_t)j * DM * FFN, DM, FFN, wb + W_FGU, 0, scr, gw, NGW, lane, W8_SCALE, args.in[13] + j * DM);
            transpose_matrix_f8<0>(args.in[16] + (size_t)j * FFN * DM, FFN, DM, wb + W_FD, 0, scr, gw, NGW, lane, W8_SCALE);
            } else {
            transpose_matrix<1>(args.in[14] + (size_t)j * DM * FFN, DM, FFN, (bf16_t*)(wb + W_FGU), 0, scr, gw, NGW, lane, args.in[13] + j * DM);
            transpose_matrix<2>(args.in[15] + (size_t)j * DM * FFN, DM, FFN, (bf16_t*)(wb + W_FGU), 0, scr, gw, NGW, lane, args.in[13] + j * DM);
            transpose_matrix<0>(args.in[16] + (size_t)j * FFN * DM, FFN, DM, (bf16_t*)(wb + W_FD), 0, scr, gw, NGW, lane);
            }
            for (int e = 0; e < NE; ++e) {
                if ((FP8_MOE >> j) & 1) {
                    transpose_matrix_f8<1>(args.in[19] + ((size_t)j * NE + e) * DM * ED, DM, ED, wb + W_MGU, e * 2 * ED, scr, gw, NGW, lane, W8_SCALE);
                    transpose_matrix_f8<2>(args.in[20] + ((size_t)j * NE + e) * DM * ED, DM, ED, wb + W_MGU, e * 2 * ED, scr, gw, NGW, lane, W8_SCALE);
                    transpose_matrix_f8<0>(args.in[21] + ((size_t)j * NE + e) * ED * DM, ED, DM, wb + W_MD, e * DM, scr, gw, NGW, lane, W8_SCALE);
                } else {
                transpose_matrix<1>(args.in[19] + ((size_t)j * NE + e) * DM * ED, DM, ED, (bf16_t*)(wb + W_MGU), e * 2 * ED, scr, gw, NGW, lane);
                transpose_matrix<2>(args.in[20] + ((size_t)j * NE + e) * DM * ED, DM, ED, (bf16_t*)(wb + W_MGU), e * 2 * ED, scr, gw, NGW, lane);
                transpose_matrix<0>(args.in[21] + ((size_t)j * NE + e) * ED * DM, ED, DM, (bf16_t*)(wb + W_MD), e * DM, scr, gw, NGW, lane);
                }
            }
        }
        f32x4 gv[4];
#pragma unroll
        for (int j = 0; j < 4; ++j) gv[j] = ((const f32x4*)args.in[1])[lane + 64 * j];
        for (int m = gw; m < NTOK; m += NGW) rms_row_to_bf16<FP8_DOWN != 0>(x + (size_t)m * DM, gv, FP8_DOWN ? (bf16_t*)((unsigned char*)XN + (size_t)m * DM) : XN + (size_t)m * DM, lane);
    }
    xcd_barrier(bar);

    pair_body<0>(args, lds, bar, G, bx, vcu);
    pair_body<1>(args, lds, bar, G, bx, vcu);
}

extern "C" void kernel_launch(void* const* d_in, const int* in_sizes, int n_in, void* d_out, int out_size, void* d_ws, size_t ws_size, hipStream_t stream) {
    static int grid = 0;
    if (grid == 0) {
        if (n_in != 23 || out_size != NTOK * DM || ws_size < WS_NEED) { fprintf(stderr, "kernel_launch: shape/workspace mismatch (n_in %d out %d ws %zu need %zu)\n", n_in, out_size, ws_size, (size_t)WS_NEED); grid = -1; return; }
        int dev = 0, cus = 0;
        if (hipGetDevice(&dev) != hipSuccess || hipDeviceGetAttribute(&cus, hipDeviceAttributeMultiprocessorCount, dev) != hipSuccess) { grid = -1; return; }
        if (hipFuncSetAttribute((const void*)fwd, hipFuncAttributeMaxDynamicSharedMemorySize, LDS_BYTES) != hipSuccess) { fprintf(stderr, "kernel_launch: hipFuncSetAttribute failed\n"); grid = -1; return; }
        int per_cu = 0;
        if (hipOccupancyMaxActiveBlocksPerMultiprocessor(&per_cu, (const void*)fwd, NWAVES * 64, LDS_BYTES) != hipSuccess || per_cu < 1) fprintf(stderr, "kernel_launch: occupancy query reports %d\n", per_cu);
        (void)hipGetLastError();
        grid = cus;
    }
    if (grid < 0) return;
    if (hipMemsetAsync((char*)d_ws + WS_CTL, 0, CTL_ZERO_BYTES, stream) != hipSuccess) return;
    Args a{};
    for (int i = 0; i < 23; ++i) a.in[i] = (const float*)d_in[i];
    a.out = (float*)d_out; a.ws = (unsigned char*)d_ws;
    hipLaunchKernelGGL(fwd, dim3(grid), dim3(NWAVES * 64), LDS_BYTES, stream, a);
    const hipError_t le = hipPeekAtLastError();
    if (le != hipSuccess) fprintf(stderr, "kernel_launch: launch failed: %s\n", hipGetErrorName(le));
}
```

```cpp
#include <hip/hip_runtime.h>
#include <hip/hip_bf16.h>
#include <cstdio>
#include <cstdint>

#define LAS __attribute__((address_space(3)))
#define GAS __attribute__((address_space(1)))
typedef unsigned short bf16_t;
typedef short bf16x8 __attribute__((ext_vector_type(8)));
typedef short s16x4 __attribute__((ext_vector_type(4)));
typedef float f32x4 __attribute__((ext_vector_type(4)));
typedef float f32x2 __attribute__((ext_vector_type(2)));
typedef float f32x16 __attribute__((ext_vector_type(16)));
typedef unsigned u32x4 __attribute__((ext_vector_type(4)));
typedef unsigned u32x2 __attribute__((ext_vector_type(2)));
typedef int i32x4 __attribute__((ext_vector_type(4)));
typedef int i32x8 __attribute__((ext_vector_type(8)));

constexpr int DM = 1024, BATCH = 32, SEQ = 2048, NTOK = BATCH * SEQ;
constexpr int MLA_H = 8, QKD = 192, DOWNP = 768;
constexpr int NQ = MLA_H * QKD  , NKV = 2048;
constexpr int SWA_NQKV = 1536;
constexpr int FFN = 2816, NE = 8, ED = 2048;
constexpr int NPAIR = NTOK * 2;
constexpr float EPS = 1e-6f;
constexpr float LOG2E = 1.4426950408889634f;
#ifndef PHMASK
#define PHMASK 0xFFFFFFFFu
#endif
#define PH(k) (((PHMASK) >> (k)) & 1u)
#define RESID_SCALE 1.0f
#ifndef FP8_MOE
#define FP8_MOE 3
#endif
#ifndef FP8_YS
#define FP8_YS 3
#endif
#ifndef FP8_S2
#define FP8_S2 2
#endif
#ifndef FP8_FFN
#define FP8_FFN 2
#endif
#ifndef FP8_ATTO
#define FP8_ATTO 1
#endif
#ifndef FP8_QK
#define FP8_QK 1
#endif
#ifndef FP8_PV
#define FP8_PV 1
#endif
#ifndef FP8_UP
#define FP8_UP 1
#endif
#ifndef FP8_DOWN
#define FP8_DOWN 1
#endif
constexpr float W8_SCALE = 32.0f, O8_SCALE = 64.0f;
constexpr float YS8_SCALE = 16.0f;

constexpr size_t MiB = 1u << 20;
constexpr size_t WS_CTL = 0, CTL_ZERO_BYTES = 1 * MiB;
constexpr size_t WS_ROPE = 1 * MiB;
constexpr size_t WS_ROUTE = 2 * MiB;
constexpr size_t WS_GATE = 3 * MiB;
constexpr size_t WS_POS = 4 * MiB;
constexpr size_t WS_CNT = 5 * MiB;
constexpr size_t WS_W = 6 * MiB;
constexpr size_t W_DQKV = 0;
constexpr size_t W_UQ = W_DQKV + (size_t)DOWNP * DM * 2;
constexpr size_t W_UKV = W_UQ + (size_t)NQ * 256 * 2;
constexpr size_t W_MO = W_UKV + (size_t)NKV * 256 * 2;
constexpr size_t W_SQKV = W_MO + (size_t)DM * DM * 2;
constexpr size_t W_SO = W_SQKV + (size_t)SWA_NQKV * DM * 2;
constexpr size_t W_FGU = W_SO + (size_t)DM * DM * 2;
constexpr size_t W_FD = W_FGU + (size_t)2 * FFN * DM * 2;
constexpr size_t W_MGU = W_FD + (size_t)DM * FFN * 2;
constexpr size_t W_MD = W_MGU + (size_t)NE * 2 * ED * DM * 2;
constexpr size_t W_PAIR = W_MD + (size_t)NE * DM * ED * 2;
constexpr size_t WS_ACT = 254 * MiB;
static_assert(WS_W + 2 * W_PAIR <= WS_ACT, "weights fit");
constexpr size_t A_H = 0;
constexpr size_t A_XN = 128 * MiB;
constexpr size_t A_DOWN = 256 * MiB;
constexpr size_t A_Q = 352 * MiB;
constexpr size_t A_K8 = 448 * MiB;
constexpr size_t A_KR8 = 512 * MiB;
constexpr size_t A_FACT = 128 * MiB;
constexpr size_t A_SQKV = 128 * MiB;
constexpr size_t A_SO = 320 * MiB;
constexpr size_t A_MACT = 128 * MiB;
constexpr size_t A_YS = 384 * MiB;
constexpr size_t A_H8 = 480 * MiB;
constexpr size_t A_STAT = 768 * MiB;
constexpr size_t WS_NEED = WS_ACT + 770 * MiB;
static_assert(WS_NEED <= 1024 * MiB, "ws");

constexpr int RING_BYTES = 147456;
constexpr int LDSCTL_OFF = RING_BYTES;
constexpr int MISC_OFF = LDSCTL_OFF + 320;
constexpr int PART_OFF = LDSCTL_OFF + 2048;
constexpr int MOETAB_OFF = LDSCTL_OFF + 1024;
constexpr int STG_OFF = LDSCTL_OFF + 6144;
constexpr int LDS_BYTES = 163840;
static_assert(STG_OFF + 8192 <= LDS_BYTES, "stat staging");

#define RLX_AGENT __ATOMIC_RELAXED, __HIP_MEMORY_SCOPE_AGENT
#define LDS_WAIT() asm volatile("s_waitcnt lgkmcnt(0)" ::: "memory")
#define VM_WAIT() asm volatile("s_waitcnt vmcnt(0)" ::: "memory")
#define SBAR() __builtin_amdgcn_sched_barrier(0)
__device__ __forceinline__ unsigned f2bf(float f) { unsigned u = __builtin_bit_cast(unsigned, f); return (u + 0x7fffu + ((u >> 16) & 1u)) >> 16; }
__device__ __forceinline__ unsigned pk2(float lo, float hi) { return f2bf(lo) | (f2bf(hi) << 16); }
__device__ __forceinline__ unsigned cvt_pk_bf16(float lo, float hi) { unsigned r; asm volatile("v_cvt_pk_bf16_f32 %0, %1, %2" : "=v"(r) : "v"(lo), "v"(hi)); return r; }
__device__ __forceinline__ u32x2 pk8_fp8(const float (&o)[8]) { int w0 = __builtin_bit_cast(int, o[0]), w1 = __builtin_bit_cast(int, o[4]);
    w0 = __builtin_amdgcn_cvt_pk_fp8_f32(o[0], o[1], w0, false); w0 = __builtin_amdgcn_cvt_pk_fp8_f32(o[2], o[3], w0, true);
    w1 = __builtin_amdgcn_cvt_pk_fp8_f32(o[4], o[5], w1, false); w1 = __builtin_amdgcn_cvt_pk_fp8_f32(o[6], o[7], w1, true);
    u32x2 r; r.x = (unsigned)w0; r.y = (unsigned)w1; return r; }
__device__ __forceinline__ unsigned fp8_1(float v) { return (unsigned)__builtin_amdgcn_cvt_pk_fp8_f32(v, v, 0, false) & 0xffu; }
__device__ __forceinline__ float bf_lo(unsigned w) { return __builtin_bit_cast(float, w << 16); }
__device__ __forceinline__ float bf_hi(unsigned w) { return __builtin_bit_cast(float, w & 0xffff0000u); }
__device__ __forceinline__ int opaque_tid(int wv) { int l; asm volatile("v_mbcnt_lo_u32_b32 %0, -1, 0\n\tv_mbcnt_hi_u32_b32 %0, -1, %0" : "=v"(l)); return wv * 64 + l; }
__device__ __forceinline__ int opaque_lane() { int l; asm volatile("v_mbcnt_lo_u32_b32 %0, -1, 0\n\tv_mbcnt_hi_u32_b32 %0, -1, %0" : "=v"(l)); return l; }
__device__ __forceinline__ void glds16_s(const void* sbase, unsigned voff, unsigned lds_dst) {
    unsigned keep;
    asm volatile("s_mov_b32 %0, m0\n\ts_mov_b32 m0, %3\n\ts_nop 0\n\tglobal_load_lds_dwordx4 %1, %2\n\ts_mov_b32 m0, %0" : "=&s"(keep) : "v"(voff), "s"(sbase), "s"(lds_dst) : "memory");
}
__device__ __forceinline__ float shx(float v, int o, int lane) { return __builtin_bit_cast(float, __builtin_amdgcn_ds_bpermute((lane ^ o) << 2, __builtin_bit_cast(int, v))); }
__device__ __forceinline__ int shxi(int v, int o, int lane) { return __builtin_amdgcn_ds_bpermute((lane ^ o) << 2, v); }
__device__ __forceinline__ float wave_sum(float v, int lane) {
#pragma unroll
    for (int o = 1; o < 64; o <<= 1) v += shx(v, o, lane);
    return v;
}

#define XB_TMO      128
#define XB_XCNT(j)  (256  + 64 * (j))
#define XB_XSUB(j)  (1280 + 64 * (j))
#define XB_XGEN(j)  (2304 + 64 * (j))
#define XB_TOP      3328
#define XB_TOPGEN   3392
#define XCD_BAR_WORDS 3456
#define XB_SPIN_CAP (1u << 18)
__device__ __forceinline__ unsigned xb_ld(unsigned* p)              { return __hip_atomic_load(p, __ATOMIC_RELAXED, __HIP_MEMORY_SCOPE_AGENT); }
__device__ __forceinline__ unsigned xb_add(unsigned* p, unsigned v) { return __hip_atomic_fetch_add(p, v, __ATOMIC_RELAXED, __HIP_MEMORY_SCOPE_AGENT); }
__device__ __forceinline__ unsigned xb_xcc_id() { return (unsigned)__builtin_amdgcn_s_getreg((3 << 11) | 20) & 0xFu; }
#define XB_SPIN(cond, bar) do { unsigned _sp = 0; while (cond) { __builtin_amdgcn_s_sleep(1); \
    if ((++_sp & 255u) == 0u) { if (xb_ld(&(bar)[XB_TMO])) break; if (_sp > XB_SPIN_CAP) { atomicAdd(&(bar)[XB_TMO], 1u); break; } } } } while (0)
struct XcdBarrier { unsigned* bar; unsigned x; volatile LAS unsigned* st; int wv; };
__device__ __forceinline__ XcdBarrier xcd_barrier_post(unsigned* bar, volatile LAS unsigned* st, int wv) {
    XcdBarrier b; b.bar = bar; b.x = xb_xcc_id(); b.st = st; b.wv = wv;
    if (opaque_tid(wv) == 0) (void)xb_add(&bar[XB_XCNT(b.x)], 1u);
    return b;
}
__device__ __forceinline__ void xcd_barrier_complete(unsigned* bar, unsigned x, unsigned& nloc, unsigned& nx) {
    const unsigned G = gridDim.x * gridDim.y * gridDim.z;
    unsigned sum, cnt, mine, sp = 0u;
    for (;;) {
        sum = 0u; cnt = 0u; mine = 0u;
#pragma unroll
        for (unsigned j = 0; j < 16; ++j) { const unsigned c = xb_ld(&bar[XB_XCNT(j)]); sum += c; cnt += (c > 0u) ? 1u : 0u; mine = (j == x) ? c : mine; }
        if (sum == G) break;
        __builtin_amdgcn_s_sleep(1);
        if ((++sp & 255u) == 0u) { if (xb_ld(&bar[XB_TMO])) break; if (sp > XB_SPIN_CAP) { atomicAdd(&bar[XB_TMO], 1u); break; } }
    }
    nloc = mine > 0u ? mine : 1u; nx = cnt > 0u ? cnt : 1u;
}
__device__ __forceinline__ void xcd_barrier(const XcdBarrier& b) {
    asm volatile("s_waitcnt vmcnt(0)" ::: "memory");
    __syncthreads();
    if (opaque_tid(b.wv) == 0) {
        unsigned* bar = b.bar;
        __builtin_amdgcn_s_waitcnt(0);
        unsigned nloc = b.st[0], nx = b.st[1];
        if (nloc == 0u) { xcd_barrier_complete(bar, b.x, nloc, nx); b.st[0] = nloc; b.st[1] = nx; }
        const unsigned old = xb_add(&bar[XB_XSUB(b.x)], 1u);
        const unsigned gen = (nloc & (nloc - 1u)) == 0u ? old >> __builtin_ctz(nloc) : old / nloc;
        if (old + 1u == (gen + 1u) * nloc) {
            __builtin_amdgcn_fence(__ATOMIC_RELEASE, "agent");
            asm volatile("s_waitcnt vmcnt(0)" ::: "memory");
            const unsigned og = xb_add(&bar[XB_TOP], 1u);
            const unsigned tg = (nx & (nx - 1u)) == 0u ? og >> __builtin_ctz(nx) : og / nx;
            if (og + 1u == (tg + 1u) * nx) xb_add(&bar[XB_TOPGEN], 1u);
            else XB_SPIN(xb_ld(&bar[XB_TOPGEN]) == tg, bar);
            __builtin_amdgcn_fence(__ATOMIC_ACQUIRE, "agent");
            xb_add(&bar[XB_XGEN(b.x)], 1u);
            asm volatile("s_waitcnt vmcnt(0)" ::: "memory");
        } else {
            XB_SPIN(xb_ld(&bar[XB_XGEN(b.x)]) == gen, bar);
            __builtin_amdgcn_fence(__ATOMIC_ACQUIRE, "agent");
            asm volatile("s_waitcnt vmcnt(0)" ::: "memory");
        }
    }
    __syncthreads();
}

namespace pg8 {
constexpr int BM = 256, BK = 64, HALF = 128, HTB = HALF * BK * 2, STAGE_BYTES = 8 * HTB, NXCD = 8, WGM = 8;
__host__ __device__ __forceinline__ int lds_byte(int r, int c) { const int st = (r >> 4) * 2 + (c >> 5), rr = r & 15, cc = c & 31, ob = rr * 64 + cc * 2; return st * 1024 + (ob ^ (((ob >> 9) & 1) << 5)); }
__host__ __device__ __forceinline__ void stage_rc(int b, int& R, int& C) { const int st = b / 1024, sb = b % 1024, swz = sb ^ (((sb >> 9) & 1) << 5); R = (st >> 1) * 16 + swz / 64; C = (st & 1) * 32 + (swz % 64) / 2; }
__host__ __device__ __forceinline__ int perm32(int rho) { const int n = rho >> 4, i = rho & 15; return 8 * (i >> 2) + 4 * n + (i & 3); }

struct Unit { int arow, brow, col, nvalid, nlo, par; };
struct Gemm { const bf16_t* A; const bf16_t* Bt; int lda, ldb, K; };

struct DenseOrder {
    int nM, nN, nwg, G, c, colw;
    __device__ void init(int M, int N, int G_, int c_, int colw_) { nM = M / BM; nN = N / BM; nwg = nM * nN; G = G_; c = c_; colw = colw_; }
    __device__ __forceinline__ bool next(int i, Unit& u) const {
        const long L = (long)i * G + c; if (L >= nwg) return false;
        int wgid = (int)L; { const int q = nwg / NXCD, r = nwg % NXCD, xcd = wgid % NXCD, off = wgid / NXCD; wgid = (xcd < r ? xcd * (q + 1) : r * (q + 1) + (xcd - r) * q) + off; }
        const int nig = WGM * nN, gid = wgid / nig, fm = gid * WGM, gsz = nM < WGM ? nM : WGM;
        const int pm = fm + ((wgid % nig) % gsz), pn = (wgid % nig) / gsz;
        u.arow = pm * BM; u.brow = pn * BM; u.col = pn * colw; u.nvalid = BM; u.nlo = 0; return true;
    }
};
struct GroupedOrder {
    int nM, nN, nwg, G, c, colw, erows; const LAS int* tab;
    __device__ void init(const LAS int* tab_, int N, int G_, int c_, int colw_) { tab = tab_; nM = tab_[8]; nN = N / BM; nwg = nM * nN; G = G_; c = c_; colw = colw_; erows = N; }
    __device__ __forceinline__ bool next(int i, Unit& u) const {
        const long L = (long)i * G + c; if (L >= nwg) return false;
        int wgid = (int)L; { const int q = nwg / NXCD, r = nwg % NXCD, xcd = wgid % NXCD, off = wgid / NXCD; wgid = (xcd < r ? xcd * (q + 1) : r * (q + 1) + (xcd - r) * q) + off; }
        const int nig = WGM * nN, gid = wgid / nig, fm = gid * WGM, rem_ = nM - fm, w_ = wgid % nig;
        int tm_, pn;
        if (rem_ >= WGM) { tm_ = w_ & (WGM - 1); pn = w_ / WGM; } else { tm_ = w_ % rem_; pn = w_ / rem_; }
        const int T = fm + tm_;
        int e = 0;
#pragma unroll
        for (int k = 1; k < 8; ++k) e += (T >= tab[k]) ? 1 : 0;
        const int lt = T - tab[e]; int arow = tab[16 + e] + lt * BM; int nv = tab[16 + e + 1] - arow; nv = nv > BM ? BM : nv;
        int lo = 0; { const int over = arow + BM - tab[24]; if (over > 0) { arow -= over; lo = over; nv += over; } }
        u.arow = __builtin_amdgcn_readfirstlane(arow); u.nvalid = __builtin_amdgcn_readfirstlane(nv); u.nlo = __builtin_amdgcn_readfirstlane(lo);
        u.brow = __builtin_amdgcn_readfirstlane(e * erows + pn * BM); u.col = __builtin_amdgcn_readfirstlane(pn * colw); return true;
    }
};

__device__ __forceinline__ u32x4 widen16(u32x2 a, u32x2 b) {
    auto r0 = __builtin_amdgcn_permlane16_swap(a.x, b.x, false, false); auto r1 = __builtin_amdgcn_permlane16_swap(a.y, b.y, false, false);
    return (u32x4){r0[0], r1[0], r0[1], r1[1]};
}
template <int NS> __device__ __forceinline__ float row_rstd(const float* stat, int row, int slot0, float inv_n) {
    float s;
    if (NS == 4) { const f32x4 a = *(const f32x4*)(stat + (size_t)row * 4); s = (a.x + a.y) + (a.z + a.w); }
    else s = stat[(size_t)row * 4 + slot0];
    return __builtin_amdgcn_rsqf(s + EPS / inv_n) * __builtin_sqrtf(1.0f / inv_n);
}
template <int NS> __device__ __forceinline__ void row_rstd8(float (&rs)[2][4], const float* stat, int row0, int slot0, float inv_n) {
#pragma unroll
    for (int ai = 0; ai < 2; ++ai)
#pragma unroll
        for (int m = 0; m < 4; ++m) rs[ai][m] = NS ? row_rstd<NS ? NS : 1>(stat, row0 + ai * HALF + m * 16, slot0, inv_n) : 1.f;
}
__device__ __forceinline__ void row_rstd8_lds(float (&rs)[2][4], const LAS float* lst, int par, int rl0, float inv_n) {
    const LAS f32x4* sl = (const LAS f32x4*)(lst + par * 1024) + rl0;
#pragma unroll
    for (int ai = 0; ai < 2; ++ai)
#pragma unroll
        for (int m = 0; m < 4; ++m) { const f32x4 a = sl[ai * HALF + m * 16]; const float sm = (a.x + a.y) + (a.z + a.w);
            rs[ai][m] = __builtin_amdgcn_rsqf(sm + EPS / inv_n) * __builtin_sqrtf(1.0f / inv_n); }
}
__device__ __forceinline__ void row_rstd8_lds1(float (&rs)[2][4], const LAS float* lst, int par, int rl0, int slot, float inv_n) {
    const LAS float* sl = lst + par * 1024 + rl0 * 4 + slot;
#pragma unroll
    for (int ai = 0; ai < 2; ++ai)
#pragma unroll
        for (int m = 0; m < 4; ++m) rs[ai][m] = __builtin_amdgcn_rsqf(sl[(ai * HALF + m * 16) * 4] + EPS / inv_n) * __builtin_sqrtf(1.0f / inv_n);
}
__device__ __forceinline__ void stat_combine(LAS float* part, float* stat, const Unit& u, int slot, int wr, int wc, int fr, int fq) {
    asm volatile("s_waitcnt lgkmcnt(0)" ::: "memory"); __builtin_amdgcn_s_barrier(); asm volatile("" ::: "memory");
    const int t = (wr * 4 + wc) * 64 + fq * 16 + fr;
    if (t < 256) { const float sum = (part[t] + part[256 + t]) + (part[512 + t] + part[768 + t]); stat[(size_t)(u.arow + t) * 4 + slot] = sum; }
}
template <bool MASK, int NS> struct EpiBf16 {
    static constexpr bool PERM = true, LSTAT = (NS == 4), LSTAT_COL = false, Z64 = true; static constexpr int NST = 16;
    __device__ __forceinline__ bool full(const Unit& u) const { return !MASK || (u.nvalid == BM && u.nlo == 0); }
    bf16_t* O; int ldc; const float* stat; int slot0; float inv_n; float oscale; int qcols = 0; float qscale = 1.f; const LAS float* lst = nullptr;
    __device__ __forceinline__ void operator()(const f32x4 (&acc)[2][2][4][2], const Unit& u, int wr, int wc, int fr, int fq) const {
        const int col0 = u.col + wc * 32 + 8 * fq; const float osc = u.col < qcols ? oscale * qscale : oscale;
        float rs[2][4]; if constexpr (NS == 4) row_rstd8_lds(rs, lst, u.par, wr * 64 + fr, inv_n); else row_rstd8<NS>(rs, stat, u.arow + wr * 64 + fr, slot0, inv_n);
#pragma unroll
        for (int ai = 0; ai < 2; ++ai)
#pragma unroll
            for (int m = 0; m < 4; ++m) { const int rl = ai * HALF + wr * 64 + m * 16 + fr; if (MASK && (rl >= u.nvalid || rl < u.nlo)) continue;
                const float r = rs[ai][m] * osc;
                bf16_t* rowp = O + (size_t)(u.arow + rl) * ldc + col0;
#pragma unroll
                for (int bj = 0; bj < 2; ++bj) { const f32x4 v0 = acc[ai][bj][m][0] * r, v1 = acc[ai][bj][m][1] * r;
                    u32x4 w; w.x = cvt_pk_bf16(v0[0], v0[1]); w.y = cvt_pk_bf16(v0[2], v0[3]); w.z = cvt_pk_bf16(v1[0], v1[1]); w.w = cvt_pk_bf16(v1[2], v1[3]);
                    *(u32x4*)(rowp + bj * HALF) = w; } }
    }
};
template <bool MASK> struct EpiF8 {
    static constexpr bool PERM = true, LSTAT = false, LSTAT_COL = false, Z64 = false; static constexpr int NST = 8;
    __device__ __forceinline__ bool full(const Unit& u) const { return !MASK || (u.nvalid == BM && u.nlo == 0); }
    unsigned char* O; int ldc; float oscale;
    __device__ __forceinline__ void operator()(const f32x4 (&acc)[2][2][4][2], const Unit& u, int wr, int wc, int fr, int fq) const {
        const int col0 = u.col + wc * 32 + 8 * fq, odd = fq & 1;
#pragma unroll
        for (int ai = 0; ai < 2; ++ai)
#pragma unroll
            for (int mp = 0; mp < 2; ++mp) { const int rl = ai * HALF + wr * 64 + (2 * mp + odd) * 16 + fr;
                unsigned char* rowp = O + (size_t)(u.arow + rl) * ldc + col0 - 8 * odd; const bool ok = !MASK || (rl < u.nvalid && rl >= u.nlo);
#pragma unroll
                for (int bj = 0; bj < 2; ++bj) { const f32x4 a0 = acc[ai][bj][2 * mp][0] * oscale, a1 = acc[ai][bj][2 * mp][1] * oscale, b0 = acc[ai][bj][2 * mp + 1][0] * oscale, b1 = acc[ai][bj][2 * mp + 1][1] * oscale;
                    const float oa[8] = {a0[0], a0[1], a0[2], a0[3], a1[0], a1[1], a1[2], a1[3]}, ob[8] = {b0[0], b0[1], b0[2], b0[3], b1[0], b1[1], b1[2], b1[3]};
                    const u32x4 w = widen16(pk8_fp8(oa), pk8_fp8(ob));
                    if (ok) *(u32x4*)(rowp + bj * HALF) = w; } }
    }
};
struct EpiKV8 {
    static constexpr bool PERM = true, LSTAT = true, LSTAT_COL = false, Z64 = true; static constexpr int NST = 8;
    __device__ __forceinline__ bool full(const Unit&) const { return true; }
    bf16_t* KV; unsigned char* k8; const float* stat; float oscale; const LAS float* lst;
    __device__ __forceinline__ void operator()(const f32x4 (&acc)[2][2][4][2], const Unit& u, int wr, int wc, int fr, int fq) const {
        const int col0 = u.col + wc * 32 + 8 * fq;
        float rs[2][4]; row_rstd8_lds1(rs, lst, u.par, wr * 64 + fr, 1, 1.f / 256.f);
        if (u.col < 1024) {
#pragma unroll
            for (int ai = 0; ai < 2; ++ai)
#pragma unroll
                for (int mp = 0; mp < 2; ++mp) { const int odd = fq & 1; const float ra = rs[ai][2 * mp] * oscale, rb = rs[ai][2 * mp + 1] * oscale;
                    unsigned char* rowp = k8 + (size_t)(u.arow + ai * HALF + wr * 64 + (2 * mp + odd) * 16 + fr) * 1024 + col0 - 8 * odd;
#pragma unroll
                    for (int bj = 0; bj < 2; ++bj) { const f32x4 a0 = acc[ai][bj][2 * mp][0] * ra, a1 = acc[ai][bj][2 * mp][1] * ra, b0 = acc[ai][bj][2 * mp + 1][0] * rb, b1 = acc[ai][bj][2 * mp + 1][1] * rb;
                        const float oa[8] = {a0[0], a0[1], a0[2], a0[3], a1[0], a1[1], a1[2], a1[3]}, ob[8] = {b0[0], b0[1], b0[2], b0[3], b1[0], b1[1], b1[2], b1[3]};
                        *(u32x4*)(rowp + bj * HALF) = widen16(pk8_fp8(oa), pk8_fp8(ob)); } }
        } else {
#pragma unroll
            for (int ai = 0; ai < 2; ++ai)
#pragma unroll
                for (int m = 0; m < 4; ++m) { const float r = rs[ai][m] * oscale; bf16_t* rowp = KV + (size_t)(u.arow + ai * HALF + wr * 64 + m * 16 + fr) * NKV + col0;
#pragma unroll
                    for (int bj = 0; bj < 2; ++bj) { const f32x4 v0 = acc[ai][bj][m][0] * r, v1 = acc[ai][bj][m][1] * r;
                        u32x4 w; w.x = cvt_pk_bf16(v0[0], v0[1]); w.y = cvt_pk_bf16(v0[2], v0[3]); w.z = cvt_pk_bf16(v1[0], v1[1]); w.w = cvt_pk_bf16(v1[2], v1[3]);
                        *(u32x4*)(rowp + bj * HALF) = w; } }
        }
    }
};
struct EpiVT8 {
    static constexpr bool PERM = true, LSTAT = true, LSTAT_COL = true, Z64 = true; static constexpr int NST = 8;
    __device__ __forceinline__ bool full(const Unit&) const { return true; }
    unsigned char* vt; const float* stat; float oscale; const LAS float* lst;
    __device__ __forceinline__ void operator()(const f32x4 (&acc)[2][2][4][2], const Unit& u, int wr, int wc, int fr, int fq) const {
        const int t0 = u.col + wc * 32 + 8 * fq; const LAS float* sl = lst + u.par * 1024 + (wc * 32 + 8 * fq) * 4 + 1;
        f32x4 rs[2][2];
#pragma unroll
        for (int bj = 0; bj < 2; ++bj)
#pragma unroll
            for (int n = 0; n < 2; ++n)
#pragma unroll
                for (int k = 0; k < 4; ++k) rs[bj][n][k] = sl[(bj * HALF + 4 * n + k) * 4];
#pragma unroll
        for (int bj = 0; bj < 2; ++bj)
#pragma unroll
            for (int n = 0; n < 2; ++n)
#pragma unroll
                for (int k = 0; k < 4; ++k) rs[bj][n][k] = __builtin_amdgcn_rsqf(rs[bj][n][k] * (1.f / 256.f) + EPS) * oscale;
#pragma unroll
        for (int bj = 0; bj < 2; ++bj) { const int tw = u.col + bj * HALF + wc * 32, base = (tw & ~63) + 16 * (wc & 1);
#pragma unroll
            for (int ai = 0; ai < 2; ++ai) { unsigned char* p = vt + (size_t)(u.arow + ai * HALF + wr * 64 + fq * 16 + fr) * NTOK + base;
#pragma unroll
                for (int n = 0; n < 2; ++n) { unsigned w[4];
#pragma unroll
                    for (int m = 0; m < 4; ++m) { const f32x4 v = acc[ai][bj][m][n] * rs[bj][n];
                        int x = 0; x = __builtin_amdgcn_cvt_pk_fp8_f32(v[0], v[1], x, false); x = __builtin_amdgcn_cvt_pk_fp8_f32(v[2], v[3], x, true); w[m] = (unsigned)x; }
                    auto x01 = __builtin_amdgcn_permlane16_swap(w[0], w[1], false, false); auto x23 = __builtin_amdgcn_permlane16_swap(w[2], w[3], false, false);
                    auto s0 = __builtin_amdgcn_permlane32_swap(x01[0], x23[0], false, false); auto s1 = __builtin_amdgcn_permlane32_swap(x01[1], x23[1], false, false);
                    *(u32x4*)(p + 32 * n) = (u32x4){s0[0], s1[0], s0[1], s1[1]}; } } }
    }
};
template <bool MASK, int NS, bool F8OUT = false> struct EpiSwiGLU {
    static constexpr bool PERM = true, LSTAT = (NS == 4), LSTAT_COL = false, Z64 = true; static constexpr int NST = F8OUT ? 4 : 8;
    __device__ __forceinline__ bool full(const Unit& u) const { return !MASK || (u.nvalid == BM && u.nlo == 0); }
    bf16_t* O; int ldc; const float* stat; float inv_n; float oscale; const LAS float* lst = nullptr;
    __device__ __forceinline__ void row8(float (&o)[8], const f32x4 (&acc)[2][2][4][2], int ai, int m, float r) const {
        const float rL = -r * LOG2E, c = __builtin_amdgcn_rcpf(r * r);
#pragma unroll
        for (int n = 0; n < 2; ++n)
#pragma unroll
            for (int k = 0; k < 4; k += 2) {
                const f32x2 ag = {acc[ai][0][m][n][k], acc[ai][0][m][n][k + 1]}, au = {acc[ai][1][m][n][k], acc[ai][1][m][n][k + 1]};
                const f32x2 t = ag * rL; const f32x2 e = {__builtin_amdgcn_exp2f(t.x), __builtin_amdgcn_exp2f(t.y)};
                const f32x2 d = __builtin_elementwise_fma(e, (f32x2){c, c}, (f32x2){c, c}); const f32x2 sg = {__builtin_amdgcn_rcpf(d.x), __builtin_amdgcn_rcpf(d.y)};
                const f32x2 r2 = (ag * au) * sg; o[n * 4 + k] = r2.x; o[n * 4 + k + 1] = r2.y; }
    }
    __device__ __forceinline__ void operator()(const f32x4 (&acc)[2][2][4][2], const Unit& u, int wr, int wc, int fr, int fq) const {
        const int col0 = u.col + wc * 32 + 8 * fq;
        float rs[2][4]; if constexpr (NS == 4) row_rstd8_lds(rs, lst, u.par, wr * 64 + fr, inv_n); else row_rstd8<NS>(rs, stat, u.arow + wr * 64 + fr, 0, inv_n);
        if constexpr (F8OUT) {
            const int odd = fq & 1;
#pragma unroll
            for (int ai = 0; ai < 2; ++ai)
#pragma unroll
                for (int mp = 0; mp < 2; ++mp) { float oa[8], ob[8]; row8(oa, acc, ai, 2 * mp, rs[ai][2 * mp] * oscale); row8(ob, acc, ai, 2 * mp + 1, rs[ai][2 * mp + 1] * oscale);
                    const u32x4 w = widen16(pk8_fp8(oa), pk8_fp8(ob));
                    const int rl = ai * HALF + wr * 64 + (2 * mp + odd) * 16 + fr;
                    if (!MASK || (rl < u.nvalid && rl >= u.nlo)) *(u32x4*)((unsigned char*)O + (size_t)(u.arow + rl) * ldc + col0 - 8 * odd) = w; }
        } else {
#pragma unroll
        for (int ai = 0; ai < 2; ++ai)
#pragma unroll
            for (int m = 0; m < 4; ++m) { const int rl = ai * HALF + wr * 64 + m * 16 + fr; if (MASK && (rl >= u.nvalid || rl < u.nlo)) continue;
                float o[8]; row8(o, acc, ai, m, rs[ai][m] * oscale);
                u32x4 w; w.x = cvt_pk_bf16(o[0], o[1]); w.y = cvt_pk_bf16(o[2], o[3]); w.z = cvt_pk_bf16(o[4], o[5]); w.w = cvt_pk_bf16(o[6], o[7]);
                *(u32x4*)(O + (size_t)(u.arow + rl) * ldc + col0) = w; }
        }
    }
};
template <bool BASE_F32, bool H8OUT = false> struct EpiResid {
    static constexpr bool PERM = true, LSTAT = false, LSTAT_COL = false, Z64 = true; static constexpr int NST = H8OUT ? 24 : 16;
    __device__ __forceinline__ bool full(const Unit&) const { return true; }
    const void* base; bf16_t* out; float* stat; LAS float* part; float scale; unsigned char* h8;
    __device__ __forceinline__ void operator()(f32x4 (&acc)[2][2][4][2], const Unit& u, int wr, int wc, int fr, int fq) const {
        const int col0 = u.col + wc * 32 + 8 * fq; const int lane = fq * 16 + fr;
#pragma unroll
        for (int ai = 0; ai < 2; ++ai)
#pragma unroll
          for (int mh = 0; mh < 2; ++mh) {
            if (BASE_F32) { f32x4 t[2][2][2];
#pragma unroll
                for (int m = 0; m < 2; ++m) { const float* bp = (const float*)base + (size_t)(u.arow + ai * HALF + wr * 64 + (mh * 2 + m) * 16 + fr) * DM + col0;
#pragma unroll
                    for (int bj = 0; bj < 2; ++bj)
#pragma unroll
                        for (int n = 0; n < 2; ++n) t[m][bj][n] = *(const f32x4*)(bp + bj * HALF + n * 4); }
#pragma unroll
                for (int m = 0; m < 2; ++m)
#pragma unroll
                    for (int bj = 0; bj < 2; ++bj)
#pragma unroll
                        for (int n = 0; n < 2; ++n) acc[ai][bj][mh * 2 + m][n] = acc[ai][bj][mh * 2 + m][n] * scale + t[m][bj][n];
            } else { u32x4 t[2][2];
#pragma unroll
                for (int m = 0; m < 2; ++m) { const bf16_t* bp = (const bf16_t*)base + (size_t)(u.arow + ai * HALF + wr * 64 + (mh * 2 + m) * 16 + fr) * DM + col0;
#pragma unroll
                    for (int bj = 0; bj < 2; ++bj) t[m][bj] = *(const u32x4*)(bp + bj * HALF); }
#pragma unroll
                for (int m = 0; m < 2; ++m)
#pragma unroll
                    for (int bj = 0; bj < 2; ++bj) { const u32x4 w = t[m][bj];
                        acc[ai][bj][mh * 2 + m][0] = acc[ai][bj][mh * 2 + m][0] * scale + (f32x4){bf_lo(w.x), bf_hi(w.x), bf_lo(w.y), bf_hi(w.y)};
                        acc[ai][bj][mh * 2 + m][1] = acc[ai][bj][mh * 2 + m][1] * scale + (f32x4){bf_lo(w.z), bf_hi(w.z), bf_lo(w.w), bf_hi(w.w)}; }
            }
#pragma unroll
            for (int m = 0; m < 2; ++m)
                asm volatile("" : "+v"(acc[ai][0][mh * 2 + m][0]), "+v"(acc[ai][0][mh * 2 + m][1]), "+v"(acc[ai][1][mh * 2 + m][0]), "+v"(acc[ai][1][mh * 2 + m][1]) :: "memory"); }
        u32x2 pk8s[2][2];
#pragma unroll
        for (int ai = 0; ai < 2; ++ai)
#pragma unroll
            for (int m = 0; m < 4; ++m) { const int rl = ai * HALF + wr * 64 + m * 16 + fr; const size_t off = (size_t)(u.arow + rl) * DM + col0; float ss = 0.f;
#pragma unroll
                for (int bj = 0; bj < 2; ++bj) { const f32x4 h0 = acc[ai][bj][m][0], h1 = acc[ai][bj][m][1];
                    ss += ((h0.x * h0.x + h0.y * h0.y) + (h0.z * h0.z + h0.w * h0.w)) + ((h1.x * h1.x + h1.y * h1.y) + (h1.z * h1.z + h1.w * h1.w));
                    u32x4 w; w.x = cvt_pk_bf16(h0.x, h0.y); w.y = cvt_pk_bf16(h0.z, h0.w); w.z = cvt_pk_bf16(h1.x, h1.y); w.w = cvt_pk_bf16(h1.z, h1.w);
                    *(u32x4*)(out + off + bj * HALF) = w;
                    if (H8OUT) { const float o8[8] = {h0.x, h0.y, h0.z, h0.w, h1.x, h1.y, h1.z, h1.w}; pk8s[m & 1][bj] = pk8_fp8(o8);
                        if (m & 1) { const int odd = fq & 1;
                            *(u32x4*)(h8 + (size_t)(u.arow + rl - 16 + 16 * odd) * DM + col0 - 8 * odd + bj * HALF) = widen16(pk8s[0][bj], pk8s[1][bj]); } } }
                ss += shx(ss, 16, lane); ss += shx(ss, 32, lane); if (fq == 0) part[wc * 256 + rl] = ss; }
        stat_combine(part, stat, u, u.col >> 8, wr, wc, fr, fq);
    }
};
__device__ __forceinline__ void rope_inv4(float (&inv)[4], int i0) {
#pragma unroll
    for (int k = 0; k < 4; ++k) inv[k] = __builtin_amdgcn_exp2f(-(float)(i0 + k) * (13.287712379549449f / 32.0f)) * 0.15915494309189535f;
}
__device__ __forceinline__ void rope8(f32x4& v0, f32x4& v1, float pos, const float (&inv)[4]) {
    float c[4], sn[4];
#pragma unroll
    for (int k = 0; k < 4; ++k) { float t = pos * inv[k]; t -= rintf(t); c[k] = __builtin_amdgcn_cosf(t); sn[k] = __builtin_amdgcn_sinf(t); }
    const float a0 = v0[0] * c[0] - v0[1] * sn[0], b0 = v0[1] * c[0] + v0[0] * sn[0];
    const float a1 = v0[2] * c[1] - v0[3] * sn[1], b1 = v0[3] * c[1] + v0[2] * sn[1];
    const float a2 = v1[0] * c[2] - v1[1] * sn[2], b2 = v1[1] * c[2] + v1[0] * sn[2];
    const float a3 = v1[2] * c[3] - v1[3] * sn[3], b3 = v1[3] * c[3] + v1[2] * sn[3];
    v0 = (f32x4){a0, b0, a1, b1}; v1 = (f32x4){a2, b2, a3, b3};
}
template <bool F8, bool QPRE = false> struct EpiQRope {
    static constexpr bool PERM = true, LSTAT = QPRE, LSTAT_COL = false, Z64 = true; static constexpr int NST = F8 ? 8 : 16;
    __device__ __forceinline__ bool full(const Unit&) const { return true; }
    bf16_t* O; float oscale; const float* stat; float qpre; const LAS float* lst;
    __device__ __forceinline__ void operator()(const f32x4 (&acc)[2][2][4][2], const Unit& u, int wr, int wc, int fr, int fq) const {
        const int col0 = u.col + wc * 32 + 8 * fq, odd = fq & 1;
        float rs[2][4];
        if (QPRE) { row_rstd8_lds1(rs, lst, u.par, wr * 64 + fr, 0, 1.f / 256.f);
#pragma unroll
            for (int ai = 0; ai < 2; ++ai)
#pragma unroll
                for (int m = 0; m < 4; ++m) rs[ai][m] *= qpre * oscale; }
#pragma unroll
        for (int bj = 0; bj < 2; ++bj) { const int c = col0 + bj * HALF, d = c % QKD; const bool isr = d >= 128; float inv[4]; rope_inv4(inv, isr ? ((d - 128) >> 1) : 0);
#pragma unroll
            for (int ai = 0; ai < 2; ++ai)
#pragma unroll
                for (int mp = 0; mp < 2; ++mp) { u32x2 pk[2];
#pragma unroll
                    for (int q = 0; q < 2; ++q) { const int m = 2 * mp + q, row = u.arow + ai * HALF + wr * 64 + m * 16 + fr; const float rsc = QPRE ? rs[ai][m] : oscale;
                        f32x4 v0 = acc[ai][bj][m][0] * rsc, v1 = acc[ai][bj][m][1] * rsc;
                        if (isr) rope8(v0, v1, (float)(row & (SEQ - 1)), inv);
                        if (F8) { const float o8[8] = {v0[0], v0[1], v0[2], v0[3], v1[0], v1[1], v1[2], v1[3]}; pk[q] = pk8_fp8(o8); }
                        else { u32x4 w; w.x = cvt_pk_bf16(v0[0], v0[1]); w.y = cvt_pk_bf16(v0[2], v0[3]); w.z = cvt_pk_bf16(v1[0], v1[1]); w.w = cvt_pk_bf16(v1[2], v1[3]);
                            *(u32x4*)(O + (size_t)row * NQ + c) = w; } }
                    if (F8) { const int row = u.arow + ai * HALF + wr * 64 + (2 * mp + odd) * 16 + fr;
                        *(u32x4*)((unsigned char*)O + (size_t)row * NQ + c - 8 * odd) = widen16(pk[0], pk[1]); } } }
    }
};
template <bool F8, bool F8UP = false> struct EpiDown {
    static constexpr bool PERM = true, LSTAT = false, LSTAT_COL = false, Z64 = true; static constexpr int NST = 0;
    __device__ __forceinline__ bool full(const Unit&) const { return false; }
    bf16_t* O; float* stat; LAS float* part; unsigned char* kr8; float oscale;
    __device__ __forceinline__ void operator()(const f32x4 (&acc)[2][2][4][2], const Unit& u, int wr, int wc, int fr, int fq) const {
        const int col0 = u.col + wc * 32 + 8 * fq, pn = u.col >> 8, lane = fq * 16 + fr;
        u32x2 pk8[2][2];
        if (pn < 2) {
#pragma unroll
            for (int ai = 0; ai < 2; ++ai)
#pragma unroll
                for (int m = 0; m < 4; ++m) { const int rl = ai * HALF + wr * 64 + m * 16 + fr; float ss = 0.f;
#pragma unroll
                    for (int bj = 0; bj < 2; ++bj) { const f32x4 v0 = acc[ai][bj][m][0] * oscale, v1 = acc[ai][bj][m][1] * oscale;
                        ss += ((v0.x * v0.x + v0.y * v0.y) + (v0.z * v0.z + v0.w * v0.w)) + ((v1.x * v1.x + v1.y * v1.y) + (v1.z * v1.z + v1.w * v1.w));
                        if (F8UP) { const float o8[8] = {v0[0], v0[1], v0[2], v0[3], v1[0], v1[1], v1[2], v1[3]}; pk8[m & 1][bj] = pk8_fp8(o8);
                            if (m & 1) { const int odd = fq & 1;
                                *(u32x4*)((unsigned char*)O + (size_t)(u.arow + rl - 16 + 16 * odd) * DOWNP + col0 - 8 * odd + bj * HALF) = widen16(pk8[0][bj], pk8[1][bj]); } }
                        else { u32x4 w; w.x = cvt_pk_bf16(v0[0], v0[1]); w.y = cvt_pk_bf16(v0[2], v0[3]); w.z = cvt_pk_bf16(v1[0], v1[1]); w.w = cvt_pk_bf16(v1[2], v1[3]);
                        *(u32x4*)(O + (size_t)(u.arow + rl) * DOWNP + col0 + bj * HALF) = w; } }
                    ss += shx(ss, 16, lane); ss += shx(ss, 32, lane); if (fq == 0) part[wc * 256 + rl] = ss; }
        } else if (wc < 2) {
            float inv[4]; rope_inv4(inv, wc * 16 + 4 * fq);
#pragma unroll
            for (int ai = 0; ai < 2; ++ai)
#pragma unroll
                for (int m = 0; m < 4; ++m) { const int row = u.arow + ai * HALF + wr * 64 + m * 16 + fr;
                    f32x4 v0 = acc[ai][0][m][0] * oscale, v1 = acc[ai][0][m][1] * oscale;
                    rope8(v0, v1, (float)(row & (SEQ - 1)), inv);
                    if (F8) { const float o8[8] = {v0[0], v0[1], v0[2], v0[3], v1[0], v1[1], v1[2], v1[3]}; *(u32x2*)(kr8 + (size_t)row * 64 + (col0 - 512)) = pk8_fp8(o8); }
                    else { u32x4 w; w.x = cvt_pk_bf16(v0[0], v0[1]); w.y = cvt_pk_bf16(v0[2], v0[3]); w.z = cvt_pk_bf16(v1[0], v1[1]); w.w = cvt_pk_bf16(v1[2], v1[3]);
                    *(u32x4*)(O + (size_t)row * DOWNP + col0) = w; } }
        }
        if (pn < 2) stat_combine(part, stat, u, pn, wr, wc, fr, fq);
        else { asm volatile("s_waitcnt lgkmcnt(0)" ::: "memory"); __builtin_amdgcn_s_barrier(); }
    }
};

template <class Epi, class Sched, bool ALIGN_EPI, bool FP8 = false>
__device__ __forceinline__ void gemm_phase(LAS unsigned char* lds, const Gemm g, const Sched& S, const Epi& E, const int wv) {
    const int tid = opaque_tid(wv), wid = __builtin_amdgcn_readfirstlane(tid >> 6), lane = tid & 63, wr = wid >> 2, wc = wid & 3, fr = lane & 15, fq = lane >> 4;
    const int K = g.K; int nt = K / BK; asm volatile("" : "+s"(nt));
    unsigned voffA[2], voffB[2];
#pragma unroll
    for (int i = 0; i < 2; ++i) { int R, C; stage_rc(tid * 16 + i * 8192, R, C); const int Rb = Epi::PERM ? ((R & ~31) + perm32(R & 31)) : R;
        voffA[i] = (unsigned)(R * g.lda + C) * 2u; voffB[i] = (unsigned)(Rb * g.ldb + C) * 2u; }
    const size_t kstep = (size_t)(BK * 2);
    const size_t hsA = (size_t)HALF * g.lda * 2, hsB = (size_t)HALF * g.ldb * 2;
    const unsigned ldsw = (unsigned)wid * 1024u, ldsb = (unsigned)(uintptr_t)lds;
    const int aoff = lds_byte(wr * 64 + fr, fq * 8), boff = lds_byte(wc * 32 + fr, fq * 8);
#define PG8_SA(b, h) (((b) * 2 + (h)) * HTB)
#define PG8_SB(b, h) ((4 + (b) * 2 + (h)) * HTB)
#define PG8_STAGE(bufoff, gbase, voff) do { _Pragma("unroll") for (int _i = 0; _i < 2; ++_i) \
        glds16_s((const char*)(gbase), (voff)[_i], ldsb + (unsigned)(bufoff) + ldsw + (unsigned)(_i * 8192)); } while (0)
#define PG8_LDA(dst, b, h) do { _Pragma("unroll") for (int m = 0; m < 4; ++m) _Pragma("unroll") for (int k = 0; k < 2; ++k) dst[m][k] = *(const LAS bf16x8*)(lds + PG8_SA(b, h) + aoff + m * 2048 + k * 1024); } while (0)
#define PG8_LDB(dst, b, h) do { _Pragma("unroll") for (int n = 0; n < 2; ++n) _Pragma("unroll") for (int k = 0; k < 2; ++k) dst[n][k] = *(const LAS bf16x8*)(lds + PG8_SB(b, h) + boff + n * 2048 + k * 1024); } while (0)
#define PG8_MMA(ai, bj, At, Bt) do { __builtin_amdgcn_s_setprio(1); _Pragma("unroll") for (int m = 0; m < 4; ++m) _Pragma("unroll") for (int n = 0; n < 2; ++n) { \
        if constexpr (FP8) { const i32x4 b0_ = __builtin_bit_cast(i32x4, Bt[n][0]), b1_ = __builtin_bit_cast(i32x4, Bt[n][1]), a0_ = __builtin_bit_cast(i32x4, At[m][0]), a1_ = __builtin_bit_cast(i32x4, At[m][1]); \
            acc[ai][bj][m][n] = __builtin_amdgcn_mfma_scale_f32_16x16x128_f8f6f4(__builtin_shufflevector(b0_, b1_, 0, 1, 2, 3, 4, 5, 6, 7), __builtin_shufflevector(a0_, a1_, 0, 1, 2, 3, 4, 5, 6, 7), acc[ai][bj][m][n], 0, 0, 0, 0x7F7F7F7F, 0, 0x7F7F7F7F); } \
        else { _Pragma("unroll") for (int k = 0; k < 2; ++k) acc[ai][bj][m][n] = __builtin_amdgcn_mfma_f32_16x16x32_bf16(Bt[n][k], At[m][k], acc[ai][bj][m][n], 0, 0, 0); } } \
        __builtin_amdgcn_s_setprio(0); } while (0)
#define PG8_WAIT_V(n) asm volatile("s_waitcnt vmcnt(" #n ")" ::: "memory")
#define PG8_WAIT_V8R(rx) asm volatile("s_cmp_eq_u32 %0, 0\n\ts_cbranch_scc1 .Lrxa%=\n\ts_waitcnt vmcnt(%1)\n\ts_branch .Lrxb%=\n.Lrxa%=:\n\ts_waitcnt vmcnt(8)\n.Lrxb%=:" :: "s"(__builtin_amdgcn_readfirstlane((int)(rx))), "n"(8 + Epi::NST) : "memory", "scc")
#define PG8_WAIT_L(n) asm volatile("s_waitcnt lgkmcnt(" #n ")" ::: "memory")
#define PG8_BAR __builtin_amdgcn_s_barrier()
#define PG8_SCHED __builtin_amdgcn_sched_barrier(0)
    Unit cur, nxt; int ui = 0; bool relax = false;
    if (!S.next(0, cur)) return;
    cur.par = 0;
#define PG8_STAT(uu) do { if constexpr (Epi::LSTAT) { if (wid >= 4) { const unsigned vo_ = (unsigned)(((wid - 4) * 64 + opaque_lane()) * 16); \
        glds16_s((const char*)(E.stat + (size_t)(Epi::LSTAT_COL ? (uu).col : (uu).arow) * 4), vo_, ldsb + (unsigned)STG_OFF + (unsigned)(uu).par * 4096u + (unsigned)(wid - 4) * 1024u); } } } while (0)
    f32x4 acc[2][2][4][2];
#pragma unroll
    for (int a = 0; a < 2; ++a)
#pragma unroll
        for (int b = 0; b < 2; ++b)
#pragma unroll
            for (int m = 0; m < 4; ++m)
#pragma unroll
                for (int n = 0; n < 2; ++n) acc[a][b][m][n] = (f32x4){0.f, 0.f, 0.f, 0.f};
    bf16x8 At[4][2], B0[2][2], B1[2][2];
    const char* cA = (const char*)g.A + (size_t)cur.arow * g.lda * 2; const char* cB = (const char*)g.Bt + (size_t)cur.brow * g.ldb * 2;
    PG8_STAT(cur);
    PG8_STAGE(PG8_SB(0, 0), cB, voffB); PG8_STAGE(PG8_SB(0, 1), cB + hsB, voffB); PG8_STAGE(PG8_SA(0, 0), cA, voffA); PG8_STAGE(PG8_SA(0, 1), cA + hsA, voffA);
    PG8_STAGE(PG8_SB(1, 0), cB + kstep, voffB); PG8_STAGE(PG8_SA(1, 0), cA + kstep, voffA); PG8_STAGE(PG8_SB(1, 1), cB + hsB + kstep, voffB);
    if (wr == 1) PG8_BAR;
    PG8_WAIT_V(8); PG8_BAR;
    PG8_WAIT_V(6); PG8_BAR;
    for (;;) {
        const bool has_next = S.next(ui + 1, nxt); nxt.par = (ui + 1) & 1;
        if (has_next) PG8_STAT(nxt);
        const char* nA = has_next ? (const char*)g.A + (size_t)nxt.arow * g.lda * 2 : cA; const char* nB = has_next ? (const char*)g.Bt + (size_t)nxt.brow * g.ldb * 2 : cB;
        for (int t = 0; t < nt; t += 2) {
            const bool last = (t == nt - 2); const bool rx = relax && t == 0;
            const char* a1 = cA + (size_t)(t + 1) * kstep;
            const char* a2 = last ? nA : cA + (size_t)(t + 2) * kstep; const char* b2 = last ? nB : cB + (size_t)(t + 2) * kstep;
            const char* a3 = a2 + kstep; const char* b3 = b2 + kstep;
            PG8_LDB(B0, 0, 0); PG8_LDB(B1, 0, 1); PG8_SCHED; PG8_LDA(At, 0, 0); PG8_STAGE(PG8_SA(1, 1), a1 + hsA, voffA);
            PG8_WAIT_V8R(rx); PG8_WAIT_L(0); PG8_BAR; PG8_MMA(0, 0, At, B0); PG8_MMA(0, 1, At, B1); PG8_BAR; PG8_SCHED;
            PG8_LDA(At, 0, 1); PG8_STAGE(PG8_SB(0, 0), b2, voffB); PG8_STAGE(PG8_SB(0, 1), b2 + hsB, voffB); PG8_STAGE(PG8_SA(0, 0), a2, voffA);
            PG8_WAIT_V8R(rx); PG8_WAIT_L(0); PG8_BAR; PG8_MMA(1, 0, At, B0); PG8_MMA(1, 1, At, B1); PG8_BAR; PG8_SCHED;
            PG8_LDB(B0, 1, 0); PG8_LDB(B1, 1, 1); PG8_SCHED; PG8_LDA(At, 1, 0); PG8_STAGE(PG8_SA(0, 1), a2 + hsA, voffA);
            PG8_WAIT_V(8); PG8_WAIT_L(0); PG8_BAR; PG8_MMA(0, 0, At, B0); PG8_MMA(0, 1, At, B1); PG8_BAR; PG8_SCHED;
            PG8_LDA(At, 1, 1); PG8_STAGE(PG8_SB(1, 0), b3, voffB); PG8_STAGE(PG8_SB(1, 1), b3 + hsB, voffB); PG8_STAGE(PG8_SA(1, 0), a3, voffA);
            PG8_WAIT_V(8); PG8_WAIT_L(0); PG8_BAR; PG8_MMA(1, 0, At, B0); PG8_MMA(1, 1, At, B1); PG8_BAR; PG8_SCHED;
        }
        if constexpr (ALIGN_EPI) { if (wr == 0) PG8_BAR; }
        { const int l2 = opaque_lane(); E(acc, cur, wr, wc, l2 & 15, l2 >> 4); relax = Epi::NST > 0 && E.full(cur); }
        if (!has_next) break;
        if constexpr (Epi::Z64) { unsigned long long zz; asm volatile("v_mov_b64 %0, 0" : "=v"(zz)); typedef unsigned long long u64x2_t __attribute__((ext_vector_type(2)));
#pragma unroll
        for (int a = 0; a < 2; ++a)
#pragma unroll
            for (int b = 0; b < 2; ++b)
#pragma unroll
                for (int m = 0; m < 4; ++m)
#pragma unroll
                    for (int n = 0; n < 2; ++n) acc[a][b][m][n] = __builtin_bit_cast(f32x4, (u64x2_t){zz, zz}); }
        else {
#pragma unroll
        for (int a = 0; a < 2; ++a)
#pragma unroll
            for (int b = 0; b < 2; ++b)
#pragma unroll
                for (int m = 0; m < 4; ++m)
#pragma unroll
                    for (int n = 0; n < 2; ++n) acc[a][b][m][n] = (f32x4){0.f, 0.f, 0.f, 0.f}; }
        cur = nxt; cA = nA; cB = nB; ++ui;
        if constexpr (ALIGN_EPI) { if (wr == 1) PG8_BAR; }
    }
    PG8_WAIT_V(0);
    if constexpr (!ALIGN_EPI) { if (wr == 0) PG8_BAR; }
    PG8_BAR;
#undef PG8_SA
#undef PG8_SB
#undef PG8_STAGE
#undef PG8_LDA
#undef PG8_LDB
#undef PG8_MMA
#undef PG8_WAIT_V
#undef PG8_WAIT_V8R
#undef PG8_WAIT_L
#undef PG8_BAR
#undef PG8_SCHED
#undef PG8_STAT
}
}

__device__ __forceinline__ int crow(int r, int hi) { return (r & 3) + 8 * (r >> 2) + 4 * hi; }
__device__ __forceinline__ int v_rd_base(int lane) { return ((lane & 3) << 3) | (((lane >> 2) & 3) << 6) | (((lane >> 4) & 1) << 5) | (((lane >> 5) & 1) << 8); }
template <int NCB> __device__ __forceinline__ int v_st(int k, int c) { const int kk = (k & ~0xC) | ((k & 4) << 1) | ((k & 8) >> 1); return ((kk >> 3) * NCB + (c >> 5)) * 512 + ((kk & 7) * 32 + (c & 31)) * 2; }
template <int OFF> __device__ __forceinline__ s16x4 tr_read(int vb) {
    s16x4 r; asm volatile("ds_read_b64_tr_b16 %0, %1 offset:%2" : "=&v"(r) : "v"(vb), "i"(OFF) : "memory"); return r;
}
template <int D0, int NCB> __device__ __forceinline__ void pv_one(f32x16& od, int vb, bf16x8 pa0, bf16x8 pa1, bf16x8 pa2, bf16x8 pa3) {
    constexpr int KS = NCB * 1024, HF = NCB * 512;
    const s16x4 l0 = tr_read<D0 * 512 + 0 * KS>(vb), h0 = tr_read<D0 * 512 + 0 * KS + HF>(vb), l1 = tr_read<D0 * 512 + 1 * KS>(vb), h1 = tr_read<D0 * 512 + 1 * KS + HF>(vb);
    const s16x4 l2 = tr_read<D0 * 512 + 2 * KS>(vb), h2 = tr_read<D0 * 512 + 2 * KS + HF>(vb), l3 = tr_read<D0 * 512 + 3 * KS>(vb), h3 = tr_read<D0 * 512 + 3 * KS + HF>(vb);
    asm volatile("s_waitcnt lgkmcnt(0)" ::: "memory"); SBAR();
#define PK(L, H) (bf16x8){L[0], L[1], L[2], L[3], H[0], H[1], H[2], H[3]}
    od = __builtin_amdgcn_mfma_f32_32x32x16_bf16(pa0, PK(l0, h0), od, 0, 0, 0);
    od = __builtin_amdgcn_mfma_f32_32x32x16_bf16(pa1, PK(l1, h1), od, 0, 0, 0);
    od = __builtin_amdgcn_mfma_f32_32x32x16_bf16(pa2, PK(l2, h2), od, 0, 0, 0);
    od = __builtin_amdgcn_mfma_f32_32x32x16_bf16(pa3, PK(l3, h3), od, 0, 0, 0);
#undef PK
}
#define PK4(P, BASE, OUT) do { unsigned a0 = cvt_pk_bf16(P[BASE + 0], P[BASE + 1]), a1 = cvt_pk_bf16(P[BASE + 2], P[BASE + 3]);   \
    unsigned b0 = cvt_pk_bf16(P[BASE + 4], P[BASE + 5]), b1 = cvt_pk_bf16(P[BASE + 6], P[BASE + 7]);                              \
    auto r0 = __builtin_amdgcn_permlane32_swap(a0, b0, false, false); auto r1 = __builtin_amdgcn_permlane32_swap(a1, b1, false, false); \
    u32x4 w = {r0[0], r1[0], r0[1], r1[1]}; OUT = __builtin_bit_cast(bf16x8, w); } while (0)

namespace mla {
constexpr int NW = 8, QBLK = 32, KVBLK = 64;
constexpr int KN_B = KVBLK * 256, KR_B = KVBLK * 128, V_B = KVBLK * 256, SLOT = KN_B + KR_B + V_B  , NSLOT = 3;
constexpr int OFF_WS = NSLOT * SLOT  , OFF_END = OFF_WS + NW * 64 * 4;
static_assert(OFF_END <= RING_BYTES, "mla lds");
constexpr int OSTR = 272;
static_assert(NW * 32 * OSTR <= OFF_WS, "O staging aliases the ring");
constexpr float SCALE = 0.07216878364870323f;
constexpr float THR = 8.f;
constexpr int LDQ = NQ, LDKV = NKV, LDR = DOWNP, LDO = DM;

__device__ __forceinline__ void partialSM(f32x16& p0, f32x16& p1, float& m_reg, float& mn, float& alpha, const float C) {
    float pmax = p0[0];
#pragma unroll
    for (int r = 1; r < 16; ++r) pmax = fmaxf(pmax, p0[r]);
#pragma unroll
    for (int r = 0; r < 16; ++r) pmax = fmaxf(pmax, p1[r]);
    { auto rr = __builtin_amdgcn_permlane32_swap(__float_as_uint(pmax), __float_as_uint(pmax), false, false);
      pmax = fmaxf(__uint_as_float(rr[0]), __uint_as_float(rr[1])); }
    if (__builtin_expect(__all((pmax - m_reg) * C <= THR * LOG2E), 1)) { mn = m_reg; alpha = 1.f; }
    else { mn = fmaxf(m_reg, pmax); alpha = __builtin_amdgcn_exp2f((m_reg - mn) * C); m_reg = mn; }
    const float mnC = -mn * C;
#pragma unroll
    for (int r = 0; r < 16; ++r) p0[r] = fmaf(p0[r], C, mnC);
#pragma unroll
    for (int r = 0; r < 16; ++r) p1[r] = fmaf(p1[r], C, mnC);
#pragma unroll
    for (int r = 0; r < 16; ++r) p0[r] = __builtin_amdgcn_exp2f(p0[r]);
}
__device__ __forceinline__ void finishSM(f32x16& p0, f32x16& p1, float alpha, float& l_reg, bf16x8& pa0, bf16x8& pa1, bf16x8& pa2, bf16x8& pa3) {
#pragma unroll
    for (int r = 0; r < 16; ++r) p1[r] = __builtin_amdgcn_exp2f(p1[r]);
    float ps = 0;
#pragma unroll
    for (int r = 0; r < 16; ++r) ps += p0[r];
#pragma unroll
    for (int r = 0; r < 16; ++r) ps += p1[r];
    { auto rr = __builtin_amdgcn_permlane32_swap(__float_as_uint(ps), __float_as_uint(ps), false, false);
      ps = __uint_as_float(rr[0]) + __uint_as_float(rr[1]); }
    l_reg = l_reg * alpha + ps;
    PK4(p0, 0, pa0); PK4(p0, 8, pa1); PK4(p1, 0, pa2); PK4(p1, 8, pa3);
}
__device__ __forceinline__ void qkt(f32x16& p0, f32x16& p1, const LAS unsigned char* slot, const bf16x8* qr, int r32, int hi) {
    p0 = f32x16{}; p1 = f32x16{};
    const LAS unsigned char* kn = slot + r32 * 256; const int xn = (r32 & 7) << 4;
    const LAS unsigned char* kr = slot + KN_B + r32 * 128; const int xr = ((r32 >> 1) & 7) << 4;
    bf16x8 f0[3], f1[3];
#define MLA_LDK(d0) do { if ((d0) < 8) { const int cb_ = (((d0) * 16 + hi * 8) * 2) ^ xn; f0[(d0) % 3] = *(const LAS bf16x8*)(kn + cb_); f1[(d0) % 3] = *(const LAS bf16x8*)(kn + 32 * 256 + cb_); } \
        else { const int cb_ = ((((d0) - 8) * 2 + hi) * 16) ^ xr; f0[(d0) % 3] = *(const LAS bf16x8*)(kr + cb_); f1[(d0) % 3] = *(const LAS bf16x8*)(kr + 32 * 128 + cb_); } } while (0)
    MLA_LDK(0); MLA_LDK(1);
#pragma unroll
    for (int d0 = 0; d0 < 12; ++d0) {
        if (d0 + 2 < 12) MLA_LDK(d0 + 2);
        SBAR();
        p0 = __builtin_amdgcn_mfma_f32_32x32x16_bf16(f0[d0 % 3], qr[d0], p0, 0, 0, 0);
        p1 = __builtin_amdgcn_mfma_f32_32x32x16_bf16(f1[d0 % 3], qr[d0], p1, 0, 0, 0);
        SBAR();
    }
#undef MLA_LDK
}
__device__ __forceinline__ void pv_all(f32x16* o, int vb, bf16x8 pa0, bf16x8 pa1, bf16x8 pa2, bf16x8 pa3) {
    s16x4 la[4], ha[4], lb[4], hb[4];
#define PV_RD(L, H, ks) do { L[0] = tr_read<0 * 512 + (ks) * 4096>(vb); H[0] = tr_read<0 * 512 + (ks) * 4096 + 2048>(vb); L[1] = tr_read<1 * 512 + (ks) * 4096>(vb); H[1] = tr_read<1 * 512 + (ks) * 4096 + 2048>(vb); \
        L[2] = tr_read<2 * 512 + (ks) * 4096>(vb); H[2] = tr_read<2 * 512 + (ks) * 4096 + 2048>(vb); L[3] = tr_read<3 * 512 + (ks) * 4096>(vb); H[3] = tr_read<3 * 512 + (ks) * 4096 + 2048>(vb); } while (0)
#define PV_PK(L, H) (bf16x8){L[0], L[1], L[2], L[3], H[0], H[1], H[2], H[3]}
#define PV_MM(L, H, pa) do { _Pragma("unroll") for (int d = 0; d < 4; ++d) o[d] = __builtin_amdgcn_mfma_f32_32x32x16_bf16(pa, PV_PK(L[d], H[d]), o[d], 0, 0, 0); } while (0)
    PV_RD(la, ha, 0); PV_RD(lb, hb, 1);
    asm volatile("s_waitcnt lgkmcnt(8)" ::: "memory"); SBAR(); PV_MM(la, ha, pa0); SBAR();
    PV_RD(la, ha, 2);
    asm volatile("s_waitcnt lgkmcnt(8)" ::: "memory"); SBAR(); PV_MM(lb, hb, pa1); SBAR();
    PV_RD(lb, hb, 3);
    asm volatile("s_waitcnt lgkmcnt(8)" ::: "memory"); SBAR(); PV_MM(la, ha, pa2); SBAR();
    asm volatile("s_waitcnt lgkmcnt(0)" ::: "memory"); SBAR(); PV_MM(lb, hb, pa3); SBAR();
#undef PV_RD
#undef PV_PK
#undef PV_MM
}
#define MLA_BAR() asm volatile("s_waitcnt vmcnt(0) lgkmcnt(0)\n\ts_barrier" ::: "memory")
template <bool O8> __device__ __forceinline__ void unit(int b, int h, int qb, const bf16_t* __restrict__ Q, const bf16_t* __restrict__ KV, const bf16_t* __restrict__ DN, const float* __restrict__ stat, bf16_t* __restrict__ O, LAS unsigned char* lds, const int wv) {
    const int tid = opaque_tid(wv), wid = __builtin_amdgcn_readfirstlane(tid >> 6), lane = tid & 63, r32 = lane & 31, hi = lane >> 5;
    const size_t tok0 = (size_t)b * SEQ;
    const bf16_t* Qb = Q + (tok0 + (size_t)qb * 256) * LDQ + h * QKD;
    const char* Kn = (const char*)(KV + tok0 * LDKV + h * 128);
    const char* Vh = (const char*)(KV + tok0 * LDKV + 1024 + h * 128);
    const char* Kr = (const char*)(DN + tok0 * LDR + 512);
    LAS float* ws = (LAS float*)(lds + OFF_WS) + wid * 64; LAS float* li_l = ws; LAS float* al_l = ws + 32;
    const unsigned ldsb = (unsigned)(uintptr_t)lds;
    unsigned vkn[2], vv[2], vkr;
#pragma unroll
    for (int i = 0; i < 2; ++i) { const int L = (wid * 2 + i) * 64 + lane; { const int row = L >> 4, c16 = (L & 15) ^ (row & 7); vkn[i] = (unsigned)(row * (LDKV * 2) + c16 * 16); }
        { const int st = L >> 5, w = L & 31, kk = (st >> 2) * 8 + (w >> 2), k = (kk & ~0xC) | ((kk & 4) << 1) | ((kk & 8) >> 1), c = (st & 3) * 32 + (w & 3) * 8; vv[i] = (unsigned)(k * (LDKV * 2) + c * 2); } }
    { const int L = wid * 64 + lane, row = L >> 3, c16 = (L & 7) ^ ((row >> 1) & 7); vkr = (unsigned)(row * (LDR * 2) + c16 * 16); }
#define MLA_ISSUE(t, sl) do { const size_t ko_ = (size_t)(t) * KVBLK; const unsigned sb_ = ldsb + (unsigned)(sl) * SLOT + (unsigned)wid * 2048u; \
        glds16_s(Kn + ko_ * (LDKV * 2), vkn[0], sb_); glds16_s(Kn + ko_ * (LDKV * 2), vkn[1], sb_ + 1024u); \
        glds16_s(Kr + ko_ * (LDR * 2), vkr, ldsb + (unsigned)(sl) * SLOT + KN_B + (unsigned)wid * 1024u); \
        glds16_s(Vh + ko_ * (LDKV * 2), vv[0], sb_ + KN_B + KR_B); glds16_s(Vh + ko_ * (LDKV * 2), vv[1], sb_ + KN_B + KR_B + 1024u); } while (0)
    MLA_ISSUE(0, 0); MLA_ISSUE(1, 1);
    float m_reg = -1e30f, l_reg = 0; f32x16 o[4] = {}; bf16x8 qr[12];
    const float Cq = SCALE * LOG2E * __builtin_amdgcn_rsqf(stat[(tok0 + (size_t)qb * 256 + wid * QBLK + r32) * 4] * (1.f / 256.f) + EPS);
    const bf16_t* Qw = Qb + (size_t)(wid * QBLK + r32) * LDQ + hi * 8;
#pragma unroll
    for (int d0 = 0; d0 < 12; ++d0) qr[d0] = *(const bf16x8*)(Qw + d0 * 16);
    const int vb0 = (int)ldsb + KN_B + KR_B + v_rd_base(lane);
#define RESC(a) do { if (__any((a) < 1.f)) { if (hi == 0) al_l[r32] = (a); asm volatile("s_waitcnt lgkmcnt(0)" ::: "memory"); \
    _Pragma("unroll") for (int d = 0; d < 4; ++d) _Pragma("unroll") for (int r = 0; r < 16; ++r) o[d][r] *= al_l[crow(r, hi)]; } } while (0)
    f32x16 p0, p1; float mn, al; bf16x8 pa0, pa1, pa2, pa3; constexpr int NT = SEQ / KVBLK;
    MLA_BAR();
#define MLA_BARC(j) asm volatile("s_cmp_lt_i32 %0, %1\n\ts_cbranch_scc1 .Lmb%=\n\ts_waitcnt vmcnt(0)\n\ts_branch .Lme%=\n.Lmb%=:\n\ts_waitcnt vmcnt(5)\n.Lme%=:\n\ts_waitcnt lgkmcnt(0)\n\ts_barrier" :: "s"(__builtin_amdgcn_readfirstlane((j) + 2)), "n"(SEQ / KVBLK) : "memory", "scc")
    const bool halfB = wid >= 4;
    if (halfB) { MLA_BARC(0); MLA_ISSUE(2, 2); }
    int sj = 0;
    for (int j = 0; j < NT; ++j) {
        const int s1 = sj == 2 ? 0 : sj + 1, s2 = s1 == 2 ? 0 : s1 + 1;
        qkt(p0, p1, lds + sj * SLOT, qr, r32, hi);
        MLA_BARC(j);
        if (!halfB && j + 2 < NT) MLA_ISSUE(j + 2, s2);
        partialSM(p0, p1, m_reg, mn, al, Cq); RESC(al);
        finishSM(p0, p1, al, l_reg, pa0, pa1, pa2, pa3); SBAR();
        pv_all(o, vb0 + sj * SLOT, pa0, pa1, pa2, pa3);
        MLA_BARC(j);
        if (halfB && j + 3 < NT) MLA_ISSUE(j + 3, sj);
        sj = s1;
    }
    if (!halfB) MLA_BARC(NT);
#undef MLA_BARC
    if (hi == 0) li_l[r32] = l_reg; asm volatile("s_waitcnt lgkmcnt(0)" ::: "memory");
    float rli[16];
#pragma unroll
    for (int r = 0; r < 16; ++r) rli[r] = __builtin_amdgcn_rcpf(li_l[crow(r, hi)]);
    MLA_BAR();
    LAS unsigned char* ost = lds + wid * (32 * OSTR);
    if constexpr (O8) {
#pragma unroll
        for (int r = 0; r < 16; ++r) { const int orow = crow(r, hi);
#pragma unroll
            for (int d0 = 0; d0 < 4; ++d0) *(LAS unsigned char*)(ost + orow * 144 + d0 * 32 + r32) = (unsigned char)fp8_1(o[d0][r] * rli[r] * O8_SCALE); }
        asm volatile("s_waitcnt lgkmcnt(0)" ::: "memory");
        unsigned char* Ow = (unsigned char*)O + (tok0 + (size_t)qb * 256 + wid * QBLK) * LDO + h * 128;
#pragma unroll
        for (int it = 0; it < 4; ++it) { const int ch = it * 64 + lane, row = ch >> 3, c16 = ch & 7;
            const u32x4 v = *(const LAS u32x4*)(ost + row * 144 + c16 * 16); *(u32x4*)(Ow + (size_t)row * LDO + c16 * 16) = v; }
    } else {
#pragma unroll
    for (int r = 0; r < 16; ++r) { const int orow = crow(r, hi);
#pragma unroll
        for (int d0 = 0; d0 < 4; ++d0) *(LAS unsigned short*)(ost + orow * OSTR + (d0 * 32 + r32) * 2) = (unsigned short)f2bf(o[d0][r] * rli[r]); }
    asm volatile("s_waitcnt lgkmcnt(0)" ::: "memory");
    bf16_t* Ow = O + (tok0 + (size_t)qb * 256 + wid * QBLK) * LDO + h * 128;
#pragma unroll
    for (int it = 0; it < 8; ++it) { const int ch = it * 64 + lane, row = ch >> 4, c16 = ch & 15;
        const u32x4 v = *(const LAS u32x4*)(ost + row * OSTR + c16 * 16); *(u32x4*)(Ow + (size_t)row * LDO + c16 * 8) = v; }
    }
    MLA_BAR();
#undef MLA_ISSUE
#undef RESC
}
#undef MLA_BAR
}

namespace mla8 {
using mla::partialSM; using mla::finishSM; using mla::pv_all;
constexpr int NW = 8, QBLK = 32, KVBLK = 64;
constexpr int KN_B = KVBLK * 128, KR_B = KVBLK * 64, V_B = KVBLK * 256, SLOT = KN_B + KR_B + V_B  , NSLOT = 3;
constexpr int OFF_WS = 3 * 40960, OSTR = 272;
static_assert(NSLOT * SLOT <= OFF_WS && OFF_WS + NW * 64 * 4 <= RING_BYTES && NW * 32 * OSTR <= OFF_WS, "mla8 lds");
constexpr float SCALE = 0.07216878364870323f;
constexpr int LDKV = NKV, LDO = DM;
__device__ __forceinline__ i32x8 cat8(bf16x8 a, bf16x8 b) { return __builtin_shufflevector(__builtin_bit_cast(i32x4, a), __builtin_bit_cast(i32x4, b), 0, 1, 2, 3, 4, 5, 6, 7); }
__device__ __forceinline__ void qkt(f32x16& p0, f32x16& p1, const LAS unsigned char* slot, const i32x8* qr, int r32, int hi) {
    p0 = f32x16{}; p1 = f32x16{};
    const LAS unsigned char* kn = slot + r32 * 128; const int xn = ((r32 >> 1) & 7) << 4;
    const LAS unsigned char* kr = slot + KN_B + r32 * 64; const int xr = ((r32 >> 2) & 3) << 4;
    bf16x8 a0[3], a1[3], b0[3], b1[3];
#pragma unroll
    for (int s = 0; s < 2; ++s) { const int c0 = ((s * 4 + hi * 2) * 16) ^ xn, c1 = ((s * 4 + hi * 2 + 1) * 16) ^ xn;
        a0[s] = *(const LAS bf16x8*)(kn + c0); a1[s] = *(const LAS bf16x8*)(kn + c1); b0[s] = *(const LAS bf16x8*)(kn + 32 * 128 + c0); b1[s] = *(const LAS bf16x8*)(kn + 32 * 128 + c1); }
    { const int c0 = ((hi * 2) * 16) ^ xr, c1 = ((hi * 2 + 1) * 16) ^ xr;
        a0[2] = *(const LAS bf16x8*)(kr + c0); a1[2] = *(const LAS bf16x8*)(kr + c1); b0[2] = *(const LAS bf16x8*)(kr + 32 * 64 + c0); b1[2] = *(const LAS bf16x8*)(kr + 32 * 64 + c1); }
#pragma unroll
    for (int s = 0; s < 3; ++s) {
        p0 = __builtin_amdgcn_mfma_scale_f32_32x32x64_f8f6f4(cat8(a0[s], a1[s]), qr[s], p0, 0, 0, 0, 0x7F7F7F7F, 0, 0x7F7F7F7F);
        p1 = __builtin_amdgcn_mfma_scale_f32_32x32x64_f8f6f4(cat8(b0[s], b1[s]), qr[s], p1, 0, 0, 0, 0x7F7F7F7F, 0, 0x7F7F7F7F); }
}
#define MLA_BAR() asm volatile("s_waitcnt vmcnt(0) lgkmcnt(0)\n\ts_barrier" ::: "memory")
template <bool O8> __device__ __forceinline__ void unit(int b, int h, int qb, const unsigned char* __restrict__ Q8, const unsigned char* __restrict__ K8, const unsigned char* __restrict__ KR8, const bf16_t* __restrict__ KV, const float* __restrict__ stat, bf16_t* __restrict__ O, LAS unsigned char* lds, const int wv) {
    const int tid = opaque_tid(wv), wid = __builtin_amdgcn_readfirstlane(tid >> 6), lane = tid & 63, r32 = lane & 31, hi = lane >> 5;
    const size_t tok0 = (size_t)b * SEQ;
    const char* Kn = (const char*)(K8 + tok0 * 1024 + h * 128);
    const char* Kr = (const char*)(KR8 + tok0 * 64);
    const char* Vh = (const char*)(KV + tok0 * LDKV + 1024 + h * 128);
    LAS float* ws = (LAS float*)(lds + OFF_WS) + wid * 64; LAS float* li_l = ws; LAS float* al_l = ws + 32;
    const unsigned ldsb = (unsigned)(uintptr_t)lds;
    unsigned vkn, vkr, vv[2];
    { const int L = wid * 64 + lane, row = L >> 3, c16 = (L & 7) ^ ((row >> 1) & 7); vkn = (unsigned)(row * 1024 + c16 * 16); }
    { const int L = (wid & 3) * 64 + lane, row = L >> 2, c16 = (L & 3) ^ ((row >> 2) & 3); vkr = (unsigned)(row * 64 + c16 * 16); }
#pragma unroll
    for (int i = 0; i < 2; ++i) { const int L = (wid * 2 + i) * 64 + lane; const int st = L >> 5, w = L & 31, kk = (st >> 2) * 8 + (w >> 2), k = (kk & ~0xC) | ((kk & 4) << 1) | ((kk & 8) >> 1), c = (st & 3) * 32 + (w & 3) * 8; vv[i] = (unsigned)(k * (LDKV * 2) + c * 2); }
#define MLA_ISSUE(t, sl) do { const size_t ko_ = (size_t)(t) * KVBLK; const unsigned sb_ = ldsb + (unsigned)(sl) * SLOT; \
        glds16_s(Kn + ko_ * 1024, vkn, sb_ + (unsigned)wid * 1024u); glds16_s(Kr + ko_ * 64, vkr, sb_ + KN_B + (unsigned)(wid & 3) * 1024u); \
        glds16_s(Vh + ko_ * (LDKV * 2), vv[0], sb_ + KN_B + KR_B + (unsigned)wid * 2048u); glds16_s(Vh + ko_ * (LDKV * 2), vv[1], sb_ + KN_B + KR_B + (unsigned)wid * 2048u + 1024u); } while (0)
    MLA_ISSUE(0, 0); MLA_ISSUE(1, 1);
    float m_reg = -1e30f, l_reg = 0; f32x16 o[4] = {}; i32x8 qr[3];
    const float Cq = SCALE * LOG2E * __builtin_amdgcn_rsqf(stat[(tok0 + (size_t)qb * 256 + wid * QBLK + r32) * 4] * (1.f / 256.f) + EPS);
    { const unsigned char* Qw = Q8 + (tok0 + (size_t)qb * 256 + wid * QBLK + r32) * NQ + h * QKD + hi * 32;
#pragma unroll
      for (int s = 0; s < 3; ++s) qr[s] = cat8(*(const bf16x8*)(Qw + s * 64), *(const bf16x8*)(Qw + s * 64 + 16)); }
    const int vb0 = (int)ldsb + KN_B + KR_B + v_rd_base(lane);
#define RESC(a) do { if (__any((a) < 1.f)) { if (hi == 0) al_l[r32] = (a); asm volatile("s_waitcnt lgkmcnt(0)" ::: "memory"); \
    _Pragma("unroll") for (int d = 0; d < 4; ++d) _Pragma("unroll") for (int r = 0; r < 16; ++r) o[d][r] *= al_l[crow(r, hi)]; } } while (0)
    f32x16 p0, p1; float mn, al; bf16x8 pa0, pa1, pa2, pa3; constexpr int NT = SEQ / KVBLK;
    MLA_BAR();
#define MLA_BARC(j) asm volatile("s_cmp_lt_i32 %0, %1\n\ts_cbranch_scc1 .Lnb%=\n\ts_waitcnt vmcnt(0)\n\ts_branch .Lne%=\n.Lnb%=:\n\ts_waitcnt vmcnt(4)\n.Lne%=:\n\ts_waitcnt lgkmcnt(0)\n\ts_barrier" :: "s"(__builtin_amdgcn_readfirstlane((j) + 2)), "n"(SEQ / KVBLK) : "memory", "scc")
    const bool halfB = wid >= 4;
    if (halfB) { MLA_BARC(0); MLA_ISSUE(2, 2); }
    int sj = 0;
    for (int j = 0; j < NT; ++j) {
        const int s1 = sj == 2 ? 0 : sj + 1, s2 = s1 == 2 ? 0 : s1 + 1;
        qkt(p0, p1, lds + sj * SLOT, qr, r32, hi);
        MLA_BARC(j);
        if (!halfB && j + 2 < NT) MLA_ISSUE(j + 2, s2);
        partialSM(p0, p1, m_reg, mn, al, Cq); RESC(al);
        finishSM(p0, p1, al, l_reg, pa0, pa1, pa2, pa3); SBAR();
        pv_all(o, vb0 + sj * SLOT, pa0, pa1, pa2, pa3);
        MLA_BARC(j);
        if (halfB && j + 3 < NT) MLA_ISSUE(j + 3, sj);
        sj = s1;
    }
    if (!halfB) MLA_BARC(NT);
#undef MLA_BARC
    if (hi == 0) li_l[r32] = l_reg; asm volatile("s_waitcnt lgkmcnt(0)" ::: "memory");
    float rli[16];
#pragma unroll
    for (int r = 0; r < 16; ++r) rli[r] = __builtin_amdgcn_rcpf(li_l[crow(r, hi)]);
    MLA_BAR();
    LAS unsigned char* ost = lds + wid * (32 * OSTR);
    if constexpr (O8) {
#pragma unroll
        for (int r = 0; r < 16; ++r) { const int orow = crow(r, hi);
#pragma unroll
            for (int d0 = 0; d0 < 4; ++d0) *(LAS unsigned char*)(ost + orow * 144 + d0 * 32 + r32) = (unsigned char)fp8_1(o[d0][r] * rli[r] * O8_SCALE); }
        asm volatile("s_waitcnt lgkmcnt(0)" ::: "memory");
        unsigned char* Ow = (unsigned char*)O + (tok0 + (size_t)qb * 256 + wid * QBLK) * LDO + h * 128;
#pragma unroll
        for (int it = 0; it < 4; ++it) { const int ch = it * 64 + lane, row = ch >> 3, c16 = ch & 7;
            const u32x4 v = *(const LAS u32x4*)(ost + row * 144 + c16 * 16); *(u32x4*)(Ow + (size_t)row * LDO + c16 * 16) = v; }
    } else {
#pragma unroll
        for (int r = 0; r < 16; ++r) { const int orow = crow(r, hi);
#pragma unroll
            for (int d0 = 0; d0 < 4; ++d0) *(LAS unsigned short*)(ost + orow * OSTR + (d0 * 32 + r32) * 2) = (unsigned short)f2bf(o[d0][r] * rli[r]); }
        asm volatile("s_waitcnt lgkmcnt(0)" ::: "memory");
        bf16_t* Ow = O + (tok0 + (size_t)qb * 256 + wid * QBLK) * LDO + h * 128;
#pragma unroll
        for (int it = 0; it < 8; ++it) { const int ch = it * 64 + lane, row = ch >> 4, c16 = ch & 15;
            const u32x4 v = *(const LAS u32x4*)(ost + row * OSTR + c16 * 16); *(u32x4*)(Ow + (size_t)row * LDO + c16 * 8) = v; }
    }
    MLA_BAR();
#undef MLA_ISSUE
#undef RESC
}
#undef MLA_BAR
}

namespace mla9 {
using mla8::cat8;
constexpr float QPRE = 0.07216878364870323f * LOG2E * 8.0f;
constexpr int NW = 8, QBLK = 32, KVBLK = 64;
constexpr int KN_B = mla8::KN_B, KR_B = mla8::KR_B, V_B = 128 * 64, SLOT = KN_B + KR_B + V_B  , NSLOT = 3;
constexpr int OFF_WS = 3 * 40960, OSTR = 272, OFF_O8 = NSLOT * SLOT;
static_assert(NSLOT * SLOT <= OFF_WS && OFF_WS + NW * 64 * 4 <= RING_BYTES && NW * 32 * OSTR <= OFF_WS && OFF_O8 + NW * 32 * 144 <= OFF_WS, "mla9 lds");
constexpr float SCALE = 0.07216878364870323f, THR = 6.f;
constexpr int LDO = DM;
__device__ __forceinline__ void qkt(f32x16& p0, f32x16& p1, const f32x16& negm, const LAS unsigned char* slot, const i32x8* qr, int r32, int hi) {
    const LAS unsigned char* kn = slot + r32 * 128; const int xn = ((r32 >> 1) & 7) << 4;
    const LAS unsigned char* kr = slot + KN_B + r32 * 64; const int xr = ((r32 >> 2) & 3) << 4;
    bf16x8 a0[3], a1[3], b0[3], b1[3];
#pragma unroll
    for (int s = 0; s < 2; ++s) { const int c0 = ((s * 4 + hi * 2) * 16) ^ xn, c1 = ((s * 4 + hi * 2 + 1) * 16) ^ xn;
        a0[s] = *(const LAS bf16x8*)(kn + c0); a1[s] = *(const LAS bf16x8*)(kn + c1); b0[s] = *(const LAS bf16x8*)(kn + 32 * 128 + c0); b1[s] = *(const LAS bf16x8*)(kn + 32 * 128 + c1); }
    { const int c0 = ((hi * 2) * 16) ^ xr, c1 = ((hi * 2 + 1) * 16) ^ xr;
        a0[2] = *(const LAS bf16x8*)(kr + c0); a1[2] = *(const LAS bf16x8*)(kr + c1); b0[2] = *(const LAS bf16x8*)(kr + 32 * 64 + c0); b1[2] = *(const LAS bf16x8*)(kr + 32 * 64 + c1); }
    p0 = __builtin_amdgcn_mfma_scale_f32_32x32x64_f8f6f4(cat8(a0[0], a1[0]), qr[0], negm, 0, 0, 0, 0x7F7F7F7F, 0, 0x7C7C7C7C);
    p1 = __builtin_amdgcn_mfma_scale_f32_32x32x64_f8f6f4(cat8(b0[0], b1[0]), qr[0], negm, 0, 0, 0, 0x7F7F7F7F, 0, 0x7C7C7C7C);
#pragma unroll
    for (int s = 1; s < 3; ++s) {
        p0 = __builtin_amdgcn_mfma_scale_f32_32x32x64_f8f6f4(cat8(a0[s], a1[s]), qr[s], p0, 0, 0, 0, 0x7F7F7F7F, 0, 0x7C7C7C7C);
        p1 = __builtin_amdgcn_mfma_scale_f32_32x32x64_f8f6f4(cat8(b0[s], b1[s]), qr[s], p1, 0, 0, 0, 0x7F7F7F7F, 0, 0x7C7C7C7C); }
}
__device__ __forceinline__ void partialSM(f32x16& p0, f32x16& p1, f32x16& negm, float& alpha, const bool first) {
    float pmax = p0[0];
#pragma unroll
    for (int r = 1; r < 16; ++r) pmax = fmaxf(pmax, p0[r]);
#pragma unroll
    for (int r = 0; r < 16; ++r) pmax = fmaxf(pmax, p1[r]);
    { auto rr = __builtin_amdgcn_permlane32_swap(__float_as_uint(pmax), __float_as_uint(pmax), false, false);
      pmax = fmaxf(__uint_as_float(rr[0]), __uint_as_float(rr[1])); }
    if (__builtin_expect(!first && __all(pmax <= THR * LOG2E), 1)) { alpha = 1.f; }
    else { const float delta = first ? pmax : fmaxf(pmax, 0.f); alpha = first ? 1.f : __builtin_amdgcn_exp2f(-delta);
#pragma unroll
        for (int r = 0; r < 16; ++r) { p0[r] -= delta; p1[r] -= delta; negm[r] -= delta; } }
#pragma unroll
    for (int r = 0; r < 16; ++r) p0[r] = __builtin_amdgcn_exp2f(p0[r]);
}
__device__ __forceinline__ void finishSM(f32x16& p0, f32x16& p1, i32x8& p8) {
#pragma unroll
    for (int r = 0; r < 16; ++r) p1[r] = __builtin_amdgcn_exp2f(p1[r]);
#pragma unroll
    for (int j = 0; j < 4; ++j) { int w = p8[j]; w = __builtin_amdgcn_cvt_pk_fp8_f32(p0[4 * j], p0[4 * j + 1], w, false); w = __builtin_amdgcn_cvt_pk_fp8_f32(p0[4 * j + 2], p0[4 * j + 3], w, true); p8[j] = w;
        int x = p8[4 + j]; x = __builtin_amdgcn_cvt_pk_fp8_f32(p1[4 * j], p1[4 * j + 1], x, false); x = __builtin_amdgcn_cvt_pk_fp8_f32(p1[4 * j + 2], p1[4 * j + 3], x, true); p8[4 + j] = x; }
}
__device__ __forceinline__ void pv_all(f32x16* o, const LAS unsigned char* vs, int c0, int c1, const i32x8& p8) {
    bf16x8 a[4], b[4];
#pragma unroll
    for (int d0 = 0; d0 < 4; ++d0) { a[d0] = *(const LAS bf16x8*)(vs + d0 * 2048 + c0); b[d0] = *(const LAS bf16x8*)(vs + d0 * 2048 + c1); }
#pragma unroll
    for (int d0 = 0; d0 < 4; ++d0) o[d0] = __builtin_amdgcn_mfma_scale_f32_32x32x64_f8f6f4(p8, cat8(a[d0], b[d0]), o[d0], 0, 0, 0, 0x7F7F7F7F, 0, 0x7F7F7F7F);
    const i32x8 ones = {0x38383838, 0x38383838, 0x38383838, 0x38383838, 0x38383838, 0x38383838, 0x38383838, 0x38383838};
    o[4] = __builtin_amdgcn_mfma_scale_f32_32x32x64_f8f6f4(p8, ones, o[4], 0, 0, 0, 0x7F7F7F7F, 0, 0x7F7F7F7F);
}
#define MLA_BAR() asm volatile("s_waitcnt vmcnt(0) lgkmcnt(0)\n\ts_barrier" ::: "memory")
template <bool O8> __device__ __forceinline__ void unit(int b, int h, int qb, const unsigned char* __restrict__ Q8, const unsigned char* __restrict__ K8, const unsigned char* __restrict__ KR8, const unsigned char* __restrict__ VT, const float* __restrict__ stat, bf16_t* __restrict__ O, LAS unsigned char* lds, const int wv, const bool pre, const int nb, const int nh, const int nqb, i32x8 (&qr)[3]) {
    const int tid = opaque_tid(wv), wid = __builtin_amdgcn_readfirstlane(tid >> 6), lane = tid & 63, r32 = lane & 31, hi = lane >> 5;
    const size_t tok0 = (size_t)b * SEQ;
    const char* Kn = (const char*)(K8 + tok0 * 1024 + h * 128);
    const char* Kr = (const char*)(KR8 + tok0 * 64);
    const char* Vt = (const char*)(VT + (size_t)h * 128 * NTOK + tok0);
    LAS float* ws = (LAS float*)(lds + OFF_WS) + wid * 64; LAS float* al_l = ws + 32;
    const unsigned ldsb = (unsigned)(uintptr_t)lds;
    unsigned vkn, vkr, vv;
    { const int L = wid * 64 + lane, row = L >> 3, c16 = (L & 7) ^ ((row >> 1) & 7); vkn = (unsigned)(row * 1024 + c16 * 16); }
    { const int L = (wid & 3) * 64 + lane, row = L >> 2, c16 = (L & 3) ^ ((row >> 2) & 3); vkr = (unsigned)(row * 64 + c16 * 16); }
    { const int L = wid * 64 + lane, c = L >> 2, q = (L & 3) ^ ((c >> 2) & 3); vv = (unsigned)c * (unsigned)NTOK + (unsigned)(q * 16); }
#define MLA_ISSUE_AT(KnX, KrX, VtX, t, sl) do { const size_t ko_ = (size_t)(t) * KVBLK; const unsigned sb_ = ldsb + (unsigned)(sl) * SLOT; \
        glds16_s((KnX) + ko_ * 1024, vkn, sb_ + (unsigned)wid * 1024u); glds16_s((KrX) + ko_ * 64, vkr, sb_ + KN_B + (unsigned)(wid & 3) * 1024u); \
        glds16_s((VtX) + ko_, vv, sb_ + KN_B + KR_B + (unsigned)wid * 1024u); } while (0)
#define MLA_ISSUE(t, sl) MLA_ISSUE_AT(Kn, Kr, Vt, t, sl)
    if (!pre) { MLA_ISSUE(0, 0); MLA_ISSUE(1, 1); }
    f32x16 o[5] = {}; f32x16 negm = {};
    if (!pre) { const unsigned char* Qw = Q8 + (tok0 + (size_t)qb * 256 + wid * QBLK + r32) * NQ + h * QKD + hi * 32;
#pragma unroll
      for (int s = 0; s < 3; ++s) qr[s] = cat8(*(const bf16x8*)(Qw + s * 64), *(const bf16x8*)(Qw + s * 64 + 16)); }
    const int xv = ((r32 >> 2) & 3) << 4, vc0 = ((hi * 2) * 16) ^ xv, vc1 = ((hi * 2 + 1) * 16) ^ xv;
    const LAS unsigned char* vbase = lds + KN_B + KR_B + r32 * 64;
#define RESC(a) do { if (__any((a) < 1.f)) { if (hi == 0) al_l[r32] = (a); asm volatile("s_waitcnt lgkmcnt(0)" ::: "memory"); \
    _Pragma("unroll") for (int d = 0; d < 5; ++d) _Pragma("unroll") for (int r = 0; r < 16; ++r) o[d][r] *= al_l[crow(r, hi)]; } } while (0)
    f32x16 p0, p1; float al; i32x8 p8 = {}; constexpr int NT = SEQ / KVBLK;
    MLA_BAR();
#define MLA_BARC(j) asm volatile("s_cmp_lt_i32 %0, %1\n\ts_cbranch_scc1 .Lpb%=\n\ts_waitcnt vmcnt(0)\n\ts_branch .Lpe%=\n.Lpb%=:\n\ts_waitcnt vmcnt(3)\n.Lpe%=:\n\ts_waitcnt lgkmcnt(0)\n\ts_barrier" :: "s"(__builtin_amdgcn_readfirstlane((j) + 2)), "n"(SEQ / KVBLK) : "memory", "scc")
    const bool halfB = wid >= 4;
    if (halfB) { MLA_BARC(0); MLA_ISSUE(2, 2); }
    int sj = 0;
    for (int j = 0; j < NT; ++j) {
        const int s1 = sj == 2 ? 0 : sj + 1, s2 = s1 == 2 ? 0 : s1 + 1;
        qkt(p0, p1, negm, lds + sj * SLOT, qr, r32, hi);
        MLA_BARC(j);
        if (!halfB && j + 2 < NT) MLA_ISSUE(j + 2, s2);
        partialSM(p0, p1, negm, al, j == 0); RESC(al);
        finishSM(p0, p1, p8); SBAR();
        pv_all(o, vbase + sj * SLOT, vc0, vc1, p8);
        MLA_BARC(j);
        if (halfB && j + 3 < NT) MLA_ISSUE(j + 3, sj);
        sj = s1;
    }
    if (!halfB) MLA_BARC(NT);
#undef MLA_BARC
    float rli[16];
#pragma unroll
    for (int r = 0; r < 16; ++r) rli[r] = __builtin_amdgcn_rcpf(o[4][r]);
    MLA_BAR();
    if constexpr (O8) { if (nb >= 0) { const unsigned char* Qn = Q8 + ((size_t)nb * SEQ + (size_t)nqb * 256 + wid * QBLK + r32) * NQ + nh * QKD + hi * 32;
#pragma unroll
        for (int s = 0; s < 3; ++s) qr[s] = cat8(*(const bf16x8*)(Qn + s * 64), *(const bf16x8*)(Qn + s * 64 + 16)); } }
    if constexpr (O8) { if (nb >= 0) { const size_t tokn = (size_t)nb * SEQ; const char* KnN = (const char*)(K8 + tokn * 1024 + nh * 128); const char* KrN = (const char*)(KR8 + tokn * 64); const char* VtN = (const char*)(VT + (size_t)nh * 128 * NTOK + tokn);
        MLA_ISSUE_AT(KnN, KrN, VtN, 0, 0); MLA_ISSUE_AT(KnN, KrN, VtN, 1, 1); } }
    LAS unsigned char* ost = O8 ? lds + OFF_O8 + wid * (32 * 144) : lds + wid * (32 * OSTR);
    if constexpr (O8) {
#pragma unroll
        for (int r = 0; r < 16; ++r) { const int orow = crow(r, hi);
#pragma unroll
            for (int d0 = 0; d0 < 4; ++d0) *(LAS unsigned char*)(ost + orow * 144 + d0 * 32 + r32) = (unsigned char)fp8_1(o[d0][r] * rli[r] * O8_SCALE); }
        asm volatile("s_waitcnt lgkmcnt(0)" ::: "memory");
        unsigned char* Ow = (unsigned char*)O + (tok0 + (size_t)qb * 256 + wid * QBLK) * LDO + h * 128;
#pragma unroll
        for (int it = 0; it < 4; ++it) { const int ch = it * 64 + lane, row = ch >> 3, c16 = ch & 7;
            const u32x4 v = *(const LAS u32x4*)(ost + row * 144 + c16 * 16); *(u32x4*)(Ow + (size_t)row * LDO + c16 * 16) = v; }
    } else {
#pragma unroll
        for (int r = 0; r < 16; ++r) { const int orow = crow(r, hi);
#pragma unroll
            for (int d0 = 0; d0 < 4; ++d0) *(LAS unsigned short*)(ost + orow * OSTR + (d0 * 32 + r32) * 2) = (unsigned short)f2bf(o[d0][r] * rli[r]); }
        asm volatile("s_waitcnt lgkmcnt(0)" ::: "memory");
        bf16_t* Ow = O + (tok0 + (size_t)qb * 256 + wid * QBLK) * LDO + h * 128;
#pragma unroll
        for (int it = 0; it < 8; ++it) { const int ch = it * 64 + lane, row = ch >> 4, c16 = ch & 15;
            const u32x4 v = *(const LAS u32x4*)(ost + row * OSTR + c16 * 16); *(u32x4*)(Ow + (size_t)row * LDO + c16 * 8) = v; }
        MLA_BAR();
    }
#undef MLA_ISSUE_AT
#undef MLA_ISSUE
#undef RESC
}
#undef MLA_BAR
}

namespace swa {
constexpr int KT = 8192, SLOT = 16384, NSLOT = 6, NTILE_SEQ = SEQ / 64;
constexpr int OFF_O = NSLOT * SLOT  , OSTR = 144, OFF_WS = OFF_O + 8 * 32 * OSTR  , OFF_END = OFF_WS + 8 * 64 * 4;
static_assert(OFF_END <= RING_BYTES, "swa lds");
constexpr int LD = SWA_NQKV;
constexpr float C = 0.125f * LOG2E, THRL = 24.f;
template <bool O8> __device__ __forceinline__ void superunit(int b, int g, int qb0, int nqb, const bf16_t* __restrict__ QKV, const float* __restrict__ sink, bf16_t* __restrict__ O, LAS unsigned char* lds, const int wv) {
    const int tid = opaque_tid(wv), wid = __builtin_amdgcn_readfirstlane(tid >> 6), lane = tid & 63, r32 = lane & 31, hi = lane >> 5;
    const size_t tok0 = (size_t)b * SEQ; const unsigned ldsb = (unsigned)(uintptr_t)lds;
    const char* Kg = (const char*)(QKV + tok0 * LD + 1024 + g * 64); const char* Vg = (const char*)(QKV + tok0 * LD + 1280 + g * 64);
    unsigned vk, vv;
    { const int L = wid * 64 + lane; { const int row = L >> 3, c16 = (L & 7) ^ ((row >> 1) & 7); vk = (unsigned)(row * (LD * 2) + c16 * 16); }
      { const int st = L >> 5, w = L & 31, kk = (st >> 1) * 8 + (w >> 2), k = (kk & ~0xC) | ((kk & 4) << 1) | ((kk & 8) >> 1), c = (st & 1) * 32 + (w & 3) * 8; vv = (unsigned)(k * (LD * 2) + c * 2); } }
#define SWA_ISSUE(T) do { const size_t ko_ = (size_t)(T) * 64 * (LD * 2); const unsigned sb_ = ldsb + (unsigned)((T) % NSLOT) * SLOT + (unsigned)wid * 1024u; \
        glds16_s(Kg + ko_, vk, sb_); glds16_s(Vg + ko_, vv, sb_ + KT); } while (0)
    { const int t0 = qb0 - 2 < 0 ? 0 : qb0 - 2, t1 = qb0 + 2 > NTILE_SEQ - 1 ? NTILE_SEQ - 1 : qb0 + 2;
      for (int T = t0; T <= t1; ++T) SWA_ISSUE(T); }
    const int qh = g * 4 + (wid >> 1);
    const float slope2 = __builtin_amdgcn_exp2f(-0.5f * (float)(qh + 1)) * LOG2E;
    const float sink2 = sink[qh] * LOG2E, nslope2 = -slope2, rbf = (float)(4 * hi - (wid & 1) * 32 - r32);
    const bf16x8 ones8 = {0x3F80, 0x3F80, 0x3F80, 0x3F80, 0x3F80, 0x3F80, 0x3F80, 0x3F80};
    LAS float* al_l = (LAS float*)(lds + OFF_WS) + wid * 64; LAS float* li_l = al_l + 32;
    const int vrb = (int)ldsb + KT + v_rd_base(lane);
    const int xr = ((r32 >> 1) & 7) << 4;
    bf16x8 qr[4], qn[4];
    { const bf16_t* Qw = QKV + (tok0 + (size_t)(qb0 * 64 + (wid & 1) * 32 + r32)) * LD + qh * 64 + hi * 8;
#pragma unroll
      for (int d0 = 0; d0 < 4; ++d0) qr[d0] = *(const bf16x8*)(Qw + d0 * 16); }
    asm volatile("s_waitcnt vmcnt(0) lgkmcnt(0)\n\ts_barrier" ::: "memory");
    for (int qb = qb0; qb < qb0 + nqb; ++qb) {
        const bool more = qb + 1 < qb0 + nqb;
        if (more && qb + 3 < NTILE_SEQ) SWA_ISSUE(qb + 3);
        const int q0 = qb * 64, rowb = q0 + (wid & 1) * 32;
        if (more) { const bf16_t* Qw = QKV + (tok0 + (size_t)(rowb + 64 + r32)) * LD + qh * 64 + hi * 8;
#pragma unroll
            for (int d0 = 0; d0 < 4; ++d0) qn[d0] = *(const bf16x8*)(Qw + d0 * 16); }
        asm volatile("" ::: "memory");
        const int T0 = qb - 2 < 0 ? 0 : qb - 2, T1 = qb + 2 > NTILE_SEQ - 1 ? NTILE_SEQ - 1 : qb + 2;
        float rbq = rbf; asm volatile("" : "+v"(rbq));
        float m_reg = 0.f; f32x16 o[2] = {}, osum = {};
#define SWA_RAMP(p0, p1, A, S) do { const float s2_ = (S) + (S), s8_ = 8.f * (S), s32_ = 32.f * (S); \
            p0[0] = (A); p0[1] = (A) + (S); p0[2] = (A) + s2_; p0[3] = p0[1] + s2_; \
            _Pragma("unroll") for (int r = 4; r < 16; ++r) p0[r] = p0[r - 4] + s8_; \
            _Pragma("unroll") for (int r = 0; r < 16; ++r) p1[r] = p0[r] + s32_; } while (0)
        for (int T = T0; T <= T1; ++T) {
            const LAS unsigned char* Ks = lds + (T % NSLOT) * SLOT + r32 * 128; f32x16 p0, p1;
            { const int dt = T - qb; const float base = rbq + (float)(dt * 64);
              SWA_RAMP(p0, p1, base, 1.0f);
              if (dt == -2 || dt == 2) {
#pragma unroll
                  for (int r = 0; r < 16; ++r) { const float a0 = __builtin_fabsf(p0[r]), a1 = __builtin_fabsf(p1[r]);
                      p0[r] = a0 > 128.f ? -INFINITY : fmaf(nslope2, a0, -m_reg); p1[r] = a1 > 128.f ? -INFINITY : fmaf(nslope2, a1, -m_reg); } }
              else {
#pragma unroll
                  for (int r = 0; r < 16; ++r) { p0[r] = fmaf(nslope2, __builtin_fabsf(p0[r]), -m_reg); p1[r] = fmaf(nslope2, __builtin_fabsf(p1[r]), -m_reg); } } }
#pragma unroll
            for (int d0 = 0; d0 < 4; ++d0) { const int cb = ((d0 * 2 + hi) * 16) ^ xr;
                const bf16x8 b0 = *(const LAS bf16x8*)(Ks + cb), b1 = *(const LAS bf16x8*)(Ks + 32 * 128 + cb);
                p0 = __builtin_amdgcn_mfma_f32_32x32x16_bf16(b0, qr[d0], p0, 0, 0, 0);
                p1 = __builtin_amdgcn_mfma_f32_32x32x16_bf16(b1, qr[d0], p1, 0, 0, 0); }
            float pmax = p0[0];
#pragma unroll
            for (int r = 1; r < 16; ++r) pmax = fmaxf(pmax, p0[r]);
#pragma unroll
            for (int r = 0; r < 16; ++r) pmax = fmaxf(pmax, p1[r]);
            { auto rr = __builtin_amdgcn_permlane32_swap(__float_as_uint(pmax), __float_as_uint(pmax), false, false);
              pmax = fmaxf(__uint_as_float(rr[0]), __uint_as_float(rr[1])); }
            const bool first = (T == T0);
            if (__builtin_expect(!first && __all(pmax <= THRL), 1)) { }
            else { const float delta = first ? pmax : fmaxf(pmax, 0.f); m_reg += delta;
#pragma unroll
                for (int r = 0; r < 16; ++r) { p0[r] -= delta; p1[r] -= delta; }
                if (!first) { if (hi == 0) al_l[r32] = __builtin_amdgcn_exp2f(-delta); asm volatile("s_waitcnt lgkmcnt(0)" ::: "memory");
#pragma unroll
                    for (int r = 0; r < 16; ++r) { const float a = al_l[crow(r, hi)]; o[0][r] *= a; o[1][r] *= a; osum[r] *= a; } } }
#pragma unroll
            for (int r = 0; r < 16; ++r) { p0[r] = __builtin_amdgcn_exp2f(p0[r]); p1[r] = __builtin_amdgcn_exp2f(p1[r]); }
            bf16x8 pa0, pa1, pa2, pa3;
            PK4(p0, 0, pa0); PK4(p0, 8, pa1); PK4(p1, 0, pa2); PK4(p1, 8, pa3);
            const int vb = vrb + (T % NSLOT) * SLOT;
            pv_one<0, 2>(o[0], vb, pa0, pa1, pa2, pa3); pv_one<1, 2>(o[1], vb, pa0, pa1, pa2, pa3);
            osum = __builtin_amdgcn_mfma_f32_32x32x16_bf16(pa0, ones8, osum, 0, 0, 0); osum = __builtin_amdgcn_mfma_f32_32x32x16_bf16(pa1, ones8, osum, 0, 0, 0);
            osum = __builtin_amdgcn_mfma_f32_32x32x16_bf16(pa2, ones8, osum, 0, 0, 0); osum = __builtin_amdgcn_mfma_f32_32x32x16_bf16(pa3, ones8, osum, 0, 0, 0);
        }
#undef SWA_RAMP
        { const float e = __builtin_amdgcn_exp2f(sink2 - m_reg);
          if (hi == 0) li_l[r32] = e; asm volatile("s_waitcnt lgkmcnt(0)" ::: "memory"); }
        LAS unsigned char* ost = lds + OFF_O + wid * (32 * OSTR);
        if constexpr (O8) {
#pragma unroll
            for (int r = 0; r < 16; ++r) { const int orow = crow(r, hi); const float rl = __builtin_amdgcn_rcpf(osum[r] + li_l[orow]) * O8_SCALE;
#pragma unroll
                for (int d0 = 0; d0 < 2; ++d0) *(LAS unsigned char*)(ost + orow * 80 + d0 * 32 + r32) = (unsigned char)fp8_1(o[d0][r] * rl); }
            asm volatile("s_waitcnt lgkmcnt(0)" ::: "memory");
            unsigned char* Ow = (unsigned char*)O + (tok0 + (size_t)rowb) * DM + qh * 64;
#pragma unroll
            for (int it = 0; it < 2; ++it) { const int ch = it * 64 + lane, row = ch >> 2, c16 = ch & 3;
                const u32x4 v = *(const LAS u32x4*)(ost + row * 80 + c16 * 16); *(u32x4*)(Ow + (size_t)row * DM + c16 * 16) = v; }
            asm volatile("s_waitcnt vmcnt(2) lgkmcnt(0)\n\ts_barrier" ::: "memory");
        } else {
#pragma unroll
            for (int r = 0; r < 16; ++r) { const int orow = crow(r, hi); const float rl = __builtin_amdgcn_rcpf(osum[r] + li_l[orow]);
#pragma unroll
                for (int d0 = 0; d0 < 2; ++d0) *(LAS unsigned short*)(ost + orow * OSTR + (d0 * 32 + r32) * 2) = (unsigned short)f2bf(o[d0][r] * rl); }
            asm volatile("s_waitcnt lgkmcnt(0)" ::: "memory");
            bf16_t* Ow = O + (tok0 + (size_t)rowb) * DM + qh * 64;
#pragma unroll
            for (int it = 0; it < 4; ++it) { const int ch = it * 64 + lane, row = ch >> 3, c16 = ch & 7;
                const u32x4 v = *(const LAS u32x4*)(ost + row * OSTR + c16 * 16); *(u32x4*)(Ow + (size_t)row * DM + c16 * 8) = v; }
            asm volatile("s_waitcnt vmcnt(4) lgkmcnt(0)\n\ts_barrier" ::: "memory");
        }
#pragma unroll
        for (int d0 = 0; d0 < 4; ++d0) qr[d0] = qn[d0];
    }
    asm volatile("s_waitcnt vmcnt(0)" ::: "memory");
#undef SWA_ISSUE
}
}

constexpr int NWAVES = 8;
struct Args { const float* in[23]; float* out; unsigned char* ws; };
static_assert(sizeof(Args) == 25 * 8, "no padding");

template <int KIND> __device__ __forceinline__ int map_row(int n) {
    if (KIND == 0) return n;
    if (KIND == 1) return ((n >> 7) << 8) + (n & 127);
    if (KIND == 2) return ((n >> 7) << 8) + 128 + (n & 127);
    if (KIND == 3) { const int h = n / QKD; int d = n - h * QKD; if (d >= 128) { const int i = d - 128; d = 128 + (i < 32 ? 2 * i : 2 * (i - 32) + 1); } return h * QKD + d; }
    if (KIND == 4) { if (n >= 512) { const int i = n - 512; n = 512 + (i < 32 ? 2 * i : 2 * (i - 32) + 1); } return n; }
    return n;
}
template <int KIND, bool F8> __device__ __forceinline__ void transpose_any(const float* W, int K, int N, void* WTv, int row_off, LAS float* scr, int gw, int NGW, int lane, float scale, const float* gk) {
    const int nblk = N / 32, nitems = (K / 64) * nblk;
    f32x4 t[8];
#define TR_LOAD(item) do { const int kb_ = (item) / nblk, nb_ = (item) % nblk; _Pragma("unroll") for (int i = 0; i < 8; ++i) t[i] = *(const f32x4*)(W + (size_t)(64 * kb_ + (lane >> 3) + 8 * i) * N + 32 * nb_ + 4 * (lane & 7)); } while (0)
    int item = gw;
    if (item < nitems) TR_LOAD(item);
    for (; item < nitems; item += NGW) {
        const int kb = item / nblk, nb = item % nblk, k0 = 64 * kb, n0 = 32 * nb;
#pragma unroll
        for (int i = 0; i < 8; ++i) { const int kk = (lane >> 3) + 8 * i; f32x4 v = t[i]; if (F8) v = v * scale; if (gk) v = v * gk[k0 + kk];
            LAS float* d = scr + kk * 33 + 4 * (lane & 7); d[0] = v.x; d[1] = v.y; d[2] = v.z; d[3] = v.w; }
        if (item + NGW < nitems) TR_LOAD(item + NGW);
        LDS_WAIT(); asm volatile("" ::: "memory");
        const int c = lane & 7;
#pragma unroll
        for (int j = 0; j < 4; ++j) { const int n = (lane >> 3) + 8 * j; const LAS float* sp = scr + (8 * c) * 33 + n;
            if (F8) { const float o[8] = {sp[0 * 33], sp[1 * 33], sp[2 * 33], sp[3 * 33], sp[4 * 33], sp[5 * 33], sp[6 * 33], sp[7 * 33]};
                *(u32x2*)((unsigned char*)WTv + (size_t)(row_off + map_row<KIND>(n0 + n)) * K + k0 + 8 * c) = pk8_fp8(o); }
            else { u32x4 o; o.x = pk2(sp[0 * 33], sp[1 * 33]); o.y = pk2(sp[2 * 33], sp[3 * 33]); o.z = pk2(sp[4 * 33], sp[5 * 33]); o.w = pk2(sp[6 * 33], sp[7 * 33]);
                *(u32x4*)((bf16_t*)WTv + (size_t)(row_off + map_row<KIND>(n0 + n)) * K + k0 + 8 * c) = o; } }
        LDS_WAIT(); asm volatile("" ::: "memory");
    }
#undef TR_LOAD
}
template <int KIND> __device__ __forceinline__ void transpose_matrix(const float* W, int K, int N, bf16_t* WT, int row_off, LAS float* scr, int gw, int NGW, int lane, const float* gk = nullptr) {
    transpose_any<KIND, false>(W, K, N, WT, row_off, scr, gw, NGW, lane, 1.f, gk);
}
template <int KIND> __device__ __forceinline__ void transpose_matrix_f8(const float* W, int K, int N, unsigned char* WT, int row_off, LAS float* scr, int gw, int NGW, int lane, float scale, const float* gk = nullptr) {
    transpose_any<KIND, true>(W, K, N, WT, row_off, scr, gw, NGW, lane, scale, gk);
}
template <bool F8> __device__ __forceinline__ void rms_row_to_bf16(const float* xrow, const f32x4 (&gv)[4], bf16_t* orow, int lane) {
    const f32x4* xr = (const f32x4*)xrow + lane; f32x4 v[4]; float s = 0.f;
#pragma unroll
    for (int j = 0; j < 4; ++j) { v[j] = xr[64 * j]; s += (v[j].x * v[j].x + v[j].y * v[j].y) + (v[j].z * v[j].z + v[j].w * v[j].w); }
    const float rstd = 1.0f / sqrtf(wave_sum(s, lane) * (1.f / DM) + EPS);
    if (F8) { unsigned* o4 = (unsigned*)orow + lane;
#pragma unroll
        for (int j = 0; j < 4; ++j) { const f32x4 y = v[j] * rstd * gv[j]; int w = 0; w = __builtin_amdgcn_cvt_pk_fp8_f32(y.x, y.y, w, false); w = __builtin_amdgcn_cvt_pk_fp8_f32(y.z, y.w, w, true); o4[64 * j] = (unsigned)w; } }
    else { unsigned long long* o8 = (unsigned long long*)orow + lane;
#pragma unroll
    for (int j = 0; j < 4; ++j) { const f32x4 y = v[j] * rstd * gv[j]; o8[64 * j] = (unsigned long long)pk2(y.x, y.y) | ((unsigned long long)pk2(y.z, y.w) << 32); } }
}

#define PHASE_IDS const int tid = opaque_tid(bar.wv), lane = tid & 63, wave = __builtin_amdgcn_readfirstlane(tid >> 6), gw = vcu * NWAVES + wave; (void)gw; (void)lane
template <int j> __device__ __forceinline__ void pair_body(const Args& args, LAS unsigned char* lds, const XcdBarrier& bar, const int G, const int bx, const int vcu) {
    const int NGW = G * NWAVES;
    unsigned char* ws = args.ws;
    LAS int* moetab = (LAS int*)(lds + MOETAB_OFF);
    const float* x = args.in[0];
    int* route = (int*)(ws + WS_ROUTE); f32x2* gate = (f32x2*)(ws + WS_GATE); int* posb = (int*)(ws + WS_POS); int* cnt = (int*)(ws + WS_CNT);
    unsigned char* act = ws + WS_ACT;
    bf16_t* H = (bf16_t*)(act + A_H); bf16_t* XN = (bf16_t*)(act + A_XN); bf16_t* DOWN = (bf16_t*)(act + A_DOWN); bf16_t* QB = (bf16_t*)(act + A_Q);
    bf16_t* KVB = (bf16_t*)args.out;
    bf16_t* FACT = (bf16_t*)(act + A_FACT); bf16_t* SQKV = (bf16_t*)(act + A_SQKV); bf16_t* SO = (bf16_t*)(act + A_SO); bf16_t* XS = (bf16_t*)args.out; bf16_t* MACT = (bf16_t*)(act + A_MACT);
    float* STAT = (float*)(act + A_STAT); LAS float* PART = (LAS float*)(lds + PART_OFF);
    constexpr bool F8M = ((FP8_MOE >> j) & 1) != 0, F8F = ((FP8_FFN >> j) & 1) != 0, S8 = ((FP8_S2 >> j) & 1) != 0, Y8 = F8M && ((FP8_YS >> j) & 1) != 0;
    unsigned char* H8 = act + A_H8;
    bf16_t* YS = F8M ? (bf16_t*)(act + A_YS) : XS;
    constexpr bool FINAL_DIRECT = (j == 1) && F8M;
    {
        unsigned char* wb = ws + WS_W + (size_t)j * W_PAIR;
        if (PH(1)) { constexpr bool D8 = FP8_DOWN != 0; pg8::Gemm g{XN, (const bf16_t*)(wb + W_DQKV), D8 ? DM / 2 : DM, D8 ? DM / 2 : DM, D8 ? DM / 2 : DM}; pg8::DenseOrder S; S.init(NTOK, DOWNP, G, bx, 256);
          pg8::EpiDown<FP8_QK != 0, FP8_UP != 0> E{DOWN, STAT, PART, act + A_KR8, D8 ? 1.0f / W8_SCALE : 1.0f}; pg8::gemm_phase<pg8::EpiDown<FP8_QK != 0, FP8_UP != 0>, pg8::DenseOrder, true, D8>(lds, g, S, E, bar.wv); }
        xcd_barrier(bar);
        if (PH(3)) { constexpr bool U8 = FP8_UP != 0; constexpr int KU = U8 ? 128 : 256, LDD = U8 ? DOWNP / 2 : DOWNP; const float us = U8 ? 1.0f / W8_SCALE : 1.0f;
          const bf16_t* CQ = DOWN; const bf16_t* CKV = U8 ? (const bf16_t*)((const unsigned char*)DOWN + 256) : DOWN + 256;
          { pg8::Gemm g{CQ, (const bf16_t*)(wb + W_UQ), LDD, KU, KU}; pg8::DenseOrder S; S.init(NTOK, NQ, G, bx, 256);
            pg8::EpiQRope<FP8_QK != 0, FP8_PV != 0> E{QB, us, STAT, mla9::QPRE, (const LAS float*)(lds + STG_OFF)}; pg8::gemm_phase<pg8::EpiQRope<FP8_QK != 0, FP8_PV != 0>, pg8::DenseOrder, true, U8>(lds, g, S, E, bar.wv); }
          if constexpr (FP8_PV != 0) {
            { pg8::Gemm g{CKV, (const bf16_t*)(wb + W_UKV), LDD, KU, KU}; pg8::DenseOrder Sk; Sk.init(NTOK, 1024, G, bx, 256);
              pg8::EpiKV8 Ek{KVB, act + A_K8, STAT, us, (const LAS float*)(lds + STG_OFF)}; pg8::gemm_phase<pg8::EpiKV8, pg8::DenseOrder, true, U8>(lds, g, Sk, Ek, bar.wv); }
            { pg8::Gemm gv{U8 ? (const bf16_t*)(wb + W_UKV + (size_t)1024 * 256) : (const bf16_t*)(wb + W_UKV) + (size_t)1024 * 256, CKV, KU, LDD, KU}; pg8::DenseOrder Sv; Sv.init(1024, NTOK, G, bx, 256);
              pg8::EpiVT8 Ev{(unsigned char*)args.out, STAT, us, (const LAS float*)(lds + STG_OFF)}; pg8::gemm_phase<pg8::EpiVT8, pg8::DenseOrder, true, U8>(lds, gv, Sv, Ev, bar.wv); } }
          else { pg8::Gemm g{CKV, (const bf16_t*)(wb + W_UKV), LDD, KU, KU}; pg8::DenseOrder S; S.init(NTOK, NKV, G, bx, 256);
            if constexpr (FP8_QK != 0) { pg8::EpiKV8 E{KVB, act + A_K8, STAT, us, (const LAS float*)(lds + STG_OFF)}; pg8::gemm_phase<pg8::EpiKV8, pg8::DenseOrder, true, U8>(lds, g, S, E, bar.wv); }
            else { pg8::EpiBf16<false, 1> E{KVB, NKV, STAT, 1, 1.f / 256.f, 1.f}; pg8::gemm_phase<pg8::EpiBf16<false, 1>, pg8::DenseOrder, true>(lds, g, S, E, bar.wv); } } }
        xcd_barrier(bar);
        if (PH(4)) { const int NU = BATCH * MLA_H * (SEQ / 256);
          i32x8 mqr[3] = {};
          for (int u = vcu; u < NU; u += G) { const int bh = u >> 3, qb = u & 7;
              if constexpr (FP8_PV != 0) { const int un = u + G, nbh = un >> 3; mla9::unit<FP8_ATTO != 0>(bh >> 3, bh & 7, qb, (const unsigned char*)QB, act + A_K8, act + A_KR8, (const unsigned char*)args.out, STAT, XN, lds, bar.wv, (FP8_ATTO != 0) && u != vcu, un < NU ? (nbh >> 3) : -1, nbh & 7, un & 7, mqr); }
              else if constexpr (FP8_QK != 0) mla8::unit<FP8_ATTO != 0>(bh >> 3, bh & 7, qb, (const unsigned char*)QB, act + A_K8, act + A_KR8, KVB, STAT, XN, lds, bar.wv);
              else mla::unit<FP8_ATTO != 0>(bh >> 3, bh & 7, qb, QB, KVB, DOWN, STAT, XN, lds, bar.wv); } }
        xcd_barrier(bar);
        if (PH(5)) { constexpr bool F8 = FP8_ATTO != 0; pg8::Gemm g{XN, (const bf16_t*)(wb + W_MO), F8 ? DM / 2 : DM, F8 ? DM / 2 : DM, F8 ? DM / 2 : DM}; pg8::DenseOrder S; S.init(NTOK, DM, G, bx, 256);
          pg8::EpiResid<j == 0, F8F> E{j == 0 ? (const void*)x : (const void*)H, H, STAT, PART, F8 ? RESID_SCALE / (W8_SCALE * O8_SCALE) : RESID_SCALE, H8}; pg8::gemm_phase<pg8::EpiResid<j == 0, F8F>, pg8::DenseOrder, true, F8>(lds, g, S, E, bar.wv); }
        xcd_barrier(bar);
        if (PH(7)) {
          if constexpr (F8F) { pg8::Gemm g{(const bf16_t*)H8, (const bf16_t*)(wb + W_FGU), DM / 2, DM / 2, DM / 2}; pg8::DenseOrder S; S.init(NTOK, 2 * FFN, G, bx, 128);
            pg8::EpiSwiGLU<false, 4, true> E{FACT, FFN, STAT, 1.f / 1024.f, 1.0f / W8_SCALE, (const LAS float*)(lds + STG_OFF)}; pg8::gemm_phase<pg8::EpiSwiGLU<false, 4, true>, pg8::DenseOrder, true, true>(lds, g, S, E, bar.wv); }
          else { pg8::Gemm g{H, (const bf16_t*)(wb + W_FGU), DM, DM, DM}; pg8::DenseOrder S; S.init(NTOK, 2 * FFN, G, bx, 128);
            pg8::EpiSwiGLU<false, 4> E{FACT, FFN, STAT, 1.f / 1024.f, 1.f, (const LAS float*)(lds + STG_OFF)}; pg8::gemm_phase<pg8::EpiSwiGLU<false, 4>, pg8::DenseOrder, true>(lds, g, S, E, bar.wv); } }
        xcd_barrier(bar);
        if (PH(8)) {
          if constexpr (F8F) { pg8::Gemm g{FACT, (const bf16_t*)(wb + W_FD), FFN / 2, FFN / 2, FFN / 2}; pg8::DenseOrder S; S.init(NTOK, DM, G, bx, 256);
            pg8::EpiResid<false, S8> E{H, H, STAT, PART, RESID_SCALE / W8_SCALE, H8}; pg8::gemm_phase<pg8::EpiResid<false, S8>, pg8::DenseOrder, true, true>(lds, g, S, E, bar.wv); }
          else { pg8::Gemm g{FACT, (const bf16_t*)(wb + W_FD), FFN, FFN, FFN}; pg8::DenseOrder S; S.init(NTOK, DM, G, bx, 256);
            pg8::EpiResid<false, S8> E{H, H, STAT, PART, RESID_SCALE, H8}; pg8::gemm_phase<pg8::EpiResid<false, S8>, pg8::DenseOrder, true>(lds, g, S, E, bar.wv); } }
        xcd_barrier(bar);
        if (PH(10)) { pg8::Gemm g{S8 ? (const bf16_t*)H8 : H, (const bf16_t*)(wb + W_SQKV), S8 ? DM / 2 : DM, S8 ? DM / 2 : DM, S8 ? DM / 2 : DM}; pg8::DenseOrder S; S.init(NTOK, SWA_NQKV, G, bx, 256);
          pg8::EpiBf16<false, 4> E{SQKV, SWA_NQKV, STAT, 0, 1.f / 1024.f, S8 ? 1.0f / W8_SCALE : 1.f, 1024, swa::C, (const LAS float*)(lds + STG_OFF)}; pg8::gemm_phase<pg8::EpiBf16<false, 4>, pg8::DenseOrder, true, S8>(lds, g, S, E, bar.wv); }
        xcd_barrier(bar);
        if (PH(11)) { constexpr int NQB = 16, NSU = BATCH * 4 * (SEQ / 64 / NQB);
          for (int su = vcu; su < NSU; su += G) { const int bg = su >> 1, qb0 = (su & 1) * NQB; swa::superunit<FP8_ATTO != 0>(bg >> 2, bg & 3, qb0, NQB, SQKV, args.in[11] + j * 16, SO, lds, bar.wv); } }
        xcd_barrier(bar);
        if (PH(12)) { constexpr bool F8 = FP8_ATTO != 0; pg8::Gemm g{SO, (const bf16_t*)(wb + W_SO), F8 ? DM / 2 : DM, F8 ? DM / 2 : DM, F8 ? DM / 2 : DM}; pg8::DenseOrder S; S.init(NTOK, DM, G, bx, 256);
          pg8::EpiResid<false> E{H, H, STAT, PART, F8 ? RESID_SCALE / (W8_SCALE * O8_SCALE) : RESID_SCALE, nullptr}; pg8::gemm_phase<pg8::EpiResid<false>, pg8::DenseOrder, true, F8>(lds, g, S, E, bar.wv); }
        xcd_barrier(bar);
        if (PH(13)) { PHASE_IDS; constexpr int WSTR = 1032;
          LAS bf16_t* wsp = (LAS bf16_t*)lds;
          LAS int* lcnt = (LAS int*)(lds + 65536);
          const float* router = args.in[18] + (size_t)j * DM * NE; const float* mg = args.in[17] + j * DM;
          for (int i = tid; i < DM * NE; i += NWAVES * 64) { const int e = i & 7, k = i >> 3; const float w = router[i] * mg[k];
              const unsigned w1 = f2bf(w); const float r1 = w - __uint_as_float(w1 << 16); const unsigned w2 = f2bf(r1); const float r2 = r1 - __uint_as_float(w2 << 16); const unsigned w3 = f2bf(r2);
              wsp[(0 * 8 + e) * WSTR + k] = (bf16_t)w1; wsp[(1 * 8 + e) * WSTR + k] = (bf16_t)w2; wsp[(2 * 8 + e) * WSTR + k] = (bf16_t)w3; }
          __syncthreads();
          const int n16 = lane & 15, kg = lane >> 4;
          const LAS bf16_t* wl = wsp + (n16 & 7) * WSTR + 8 * kg;
          for (int ck = vcu; ck < NTOK / 256; ck += G) {
              if (tid < 8) lcnt[tid] = 0;
              __syncthreads();
              const int tokb = ck * 256 + wave * 32;
              const bf16_t* h0 = H + (size_t)(tokb + n16) * DM + 8 * kg; const bf16_t* h1 = h0 + (size_t)16 * DM;
              f32x4 acc0 = {0.f, 0.f, 0.f, 0.f}, acc1 = {0.f, 0.f, 0.f, 0.f};
              bf16x8 ha[8], hb[8], na[8], nb[8];
#pragma unroll
              for (int i = 0; i < 8; ++i) { na[i] = *(const bf16x8*)(h0 + i * 32); nb[i] = *(const bf16x8*)(h1 + i * 32); }
              const f32x4 st0 = *(const f32x4*)(STAT + (size_t)(tokb + n16) * 4), st1 = *(const f32x4*)(STAT + (size_t)(tokb + 16 + n16) * 4);
              for (int g8 = 0; g8 < 4; ++g8) {
#pragma unroll
                  for (int i = 0; i < 8; ++i) { ha[i] = na[i]; hb[i] = nb[i]; }
                  if (g8 < 3) {
#pragma unroll
                      for (int i = 0; i < 8; ++i) { na[i] = *(const bf16x8*)(h0 + ((g8 + 1) * 8 + i) * 32); nb[i] = *(const bf16x8*)(h1 + ((g8 + 1) * 8 + i) * 32); } }
#pragma unroll
                  for (int i = 0; i < 8; ++i) { const int kk = g8 * 8 + i;
#pragma unroll
                      for (int sp = 0; sp < 3; ++sp) { const bf16x8 wf = *(const LAS bf16x8*)(wl + sp * 8 * WSTR + kk * 32);
                          acc0 = __builtin_amdgcn_mfma_f32_16x16x32_bf16(wf, ha[i], acc0, 0, 0, 0); acc1 = __builtin_amdgcn_mfma_f32_16x16x32_bf16(wf, hb[i], acc1, 0, 0, 0); } } }
#pragma unroll
              for (int bt = 0; bt < 2; ++bt) { const f32x4 ac = bt ? acc1 : acc0; const f32x4 st4 = bt ? st1 : st0; const int tok = tokb + bt * 16 + n16;
                  const float rstd = 1.0f / sqrtf(((st4.x + st4.y) + (st4.z + st4.w)) * (1.f / DM) + EPS);
                  float lg[8];
#pragma unroll
                  for (int q4 = 0; q4 < 4; ++q4) { auto rr = __builtin_amdgcn_permlane16_swap(__float_as_uint(ac[q4]), __float_as_uint(ac[q4]), false, false);
                      lg[q4] = __uint_as_float(rr[0]) * rstd; lg[4 + q4] = __uint_as_float(rr[1]) * rstd; }
                  int i0 = 0; float v0 = lg[0];
#pragma unroll
                  for (int e = 1; e < 8; ++e) if (lg[e] > v0) { v0 = lg[e]; i0 = e; }
                  int i1 = -1; float v1 = -INFINITY;
#pragma unroll
                  for (int e = 0; e < 8; ++e) if (e != i0 && lg[e] > v1) { v1 = lg[e]; i1 = e; }
                  const float g0 = 1.0f / (1.0f + __expf(v1 - v0));
                  if (lane < 16) { route[tok] = i0 | (i1 << 8); gate[tok] = (f32x2){g0, 1.0f - g0}; __hip_atomic_fetch_add(lcnt + i0, 1, __ATOMIC_RELAXED, __HIP_MEMORY_SCOPE_WORKGROUP); __hip_atomic_fetch_add(lcnt + i1, 1, __ATOMIC_RELAXED, __HIP_MEMORY_SCOPE_WORKGROUP); } }
              __syncthreads();
              if (tid < 8) cnt[ck * 8 + tid] = lcnt[tid];
              __syncthreads();
          } }
        xcd_barrier(bar);
        if (PH(14)) { PHASE_IDS; LAS int* red = (LAS int*)lds;
          LAS int* tp = (LAS int*)(lds + 1024);
          LAS int* wcn = (LAS int*)(lds + 2048);
          LAS int* lpos = (LAS int*)(lds + 4096);
          f32x4 gv[4];
#pragma unroll
          for (int k = 0; k < 4; ++k) gv[k] = ((const f32x4*)(args.in[17] + j * DM))[F8M ? 4 * lane + k : lane + 64 * k];
          int v[8];
          if (tid < 256) { const i32x4 c0 = ((const i32x4*)cnt)[tid * 2], c1 = ((const i32x4*)cnt)[tid * 2 + 1]; v[0] = c0.x; v[1] = c0.y; v[2] = c0.z; v[3] = c0.w; v[4] = c1.x; v[5] = c1.y; v[6] = c1.z; v[7] = c1.w; }
          else {
#pragma unroll
              for (int e = 0; e < 8; ++e) v[e] = 0; }
#pragma unroll
          for (int e = 0; e < 8; ++e) { int tot = v[e];
#pragma unroll
              for (int o = 1; o < 64; o <<= 1) tot += shxi(tot, o, lane);
              if (lane == 0) red[wave * 16 + e] = tot; }
          __syncthreads();
          if (tid < 8) { int sm = 0;
#pragma unroll
              for (int w = 0; w < 8; ++w) sm += red[w * 16 + tid];
              tp[tid] = sm; }
          __syncthreads();
          if (tid == 0) { int rs = 0, ts = 0;
              for (int e = 0; e < 8; ++e) { moetab[e] = ts; moetab[16 + e] = rs; rs += tp[e]; ts += (tp[e] + 255) >> 8; }
              moetab[8] = ts; moetab[24] = rs; }
          __syncthreads();
          for (int ck = vcu; ck < NTOK / 256; ck += G) {
#pragma unroll
              for (int e = 0; e < 8; ++e) { int pre = (tid < ck) ? v[e] : 0;
#pragma unroll
                  for (int o = 1; o < 64; o <<= 1) pre += shxi(pre, o, lane);
                  if (lane == 0) red[wave * 16 + 8 + e] = pre; }
              __syncthreads();
              if (tid < 8) { int sm = 0;
#pragma unroll
                  for (int w = 0; w < 8; ++w) sm += red[w * 16 + 8 + tid];
                  tp[8 + tid] = sm; }
              int e0 = 0, e1 = 0, r0 = 0, r1 = 0;
              if (tid < 256) { const int re = route[ck * 256 + tid]; e0 = re & 255; e1 = re >> 8; }
#pragma unroll
              for (int e = 0; e < 8; ++e) { const bool f = (tid < 256) && (e0 == e || e1 == e); const unsigned long long mk = __ballot(f);
                  const int rk = __popcll(mk & ((1ull << lane) - 1ull));
                  if (e0 == e) r0 = rk; if (e1 == e) r1 = rk;
                  if (lane == 0 && wave < 4) wcn[wave * 8 + e] = __popcll(mk); }
              __syncthreads();
              if (tid < 256) { int p0 = moetab[16 + e0] + tp[8 + e0] + r0, p1 = moetab[16 + e1] + tp[8 + e1] + r1;
                  for (int w = 0; w < wave; ++w) { p0 += wcn[w * 8 + e0]; p1 += wcn[w * 8 + e1]; }
                  lpos[tid * 2] = p0; lpos[tid * 2 + 1] = p1; posb[(size_t)(ck * 256 + tid) * 2] = p0; posb[(size_t)(ck * 256 + tid) * 2 + 1] = p1; }
              __syncthreads();
              { const int tb = wave * 32, tokb = ck * 256 + tb;
                u32x2 nx[2][4]; f32x4 nst[2];
#pragma unroll
                for (int q = 0; q < 2; ++q) { const u32x2* hr = (const u32x2*)(H + (size_t)(tokb + q) * DM) + (F8M ? 4 * lane : lane);
#pragma unroll
                    for (int k = 0; k < 4; ++k) nx[q][k] = hr[F8M ? k : 64 * k];
                    nst[q] = *(const f32x4*)(STAT + (size_t)(tokb + q) * 4); }
                for (int r = 0; r < 32; r += 2) {
                  u32x2 cu[2][4]; f32x4 cst[2];
#pragma unroll
                  for (int q = 0; q < 2; ++q) { cst[q] = nst[q];
#pragma unroll
                      for (int k = 0; k < 4; ++k) cu[q][k] = nx[q][k]; }
                  if (r + 2 < 32) {
#pragma unroll
                      for (int q = 0; q < 2; ++q) { const u32x2* hr = (const u32x2*)(H + (size_t)(tokb + r + 2 + q) * DM) + (F8M ? 4 * lane : lane);
#pragma unroll
                          for (int k = 0; k < 4; ++k) nx[q][k] = hr[F8M ? k : 64 * k];
                          nst[q] = *(const f32x4*)(STAT + (size_t)(tokb + r + 2 + q) * 4); } }
#pragma unroll
                  for (int q = 0; q < 2; ++q) { const int t = tb + r + q; const int p0 = lpos[t * 2], p1 = lpos[t * 2 + 1];
                      const f32x4 st4 = cst[q];
                      const float rstd = 1.0f / sqrtf(((st4.x + st4.y) + (st4.z + st4.w)) * (1.f / DM) + EPS);
                      if (F8M) { unsigned pk[4];
#pragma unroll
                          for (int k = 0; k < 4; ++k) { const u32x2 w = cu[q][k]; const f32x4 y = (f32x4){bf_lo(w.x), bf_hi(w.x), bf_lo(w.y), bf_hi(w.y)} * rstd * gv[k];
                              int ow = 0; ow = __builtin_amdgcn_cvt_pk_fp8_f32(y.x, y.y, ow, false); ow = __builtin_amdgcn_cvt_pk_fp8_f32(y.z, y.w, ow, true); pk[k] = (unsigned)ow; }
                          const u32x4 pw = {pk[0], pk[1], pk[2], pk[3]};
                          *((u32x4*)((unsigned char*)XS + (size_t)p0 * DM) + lane) = pw; *((u32x4*)((unsigned char*)XS + (size_t)p1 * DM) + lane) = pw; }
                      else { u32x2* o0 = (u32x2*)(XS + (size_t)p0 * DM) + lane; u32x2* o1 = (u32x2*)(XS + (size_t)p1 * DM) + lane;
#pragma unroll
                          for (int k = 0; k < 4; ++k) { const u32x2 w = cu[q][k]; const f32x4 y = (f32x4){bf_lo(w.x), bf_hi(w.x), bf_lo(w.y), bf_hi(w.y)} * rstd * gv[k];
                              u32x2 ow; ow.x = pk2(y.x, y.y); ow.y = pk2(y.z, y.w); o0[64 * k] = ow; o1[64 * k] = ow; } } }
                } }
              __syncthreads();
          } }
        xcd_barrier(bar);
        if (PH(15)) {
          if constexpr (F8M) { pg8::Gemm g{XS, (const bf16_t*)(wb + W_MGU), DM / 2, DM / 2, DM / 2}; pg8::GroupedOrder S; S.init(moetab, 2 * ED, G, bx, 128);
            pg8::EpiSwiGLU<true, 0, true> E{MACT, ED, nullptr, 0.f, 1.0f / W8_SCALE}; pg8::gemm_phase<pg8::EpiSwiGLU<true, 0, true>, pg8::GroupedOrder, true, true>(lds, g, S, E, bar.wv); }
          else { pg8::Gemm g{XS, (const bf16_t*)(wb + W_MGU), DM, DM, DM}; pg8::GroupedOrder S; S.init(moetab, 2 * ED, G, bx, 128);
            pg8::EpiSwiGLU<true, 0> E{MACT, ED, nullptr, 0.f, 1.f}; pg8::gemm_phase<pg8::EpiSwiGLU<true, 0>, pg8::GroupedOrder, true>(lds, g, S, E, bar.wv); } }
        xcd_barrier(bar);
        if (PH(16)) {
          if constexpr (F8M) { pg8::Gemm g{MACT, (const bf16_t*)(wb + W_MD), ED / 2, ED / 2, ED / 2}; pg8::GroupedOrder S; S.init(moetab, DM, G, bx, 256);
            if constexpr (Y8) { pg8::EpiF8<true> E{(unsigned char*)YS, DM, YS8_SCALE / W8_SCALE}; pg8::gemm_phase<pg8::EpiF8<true>, pg8::GroupedOrder, true, true>(lds, g, S, E, bar.wv); }
            else { pg8::EpiBf16<true, 0> E{YS, DM, nullptr, 0, 0.f, 1.0f / W8_SCALE}; pg8::gemm_phase<pg8::EpiBf16<true, 0>, pg8::GroupedOrder, true, true>(lds, g, S, E, bar.wv); } }
          else { pg8::Gemm g{MACT, (const bf16_t*)(wb + W_MD), ED, ED, ED}; pg8::GroupedOrder S; S.init(moetab, DM, G, bx, 256);
            pg8::EpiBf16<true, 0> E{XS, DM, nullptr, 0, 0.f, 1.f}; pg8::gemm_phase<pg8::EpiBf16<true, 0>, pg8::GroupedOrder, true>(lds, g, S, E, bar.wv); } }
        xcd_barrier(bar);
        if (PH(17)) { PHASE_IDS;
          f32x4 gv[4];
#pragma unroll
          for (int k = 0; k < 4; ++k) gv[k] = ((const f32x4*)(j == 0 ? args.in[1] + DM : args.in[22]))[lane + 64 * k];
          if constexpr (Y8) {
            int qa0 = 0, qa1 = 0, qb0 = 0, qb1 = 0; f32x2 ga = {0.f, 0.f}, gb = {0.f, 0.f};
            u32x2 nh[4]; unsigned na[4], nb2[4];
            int m = gw;
            if (m < NTOK) { qa0 = posb[(size_t)m * 2]; qa1 = posb[(size_t)m * 2 + 1]; ga = gate[m]; }
            if (m + NGW < NTOK) { qb0 = posb[(size_t)(m + NGW) * 2]; qb1 = posb[(size_t)(m + NGW) * 2 + 1]; gb = gate[m + NGW]; }
            if (m < NTOK) { const u32x2* hq = (const u32x2*)(H + (size_t)m * DM) + lane; const unsigned* y0 = (const unsigned*)((const unsigned char*)YS + (size_t)qa0 * DM) + lane; const unsigned* y1 = (const unsigned*)((const unsigned char*)YS + (size_t)qa1 * DM) + lane;
#pragma unroll
                for (int k = 0; k < 4; ++k) { nh[k] = hq[64 * k]; na[k] = y0[64 * k]; nb2[k] = y1[64 * k]; } }
            for (; m < NTOK; m += NGW) {
              const f32x2 gg = ga * (RESID_SCALE / YS8_SCALE);
              u32x2 ch[4]; unsigned ca[4], cb[4];
#pragma unroll
              for (int k = 0; k < 4; ++k) { ch[k] = nh[k]; ca[k] = na[k]; cb[k] = nb2[k]; }
              qa0 = qb0; qa1 = qb1; ga = gb;
              if (m + NGW < NTOK) { const u32x2* hq = (const u32x2*)(H + (size_t)(m + NGW) * DM) + lane; const unsigned* y0 = (const unsigned*)((const unsigned char*)YS + (size_t)qa0 * DM) + lane; const unsigned* y1 = (const unsigned*)((const unsigned char*)YS + (size_t)qa1 * DM) + lane;
#pragma unroll
                  for (int k = 0; k < 4; ++k) { nh[k] = hq[64 * k]; na[k] = y0[64 * k]; nb2[k] = y1[64 * k]; } }
              if (m + 2 * NGW < NTOK) { qb0 = posb[(size_t)(m + 2 * NGW) * 2]; qb1 = posb[(size_t)(m + 2 * NGW) * 2 + 1]; gb = gate[m + 2 * NGW]; }
              u32x2* hr = (u32x2*)(H + (size_t)m * DM) + lane;
              f32x4 v[4]; float ss = 0.f;
#pragma unroll
              for (int k = 0; k < 4; ++k) { const unsigned a = ca[k], b = cb[k]; const u32x2 hw = ch[k]; f32x4 hv = (f32x4){bf_lo(hw.x), bf_hi(hw.x), bf_lo(hw.y), bf_hi(hw.y)};
                  const auto al = __builtin_amdgcn_cvt_pk_f32_fp8((int)a, false), ah = __builtin_amdgcn_cvt_pk_f32_fp8((int)a, true), bl = __builtin_amdgcn_cvt_pk_f32_fp8((int)b, false), bh = __builtin_amdgcn_cvt_pk_f32_fp8((int)b, true);
                  hv.x += gg.x * al[0] + gg.y * bl[0]; hv.y += gg.x * al[1] + gg.y * bl[1]; hv.z += gg.x * ah[0] + gg.y * bh[0]; hv.w += gg.x * ah[1] + gg.y * bh[1];
                  v[k] = hv; ss += (hv.x * hv.x + hv.y * hv.y) + (hv.z * hv.z + hv.w * hv.w); }
              if (!FINAL_DIRECT) {
#pragma unroll
                  for (int k = 0; k < 4; ++k) { u32x2 ow; ow.x = pk2(v[k].x, v[k].y); ow.y = pk2(v[k].z, v[k].w); hr[64 * k] = ow; } }
              if (j == 0 || FINAL_DIRECT) { const float rstd = 1.0f / sqrtf(wave_sum(ss, lane) * (1.f / DM) + EPS);
                  if (j == 0) { if (FP8_DOWN) { unsigned* o4 = (unsigned*)((unsigned char*)XN + (size_t)m * DM) + lane;
#pragma unroll
                      for (int k = 0; k < 4; ++k) { const f32x4 y = v[k] * rstd * gv[k]; int w = 0; w = __builtin_amdgcn_cvt_pk_fp8_f32(y.x, y.y, w, false); w = __builtin_amdgcn_cvt_pk_fp8_f32(y.z, y.w, w, true); o4[64 * k] = (unsigned)w; } }
                    else { u32x2* o8 = (u32x2*)(XN + (size_t)m * DM) + lane;
#pragma unroll
                      for (int k = 0; k < 4; ++k) { const f32x4 y = v[k] * rstd * gv[k]; u32x2 ow; ow.x = pk2(y.x, y.y); ow.y = pk2(y.z, y.w); o8[64 * k] = ow; } } }
                  else { f32x4* o = (f32x4*)(args.out + (size_t)m * DM) + lane;
#pragma unroll
                      for (int k = 0; k < 4; ++k) o[64 * k] = v[k] * rstd * gv[k]; } }
            }
          } else
          for (int m = gw; m < NTOK; m += NGW) {
              const int p0 = posb[(size_t)m * 2], p1 = posb[(size_t)m * 2 + 1]; const f32x2 gg = gate[m] * (Y8 ? RESID_SCALE / YS8_SCALE : RESID_SCALE);
              u32x2* hr = (u32x2*)(H + (size_t)m * DM) + lane;
              f32x4 v[4]; float ss = 0.f;
              if constexpr (Y8) { const unsigned* y0 = (const unsigned*)((const unsigned char*)YS + (size_t)p0 * DM) + lane; const unsigned* y1 = (const unsigned*)((const unsigned char*)YS + (size_t)p1 * DM) + lane;
#pragma unroll
                for (int k = 0; k < 4; ++k) { const unsigned a = y0[64 * k], b = y1[64 * k]; const u32x2 hw = hr[64 * k]; f32x4 hv = (f32x4){bf_lo(hw.x), bf_hi(hw.x), bf_lo(hw.y), bf_hi(hw.y)};
                  const auto al = __builtin_amdgcn_cvt_pk_f32_fp8((int)a, false), ah = __builtin_amdgcn_cvt_pk_f32_fp8((int)a, true), bl = __builtin_amdgcn_cvt_pk_f32_fp8((int)b, false), bh = __builtin_amdgcn_cvt_pk_f32_fp8((int)b, true);
                  hv.x += gg.x * al[0] + gg.y * bl[0]; hv.y += gg.x * al[1] + gg.y * bl[1]; hv.z += gg.x * ah[0] + gg.y * bh[0]; hv.w += gg.x * ah[1] + gg.y * bh[1];
                  v[k] = hv; ss += (hv.x * hv.x + hv.y * hv.y) + (hv.z * hv.z + hv.w * hv.w); } }
              else { const u32x2* y0 = (const u32x2*)(YS + (size_t)p0 * DM) + lane; const u32x2* y1 = (const u32x2*)(YS + (size_t)p1 * DM) + lane;
#pragma unroll
              for (int k = 0; k < 4; ++k) { const u32x2 a = y0[64 * k], b = y1[64 * k], hw = hr[64 * k]; f32x4 hv = (f32x4){bf_lo(hw.x), bf_hi(hw.x), bf_lo(hw.y), bf_hi(hw.y)};
                  hv.x += gg.x * bf_lo(a.x) + gg.y * bf_lo(b.x); hv.y += gg.x * bf_hi(a.x) + gg.y * bf_hi(b.x);
                  hv.z += gg.x * bf_lo(a.y) + gg.y * bf_lo(b.y); hv.w += gg.x * bf_hi(a.y) + gg.y * bf_hi(b.y);
                  v[k] = hv; ss += (hv.x * hv.x + hv.y * hv.y) + (hv.z * hv.z + hv.w * hv.w); } }
              if (!FINAL_DIRECT) {
#pragma unroll
                  for (int k = 0; k < 4; ++k) { u32x2 ow; ow.x = pk2(v[k].x, v[k].y); ow.y = pk2(v[k].z, v[k].w); hr[64 * k] = ow; } }
              if (j == 0 || FINAL_DIRECT) { const float rstd = 1.0f / sqrtf(wave_sum(ss, lane) * (1.f / DM) + EPS);
                  if (j == 0) { if (FP8_DOWN) { unsigned* o4 = (unsigned*)((unsigned char*)XN + (size_t)m * DM) + lane;
#pragma unroll
                      for (int k = 0; k < 4; ++k) { const f32x4 y = v[k] * rstd * gv[k]; int w = 0; w = __builtin_amdgcn_cvt_pk_fp8_f32(y.x, y.y, w, false); w = __builtin_amdgcn_cvt_pk_fp8_f32(y.z, y.w, w, true); o4[64 * k] = (unsigned)w; } }
                    else { u32x2* o8 = (u32x2*)(XN + (size_t)m * DM) + lane;
#pragma unroll
                      for (int k = 0; k < 4; ++k) { const f32x4 y = v[k] * rstd * gv[k]; u32x2 ow; ow.x = pk2(y.x, y.y); ow.y = pk2(y.z, y.w); o8[64 * k] = ow; } } }
                  else { f32x4* o = (f32x4*)(args.out + (size_t)m * DM) + lane;
#pragma unroll
                      for (int k = 0; k < 4; ++k) o[64 * k] = v[k] * rstd * gv[k]; } }
          } }
        if (j == 0 || !FINAL_DIRECT) xcd_barrier(bar);
        if (j == 1 && !FINAL_DIRECT && PH(18)) { PHASE_IDS; float* outp = args.out;
          f32x4 gv[4];
#pragma unroll
          for (int k = 0; k < 4; ++k) gv[k] = ((const f32x4*)args.in[22])[lane + 64 * k];
          for (int m = gw; m < NTOK; m += NGW) {
              const u32x2* hr = (const u32x2*)(H + (size_t)m * DM) + lane; f32x4 v[4]; float ss = 0.f;
#pragma unroll
              for (int k = 0; k < 4; ++k) { const u32x2 hw = hr[64 * k]; v[k] = (f32x4){bf_lo(hw.x), bf_hi(hw.x), bf_lo(hw.y), bf_hi(hw.y)}; ss += (v[k].x * v[k].x + v[k].y * v[k].y) + (v[k].z * v[k].z + v[k].w * v[k].w); }
              const float rstd = 1.0f / sqrtf(wave_sum(ss, lane) * (1.f / DM) + EPS);
              f32x4* o = (f32x4*)(outp + (size_t)m * DM) + lane;
#pragma unroll
              for (int k = 0; k < 4; ++k) o[64 * k] = v[k] * rstd * gv[k];
          } }
    }
}

__global__ void __launch_bounds__(NWAVES * 64, 2) fwd(Args args) {
    extern __shared__ __attribute__((aligned(16))) unsigned char lds_raw[];
    LAS unsigned char* lds = (LAS unsigned char*)lds_raw;
    const int G = gridDim.x, bx = blockIdx.x, vcu = (G % 8 == 0) ? (bx % 8) * (G / 8) + bx / 8 : bx;
    const int NGW = G * NWAVES;
    unsigned char* ws = args.ws;
    unsigned* ctl = (unsigned*)(ws + WS_CTL);
    const int wv0 = __builtin_amdgcn_readfirstlane((int)threadIdx.x >> 6);
    for (int u = opaque_tid(wv0); u < (LDS_BYTES - LDSCTL_OFF) / 4; u += NWAVES * 64) ((LAS unsigned*)(lds + LDSCTL_OFF))[u] = 0u;
    __syncthreads();
    volatile LAS unsigned* MISC = (volatile LAS unsigned*)(lds + MISC_OFF);
    XcdBarrier bar = xcd_barrier_post(ctl + 4096, MISC + 8, wv0);
    const float* x = args.in[0];
    bf16_t* XN = (bf16_t*)(ws + WS_ACT + A_XN);

    if (PH(0)) { PHASE_IDS;
        LAS float* scr = (LAS float*)(lds + wave * 16384);
        for (int j = 0; j < 2; ++j) {
            unsigned char* wb = ws + WS_W + (size_t)j * W_PAIR;
            if (FP8_DOWN) { transpose_matrix_f8<4>(args.in[2] + (size_t)j * DM * 576, DM, 576, wb + W_DQKV, 0, scr, gw, NGW, lane, W8_SCALE);
              for (int i = gw * 64 + lane; i < (DOWNP - 576) * DM / 16; i += NGW * 64) ((u32x4*)(wb + W_DQKV + (size_t)576 * DM))[i] = (u32x4){0u, 0u, 0u, 0u}; }
            else { transpose_matrix<4>(args.in[2] + (size_t)j * DM * 576, DM, 576, (bf16_t*)(wb + W_DQKV), 0, scr, gw, NGW, lane);
            for (int i = gw * 64 + lane; i < (DOWNP - 576) * DM / 8; i += NGW * 64) ((u32x4*)(wb + W_DQKV + (size_t)576 * DM * 2))[i] = (u32x4){0u, 0u, 0u, 0u}; }
            if (FP8_UP) {
            transpose_matrix_f8<3>(args.in[4] + (size_t)j * 256 * NQ, 256, NQ, wb + W_UQ, 0, scr, gw, NGW, lane, W8_SCALE, args.in[3] + j * 256);
            transpose_matrix_f8<0>(args.in[6] + (size_t)j * 256 * 1024, 256, 1024, wb + W_UKV, 0, scr, gw, NGW, lane, W8_SCALE, args.in[5] + j * 256);
            transpose_matrix_f8<0>(args.in[7] + (size_t)j * 256 * 1024, 256, 1024, wb + W_UKV, 1024, scr, gw, NGW, lane, W8_SCALE, args.in[5] + j * 256);
            } else {
            transpose_matrix<3>(args.in[4] + (size_t)j * 256 * NQ, 256, NQ, (bf16_t*)(wb + W_UQ), 0, scr, gw, NGW, lane, args.in[3] + j * 256);
            transpose_matrix<0>(args.in[6] + (size_t)j * 256 * 1024, 256, 1024, (bf16_t*)(wb + W_UKV), 0, scr, gw, NGW, lane, args.in[5] + j * 256);
            transpose_matrix<0>(args.in[7] + (size_t)j * 256 * 1024, 256, 1024, (bf16_t*)(wb + W_UKV), 1024, scr, gw, NGW, lane, args.in[5] + j * 256);
            }
            if (FP8_ATTO) transpose_matrix_f8<0>(args.in[8] + (size_t)j * DM * DM, DM, DM, wb + W_MO, 0, scr, gw, NGW, lane, W8_SCALE);
            else transpose_matrix<0>(args.in[8] + (size_t)j * DM * DM, DM, DM, (bf16_t*)(wb + W_MO), 0, scr, gw, NGW, lane);
            if ((FP8_S2 >> j) & 1) transpose_matrix_f8<0>(args.in[10] + (size_t)j * DM * SWA_NQKV, DM, SWA_NQKV, wb + W_SQKV, 0, scr, gw, NGW, lane, W8_SCALE, args.in[9] + j * DM);
            else transpose_matrix<0>(args.in[10] + (size_t)j * DM * SWA_NQKV, DM, SWA_NQKV, (bf16_t*)(wb + W_SQKV), 0, scr, gw, NGW, lane, args.in[9] + j * DM);
            if (FP8_ATTO) transpose_matrix_f8<0>(args.in[12] + (size_t)j * DM * DM, DM, DM, wb + W_SO, 0, scr, gw, NGW, lane, W8_SCALE);
            else transpose_matrix<0>(args.in[12] + (size_t)j * DM * DM, DM, DM, (bf16_t*)(wb + W_SO), 0, scr, gw, NGW, lane);
            if ((FP8_FFN >> j) & 1) {
            transpose_matrix_f8<1>(args.in[14] + (size_t)j * DM * FFN, DM, FFN, wb + W_FGU, 0, scr, gw, NGW, lane, W8_SCALE, args.in[13] + j * DM);
            transpose_matrix_f8<2>(args.in[15] + (size_t)j * DM * FFN, DM, FFN, wb + W_FGU, 0, scr, gw, NGW, lane, W8_SCALE, args.in[13] + j * DM);
            transpose_matrix_f8<0>(args.in[16] + (size_t)j * FFN * DM, FFN, DM, wb + W_FD, 0, scr, gw, NGW, lane, W8_SCALE);
            } else {
            transpose_matrix<1>(args.in[14] + (size_t)j * DM * FFN, DM, FFN, (bf16_t*)(wb + W_FGU), 0, scr, gw, NGW, lane, args.in[13] + j * DM);
            transpose_matrix<2>(args.in[15] + (size_t)j * DM * FFN, DM, FFN, (bf16_t*)(wb + W_FGU), 0, scr, gw, NGW, lane, args.in[13] + j * DM);
            transpose_matrix<0>(args.in[16] + (size_t)j * FFN * DM, FFN, DM, (bf16_t*)(wb + W_FD), 0, scr, gw, NGW, lane);
            }
            for (int e = 0; e < NE; ++e) {
                if ((FP8_MOE >> j) & 1) {
                    transpose_matrix_f8<1>(args.in[19] + ((size_t)j * NE + e) * DM * ED, DM, ED, wb + W_MGU, e * 2 * ED, scr, gw, NGW, lane, W8_SCALE);
                    transpose_matrix_f8<2>(args.in[20] + ((size_t)j * NE + e) * DM * ED, DM, ED, wb + W_MGU, e * 2 * ED, scr, gw, NGW, lane, W8_SCALE);
                    transpose_matrix_f8<0>(args.in[21] + ((size_t)j * NE + e) * ED * DM, ED, DM, wb + W_MD, e * DM, scr, gw, NGW, lane, W8_SCALE);
                } else {
                transpose_matrix<1>(args.in[19] + ((size_t)j * NE + e) * DM * ED, DM, ED, (bf16_t*)(wb + W_MGU), e * 2 * ED, scr, gw, NGW, lane);
                transpose_matrix<2>(args.in[20] + ((size_t)j * NE + e) * DM * ED, DM, ED, (bf16_t*)(wb + W_MGU), e * 2 * ED, scr, gw, NGW, lane);
                transpose_matrix<0>(args.in[21] + ((size_t)j * NE + e) * ED * DM, ED, DM, (bf16_t*)(wb + W_MD), e * DM, scr, gw, NGW, lane);
                }
            }
        }
        f32x4 gv[4];
#pragma unroll
        for (int j = 0; j < 4; ++j) gv[j] = ((const f32x4*)args.in[1])[lane + 64 * j];
        for (int m = gw; m < NTOK; m += NGW) rms_row_to_bf16<FP8_DOWN != 0>(x + (size_t)m * DM, gv, FP8_DOWN ? (bf16_t*)((unsigned char*)XN + (size_t)m * DM) : XN + (size_t)m * DM, lane);
    }
    xcd_barrier(bar);

    pair_body<0>(args, lds, bar, G, bx, vcu);
    pair_body<1>(args, lds, bar, G, bx, vcu);
}

extern "C" void kernel_launch(void* const* d_in, const int* in_sizes, int n_in, void* d_out, int out_size, void* d_ws, size_t ws_size, hipStream_t stream) {
    static int grid = 0;
    if (grid == 0) {
        if (n_in != 23 || out_size != NTOK * DM || ws_size < WS_NEED) { fprintf(stderr, "kernel_launch: shape/workspace mismatch (n_in %d out %d ws %zu need %zu)\n", n_in, out_size, ws_size, (size_t)WS_NEED); grid = -1; return; }
        int dev = 0, cus = 0;
        if (hipGetDevice(&dev) != hipSuccess || hipDeviceGetAttribute(&cus, hipDeviceAttributeMultiprocessorCount, dev) != hipSuccess) { grid = -1; return; }
        if (hipFuncSetAttribute((const void*)fwd, hipFuncAttributeMaxDynamicSharedMemorySize, LDS_BYTES) != hipSuccess) { fprintf(stderr, "kernel_launch: hipFuncSetAttribute failed\n"); grid = -1; return; }
        int per_cu = 0;
        if (hipOccupancyMaxActiveBlocksPerMultiprocessor(&per_cu, (const void*)fwd, NWAVES * 64, LDS_BYTES) != hipSuccess || per_cu < 1) fprintf(stderr, "kernel_launch: occupancy query reports %d\n", per_cu);
        (void)hipGetLastError();
        grid = cus;
    }
    if (grid < 0) return;
    if (hipMemsetAsync((char*)d_ws + WS_CTL, 0, CTL_ZERO_BYTES, stream) != hipSuccess) return;
    Args a{};
    for (int i = 0; i < 23; ++i) a.in[i] = (const float*)d_in[i];
    a.out = (float*)d_out; a.ws = (unsigned char*)d_ws;
    hipLaunchKernelGGL(fwd, dim3(grid), dim3(NWAVES * 64), LDS_BYTES, stream, a);
    const hipError_t le = hipPeekAtLastError();
    if (le != hipSuccess) fprintf(stderr, "kernel_launch: launch failed: %s\n", hipGetErrorName(le));
}
```
